# Optimizing an MI355X kernel written in HIP

```python
import jax, jax.numpy as jnp
from jax import lax
import numpy as np

D_MODEL = 1024
BATCH = 16
SEQ = 2048
DEPTH = 4

HEAD_DIM = 64
ATT_WIDTH = D_MODEL // 2
ML_WIDTH = D_MODEL // 4
GM_WIDTH = D_MODEL // 4
MIX_WIDTH = ATT_WIDTH + ML_WIDTH + GM_WIDTH
N_ATT_HEADS = ATT_WIDTH // HEAD_DIM
N_KV_HEADS = max(1, N_ATT_HEADS // 4)
KV_WIDTH = N_KV_HEADS * HEAD_DIM
N_ML_HEADS = ML_WIDTH // HEAD_DIM
N_GM_GROUPS = GM_WIDTH // HEAD_DIM
WINDOW = 128
ATT_BLOCK = 128
N_REL_BUCKETS = 32
REL_MAX_DIST = 128
ML_CHUNK = 128
ML_CONV = 3
N_ML_GATES = 4 * N_ML_HEADS
GM_CHUNK = 128
N_EXPERTS = 16
EC_CAPACITY_FACTOR = 2
D_EXPERT = 2 * D_MODEL
DN_ALPHA = (2 * DEPTH) ** 0.25
DN_BETA = (8 * DEPTH) ** -0.25
LN_EPS = 1e-5
NEG_INF = -1e30
PROJ_SPLITS = (ATT_WIDTH, KV_WIDTH, KV_WIDTH, ML_WIDTH, ML_WIDTH, ML_WIDTH, ML_WIDTH, N_ML_GATES, GM_WIDTH, GM_WIDTH)
PROJ_WIDTH = ATT_WIDTH + 2 * KV_WIDTH + 4 * ML_WIDTH + N_ML_GATES + 2 * GM_WIDTH

kernel_name = "hybrid_parallel_groups_ec_moe_encoder"


def layer_norm(x, g=None, b=None):
    xf = x.astype(jnp.float32)
    mu = xf.mean(-1, keepdims=True)
    var = jnp.mean(jnp.square(xf - mu), -1, keepdims=True)
    y = (xf - mu) * lax.rsqrt(var + LN_EPS)
    if g is not None:
        y = y * g.astype(jnp.float32) + b.astype(jnp.float32)
    return y.astype(x.dtype)


def t5_buckets(rel):
    nb = N_REL_BUCKETS // 2
    max_exact = nb // 2
    ret = np.where(rel > 0, nb, 0)
    n = np.abs(rel)
    large = max_exact + (np.log(np.maximum(n, 1) / max_exact) / np.log(REL_MAX_DIST / max_exact) * (nb - max_exact)).astype(np.int32)
    large = np.minimum(large, nb - 1)
    return (ret + np.where(n < max_exact, n, large)).astype(np.int32)


def windowed_gqa(q, k, v, sink, rel_bias):
    B, S, Hq, dh = q.shape
    Hkv = k.shape[2]
    G = Hq // Hkv
    nb = S // ATT_BLOCK
    band = 3 * ATT_BLOCK

    def to_band(t):
        tp = jnp.pad(t, ((0, 0), (ATT_BLOCK, ATT_BLOCK), (0, 0), (0, 0)))
        blocks = tp.reshape(B, nb + 2, ATT_BLOCK, Hkv, dh)
        return jnp.concatenate([blocks[:, :-2], blocks[:, 1:-1], blocks[:, 2:]], axis=2)

    kb, vb = to_band(k), to_band(v)
    qb = q.reshape(B, nb, ATT_BLOCK, Hkv, G, dh)
    logits = jnp.einsum('bnqhgd,bnshd->bhgnqs', qb, kb, preferred_element_type=jnp.float32) * (dh ** -0.5)
    qi = np.arange(ATT_BLOCK)[:, None]
    sj = np.arange(band)[None, :]
    rel = sj - ATT_BLOCK - qi
    bias = rel_bias[t5_buckets(rel)].astype(jnp.float32)
    bias = bias.transpose(2, 0, 1).reshape(Hkv, G, 1, ATT_BLOCK, band)
    kpos = np.arange(nb)[:, None] * ATT_BLOCK - ATT_BLOCK + sj
    mask = (np.abs(rel) <= WINDOW)[None] & ((kpos >= 0) & (kpos < S))[:, None, :]
    logits = jnp.where(mask, logits + bias, NEG_INF)
    sink_col = jnp.broadcast_to(sink.astype(jnp.float32).reshape(Hkv, G, 1, 1, 1), logits.shape[:-1] + (1,))
    probs = jax.nn.softmax(jnp.concatenate([logits, sink_col], axis=-1), axis=-1)[..., :-1]
    out = jnp.einsum('bhgnqs,bnshd->bnqhgd', probs.astype(vb.dtype), vb)
    return out.reshape(B, S, Hq * dh)


def short_conv(t, w, b):
    C = t.shape[-1]
    y = lax.conv_general_dilated(t, w[:, None, :], window_strides=(1,), padding=[(ML_CONV // 2, ML_CONV // 2)],
                                 dimension_numbers=('NWC', 'WIO', 'NWC'), feature_group_count=C)
    return y + b


def mlstm_direction(q, k, v, ig, lf):
    B, H, S, dh = q.shape
    nc = S // ML_CHUNK

    def chunks(t):
        return jnp.moveaxis(t.reshape((B, H, nc, ML_CHUNK) + t.shape[3:]), 2, 0)

    tril = jnp.tril(jnp.ones((ML_CHUNK, ML_CHUNK), dtype=bool))

    def step(carry, inp):
        C, n, m = carry
        qc, kc, vc, ic, fc = inp
        b = jnp.cumsum(fc, axis=-1)
        dmat = jnp.where(tril, b[..., :, None] - b[..., None, :] + ic[..., None, :], -jnp.inf)
        inter = b + m[..., None]
        m_t = jnp.maximum(inter, dmat.max(-1))
        s = jnp.einsum('bhtd,bhsd->bhts', qc, kc) * jnp.exp(dmat - m_t[..., None])
        iw = jnp.exp(inter - m_t)
        num = jnp.einsum('bhts,bhsd->bhtd', s, vc) + iw[..., None] * jnp.einsum('bhed,bhtd->bhte', C, qc)
        den = s.sum(-1) + iw * jnp.einsum('bhd,bhtd->bht', n, qc)
        h = num / jnp.maximum(jnp.abs(den), jnp.exp(-m_t))[..., None]
        bL = b[..., -1]
        ws = bL[..., None] - b + ic
        m_new = jnp.maximum(bL + m, ws.max(-1))
        wexp = jnp.exp(ws - m_new[..., None])
        decay = jnp.exp(bL + m - m_new)
        C_new = decay[..., None, None] * C + jnp.einsum('bhs,bhse,bhsd->bhed', wexp, vc, kc)
        n_new = decay[..., None] * n + jnp.einsum('bhs,bhsd->bhd', wexp, kc)
        return (C_new, n_new, m_new), h

    init = (jnp.zeros((B, H, dh, dh), jnp.float32), jnp.zeros((B, H, dh), jnp.float32), jnp.zeros((B, H), jnp.float32))
    _, h = lax.scan(step, init, (chunks(q), chunks(k), chunks(v), chunks(ig), chunks(lf)))
    return jnp.moveaxis(h, 0, 2).reshape(B, H, S, dh)


def mlstm_bidir(mq, mk, mv, mo, gates):
    B, S, _ = mq.shape
    H = N_ML_HEADS

    def heads(t):
        return t.astype(jnp.float32).reshape(B, S, H, HEAD_DIM).transpose(0, 2, 1, 3)

    q, k, v = heads(mq), heads(mk) * (HEAD_DIM ** -0.5), heads(mv)
    g = gates.astype(jnp.float32).reshape(B, S, 4, H).transpose(2, 0, 3, 1)
    flip = lambda t: jnp.flip(t, axis=2)
    h_f = mlstm_direction(q, k, v, g[0], jax.nn.log_sigmoid(g[1]))
    h_b = flip(mlstm_direction(flip(q), flip(k), flip(v), flip(g[2]), flip(jax.nn.log_sigmoid(g[3]))))
    h = (h_f + h_b).transpose(0, 2, 1, 3).reshape(B, S, ML_WIDTH)
    return jax.nn.sigmoid(mo) * h.astype(mo.dtype)


def spatial_gating(u, v, w_s, b_s):
    B, S, _ = u.shape
    u = jax.nn.gelu(u, approximate=False)
    v = layer_norm(jax.nn.gelu(v, approximate=False))
    nc = S // GM_CHUNK
    vb = v.reshape(B, nc, GM_CHUNK, N_GM_GROUPS, HEAD_DIM)
    s = jnp.einsum('gts,bnsgc->bntgc', w_s, vb) + b_s.T[:, :, None]
    return u * s.reshape(B, S, GM_WIDTH)


def expert_choice_ffn(h, w_router, w_gate, w_up, w_down):
    B, S, D = h.shape
    cap = max(1, min(S, EC_CAPACITY_FACTOR * S // N_EXPERTS))
    aff = jax.nn.softmax(jnp.einsum('bsd,de->bse', h, w_router, preferred_element_type=jnp.float32), axis=-1)
    gate, idx = lax.top_k(aff.transpose(0, 2, 1), cap)
    xg = jax.vmap(lambda hb, ib: hb[ib])(h, idx)
    hid = jax.nn.silu(jnp.einsum('becd,edf->becf', xg, w_gate)) * jnp.einsum('becd,edf->becf', xg, w_up)
    ye = jnp.einsum('becf,efd->becd', hid, w_down) * gate.astype(h.dtype)[..., None]
    scatter = lambda yb, ib: jnp.zeros((S, D), yb.dtype).at[ib.reshape(-1)].add(yb.reshape(-1, D))
    return jax.vmap(scatter)(ye, idx)


def hybrid_layer(x, c, w_ada, b_ada, w_in, conv_w, conv_b, gate_b, sink, rel_bias, w_s, b_s, w_out,
                 w_router, w_gate, w_up, w_down, ln_g, ln_b):
    B, S, D = x.shape
    mod = jax.nn.silu(c) @ w_ada + b_ada
    sh1, sc1, g1, sh2, sc2, g2 = [m[:, None, :] for m in jnp.split(mod, 6, axis=-1)]
    h = layer_norm(x) * (1 + sc1) + sh1
    proj = h @ w_in
    aq, ak, av, mq, mk, mv, mo, mg, gu, gv = jnp.split(proj, np.cumsum(PROJ_SPLITS)[:-1].tolist(), axis=-1)
    att = windowed_gqa(aq.reshape(B, S, N_ATT_HEADS, HEAD_DIM), ak.reshape(B, S, N_KV_HEADS, HEAD_DIM),
                       av.reshape(B, S, N_KV_HEADS, HEAD_DIM), sink, rel_bias)
    mqk = jax.nn.silu(short_conv(jnp.concatenate([mq, mk], axis=-1), conv_w, conv_b))
    mq, mk = jnp.split(mqk, 2, axis=-1)
    ml = mlstm_bidir(mq, mk, mv, mo, mg + gate_b)
    gm = spatial_gating(gu, gv, w_s, b_s)
    mix = jnp.concatenate([att, ml, gm], axis=-1) @ w_out
    x = layer_norm(DN_ALPHA * x + (1 + g1) * mix, ln_g[0], ln_b[0])
    h2 = layer_norm(x) * (1 + sc2) + sh2
    y = expert_choice_ffn(h2, w_router, w_gate, w_up, w_down)
    return layer_norm(DN_ALPHA * x + (1 + g2) * y, ln_g[1], ln_b[1])


def setup_inputs(seed: int = 0) -> dict:
    key = jax.random.key(seed)
    ks = jax.random.split(key, 20)
    nrm = lambda k, shape, scale: jax.random.normal(k, shape, jnp.float32) * scale
    D = D_MODEL
    lin = jnp.linspace(3.0, 6.0, N_ML_HEADS, dtype=jnp.float32)
    zer = jnp.zeros((N_ML_HEADS,), jnp.float32)
    gate_base = jnp.concatenate([zer, lin, zer, lin])
    return {
        'x': nrm(ks[0], (BATCH, SEQ, D), 1.0),
        'c': nrm(ks[1], (BATCH, D), 1.0),
        'w_ada': nrm(ks[2], (DEPTH, D, 6 * D), 0.2 * D ** -0.5),
        'b_ada': nrm(ks[3], (DEPTH, 6 * D), 0.02),
        'w_in': nrm(ks[4], (DEPTH, D, PROJ_WIDTH), D ** -0.5),
        'conv_w': nrm(ks[5], (DEPTH, ML_CONV, 2 * ML_WIDTH), ML_CONV ** -0.5),
        'conv_b': nrm(ks[6], (DEPTH, 2 * ML_WIDTH), 0.02),
        'gate_b': gate_base + nrm(ks[7], (DEPTH, N_ML_GATES), 0.1),
        'sink': nrm(ks[8], (DEPTH, N_ATT_HEADS), 0.5),
        'rel_bias': nrm(ks[9], (N_REL_BUCKETS, N_ATT_HEADS), 0.1),
        'w_s': nrm(ks[10], (DEPTH, N_GM_GROUPS, GM_CHUNK, GM_CHUNK), GM_CHUNK ** -0.5),
        'b_s': 1.0 + nrm(ks[11], (DEPTH, N_GM_GROUPS, GM_CHUNK), 0.02),
        'w_out': nrm(ks[12], (DEPTH, MIX_WIDTH, D), DN_BETA * MIX_WIDTH ** -0.5),
        'w_router': nrm(ks[13], (DEPTH, D, N_EXPERTS), D ** -0.5),
        'w_gate': nrm(ks[14], (DEPTH, N_EXPERTS, D, D_EXPERT), D ** -0.5),
        'w_up': nrm(ks[15], (DEPTH, N_EXPERTS, D, D_EXPERT), D ** -0.5),
        'w_down': nrm(ks[16], (DEPTH, N_EXPERTS, D_EXPERT, D), DN_BETA * D_EXPERT ** -0.5),
        'ln_g': 1.0 + nrm(ks[17], (DEPTH, 2, D), 0.02),
        'ln_b': nrm(ks[18], (DEPTH, 2, D), 0.02),
    }


def reference(x, c, w_ada, b_ada, w_in, conv_w, conv_b, gate_b, sink, rel_bias, w_s, b_s, w_out,
              w_router, w_gate, w_up, w_down, ln_g, ln_b):
    for l in range(DEPTH):
        x = hybrid_layer(x, c, w_ada[l], b_ada[l], w_in[l], conv_w[l], conv_b[l], gate_b[l], sink[l], rel_bias,
                         w_s[l], b_s[l], w_out[l], w_router[l], w_gate[l], w_up[l], w_down[l], ln_g[l], ln_b[l])
    return x
```

```cpp
#include <hip/hip_runtime.h>
#include <cstdio>
#include <cstdint>
__device__ __forceinline__ int opaque_tid() { int t = threadIdx.x; asm volatile("" : "+v"(t)); return t; }
namespace pg8 {
#define PG8_LAS __attribute__((address_space(3)))
typedef unsigned short bf16_t;
typedef short bf16x8 __attribute__((ext_vector_type(8)));
typedef float f32x4 __attribute__((ext_vector_type(4)));
typedef unsigned u32x4 __attribute__((ext_vector_type(4)));
constexpr int BM = 256, BK = 64, HALF = 128, HTB = HALF * BK * 2  , STAGE_BYTES = 8 * HTB, NXCD = 8, WGM = 8;

__host__ __device__ __forceinline__ int lds_byte(int r, int c) { const int st = (r >> 4) * 2 + (c >> 5), rr = r & 15, cc = c & 31, ob = rr * 64 + cc * 2; return st * 1024 + (ob ^ (((ob >> 9) & 1) << 5)); }
__host__ __device__ __forceinline__ void stage_rc(int b, int& R, int& C) { const int st = b / 1024, sb = b % 1024, swz = sb ^ (((sb >> 9) & 1) << 5); R = (st >> 1) * 16 + swz / 64; C = (st & 1) * 32 + (swz % 64) / 2; }
__host__ __device__ __forceinline__ int perm32(int rho) { const int n = rho >> 4, i = rho & 15; return 8 * (i >> 2) + 4 * n + (i & 3); }

struct Unit { int pm, pn; };
struct Gemm { const bf16_t* A; const bf16_t* Bt; int M, N, K; int sa, sb; };
typedef int v4i_t __attribute__((ext_vector_type(4)));
typedef int v8i_t __attribute__((ext_vector_type(8)));
__device__ __forceinline__ v8i_t cat32(bf16x8 lo, bf16x8 hi) { const v4i_t a = __builtin_bit_cast(v4i_t, lo), b = __builtin_bit_cast(v4i_t, hi); return __builtin_shufflevector(a, b, 0, 1, 2, 3, 4, 5, 6, 7); }

struct StaticOrder {
    int nM, nN, nwg, G, c;
    __host__ __device__ void init(int M, int N, int G_, int c_) { nM = M / BM; nN = N / BM; nwg = nM * nN; G = G_; c = c_; }
    __host__ __device__ bool next(int i, Unit& u) const {
        const long L = (long)i * G + c; if (L >= nwg) return false;
        int wgid = (int)L; { const int q = nwg / NXCD, r = nwg % NXCD, xcd = wgid % NXCD, off = wgid / NXCD; wgid = (xcd < r ? xcd * (q + 1) : r * (q + 1) + (xcd - r) * q) + off; }
        const int nig = WGM * nN, gid = wgid / nig, fm = gid * WGM, gsz = (nM - fm) < WGM ? (nM - fm) : WGM;
        u.pm = fm + ((wgid % nig) % gsz); u.pn = (wgid % nig) / gsz; return true;
    }
    __device__ __forceinline__ void a_ready(const Unit&) const {}
    __device__ __forceinline__ void done(const Unit&) const {}
    __device__ __forceinline__ unsigned a_rowoff_unused() const { return 0u; }
};

typedef float f32x2p __attribute__((ext_vector_type(2))); typedef __bf16 bf16x2p __attribute__((ext_vector_type(2)));
__device__ __forceinline__ unsigned cvt_pk_bf16(float lo, float hi) { const f32x2p v = {lo, hi}; return __builtin_bit_cast(unsigned, __builtin_convertvector(v, bf16x2p)); }
__device__ __forceinline__ float silu_f(float x) { return x * __builtin_amdgcn_rcpf(1.0f + __builtin_amdgcn_exp2f(x * -1.4426950408889634f)); }

struct EpiBf16 {
    static constexpr bool PERM = true, AFTER_DRAIN = false;
    bf16_t* O; int ldc;
    __device__ __forceinline__ void operator()(const f32x4 (&acc)[2][2][4][2], const Unit& u, int wr, int wc, int fr, int fq) const {
        const int row0 = u.pm * BM + wr * 64 + fr, col0 = u.pn * BM + wc * 32 + 8 * fq;
#pragma unroll
        for (int ai = 0; ai < 2; ++ai)
#pragma unroll
            for (int m = 0; m < 4; ++m) { bf16_t* rowp = O + (size_t)(row0 + ai * HALF + m * 16) * ldc + col0;
#pragma unroll
                for (int bj = 0; bj < 2; ++bj) { const f32x4 v0 = acc[ai][bj][m][0], v1 = acc[ai][bj][m][1];
                    u32x4 w; w.x = cvt_pk_bf16(v0[0], v0[1]); w.y = cvt_pk_bf16(v0[2], v0[3]); w.z = cvt_pk_bf16(v1[0], v1[1]); w.w = cvt_pk_bf16(v1[2], v1[3]);
                    *(u32x4*)(rowp + bj * HALF) = w; } }
    }
};
struct EpiProj {
    static constexpr bool PERM = true, AFTER_DRAIN = false;
    bf16_t* O; float* gates; const float* gate_b;
    __device__ __forceinline__ void operator()(const f32x4 (&acc)[2][2][4][2], const Unit& u, int wr, int wc, int fr, int fq) const {
        const int row0 = u.pm * BM + wr * 64 + fr;
        if (u.pn < 9) { const int col0 = u.pn * BM + wc * 32 + 8 * fq;
#pragma unroll
            for (int ai = 0; ai < 2; ++ai)
#pragma unroll
                for (int m = 0; m < 4; ++m) { bf16_t* rowp = O + (size_t)(row0 + ai * HALF + m * 16) * 2304 + col0;
#pragma unroll
                    for (int bj = 0; bj < 2; ++bj) { const f32x4 v0 = acc[ai][bj][m][0], v1 = acc[ai][bj][m][1];
                        u32x4 w; w.x = cvt_pk_bf16(v0[0], v0[1]); w.y = cvt_pk_bf16(v0[2], v0[3]); w.z = cvt_pk_bf16(v1[0], v1[1]); w.w = cvt_pk_bf16(v1[2], v1[3]);
                        *(u32x4*)(rowp + bj * HALF) = w; } }
        } else if (wc == 0 && fq < 2) { const f32x4 g0 = *(const f32x4*)(gate_b + 8 * fq), g1 = *(const f32x4*)(gate_b + 8 * fq + 4);
#pragma unroll
            for (int ai = 0; ai < 2; ++ai)
#pragma unroll
                for (int m = 0; m < 4; ++m) { float* gp = gates + (size_t)(row0 + ai * HALF + m * 16) * 16 + 8 * fq;
                    *(f32x4*)gp = acc[ai][0][m][0] + g0; *(f32x4*)(gp + 4) = acc[ai][0][m][1] + g1; } }
    }
};
struct EpiSwiGLU {
    static constexpr bool PERM = true, AFTER_DRAIN = false;
    bf16_t* H;
    __device__ __forceinline__ void operator()(const f32x4 (&acc)[2][2][4][2], const Unit& u, int wr, int wc, int fr, int fq) const {
        const int row0 = u.pm * BM + wr * 64 + fr, col0 = (u.pn & 15) * 128 + wc * 32 + 8 * fq;
#pragma unroll
        for (int ai = 0; ai < 2; ++ai)
#pragma unroll
            for (int m = 0; m < 4; ++m) { bf16_t* rowp = H + (size_t)(row0 + ai * HALF + m * 16) * 2048 + col0;
                const f32x4 g0 = acc[ai][0][m][0], g1 = acc[ai][0][m][1], u0 = acc[ai][1][m][0], u1 = acc[ai][1][m][1];
                u32x4 w; w.x = cvt_pk_bf16(silu_f(g0[0]) * u0[0], silu_f(g0[1]) * u0[1]); w.y = cvt_pk_bf16(silu_f(g0[2]) * u0[2], silu_f(g0[3]) * u0[3]);
                w.z = cvt_pk_bf16(silu_f(g1[0]) * u1[0], silu_f(g1[1]) * u1[1]); w.w = cvt_pk_bf16(silu_f(g1[2]) * u1[2], silu_f(g1[3]) * u1[3]);
                *(u32x4*)rowp = w; }
    }
};
__device__ __forceinline__ unsigned pk4_fp8(float a, float b, float c, float d) {
    a = __builtin_amdgcn_fmed3f(a, -448.f, 448.f); b = __builtin_amdgcn_fmed3f(b, -448.f, 448.f); c = __builtin_amdgcn_fmed3f(c, -448.f, 448.f); d = __builtin_amdgcn_fmed3f(d, -448.f, 448.f);
    int w = 0; w = __builtin_amdgcn_cvt_pk_fp8_f32(a, b, w, false); w = __builtin_amdgcn_cvt_pk_fp8_f32(c, d, w, true); return (unsigned)w; }
constexpr float HID_SCALE = 4.0f;
typedef unsigned u32x2e __attribute__((ext_vector_type(2)));
struct EpiSwiGLU8 {
    static constexpr bool PERM = true, AFTER_DRAIN = false;
    unsigned char* H;
    __device__ __forceinline__ void operator()(const f32x4 (&acc)[2][2][4][2], const Unit& u, int wr, int wc, int fr, int fq) const {
        const int row0 = u.pm * BM + wr * 64 + fr, col0 = (u.pn & 15) * 128 + wc * 32 + 8 * fq;
#pragma unroll
        for (int ai = 0; ai < 2; ++ai)
#pragma unroll
            for (int m = 0; m < 4; ++m) { unsigned char* rowp = H + (size_t)(row0 + ai * HALF + m * 16) * 2048 + col0;
                const f32x4 g0 = acc[ai][0][m][0], g1 = acc[ai][0][m][1], u0 = acc[ai][1][m][0], u1 = acc[ai][1][m][1];
                u32x2e w; w.x = pk4_fp8(silu_f(g0[0]) * u0[0] * HID_SCALE, silu_f(g0[1]) * u0[1] * HID_SCALE, silu_f(g0[2]) * u0[2] * HID_SCALE, silu_f(g0[3]) * u0[3] * HID_SCALE);
                w.y = pk4_fp8(silu_f(g1[0]) * u1[0] * HID_SCALE, silu_f(g1[1]) * u1[1] * HID_SCALE, silu_f(g1[2]) * u1[2] * HID_SCALE, silu_f(g1[3]) * u1[3] * HID_SCALE);
                *(u32x2e*)rowp = w; }
    }
};
struct EpiScaleBf16 {
    static constexpr bool PERM = true, AFTER_DRAIN = false;
    bf16_t* Y; const float* gate;
    __device__ __forceinline__ void operator()(const f32x4 (&acc)[2][2][4][2], const Unit& u, int wr, int wc, int fr, int fq) const {
        const int row0 = u.pm * BM + wr * 64 + fr, col0 = (u.pn & 3) * BM + wc * 32 + 8 * fq;
#pragma unroll
        for (int ai = 0; ai < 2; ++ai)
#pragma unroll
            for (int m = 0; m < 4; ++m) { const int r = row0 + ai * HALF + m * 16; const float gv = gate[r]; bf16_t* rowp = Y + (size_t)r * 1024 + col0;
#pragma unroll
                for (int bj = 0; bj < 2; ++bj) { const f32x4 v0 = acc[ai][bj][m][0] * gv, v1 = acc[ai][bj][m][1] * gv;
                    u32x4 w; w.x = cvt_pk_bf16(v0[0], v0[1]); w.y = cvt_pk_bf16(v0[2], v0[3]); w.z = cvt_pk_bf16(v1[0], v1[1]); w.w = cvt_pk_bf16(v1[2], v1[3]);
                    *(u32x4*)(rowp + bj * HALF) = w; } }
    }
};
struct MoeOrder1 {
    int G, c; const unsigned short* idx;
    __device__ __forceinline__ int a_rowtok(const Unit& u, int r) const { return idx[((u.pm * 2 + (r >> 7)) * 64 + (r & 63)) * 2 + ((r >> 6) & 1)]; }
    __device__ __forceinline__ unsigned a_rowoff(const Unit& u, int r) const { return (unsigned)(((u.pm & 15) * 2048 + a_rowtok(u, r)) * 1024); }
    __device__ __forceinline__ unsigned a_rowpair(const Unit& u, int hh, int r0) const { return *(const unsigned*)(idx + ((u.pm * 2 + hh) * 64 + r0) * 2); }
    __device__ __forceinline__ unsigned a_rowoff_tok(const Unit& u, int tok) const { return (unsigned)(((u.pm & 15) * 2048 + tok) * 1024); }
    __device__ __forceinline__ bool next(int i, Unit& u) const {
        const long L = (long)i * G + c; if (L >= 4096) return false;
        const int e = (int)(L >> 8), rem = (int)(L & 255), x = rem & 7, v = rem >> 3;
        const int b = 4 * (x >> 1) + (v >> 3), j = 8 * (x & 1) + (v & 7);
        u.pm = e * 16 + b; u.pn = e * 16 + j; return true;
    }
    __device__ __forceinline__ void a_ready(const Unit&) const {}
    __device__ __forceinline__ void done(const Unit&) const {}
    __device__ __forceinline__ unsigned a_rowoff_unused() const { return 0u; }
};
struct MoeOrder2 {
    int G, c;
    __device__ __forceinline__ bool next(int i, Unit& u) const {
        const long L = (long)i * G + c; if (L >= 1024) return false;
        const int rnd = (int)(L >> 8), rem = (int)(L & 255), x = rem & 7, v = rem >> 3;
        const int e = rnd * 4 + (x >> 1), b = 8 * (x & 1) + (v >> 2), j = v & 3;
        u.pm = e * 16 + b; u.pn = e * 4 + j; return true;
    }
    __device__ __forceinline__ void a_ready(const Unit&) const {}
    __device__ __forceinline__ void done(const Unit&) const {}
    __device__ __forceinline__ unsigned a_rowoff_unused() const { return 0u; }
};

template <class Epi, class Sched, bool ALIGN_EPI = false, bool SP2 = false, bool F8 = false, bool GATH = false>
__device__ __forceinline__ void gemm_phase(PG8_LAS unsigned char* lds, const Gemm g, const Sched& S, const Epi& E) {
    const int tid = opaque_tid(), wid = __builtin_amdgcn_readfirstlane(tid >> 6), lane = tid & 63, wr = wid >> 2, wc = wid & 3, fr = lane & 15, fq = lane >> 4;
    const int K = g.K, RB = F8 ? K : 2 * K, nt = RB / 128;
    unsigned voffA[2], voffB[2];
#pragma unroll
    for (int i = 0; i < 2; ++i) { int R, C; stage_rc(tid * 16 + i * 8192, R, C); const int Rb = Epi::PERM ? ((R & ~31) + perm32(R & 31)) : R;
        voffA[i] = (unsigned)(R * RB + C * 2); voffB[i] = (unsigned)(Rb * RB + C * 2); }
    const __amdgpu_buffer_rsrc_t rsA = __builtin_amdgcn_make_buffer_rsrc((void*)g.A, 0, 0x7fffffff, 0x00020000), rsB = __builtin_amdgcn_make_buffer_rsrc((void*)g.Bt, 0, 0x7fffffff, 0x00020000);
    const size_t kstep = (size_t)(BK * 2);
    const size_t hstep = (size_t)HALF * RB;
    const size_t tstep = 2 * hstep;
    const unsigned ldsw = (unsigned)wid * 1024u;
    const int aoff = lds_byte(wr * 64 + fr, fq * 8), boff = lds_byte(wc * 32 + fr, fq * 8);
#define PG8_SA(b, h) (((b) * 2 + (h)) * HTB)
#define PG8_SB(b, h) ((4 + (b) * 2 + (h)) * HTB)
#define PG8_STAGE(bufoff, gbase, voff, rs, base) do { if constexpr (F8) { const int so_ = __builtin_amdgcn_readfirstlane((int)((const char*)(gbase) - (const char*)(base))); _Pragma("unroll") for (int _i = 0; _i < 2; ++_i) \
        __builtin_amdgcn_raw_ptr_buffer_load_lds(rs, (PG8_LAS void*)(lds + (bufoff) + ldsw + _i * 8192), 16, (int)(voff)[_i], so_, 0, 0); } \
        else { _Pragma("unroll") for (int _i = 0; _i < 2; ++_i) \
        __builtin_amdgcn_global_load_lds((const unsigned*)((const char*)(gbase) + (voff)[_i]), (PG8_LAS unsigned*)(lds + (bufoff) + ldsw + _i * 8192), 16, 0, 0); } } while (0)
#define PG8_STAGEA(bufoff, gptr, half, usenext) do { if constexpr (GATH) { const int so_ = __builtin_amdgcn_readfirstlane((int)((const char*)(gptr) - (const char*)g.A)); _Pragma("unroll") for (int _i = 0; _i < 2; ++_i) \
        __builtin_amdgcn_raw_ptr_buffer_load_lds(rsA, (PG8_LAS void*)(lds + (bufoff) + ldsw + _i * 8192), 16, (int)vAc[half][_i], so_, 0, 0); } \
        else { PG8_STAGE(bufoff, (gptr) + (half) * hstep, voffA, rsA, g.A); } } while (0)
#define PG8_GSWITCH do { if constexpr (GATH) { if (un) {   \
        asm volatile("" : "+v"(tpk[0]), "+v"(tpk[1]));     \
        _Pragma("unroll") for (int hh = 0; hh < 2; ++hh) _Pragma("unroll") for (int i = 0; i < 2; ++i) { int R, C; stage_rc(opaque_tid() * 16 + i * 8192, R, C); vAc[hh][i] = S.a_rowoff_tok(nxt, (int)((tpk[hh] >> (16 * i)) & 0xffffu)) + (unsigned)(C * 2); } } } } while (0)
#define PG8_LDA(dst, b, h) do { if constexpr (F8) { _Pragma("unroll") for (int m = 0; m < 4; ++m) dst##8[m] = cat32(*(const PG8_LAS bf16x8*)(lds + PG8_SA(b, h) + aoff + m * 2048), *(const PG8_LAS bf16x8*)(lds + PG8_SA(b, h) + aoff + m * 2048 + 1024)); } \
        else { _Pragma("unroll") for (int m = 0; m < 4; ++m) _Pragma("unroll") for (int k = 0; k < 2; ++k) dst[m][k] = *(const PG8_LAS bf16x8*)(lds + PG8_SA(b, h) + aoff + m * 2048 + k * 1024); } } while (0)
#define PG8_LDB(dst, b, h) do { if constexpr (F8) { _Pragma("unroll") for (int n = 0; n < 2; ++n) dst##8[n] = cat32(*(const PG8_LAS bf16x8*)(lds + PG8_SB(b, h) + boff + n * 2048), *(const PG8_LAS bf16x8*)(lds + PG8_SB(b, h) + boff + n * 2048 + 1024)); } \
        else { _Pragma("unroll") for (int n = 0; n < 2; ++n) _Pragma("unroll") for (int k = 0; k < 2; ++k) dst[n][k] = *(const PG8_LAS bf16x8*)(lds + PG8_SB(b, h) + boff + n * 2048 + k * 1024); } } while (0)
#define PG8_MMA(ai, bj, At, Bt) do { __builtin_amdgcn_s_setprio(1); _Pragma("unroll") for (int m = 0; m < 4; ++m) _Pragma("unroll") for (int n = 0; n < 2; ++n) { \
        if constexpr (F8) { acc[ai][bj][m][n] = __builtin_amdgcn_mfma_scale_f32_16x16x128_f8f6f4(Bt##8[n], At##8[m], acc[ai][bj][m][n], 0, 0, 0, g.sb, 0, g.sa); } \
        else { _Pragma("unroll") for (int k = 0; k < 2; ++k) acc[ai][bj][m][n] = __builtin_amdgcn_mfma_f32_16x16x32_bf16(Bt[n][k], At[m][k], acc[ai][bj][m][n], 0, 0, 0); } } __builtin_amdgcn_s_setprio(0); } while (0)
#define PG8_WAIT_V(n) asm volatile("s_waitcnt vmcnt(" #n ")" ::: "memory")
#define PG8_WAIT_L(n) asm volatile("s_waitcnt lgkmcnt(" #n ")" ::: "memory")
#define PG8_BAR __builtin_amdgcn_s_barrier()
#define PG8_SCHED __builtin_amdgcn_sched_barrier(0)
    Unit cur, nxt; int ui = 0;
    if (!S.next(0, cur)) return;
    f32x4 acc[2][2][4][2];
#pragma unroll
    for (int a = 0; a < 2; ++a)
#pragma unroll
        for (int b = 0; b < 2; ++b)
#pragma unroll
            for (int m = 0; m < 4; ++m)
#pragma unroll
                for (int n = 0; n < 2; ++n) acc[a][b][m][n] = (f32x4){0.f, 0.f, 0.f, 0.f};
    bf16x8 At[4][2], B0[2][2], B1[2][2];
    v8i_t At8[4], B08[2], B18[2];
    const char* cA = (const char*)g.A + (GATH ? (size_t)0 : (size_t)cur.pm * tstep); const char* cB = (const char*)g.Bt + (size_t)cur.pn * tstep;
    unsigned vAc[2][2];
    if constexpr (GATH) { unsigned tp0[2];
#pragma unroll
        for (int hh = 0; hh < 2; ++hh) { int R0, C0; stage_rc(tid * 16, R0, C0); tp0[hh] = S.a_rowpair(cur, hh, R0); }
#pragma unroll
        for (int hh = 0; hh < 2; ++hh)
#pragma unroll
            for (int i = 0; i < 2; ++i) { int R, C; stage_rc(tid * 16 + i * 8192, R, C); vAc[hh][i] = S.a_rowoff_tok(cur, (int)((tp0[hh] >> (16 * i)) & 0xffffu)) + (unsigned)(C * 2); } }
    S.a_ready(cur);
    if constexpr (SP2) {
        PG8_STAGE(PG8_SB(0, 0), cB, voffB, rsB, g.Bt); PG8_STAGE(PG8_SB(0, 1), cB + hstep, voffB, rsB, g.Bt); PG8_STAGEA(PG8_SA(0, 0), cA, 0, false); PG8_STAGEA(PG8_SA(0, 1), cA, 1, false);
        if (wr == 1) PG8_BAR;
        PG8_WAIT_V(2); PG8_BAR;
        PG8_STAGE(PG8_SB(1, 0), cB + kstep, voffB, rsB, g.Bt); PG8_STAGEA(PG8_SA(1, 0), cA + kstep, 0, false); PG8_STAGE(PG8_SB(1, 1), cB + hstep + kstep, voffB, rsB, g.Bt);
        PG8_WAIT_V(6); PG8_BAR;
    } else {
        PG8_STAGE(PG8_SB(0, 0), cB, voffB, rsB, g.Bt); PG8_STAGEA(PG8_SA(0, 0), cA, 0, false); PG8_STAGE(PG8_SB(0, 1), cB + hstep, voffB, rsB, g.Bt); PG8_STAGEA(PG8_SA(0, 1), cA, 1, false);
        if (wr == 1) PG8_BAR;
        PG8_WAIT_V(4); PG8_BAR;
        PG8_STAGE(PG8_SB(1, 0), cB + kstep, voffB, rsB, g.Bt); PG8_STAGEA(PG8_SA(1, 0), cA + kstep, 0, false); PG8_STAGE(PG8_SB(1, 1), cB + hstep + kstep, voffB, rsB, g.Bt);
        PG8_WAIT_V(6); PG8_BAR;
    }
    unsigned tpk[2] = {0u, 0u};
    if constexpr (GATH) { Unit n1; if (S.next(1, n1)) {
#pragma unroll
        for (int hh = 0; hh < 2; ++hh) { int R0, C0; stage_rc(opaque_tid() * 16, R0, C0); tpk[hh] = S.a_rowpair(n1, hh, R0); } } }
    for (;;) {
        const bool has_next = S.next(ui + 1, nxt);
        const char* nA = (has_next && !GATH) ? (const char*)g.A + (size_t)nxt.pm * tstep : cA; const char* nB = has_next ? (const char*)g.Bt + (size_t)nxt.pn * tstep : cB;

#pragma unroll 1
        for (int t = 0; t < nt; t += 2) {
            const bool last = (t == nt - 2); const bool un = last && has_next;

            const char* a1 = cA + (size_t)(t + 1) * kstep;
            const char* a2 = last ? nA : cA + (size_t)(t + 2) * kstep; const char* b2 = last ? nB : cB + (size_t)(t + 2) * kstep;
            const char* a3 = a2 + kstep; const char* b3 = b2 + kstep;
            if (last && has_next) S.a_ready(nxt);
            if constexpr (SP2) {
            PG8_LDB(B0, 0, 0); PG8_LDB(B1, 0, 1); PG8_SCHED; PG8_LDA(At, 0, 0); PG8_STAGEA(PG8_SA(1, 1), a1, 1, false); PG8_GSWITCH;
            PG8_WAIT_V(8); PG8_WAIT_L(0); PG8_BAR; PG8_MMA(0, 0, At, B0); PG8_MMA(0, 1, At, B1); PG8_BAR; PG8_SCHED;
            PG8_LDA(At, 0, 1); PG8_STAGE(PG8_SB(0, 0), b2, voffB, rsB, g.Bt); PG8_STAGE(PG8_SB(0, 1), b2 + hstep, voffB, rsB, g.Bt); PG8_STAGEA(PG8_SA(0, 0), a2, 0, un);
            PG8_WAIT_V(8); PG8_WAIT_L(0); PG8_BAR; PG8_MMA(1, 0, At, B0); PG8_MMA(1, 1, At, B1); PG8_BAR; PG8_SCHED;
            PG8_LDB(B0, 1, 0); PG8_LDB(B1, 1, 1); PG8_SCHED; PG8_LDA(At, 1, 0); PG8_STAGEA(PG8_SA(0, 1), a2, 1, un);
            PG8_WAIT_V(8); PG8_WAIT_L(0); PG8_BAR; PG8_MMA(0, 0, At, B0); PG8_MMA(0, 1, At, B1); PG8_BAR; PG8_SCHED;
            PG8_LDA(At, 1, 1); PG8_STAGE(PG8_SB(1, 0), b3, voffB, rsB, g.Bt); PG8_STAGE(PG8_SB(1, 1), b3 + hstep, voffB, rsB, g.Bt); PG8_STAGEA(PG8_SA(1, 0), a3, 0, un);
            PG8_WAIT_V(8); PG8_WAIT_L(0); PG8_BAR; PG8_MMA(1, 0, At, B0); PG8_MMA(1, 1, At, B1); PG8_BAR; PG8_SCHED;
            } else {
            PG8_LDB(B0, 0, 0); PG8_SCHED; PG8_LDA(At, 0, 0); PG8_STAGEA(PG8_SA(1, 1), a1, 1, false); PG8_GSWITCH;
            PG8_WAIT_L(8); PG8_BAR; PG8_WAIT_L(0); PG8_MMA(0, 0, At, B0); PG8_BAR; PG8_SCHED;
            PG8_LDB(B1, 0, 1); PG8_STAGE(PG8_SB(0, 0), b2, voffB, rsB, g.Bt);
            PG8_BAR; PG8_WAIT_L(0); PG8_MMA(0, 1, At, B1); PG8_BAR;
            PG8_LDA(At, 0, 1); PG8_STAGEA(PG8_SA(0, 0), a2, 0, un);
            PG8_BAR; PG8_WAIT_L(0); PG8_MMA(1, 0, At, B0); PG8_BAR; PG8_SCHED;
            PG8_STAGE(PG8_SB(0, 1), b2 + hstep, voffB, rsB, g.Bt);
            PG8_WAIT_V(6); PG8_BAR; PG8_MMA(1, 1, At, B1); PG8_BAR;
            PG8_LDB(B0, 1, 0); PG8_SCHED; PG8_LDA(At, 1, 0); PG8_STAGEA(PG8_SA(0, 1), a2, 1, un);
            PG8_WAIT_L(8); PG8_BAR; PG8_WAIT_L(0); PG8_MMA(0, 0, At, B0); PG8_BAR; PG8_SCHED;
            PG8_LDB(B1, 1, 1); PG8_STAGE(PG8_SB(1, 0), b3, voffB, rsB, g.Bt);
            PG8_BAR; PG8_WAIT_L(0); PG8_MMA(0, 1, At, B1); PG8_BAR;
            PG8_LDA(At, 1, 1); PG8_STAGEA(PG8_SA(1, 0), a3, 0, un);
            PG8_BAR; PG8_WAIT_L(0); PG8_MMA(1, 0, At, B0); PG8_BAR; PG8_SCHED;
            PG8_STAGE(PG8_SB(1, 1), b3 + hstep, voffB, rsB, g.Bt);
            PG8_WAIT_V(6); PG8_BAR; PG8_MMA(1, 1, At, B1); PG8_BAR;
            }
        }
        if constexpr (ALIGN_EPI) { if (wr == 0) PG8_BAR; }
        unsigned tpk2[2] = {0u, 0u};
        if constexpr (GATH) { Unit n2; if (S.next(ui + 2, n2)) {
#pragma unroll
            for (int hh = 0; hh < 2; ++hh) { int R0, C0; stage_rc(opaque_tid() * 16, R0, C0); tpk2[hh] = S.a_rowpair(n2, hh, R0); } } }
        if constexpr (!Epi::AFTER_DRAIN) { const int t2 = opaque_tid(), w2 = __builtin_amdgcn_readfirstlane(t2 >> 6), l2 = t2 & 63; E(acc, cur, w2 >> 2, w2 & 3, l2 & 15, l2 >> 4); S.done(cur); }
        if (!has_next) break;
#pragma unroll
        for (int a = 0; a < 2; ++a)
#pragma unroll
            for (int b = 0; b < 2; ++b)
#pragma unroll
                for (int m = 0; m < 4; ++m)
#pragma unroll
                    for (int n = 0; n < 2; ++n) acc[a][b][m][n] = (f32x4){0.f, 0.f, 0.f, 0.f};
        cur = nxt; cA = nA; cB = nB; ++ui;
        if constexpr (GATH) { asm volatile("" : "+v"(tpk2[0]), "+v"(tpk2[1]));
            tpk[0] = tpk2[0]; tpk[1] = tpk2[1]; }

        if constexpr (ALIGN_EPI) { if (wr == 1) PG8_BAR; }
    }
    PG8_WAIT_V(0);
    if constexpr (!ALIGN_EPI) { if (wr == 0) PG8_BAR; }
    PG8_BAR;
    if constexpr (Epi::AFTER_DRAIN) { E.fused(acc, cur, wr, wc, fr, fq, lds, wid, lane); S.done(cur); }
#undef PG8_SA
#undef PG8_SB
#undef PG8_STAGE
#undef PG8_LDA
#undef PG8_LDB
#undef PG8_MMA
#undef PG8_WAIT_V
#undef PG8_WAIT_L
#undef PG8_BAR
#undef PG8_SCHED
}
}

#define GAS __attribute__((address_space(1)))
#define LAS __attribute__((address_space(3)))
typedef unsigned short bf16;
typedef float f32x4 __attribute__((ext_vector_type(4)));
typedef unsigned u32x4 __attribute__((ext_vector_type(4)));
typedef unsigned u32x2 __attribute__((ext_vector_type(2)));
typedef short bf16x8 __attribute__((ext_vector_type(8)));

constexpr int DM = 1024, BATCH = 16, SEQ = 2048, DEPTH = 4, NTOK = BATCH * SEQ;
constexpr int PW_IN = 2320, PN = 2304, PNW = 2560;
constexpr int C_AQ = 0, C_AK = 512, C_AV = 640, C_MQ = 768, C_MK = 1024, C_MV = 1280, C_MO = 1536, C_GU = 1792, C_GV = 2048;
constexpr int NE = 16, CAP = 256, DE = 2048, NGRP = 256;
constexpr float DN_ALPHA = 1.6817928305074290f;
constexpr float LN_EPS = 1e-5f;

constexpr size_t MiB = 1u << 20;
constexpr size_t WS_CTL = 0, CTL_BYTES = 1 * MiB;
constexpr size_t WS_MOD = 1 * MiB;
constexpr size_t WS_WIN = 1520 * MiB;
constexpr size_t WS_WOUT = 22 * MiB;
constexpr size_t WS_WS = 30 * MiB;
constexpr size_t WS_GATES = 32 * MiB;
constexpr size_t WS_AFF = 34 * MiB;
constexpr size_t WS_SLOT = 36 * MiB;
constexpr size_t WS_IDX = 37 * MiB;
constexpr size_t WS_GATEV = 38 * MiB;
constexpr size_t WS_DC = 40 * MiB;
constexpr size_t WS_DN = 72 * MiB;
constexpr size_t WS_DS = 73 * MiB;
constexpr size_t WS_QKT = 80 * MiB;
constexpr size_t WS_H = 128 * MiB;
constexpr size_t WS_XA = 192 * MiB;
constexpr size_t WS_PROJ = 320 * MiB;
constexpr size_t WS_MIXCAT = 464 * MiB;
constexpr size_t WS_MIX = 528 * MiB;
constexpr size_t WS_XG = 592 * MiB;
constexpr size_t WS_HID = 720 * MiB;
constexpr size_t WS_YE = 976 * MiB;
constexpr size_t WS_WGU = 1104 * MiB;
constexpr size_t WS_WD = 1360 * MiB;
constexpr size_t WS_H8 = 1488 * MiB;
constexpr size_t WS_END = 1540 * MiB;
constexpr float W1_SCALE = 128.f, W2_SCALE = 512.f, ACT_SCALE = 8.f;
constexpr int SC_A1 = 0x7C7C7C7C, SC_B1 = 0x78787878, SC_A2 = 0x7D7D7D7D, SC_B2 = 0x76767676;
constexpr size_t WS_HFB = WS_HID;
constexpr size_t WS_VN = WS_HID + 64 * MiB;

struct P {
    const float *x, *c, *w_ada, *b_ada, *w_in, *conv_w, *conv_b, *gate_b, *sink, *rel_bias, *w_s, *b_s, *w_out, *w_router, *w_gate, *w_up, *w_down, *ln_g, *ln_b;
    float* out; unsigned char* ws;
};

typedef float f32x2c __attribute__((ext_vector_type(2))); typedef __bf16 bf16x2c __attribute__((ext_vector_type(2)));
__device__ __forceinline__ unsigned pk2(float lo, float hi) { const f32x2c v = {lo, hi}; return __builtin_bit_cast(unsigned, __builtin_convertvector(v, bf16x2c)); }
__device__ __forceinline__ unsigned f2bf(float f) { return pk2(f, 0.f) & 0xffffu; }
__device__ __forceinline__ float bf2f(unsigned short b) { return __builtin_bit_cast(float, (unsigned)b << 16); }
__device__ __forceinline__ float bflo(unsigned w) { return __builtin_bit_cast(float, w << 16); }
__device__ __forceinline__ float bfhi(unsigned w) { return __builtin_bit_cast(float, w & 0xffff0000u); }
__device__ __forceinline__ float sigmoid_f(float x) { return __builtin_amdgcn_rcpf(1.0f + __builtin_amdgcn_exp2f(x * -1.4426950408889634f)); }
__device__ __forceinline__ float silu_acc(float x) { return x * __builtin_amdgcn_rcpf(1.0f + __builtin_amdgcn_exp2f(x * -1.4426950408889634f)); }
__device__ __forceinline__ float gelu_erf(float x) { return 0.5f * x * (1.0f + erff(x * 0.70710678118654752f)); }
__device__ __forceinline__ float logsigmoid_f(float x) { return fminf(x, 0.f) - __logf(1.0f + __expf(-fabsf(x))); }
__device__ __forceinline__ int t5_bucket(int rel) {
    const int n = rel < 0 ? -rel : rel;
    int bk = n < 8 ? n : n < 12 ? 8 : n < 16 ? 9 : n < 23 ? 10 : n < 32 ? 11 : n < 46 ? 12 : n < 64 ? 13 : n < 91 ? 14 : 15;
    return bk + (rel > 0 ? 16 : 0);
}

__device__ __forceinline__ int unit_of(int wg, int G, int i, int N) {
    if (G == 256) { const int per = N >> 8; if (i >= per) return N; return ((((wg & 7) << 5) | (wg >> 3)) * per) + i; }
    const int u = wg + i * G; return u < N ? u : N;
}
template <int CTRL> __device__ __forceinline__ float dpp_f(float v) { return __builtin_bit_cast(float, __builtin_amdgcn_update_dpp(0, __builtin_bit_cast(int, v), CTRL, 0xf, 0xf, true)); }
#define DPP_X1 0xB1
#define DPP_X2 0x4E
#define DPP_HM 0x141
#define DPP_RM 0x140
__device__ __forceinline__ float r16_sum(float v) { v += dpp_f<DPP_X1>(v); v += dpp_f<DPP_X2>(v); v += dpp_f<DPP_HM>(v); v += dpp_f<DPP_RM>(v); return v; }
__device__ __forceinline__ float r16_max(float v) { v = fmaxf(v, dpp_f<DPP_X1>(v)); v = fmaxf(v, dpp_f<DPP_X2>(v)); v = fmaxf(v, dpp_f<DPP_HM>(v)); v = fmaxf(v, dpp_f<DPP_RM>(v)); return v; }
__device__ __forceinline__ float wave_sum(float v) {
#pragma unroll
    for (int o = 1; o < 64; o <<= 1) v += __shfl_xor(v, o);
    return v;
}
constexpr int RB_PITCH = 2080;
constexpr int RB_W = 0, RB_ST = 16 * RB_PITCH, RW_VEC = 100352;
__device__ __forceinline__ void r16_ln(f32x4 (&v)[16]) {
    float s = 0.f;
#pragma unroll
    for (int k = 0; k < 16; ++k) s += (v[k][0] + v[k][1]) + (v[k][2] + v[k][3]);
    const float mean = r16_sum(s) * (1.f / DM); float q = 0.f;
#pragma unroll
    for (int k = 0; k < 16; ++k) { v[k] = v[k] - mean; q += (v[k][0] * v[k][0] + v[k][1] * v[k][1]) + (v[k][2] * v[k][2] + v[k][3] * v[k][3]); }
    const float rstd = 1.0f / sqrtf(r16_sum(q) * (1.f / DM) + LN_EPS);
#pragma unroll
    for (int k = 0; k < 16; ++k) v[k] = v[k] * rstd;
}
__device__ __forceinline__ float r16_fold(const float (&acc)[16], int c) {
    float a8[8], a4[4], a2[2];
    { const bool hi = c >= 8;
#pragma unroll
      for (int e = 0; e < 8; ++e) { const float send = hi ? acc[e] : acc[e + 8], keep = hi ? acc[e + 8] : acc[e]; a8[e] = keep + dpp_f<DPP_RM>(send); } }
    { const bool hi = (c & 7) >= 4;
#pragma unroll
      for (int e = 0; e < 4; ++e) { const float send = hi ? a8[e] : a8[e + 4], keep = hi ? a8[e + 4] : a8[e]; a4[e] = keep + dpp_f<DPP_HM>(send); } }
    { const bool hi = (c & 2) != 0;
#pragma unroll
      for (int e = 0; e < 2; ++e) { const float send = hi ? a4[e] : a4[e + 2], keep = hi ? a4[e + 2] : a4[e]; a2[e] = keep + dpp_f<DPP_X2>(send); } }
    const bool hi = (c & 1) != 0; const float send = hi ? a2[0] : a2[1], keep = hi ? a2[1] : a2[0];
    return keep + dpp_f<DPP_X1>(send);
}
__device__ __forceinline__ void r16_matvec2(const f32x4 (&v0)[16], const f32x4 (&v1)[16], const LAS float* wT, int c, float& r0, float& r1) {
    float a0[16], a1[16];
    asm volatile("" ::: "memory");
#pragma unroll
    for (int e = 0; e < 16; ++e) { float s0 = 0.f, s1 = 0.f;
#pragma unroll
        for (int k = 0; k < 16; ++k) { const f32x4 w = *(const LAS f32x4*)(wT + e * DM + 64 * k + 4 * c);
            s0 += (v0[k][0] * w[0] + v0[k][1] * w[1]) + (v0[k][2] * w[2] + v0[k][3] * w[3]); s1 += (v1[k][0] * w[0] + v1[k][1] * w[1]) + (v1[k][2] * w[2] + v1[k][3] * w[3]); }
        a0[e] = s0; a1[e] = s1; }
    r0 = r16_fold(a0, c); r1 = r16_fold(a1, c);
}
#define RC(k) (128 * ((k) >> 1) + 8 * c + 4 * ((k) & 1))
__device__ __forceinline__ int rpos(int col) { return (col & ~127) | (((col >> 2) & 1) << 6) | (((col & 127) >> 3) << 2) | (col & 3); }
__device__ __forceinline__ f32x4 bf4lo(u32x4 w) { return (f32x4){bflo(w.x), bfhi(w.x), bflo(w.y), bfhi(w.y)}; }
__device__ __forceinline__ f32x4 bf4hi(u32x4 w) { return (f32x4){bflo(w.z), bfhi(w.z), bflo(w.w), bfhi(w.w)}; }
__device__ __forceinline__ void r16_store_bf16(bf16* rowp, int c, const f32x4 (&v)[16]) {
#pragma unroll
    for (int kk = 0; kk < 8; ++kk) { u32x4 w; w.x = pk2(v[2 * kk][0], v[2 * kk][1]); w.y = pk2(v[2 * kk][2], v[2 * kk][3]); w.z = pk2(v[2 * kk + 1][0], v[2 * kk + 1][1]); w.w = pk2(v[2 * kk + 1][2], v[2 * kk + 1][3]);
        *(u32x4*)(rowp + 128 * kk + 8 * c) = w; }
}
__device__ __forceinline__ void fill_wrouter(LAS unsigned char* wb, const float* src, int tid) {
    f32x4 aa[2][4];
#pragma unroll
    for (int j = 0; j < 2; ++j) { const float* sp = src + (size_t)(tid + 512 * j) * 16;
#pragma unroll
        for (int k = 0; k < 4; ++k) aa[j][k] = *(const f32x4*)(sp + 4 * k); }
#pragma unroll
    for (int j = 0; j < 2; ++j) { const int d = tid + 512 * j; const f32x4 a0 = aa[j][0], a1 = aa[j][1], a2 = aa[j][2], a3 = aa[j][3];
#pragma unroll
        for (int k = 0; k < 4; ++k) { *(LAS bf16*)(wb + k * RB_PITCH + 2 * d) = (bf16)f2bf(a0[k]); *(LAS bf16*)(wb + (4 + k) * RB_PITCH + 2 * d) = (bf16)f2bf(a1[k]);
            *(LAS bf16*)(wb + (8 + k) * RB_PITCH + 2 * d) = (bf16)f2bf(a2[k]); *(LAS bf16*)(wb + (12 + k) * RB_PITCH + 2 * d) = (bf16)f2bf(a3[k]); } }
}
__device__ __forceinline__ void fill_vec(LAS float* dst, const float* src, int tid) {
    *(LAS f32x4*)(dst + rpos(4 * (tid & 255))) = *(const f32x4*)(src + 4 * (tid & 255));
}
__device__ __forceinline__ void fill_vec3(LAS float* da, const float* sa, bool wb, LAS float* db, const float* sb, bool wc, LAS float* dc, const float* sc, int tid) {
    const int o = 4 * (tid & 255);
    const f32x4 ra = *(const f32x4*)(sa + o), rb = *(const f32x4*)((wb ? sb : sa) + o), rc = *(const f32x4*)((wc ? sc : sa) + o);
    *(LAS f32x4*)(da + rpos(o)) = ra; if (wb) *(LAS f32x4*)(db + rpos(o)) = rb; if (wc) *(LAS f32x4*)(dc + rpos(o)) = rc;
}
__device__ __forceinline__ void rows_entry_simple(const P& p, int wg, int G) {
    const int tid = opaque_tid(), lane = tid & 63, gw = wg * 8 + (tid >> 6), ngw = G * 8;
    const float* mod = (const float*)(p.ws + WS_MOD); bf16* H = (bf16*)(p.ws + WS_H);
    for (int m = gw; m < NTOK; m += ngw) { const int b = m / SEQ; const float* mb = mod + (size_t)b * 6 * DM; const float* xr = p.x + (size_t)m * DM;
        f32x4 v[4]; float s = 0.f;
#pragma unroll
        for (int j = 0; j < 4; ++j) { v[j] = *(const f32x4*)(xr + 256 * j + 4 * lane); s += (v[j][0] + v[j][1]) + (v[j][2] + v[j][3]); }
        const float mean = wave_sum(s) * (1.f / DM); float q = 0.f;
#pragma unroll
        for (int j = 0; j < 4; ++j) { v[j] = v[j] - mean; q += (v[j][0] * v[j][0] + v[j][1] * v[j][1]) + (v[j][2] * v[j][2] + v[j][3] * v[j][3]); }
        const float rstd = 1.0f / sqrtf(wave_sum(q) * (1.f / DM) + LN_EPS);
#pragma unroll
        for (int j = 0; j < 4; ++j) { const f32x4 sc = *(const f32x4*)(mb + DM + 256 * j + 4 * lane), sh = *(const f32x4*)(mb + 256 * j + 4 * lane); const f32x4 o = v[j] * rstd * (sc + 1.0f) + sh;
            u32x2 w; w.x = pk2(o[0], o[1]); w.y = pk2(o[2], o[3]); *(u32x2*)(H + (size_t)m * DM + 256 * j + 4 * lane) = w; }
    }
}
template <int WHICH>
__device__ __forceinline__ void rows_phase(const P& p, int l, const float* xin, LAS unsigned char* L, int wg, int G, bool dummy = false) {
    const int tid = opaque_tid(), lane = tid & 63, wave = __builtin_amdgcn_readfirstlane(tid >> 6), q = lane >> 4, c = lane & 15;
    LAS float* vec = (LAS float*)(L + RW_VEC);
    const float* modl = (const float*)(p.ws + WS_MOD) + (size_t)l * BATCH * 6 * DM;
    bf16* H = (bf16*)(p.ws + (dummy ? WS_HID : WS_H)); bf16* xa = (bf16*)(p.ws + (dummy ? WS_XG : WS_XA));
    const bool xbf = (WHICH == 2) || (l != 0);
    float* affo = (float*)(p.ws + (dummy ? WS_HID + 128 * MiB : WS_AFF)); float* gato = (float*)(p.ws + (dummy ? WS_HID + 130 * MiB : WS_GATES));
    const bool last = (WHICH == 2) && (l == DEPTH - 1);
    if (WHICH == 1) fill_wrouter(L + RB_W, p.w_router + (size_t)l * DM * 16, tid);
    for (int bi = 0, blk; (blk = unit_of(wg, G, bi, NTOK / 128)) < NTOK / 128; ++bi) {
        const int b = (blk * 128) / SEQ; const float* mb = modl + (size_t)b * 6 * DM;
        __syncthreads();
        { const int half = tid >> 8;
          if (WHICH == 0) { fill_vec(vec + half * DM, mb + (half ? 0 : 1) * DM, tid); }
          if (WHICH == 1) fill_vec3(vec + half * DM, half ? p.ln_g + (size_t)(l * 2) * DM : mb + 2 * DM, true, vec + (2 + half) * DM, half ? mb + 4 * DM : p.ln_b + (size_t)(l * 2) * DM, half == 0, vec + 4 * DM, mb + 3 * DM, tid);
          if (WHICH == 2) { const float* mbn = mb + (size_t)BATCH * 6 * DM;
              fill_vec3(vec + half * DM, half ? p.ln_g + (size_t)(l * 2 + 1) * DM : mb + 5 * DM, half == 0, vec + 2 * DM, p.ln_b + (size_t)(l * 2 + 1) * DM, !last, vec + (3 + half) * DM, mbn + (half ? 0 : 1) * DM, tid); } }
        __syncthreads();
#pragma unroll 1
        for (int it = 0; it < 4; ++it) {
            asm volatile("" ::: "memory");
            const int m = blk * 128 + wave * 16 + it * 4 + q;
            f32x4 v[16];
            if (!xbf) {
#pragma unroll
                for (int k = 0; k < 16; ++k) v[k] = *(const f32x4*)(xin + (size_t)m * DM + RC(k)); }
            else { const bf16* xb = (const bf16*)xin + (size_t)m * DM;
#pragma unroll
                for (int kk = 0; kk < 8; ++kk) { const u32x4 w = *(const u32x4*)(xb + 128 * kk + 8 * c); v[2 * kk] = bf4lo(w); v[2 * kk + 1] = bf4hi(w); } }
            if (WHICH == 1) {
                const bf16* mix = (const bf16*)(p.ws + WS_MIX) + (size_t)m * DM;
                u32x4 mw[8];
#pragma unroll
                for (int kk = 0; kk < 8; ++kk) mw[kk] = *(const u32x4*)(mix + 128 * kk + 8 * c);
#pragma unroll
                for (int k = 0; k < 16; ++k) { const f32x4 g1 = *(const LAS f32x4*)(vec + 64 * k + 4 * c); const f32x4 mx = (k & 1) ? bf4hi(mw[k >> 1]) : bf4lo(mw[k >> 1]);
                    v[k] = v[k] * DN_ALPHA + (g1 + 1.0f) * mx; }
            }
            if (WHICH == 2) {
                const bf16* ye = (const bf16*)(p.ws + WS_YE); const short* slot = (const short*)(p.ws + WS_SLOT);
                const int t = m % SEQ; const int sl = slot[((size_t)b * 16 + c) * SEQ + t];
                const unsigned long long bal = __ballot(sl >= 0);
                unsigned rem = (unsigned)(bal >> (16 * q)) & 0xffffu;
                const int c0 = __popcll(bal & 0xffffull), c1 = __popcll(bal & 0xffff0000ull), c2 = __popcll(bal & 0xffff00000000ull), c3 = __popcll(bal & 0xffff000000000000ull);
                const int m01 = c0 > c1 ? c0 : c1, m23 = c2 > c3 ? c2 : c3, maxc = m01 > m23 ? m01 : m23;
                f32x4 y[16];
#pragma unroll
                for (int k = 0; k < 16; ++k) y[k] = (f32x4){0.f, 0.f, 0.f, 0.f};
                for (int kk = 0; kk < maxc; kk += 2) {
                    const bool va = rem != 0u; const int ea = va ? __builtin_ctz(rem) : 0; rem &= rem - 1u;
                    const bool vb = rem != 0u; const int eb = vb ? __builtin_ctz(rem) : 0; rem &= rem - 1u;
                    const int sa = __shfl(sl, (lane & 48) | ea), sb = __shfl(sl, (lane & 48) | eb);
                    const bf16* ra = ye + ((size_t)(ea * 16 + b) * CAP + (va ? sa : 0)) * DM; const bf16* rb = ye + ((size_t)(eb * 16 + b) * CAP + (vb ? sb : 0)) * DM;
                    u32x4 wa[8], wb[8];
#pragma unroll
                    for (int kk = 0; kk < 8; ++kk) { wa[kk] = *(const u32x4*)(ra + 128 * kk + 8 * c); wb[kk] = *(const u32x4*)(rb + 128 * kk + 8 * c); }
                    const float fa = va ? 1.f : 0.f, fb = vb ? 1.f : 0.f;
#pragma unroll
                    for (int k = 0; k < 16; ++k) { y[k] = y[k] + ((k & 1) ? bf4hi(wa[k >> 1]) : bf4lo(wa[k >> 1])) * fa + ((k & 1) ? bf4hi(wb[k >> 1]) : bf4lo(wb[k >> 1])) * fb; }
                }
#pragma unroll
                for (int k = 0; k < 16; ++k) { const f32x4 g2 = *(const LAS f32x4*)(vec + 64 * k + 4 * c); v[k] = v[k] * DN_ALPHA + (g2 + 1.0f) * y[k]; }
            }
            if (WHICH != 0) {
                r16_ln(v);
                const bool of32 = last && !dummy;
#pragma unroll
                for (int k = 0; k < 16; ++k) { const f32x4 gg = *(const LAS f32x4*)(vec + DM + 64 * k + 4 * c), bb = *(const LAS f32x4*)(vec + 2 * DM + 64 * k + 4 * c); v[k] = v[k] * gg + bb; }
                if (of32) {
#pragma unroll
                    for (int k = 0; k < 16; ++k) *(f32x4*)(p.out + (size_t)m * DM + RC(k)) = v[k]; }
                else r16_store_bf16(xa + (size_t)m * DM, c, v);
            }
            if (!last) {
                r16_ln(v);
                const int o_sc = WHICH == 0 ? 0 : 3, o_sh = WHICH == 0 ? 1 : 4;
#pragma unroll
                for (int k = 0; k < 16; ++k) { const f32x4 sc = *(const LAS f32x4*)(vec + o_sc * DM + 64 * k + 4 * c), sh = *(const LAS f32x4*)(vec + o_sh * DM + 64 * k + 4 * c); v[k] = v[k] * (sc + 1.0f) + sh; }
                if (WHICH == 1) { unsigned char* h8 = p.ws + (dummy ? WS_HID : WS_H8) + (size_t)m * DM;
#pragma unroll
                    for (int kk = 0; kk < 8; ++kk) { u32x2 w; w.x = pg8::pk4_fp8(v[2 * kk][0] * ACT_SCALE, v[2 * kk][1] * ACT_SCALE, v[2 * kk][2] * ACT_SCALE, v[2 * kk][3] * ACT_SCALE); w.y = pg8::pk4_fp8(v[2 * kk + 1][0] * ACT_SCALE, v[2 * kk + 1][1] * ACT_SCALE, v[2 * kk + 1][2] * ACT_SCALE, v[2 * kk + 1][3] * ACT_SCALE);
                        *(u32x2*)(h8 + 128 * kk + 8 * c) = w; } }
                else r16_store_bf16(H + (size_t)m * DM, c, v);
                if (WHICH == 1) {
                    LAS unsigned char* st = L + RB_ST + wave * (4 * RB_PITCH);
#pragma unroll
                    for (int kk = 0; kk < 8; ++kk) { u32x4 w; w.x = pk2(v[2 * kk][0], v[2 * kk][1]); w.y = pk2(v[2 * kk][2], v[2 * kk][3]); w.z = pk2(v[2 * kk + 1][0], v[2 * kk + 1][1]); w.w = pk2(v[2 * kk + 1][2], v[2 * kk + 1][3]);
                        *(LAS u32x4*)(st + q * RB_PITCH + (128 * kk + 8 * c) * 2) = w; }
                    f32x4 lg = (f32x4){0.f, 0.f, 0.f, 0.f};
                    const LAS unsigned char* ap = st + (lane & 3) * RB_PITCH + (lane >> 4) * 16; const LAS unsigned char* bp = L + RB_W + (lane & 15) * RB_PITCH + (lane >> 4) * 16;
#pragma unroll 8
                    for (int ks = 0; ks < 32; ++ks) lg = __builtin_amdgcn_mfma_f32_16x16x32_bf16(*(const LAS bf16x8*)(ap + ks * 64), *(const LAS bf16x8*)(bp + ks * 64), lg, 0, 0, 0);
                    float pr[4];
#pragma unroll
                    for (int rr = 0; rr < 4; ++rr) { const float mx = r16_max(lg[rr]), ex = __expf(lg[rr] - mx), sm = r16_sum(ex); pr[rr] = ex / sm; }
                    const float mine = q == 0 ? pr[0] : q == 1 ? pr[1] : q == 2 ? pr[2] : pr[3];
                    affo[(size_t)m * 16 + c] = mine; }
            }
        }
    }
    __syncthreads();
}

__device__ __forceinline__ void transpose_item(const float* src, size_t ld_src, bf16* dst, size_t ld_dst, LAS float* scr, int lane, int nvalid = 32) {
    if (nvalid > 0) { const int kr = lane >> 3, nc = 4 * (lane & 7);
        f32x4 t[8];
#pragma unroll
        for (int i = 0; i < 8; ++i) t[i] = *(const f32x4*)(src + (size_t)(8 * i + kr) * ld_src + nc);
#pragma unroll
        for (int i = 0; i < 8; ++i) { LAS float* d = scr + (8 * i + kr) * 33 + nc; d[0] = t[i][0]; d[1] = t[i][1]; d[2] = t[i][2]; d[3] = t[i][3]; }
    }
    asm volatile("s_waitcnt lgkmcnt(0)" ::: "memory");
    const int c = lane & 7;
#pragma unroll
    for (int j = 0; j < 4; ++j) { const int n = (lane >> 3) + 8 * j; const LAS float* s = scr + (8 * c) * 33 + n;
        u32x4 o; o.x = pk2(s[0 * 33], s[1 * 33]); o.y = pk2(s[2 * 33], s[3 * 33]); o.z = pk2(s[4 * 33], s[5 * 33]); o.w = pk2(s[6 * 33], s[7 * 33]);
        if (n >= nvalid) o = (u32x4){0u, 0u, 0u, 0u};
        *(u32x4*)(dst + (size_t)n * ld_dst + 8 * c) = o; }
    asm volatile("s_waitcnt lgkmcnt(0)" ::: "memory");
}
__device__ __forceinline__ void transpose_item8(const float* src, size_t ld_src, unsigned char* dst, size_t ld_dst, float scale, LAS float* scr, int lane) {
    { const int kr = lane >> 3, nc = 4 * (lane & 7);
        f32x4 t[8];
#pragma unroll
        for (int i = 0; i < 8; ++i) t[i] = *(const f32x4*)(src + (size_t)(8 * i + kr) * ld_src + nc);
#pragma unroll
        for (int i = 0; i < 8; ++i) { LAS float* d = scr + (8 * i + kr) * 33 + nc; d[0] = t[i][0]; d[1] = t[i][1]; d[2] = t[i][2]; d[3] = t[i][3]; } }
    asm volatile("s_waitcnt lgkmcnt(0)" ::: "memory");
    const int c = lane & 3;
#pragma unroll
    for (int j = 0; j < 2; ++j) { const int n = (lane >> 2) + 16 * j; const LAS float* s = scr + (16 * c) * 33 + n;
        u32x4 o;
#pragma unroll
        for (int q = 0; q < 4; ++q) o[q] = pg8::pk4_fp8(s[(4 * q) * 33] * scale, s[(4 * q + 1) * 33] * scale, s[(4 * q + 2) * 33] * scale, s[(4 * q + 3) * 33] * scale);
        *(u32x4*)(dst + (size_t)n * ld_dst + 16 * c) = o; }
    asm volatile("s_waitcnt lgkmcnt(0)" ::: "memory");
}
constexpr int ITL_WIN = 16 * 80, ITL_WOUT = 16 * 32, ITL_WGU = NE * 16 * 128, ITL_WD = NE * 32 * 32, ITL = ITL_WIN + ITL_WOUT + ITL_WGU + ITL_WD;
constexpr int ITS = ITL_WIN + ITL_WOUT, ITM = ITL_WGU + ITL_WD;
__device__ __forceinline__ void convert_item(const P& p, int l, int it, LAS float* scr, int lane) {
    if (it < ITL_WIN) { const int kb = it / 80, nb = it % 80, n0 = 32 * nb;
        const int sc = n0 < 1792 ? n0 : n0 < 2304 ? n0 + 16 : 1792, nvalid = n0 < 2304 ? 32 : n0 == 2304 ? 16 : 0;
        transpose_item(p.w_in + (size_t)l * DM * PW_IN + (size_t)(64 * kb) * PW_IN + sc, PW_IN, (bf16*)(p.ws + WS_WIN) + (size_t)l * PNW * DM + (size_t)n0 * DM + 64 * kb, DM, scr, lane, nvalid); return; }
    it -= ITL_WIN;
    if (it < ITL_WOUT) { const int kb = it / 32, nb = it % 32;
        transpose_item(p.w_out + (size_t)l * DM * DM + (size_t)(64 * kb) * DM + 32 * nb, DM, (bf16*)(p.ws + WS_WOUT) + (size_t)l * DM * DM + (size_t)(32 * nb) * DM + 64 * kb, DM, scr, lane); return; }
    it -= ITL_WOUT;
    if (it < ITL_WGU) { const int le = l * NE + it / (16 * 128), r = it % (16 * 128), kb = r / 128, nb = r % 128, n0 = 32 * nb, pn = n0 >> 8, w = n0 & 255;
        const float* src = (w < 128 ? p.w_gate : p.w_up) + (size_t)le * DM * DE + (size_t)(64 * kb) * DE + pn * 128 + (w & 127);
        transpose_item8(src, DE, p.ws + WS_WGU + (size_t)le * 4096 * DM + (size_t)n0 * DM + 64 * kb, DM, W1_SCALE, scr, lane); return; }
    it -= ITL_WGU;
    { const int le = l * NE + it / (32 * 32), r = it % (32 * 32), kb = r / 32, nb = r % 32;
        transpose_item8(p.w_down + (size_t)le * DE * DM + (size_t)(64 * kb) * DM + 32 * nb, DM, p.ws + WS_WD + (size_t)le * DM * DE + (size_t)(32 * nb) * DE + 64 * kb, DE, W2_SCALE, scr, lane); }
}

typedef short s16x4 __attribute__((ext_vector_type(4)));
typedef float f32x16 __attribute__((ext_vector_type(16)));
#define MFMA32(a, b, c) __builtin_amdgcn_mfma_f32_32x32x16_bf16((a), (b), (c), 0, 0, 0)
__device__ __forceinline__ int crow(int reg, int h) { return (reg & 3) + 8 * (reg >> 2) + 4 * h; }
__device__ __forceinline__ unsigned cvtpk(float lo, float hi) { return pk2(lo, hi); }
__device__ __forceinline__ bf16x8 pack8(float a0, float a1, float a2, float a3, float a4, float a5, float a6, float a7) {
    u32x4 w; w.x = cvtpk(a0, a1); w.y = cvtpk(a2, a3); w.z = cvtpk(a4, a5); w.w = cvtpk(a6, a7); return __builtin_bit_cast(bf16x8, w); }
__device__ __forceinline__ s16x4 tr_read(const LAS unsigned char* p) { typedef short v4i16_t __attribute__((ext_vector_type(4))); return __builtin_bit_cast(s16x4, __builtin_amdgcn_ds_read_tr16_b64_v4i16((LAS v4i16_t*)p)); }
__device__ __forceinline__ bf16x8 cat8(s16x4 lo, s16x4 hi) { return (bf16x8){lo[0], lo[1], lo[2], lo[3], hi[0], hi[1], hi[2], hi[3]}; }
__device__ __forceinline__ int wave_sum_i(int v) {
#pragma unroll
    for (int o = 1; o < 64; o <<= 1) v += __shfl_xor(v, o);
    return v;
}
__device__ __forceinline__ float wave_max(float v) {
#pragma unroll
    for (int o = 1; o < 64; o <<= 1) v = fmaxf(v, __shfl_xor(v, o));
    return v;
}

template <int CTRL, int RMASK> __device__ __forceinline__ float dpp_id(float ident, float v) { return __builtin_bit_cast(float, __builtin_amdgcn_update_dpp(__builtin_bit_cast(int, ident), __builtin_bit_cast(int, v), CTRL, RMASK, 0xf, false)); }
__device__ __forceinline__ float wave_scan_sum(float v) {
    v += dpp_id<0x111, 0xf>(0.f, v); v += dpp_id<0x112, 0xf>(0.f, v); v += dpp_id<0x114, 0xf>(0.f, v); v += dpp_id<0x118, 0xf>(0.f, v);
    v += dpp_id<0x142, 0xa>(0.f, v); v += dpp_id<0x143, 0xc>(0.f, v); return v; }
__device__ __forceinline__ float wave_scan_max(float v) { const float NI = -3.0e38f;
    v = fmaxf(v, dpp_id<0x111, 0xf>(NI, v)); v = fmaxf(v, dpp_id<0x112, 0xf>(NI, v)); v = fmaxf(v, dpp_id<0x114, 0xf>(NI, v)); v = fmaxf(v, dpp_id<0x118, 0xf>(NI, v));
    v = fmaxf(v, dpp_id<0x142, 0xa>(NI, v)); v = fmaxf(v, dpp_id<0x143, 0xc>(NI, v)); return v; }
__device__ __forceinline__ void ph_topk(const P& p, LAS unsigned char* lds, int wg, int G) {
    const int tid = opaque_tid(), lane = tid & 63, wave = __builtin_amdgcn_readfirstlane(tid >> 6);
    LAS unsigned* hist = (LAS unsigned*)lds;
    LAS unsigned* cnt = hist + 1024;
    const float* affp = (const float*)(p.ws + WS_AFF);
    for (int ui = 0, u; (u = unit_of(wg, G, ui, 256)) < 256; ++ui) {
        const int b = u >> 4, e = u & 15, g = e * 16 + b;
        unsigned key[4];
#pragma unroll
        for (int i = 0; i < 4; ++i) key[i] = __builtin_bit_cast(unsigned, affp[((size_t)b * SEQ + i * 512 + tid) * 16 + e]);
        hist[tid] = 0u; hist[512 + tid] = 0u;
        __syncthreads();
        unsigned thr = 0u; int need = CAP;
#pragma unroll
        for (int ps = 0; ps < 4; ++ps) { const int sh = 24 - 8 * ps;
#pragma unroll
            for (int i = 0; i < 4; ++i) { const bool in = ps == 0 || (key[i] >> (sh + 8)) == (thr >> (sh + 8));
                if (in) __hip_atomic_fetch_add(hist + ps * 256 + ((key[i] >> sh) & 255u), 1u, __ATOMIC_RELAXED, __HIP_MEMORY_SCOPE_WORKGROUP); }
            __syncthreads();
            const int lp = 63 - lane; const u32x4 h4 = *(const LAS u32x4*)(hist + ps * 256 + 4 * lp);
            const int s4 = (int)(h4.x + h4.y + h4.z + h4.w), incl = (int)wave_scan_sum((float)s4), excl = incl - s4;
            const int Ls = __builtin_ctzll(__ballot(incl >= need));
            const int c3 = excl + (int)h4.w, c2 = c3 + (int)h4.z, c1 = c2 + (int)h4.y;
            const int Bl = 4 * lp + (c3 >= need ? 3 : c2 >= need ? 2 : c1 >= need ? 1 : 0), ab = c3 >= need ? excl : c2 >= need ? c3 : c1 >= need ? c2 : c1;
            thr |= (unsigned)__builtin_amdgcn_readlane(Bl, Ls) << sh; need -= __builtin_amdgcn_readlane(ab, Ls); }
        const unsigned long long lt = (1ull << lane) - 1ull;
        unsigned long long beq[4], bsel[4];
#pragma unroll
        for (int i = 0; i < 4; ++i) { beq[i] = __ballot(key[i] == thr); if (lane == 0) cnt[i * 8 + wave] = (unsigned)__popcll(beq[i]); }
        __syncthreads();
        { const float c = lane < 32 ? (float)cnt[lane & 31] : 0.f; const float ex = wave_scan_sum(c) - c;
#pragma unroll
          for (int i = 0; i < 4; ++i) { const int eqrank = (int)__builtin_bit_cast(float, __builtin_amdgcn_readlane(__builtin_bit_cast(int, ex), i * 8 + wave)) + __popcll(beq[i] & lt);
              const bool sel = key[i] > thr || (key[i] == thr && eqrank < need);
              bsel[i] = __ballot(sel); if (lane == 0) cnt[32 + i * 8 + wave] = (unsigned)__popcll(bsel[i]); } }
        __syncthreads();
        { const float c = lane < 32 ? (float)cnt[32 + (lane & 31)] : 0.f; const float ex = wave_scan_sum(c) - c;
          unsigned short* idx = (unsigned short*)(p.ws + WS_IDX) + g * CAP; float* gv = (float*)(p.ws + WS_GATEV) + g * CAP; short* slot = (short*)(p.ws + WS_SLOT) + ((size_t)b * 16 + e) * SEQ;
#pragma unroll
          for (int i = 0; i < 4; ++i) { const int sl = (int)__builtin_bit_cast(float, __builtin_amdgcn_readlane(__builtin_bit_cast(int, ex), i * 8 + wave)) + __popcll(bsel[i] & lt); const int tok = i * 512 + tid;
              const bool sel = (bsel[i] >> lane) & 1ull;
              if (sel) { idx[(((sl >> 7) * 64 + (sl & 63)) << 1) + ((sl >> 6) & 1)] = (unsigned short)tok; gv[sl] = __builtin_bit_cast(float, key[i]); }
              slot[tok] = sel ? (short)sl : (short)-1; } }
        __syncthreads();
    }
}

__device__ __forceinline__ float gelu_as(float v) {
    const float t = __builtin_amdgcn_rcpf(fabsf(v) * 0.2316418882f + 1.0f);
    float q = t * 0.5307027145f + (-0.7265760135f); q = q * t + 0.7107068705f; q = q * t + (-0.142248368f); q = q * t + 0.127414796f; q = q * t;
    const float m = v * (q * __builtin_amdgcn_exp2f(v * v * (-0.72134752044f)));
    return v < 0.f ? m : v - m;
}
constexpr int GM_PITCH = 264;
__device__ __forceinline__ void ph_gmlp(const P& p, int l, LAS unsigned char* lds, int wg, int G) {
    const int tid = opaque_tid(), lane = tid & 63, wave = __builtin_amdgcn_readfirstlane(tid >> 6), r = lane & 31, h = lane >> 5, q = lane >> 4, c = lane & 15;
    const bf16* proj = (const bf16*)(p.ws + WS_PROJ); bf16* mixcat = (bf16*)(p.ws + WS_MIXCAT);
    const bf16* wsb = (const bf16*)(p.ws + WS_WS) + (size_t)l * 4 * 128 * 128;
    for (int ui = 0, u; (u = unit_of(wg, G, ui, 256)) < 256; ++ui) {
        const size_t m0 = (size_t)u * 128;
#pragma unroll
        for (int it = 0; it < 4; ++it) { const int t = wave * 16 + it * 4 + q;
            const bf16* src = proj + (m0 + t) * PN + C_GV + 8 * c; const u32x4 x0 = *(const u32x4*)src, x1 = *(const u32x4*)(src + 128);
            float v[16];
#pragma unroll
            for (int i = 0; i < 4; ++i) { v[2 * i] = gelu_as(bflo(x0[i])); v[2 * i + 1] = gelu_as(bfhi(x0[i])); v[8 + 2 * i] = gelu_as(bflo(x1[i])); v[8 + 2 * i + 1] = gelu_as(bfhi(x1[i])); }
            float s = 0.f;
#pragma unroll
            for (int i = 0; i < 16; ++i) s += v[i];
            const float mean = r16_sum(s) * (1.f / 256.f); float qq = 0.f;
#pragma unroll
            for (int i = 0; i < 16; ++i) { v[i] -= mean; qq += v[i] * v[i]; }
            const float rstd = 1.0f / sqrtf(r16_sum(qq) * (1.f / 256.f) + LN_EPS);
            u32x4 o0, o1;
#pragma unroll
            for (int i = 0; i < 4; ++i) { o0[i] = pk2(v[2 * i] * rstd, v[2 * i + 1] * rstd); o1[i] = pk2(v[8 + 2 * i] * rstd, v[8 + 2 * i + 1] * rstd); }
            *(LAS u32x4*)(lds + (t * GM_PITCH + 8 * c) * 2) = o0; *(LAS u32x4*)(lds + (t * GM_PITCH + 128 + 8 * c) * 2) = o1; }
        __syncthreads();
        const int tt = wave & 3, ch = wave >> 2, t = tt * 32 + r;
        u32x2 uu[4][4];
#pragma unroll
        for (int ti = 0; ti < 4; ++ti)
#pragma unroll
            for (int rg = 0; rg < 4; ++rg) uu[ti][rg] = *(const u32x2*)(proj + (m0 + t) * PN + C_GU + ch * 128 + ti * 32 + 8 * rg + 4 * h);
        const int G4 = lane >> 4, q4 = c >> 2, p4 = c & 3;
#pragma unroll
        for (int gi = 0; gi < 2; ++gi) { const int g = ch * 2 + gi;
            bf16x8 wf[8];
#pragma unroll
            for (int ks = 0; ks < 8; ++ks) wf[ks] = *(const bf16x8*)(wsb + ((size_t)g * 128 + t) * 128 + ks * 16 + 8 * h);
            const float bias = p.b_s[(l * 4 + g) * 128 + t];
#pragma unroll
            for (int ci = 0; ci < 2; ++ci) { const int c0 = g * 64 + ci * 32, ti = gi * 2 + ci;
                f32x16 acc; for (int i = 0; i < 16; ++i) acc[i] = 0.f;
                const LAS unsigned char* vb = lds + ((8 * (G4 >> 1) + q4) * GM_PITCH + c0 + 16 * (G4 & 1) + 4 * p4) * 2;
#pragma unroll
                for (int ks = 0; ks < 8; ++ks) { const bf16x8 af = cat8(tr_read(vb + (ks * 16) * GM_PITCH * 2), tr_read(vb + (ks * 16 + 4) * GM_PITCH * 2)); acc = MFMA32(af, wf[ks], acc); }
                bf16* op = mixcat + (m0 + t) * DM + 768 + c0;
#pragma unroll
                for (int rg = 0; rg < 4; ++rg) { const u32x2 w = uu[ti][rg]; u32x2 o;
                    o.x = pk2(gelu_as(bflo(w.x)) * (acc[4 * rg] + bias), gelu_as(bfhi(w.x)) * (acc[4 * rg + 1] + bias));
                    o.y = pk2(gelu_as(bflo(w.y)) * (acc[4 * rg + 2] + bias), gelu_as(bfhi(w.y)) * (acc[4 * rg + 3] + bias));
                    *(u32x2*)(op + 8 * rg + 4 * h) = o; } } }
        __syncthreads();
    }
}

constexpr int AT_PITCH = 144;
constexpr int AT_K = 0, AT_V = 384 * AT_PITCH, AT_BIAS = 2 * 384 * AT_PITCH, AT_BYTES = AT_BIAS + 8 * 257 * 4;
#define AT_SOFTMAX(st, bth_, mrun_, lsum_, oa_, ob_, l2_) do { float mt_ = -3.0e38f; \
        if (diag) { _Pragma("unroll") for (int reg = 0; reg < 16; ++reg) { const int band = band0 + crow(reg, h), rel = band - 128 - qloc; const bool ok = (rel >= -128) && (rel <= 128); \
                const float bias = (bth_)[ok ? band : 128 + qloc]; l2_[reg] = (st[reg] * (0.125f * L2E) + bias) + (ok ? 0.f : -3.0e38f); mt_ = fmaxf(mt_, l2_[reg]); } }   \
        else { _Pragma("unroll") for (int reg = 0; reg < 16; ++reg) { l2_[reg] = st[reg] * (0.125f * L2E) + (bth_)[band0 + crow(reg, h)]; mt_ = fmaxf(mt_, l2_[reg]); } } \
        { const auto rr_ = __builtin_amdgcn_permlane32_swap(__float_as_uint(mt_), __float_as_uint(mt_), false, false); mt_ = fmaxf(__uint_as_float(rr_[0]), __uint_as_float(rr_[1])); } \
        const float mnew_ = fmaxf(mrun_, mt_); \
        if (__any(mnew_ > mrun_)) { const float f_ = __builtin_amdgcn_exp2f(mrun_ - mnew_); lsum_ *= f_; _Pragma("unroll") for (int i = 0; i < 16; ++i) { oa_[i] *= f_; ob_[i] *= f_; } mrun_ = mnew_; } \
        float ps_ = 0.f; _Pragma("unroll") for (int reg = 0; reg < 16; ++reg) { l2_[reg] = __builtin_amdgcn_exp2f(l2_[reg] - mrun_); ps_ += l2_[reg]; } \
        lsum_ += ps_; } while (0)
__device__ __forceinline__ void ph_attn(const P& p, int l, LAS unsigned char* lds, int wg, int G) {
    const int tid = opaque_tid(), lane = tid & 63, wave = __builtin_amdgcn_readfirstlane(tid >> 6), r = lane & 31, h = lane >> 5;
    const bf16* proj = (const bf16*)(p.ws + WS_PROJ); bf16* mixcat = (bf16*)(p.ws + WS_MIXCAT);
    LAS float* bt = (LAS float*)(lds + AT_BIAS);
    const float L2E = 1.4426950408889634f;
    for (int i = tid; i < 8 * 257; i += 512) { const int hd = i / 257, rr = i - hd * 257; bt[i] = p.rel_bias[t5_bucket(rr - 128) * 8 + hd] * L2E; }
    for (int ui = 0, u; (u = unit_of(wg, G, ui, 512)) < 512; ++ui) {
        const int b = u >> 5, n = (u >> 1) & 15, hk = u & 1;
        { u32x4 kv[6], vv[6];
#pragma unroll
          for (int i = 0; i < 6; ++i) { const int id = i * 512 + tid, row = id >> 3, chn = id & 7; int pos = (n - 1) * 128 + row; pos = pos < 0 ? 0 : (pos > SEQ - 1 ? SEQ - 1 : pos);
              const bf16* src = proj + ((size_t)b * SEQ + pos) * PN + hk * 64 + chn * 8; kv[i] = *(const u32x4*)(src + C_AK); vv[i] = *(const u32x4*)(src + C_AV); }
#pragma unroll
          for (int i = 0; i < 6; ++i) { const int id = i * 512 + tid, row = id >> 3, chn = id & 7;
              *(LAS u32x4*)(lds + AT_K + row * AT_PITCH + chn * 16) = kv[i]; *(LAS u32x4*)(lds + AT_V + row * AT_PITCH + chn * 16) = vv[i]; } }
        const int tq = wave & 3, hh0 = (wave >> 2) * 2, qloc = tq * 32 + r; const size_t m = (size_t)b * SEQ + n * 128 + qloc;
        bf16x8 qa[4], qb[4];
#pragma unroll
        for (int s = 0; s < 4; ++s) { qa[s] = *(const bf16x8*)(proj + m * PN + C_AQ + (hk * 4 + hh0) * 64 + s * 16 + 8 * h); qb[s] = *(const bf16x8*)(proj + m * PN + C_AQ + (hk * 4 + hh0 + 1) * 64 + s * 16 + 8 * h); }
        const float sinka = p.sink[l * 8 + hk * 4 + hh0] * L2E, sinkb = p.sink[l * 8 + hk * 4 + hh0 + 1] * L2E;
        __syncthreads();
        float mra = sinka, mrb = sinkb, lsa = 0.f, lsb = 0.f; f32x16 oa0, oa1, ob0, ob1; for (int i = 0; i < 16; ++i) { oa0[i] = 0.f; oa1[i] = 0.f; ob0[i] = 0.f; ob1[i] = 0.f; }
        const LAS float* btha = bt + (hk * 4 + hh0) * 257 - qloc; const LAS float* bthb = btha + 257;
        const int G4 = lane >> 4, i16 = lane & 15, q4 = i16 >> 2, p4 = i16 & 3;
#pragma unroll 1
        for (int kt = 0; kt < 12; ++kt) { const int kb = kt >> 2, tk = kt & 3;
            const int blk = n - 1 + kb; if (blk < 0 || blk > 15) continue;
            if (kb == 0 && tk < tq) continue; if (kb == 2 && tk > tq) continue;
            const bool diag = (kb != 1) && (tk == tq);
            const int band0 = kb * 128 + tk * 32;
            f32x16 sa, sb; for (int i = 0; i < 16; ++i) { sa[i] = 0.f; sb[i] = 0.f; }
#pragma unroll
            for (int s = 0; s < 4; ++s) { const bf16x8 kf = *(const LAS bf16x8*)(lds + AT_K + (band0 + r) * AT_PITCH + (s * 16 + 8 * h) * 2); sa = MFMA32(kf, qa[s], sa); sb = MFMA32(kf, qb[s], sb); }
            float la[16], lb[16];
            AT_SOFTMAX(sa, btha, mra, lsa, oa0, oa1, la);
            AT_SOFTMAX(sb, bthb, mrb, lsb, ob0, ob1, lb);
            const bf16x8 pa0 = pack8(la[0], la[1], la[2], la[3], la[4], la[5], la[6], la[7]), pa1 = pack8(la[8], la[9], la[10], la[11], la[12], la[13], la[14], la[15]);
            const bf16x8 pb0 = pack8(lb[0], lb[1], lb[2], lb[3], lb[4], lb[5], lb[6], lb[7]), pb1 = pack8(lb[8], lb[9], lb[10], lb[11], lb[12], lb[13], lb[14], lb[15]);
            const LAS unsigned char* vb = lds + AT_V + (band0 + 4 * (G4 >> 1) + q4) * AT_PITCH + (16 * (G4 & 1) + 4 * p4) * 2;
#pragma unroll
            for (int s = 0; s < 2; ++s) {
                const bf16x8 va0 = cat8(tr_read(vb + (16 * s) * AT_PITCH), tr_read(vb + (16 * s + 8) * AT_PITCH));
                const bf16x8 va1 = cat8(tr_read(vb + (16 * s) * AT_PITCH + 64), tr_read(vb + (16 * s + 8) * AT_PITCH + 64));
                oa0 = MFMA32(va0, s ? pa1 : pa0, oa0); oa1 = MFMA32(va1, s ? pa1 : pa0, oa1); ob0 = MFMA32(va0, s ? pb1 : pb0, ob0); ob1 = MFMA32(va1, s ? pb1 : pb0, ob1); }
        }
#pragma unroll
        for (int x = 0; x < 2; ++x) { float ls = x ? lsb : lsa; const float mr = x ? mrb : mra, sk = x ? sinkb : sinka;
            ls += __shfl_xor(ls, 32); ls += __builtin_amdgcn_exp2f(sk - mr);
            const float inv = 1.0f / ls; const f32x16 o0 = x ? ob0 : oa0, o1 = x ? ob1 : oa1;
            bf16* op = mixcat + m * DM + (hk * 4 + hh0 + x) * 64;
#pragma unroll
            for (int rg = 0; rg < 4; ++rg) { u32x2 w0, w1;
                w0.x = cvtpk(o0[4 * rg] * inv, o0[4 * rg + 1] * inv); w0.y = cvtpk(o0[4 * rg + 2] * inv, o0[4 * rg + 3] * inv);
                w1.x = cvtpk(o1[4 * rg] * inv, o1[4 * rg + 1] * inv); w1.y = cvtpk(o1[4 * rg + 2] * inv, o1[4 * rg + 3] * inv);
                *(u32x2*)(op + 8 * rg + 4 * h) = w0; *(u32x2*)(op + 32 + 8 * rg + 4 * h) = w1; } }
        __syncthreads();
    }
}
#undef AT_SOFTMAX

struct GateVec { int ta, tb; float b0, b1, fs0, fs1, pm0, pm1, total, mx; };
struct GateRaw { float ig0, ig1, f0, f1; };
__device__ __forceinline__ GateRaw gate_loads(const float* gates, size_t m0, int head, int dir, int lane) {
    const int ta = dir == 0 ? 2 * lane : 127 - 2 * lane, tb = dir == 0 ? ta + 1 : ta - 1;
    const float* ga = gates + (m0 + ta) * 16 + dir * 8 + head; const float* gb = gates + (m0 + tb) * 16 + dir * 8 + head;
    GateRaw g; g.ig0 = ga[0]; g.ig1 = gb[0]; g.f0 = ga[4]; g.f1 = gb[4]; return g; }
__device__ __forceinline__ GateVec gate_vectors(const GateRaw& g, int dir, int lane) {
    GateVec r; r.ta = dir == 0 ? 2 * lane : 127 - 2 * lane; r.tb = dir == 0 ? r.ta + 1 : r.ta - 1;
    const float ig0 = g.ig0, ig1 = g.ig1, lf0 = logsigmoid_f(g.f0), lf1 = logsigmoid_f(g.f1);
    const float s = lf0 + lf1, incl = wave_scan_sum(s), excl = incl - s;
    r.total = __builtin_bit_cast(float, __builtin_amdgcn_readlane(__builtin_bit_cast(int, incl), 63));
    r.b0 = excl + lf0; r.b1 = r.b0 + lf1; r.fs0 = ig0 - r.b0; r.fs1 = ig1 - r.b1;
    const float pi = wave_scan_max(fmaxf(r.fs0, r.fs1)), pe = dpp_id<0x138, 0xf>(-3.0e38f, pi);
    r.pm0 = fmaxf(pe, r.fs0); r.pm1 = fmaxf(r.pm0, r.fs1);
    r.mx = __builtin_bit_cast(float, __builtin_amdgcn_readlane(__builtin_bit_cast(int, pi), 63));
    return r;
}
constexpr int MA_P = 144;
constexpr int MA_K = 0, MA_VW = 128 * MA_P, MA_WEXP = 3 * 128 * MA_P, MA_BYTES = MA_WEXP + 1024;
__device__ __forceinline__ void ph_mlstm_a(const P& p, int l, LAS unsigned char* lds, int wg, int G) {
    const int tid = opaque_tid(), lane = tid & 63, wave = __builtin_amdgcn_readfirstlane(tid >> 6), r = lane & 31, h = lane >> 5;
    const bf16* proj = (const bf16*)(p.ws + WS_PROJ); bf16* qkt = (bf16*)(p.ws + WS_QKT); const float* gates = (const float*)(p.ws + WS_GATES);
    bf16* DC = (bf16*)(p.ws + WS_DC); float* DN = (float*)(p.ws + WS_DN); float* DS = (float*)(p.ws + WS_DS);
    LAS float* wexp = (LAS float*)(lds + MA_WEXP);
    const int c8 = tid & 7, isk = (tid >> 3) & 1, tq = tid >> 4, tv = tid >> 3;
    for (int ui = 0, u; (u = unit_of(wg, G, ui, 1024)) < 1024; ++ui) {
        const int b = u >> 6, head = (u >> 4) & 3, chunk = u & 15; const size_t m0 = (size_t)b * SEQ + chunk * 128;
        const GateRaw graw = gate_loads(gates, m0, head, wave & 1, lane);
        f32x4 wv[8];
        { const float* cwp = p.conv_w + (size_t)l * 3 * 512 + isk * 256 + head * 64 + c8 * 8; const float* cbp = p.conv_b + l * 512 + isk * 256 + head * 64 + c8 * 8;
#pragma unroll
          for (int tap = 0; tap < 3; ++tap) { wv[2 * tap] = *(const f32x4*)(cwp + tap * 512); wv[2 * tap + 1] = *(const f32x4*)(cwp + tap * 512 + 4); }
          wv[6] = *(const f32x4*)cbp; wv[7] = *(const f32x4*)(cbp + 4); }
        u32x4 xl[3][4];
#pragma unroll
        for (int i = 0; i < 4; ++i) { const int t = tq + 32 * i, tpos = chunk * 128 + t; const bf16* pr = proj + (m0 + t) * PN + (isk ? C_MK : C_MQ) + head * 64 + c8 * 8;
            xl[1][i] = *(const u32x4*)pr; xl[0][i] = *(const u32x4*)(tpos > 0 ? pr - PN : pr); xl[2][i] = *(const u32x4*)(tpos < SEQ - 1 ? pr + PN : pr); }
        u32x4 vpre[2];
#pragma unroll
        for (int i = 0; i < 2; ++i) vpre[i] = *(const u32x4*)(proj + (m0 + tv + 64 * i) * PN + C_MV + head * 64 + c8 * 8);
        if (wave < 2) { const int dir = wave; const GateVec gv = gate_vectors(graw, dir, lane);
            wexp[dir * 128 + gv.ta] = __expf(gv.fs0 - gv.mx); wexp[dir * 128 + gv.tb] = __expf(gv.fs1 - gv.mx);
            if (lane == 0) { DS[(size_t)(u * 2 + dir) * 2] = gv.total; DS[(size_t)(u * 2 + dir) * 2 + 1] = gv.total + gv.mx; } }
        { const float sc = isk ? 0.125f : 1.0f;
#pragma unroll
          for (int i = 0; i < 4; ++i) { const int t = tq + 32 * i, tpos = chunk * 128 + t; const bool hp = tpos > 0, hn = tpos < SEQ - 1;
              const u32x4 z = (u32x4){0u, 0u, 0u, 0u}; const u32x4 x0 = hp ? xl[0][i] : z, x1 = xl[1][i], x2 = hn ? xl[2][i] : z;
              float y[8];
#pragma unroll
              for (int q = 0; q < 4; ++q) { const int c = 2 * q;
                  y[c] = wv[6 + (c >> 2)][c & 3] + wv[c >> 2][c & 3] * bflo(x0[q]) + wv[2 + (c >> 2)][c & 3] * bflo(x1[q]) + wv[4 + (c >> 2)][c & 3] * bflo(x2[q]);
                  y[c + 1] = wv[6 + (c >> 2)][(c & 3) + 1] + wv[c >> 2][(c & 3) + 1] * bfhi(x0[q]) + wv[2 + (c >> 2)][(c & 3) + 1] * bfhi(x1[q]) + wv[4 + (c >> 2)][(c & 3) + 1] * bfhi(x2[q]); }
#pragma unroll
              for (int k = 0; k < 8; ++k) y[k] = silu_acc(y[k]) * sc;
              u32x4 o; o.x = pk2(y[0], y[1]); o.y = pk2(y[2], y[3]); o.z = pk2(y[4], y[5]); o.w = pk2(y[6], y[7]);
              *(u32x4*)(qkt + (m0 + t) * 512 + isk * 256 + head * 64 + c8 * 8) = o;
              if (isk) *(LAS u32x4*)(lds + MA_K + t * MA_P + c8 * 16) = o; } }
        __syncthreads();
#pragma unroll
        for (int i = 0; i < 2; ++i) { const int t = tv + 64 * i; const float wf = wexp[t], wb = wexp[128 + t]; const u32x4 x = vpre[i]; u32x4 of, ob;
#pragma unroll
            for (int q = 0; q < 4; ++q) { const float lo = bflo(x[q]), hi = bfhi(x[q]); of[q] = pk2(lo * wf, hi * wf); ob[q] = pk2(lo * wb, hi * wb); }
            *(LAS u32x4*)(lds + MA_VW + t * MA_P + c8 * 16) = of; *(LAS u32x4*)(lds + MA_VW + (128 + t) * MA_P + c8 * 16) = ob; }
        __syncthreads();
        { const int dir = wave >> 2, et = (wave >> 1) & 1, dt = wave & 1;
          const int G4 = lane >> 4, i16 = lane & 15, q4 = i16 >> 2, p4 = i16 & 3;
          const LAS unsigned char* ab = lds + MA_VW + (dir * 128 + 4 * (G4 >> 1) + q4) * MA_P + (et * 32 + 16 * (G4 & 1) + 4 * p4) * 2;
          const LAS unsigned char* bb = lds + MA_K + (4 * (G4 >> 1) + q4) * MA_P + (dt * 32 + 16 * (G4 & 1) + 4 * p4) * 2;
          f32x16 acc, accn; for (int i = 0; i < 16; ++i) { acc[i] = 0.f; accn[i] = 0.f; }
#pragma unroll
          for (int ks = 0; ks < 8; ++ks) { const bf16x8 af = cat8(tr_read(ab + (16 * ks) * MA_P), tr_read(ab + (16 * ks + 8) * MA_P)), kf = cat8(tr_read(bb + (16 * ks) * MA_P), tr_read(bb + (16 * ks + 8) * MA_P));
              acc = MFMA32(af, kf, acc);
              if (et == 0) { const f32x4 w0 = *(const LAS f32x4*)(wexp + dir * 128 + 16 * ks + 4 * h), w1 = *(const LAS f32x4*)(wexp + dir * 128 + 16 * ks + 8 + 4 * h);
                  const bool r0 = r == 0; const bf16x8 wa = pack8(r0 ? w0[0] : 0.f, r0 ? w0[1] : 0.f, r0 ? w0[2] : 0.f, r0 ? w0[3] : 0.f, r0 ? w1[0] : 0.f, r0 ? w1[1] : 0.f, r0 ? w1[2] : 0.f, r0 ? w1[3] : 0.f);
                  accn = MFMA32(wa, kf, accn); } }
          bf16* dc = DC + (size_t)(u * 2 + dir) * 4096;
#pragma unroll
          for (int reg = 0; reg < 16; ++reg) dc[(et * 32 + crow(reg, h)) * 64 + dt * 32 + r] = (bf16)f2bf(acc[reg]);
          if (et == 0 && h == 0) DN[(size_t)(u * 2 + dir) * 64 + dt * 32 + r] = accn[0]; }
        __syncthreads();
    }
}
constexpr int MC_PITCH = 144;
constexpr int MC_Q = 0, MC_K = 128 * MC_PITCH, MC_V = 2 * 128 * MC_PITCH, MC_C = 3 * 128 * MC_PITCH;
constexpr int MC_X = 131072 + 1024;
constexpr int MC_VEC = MC_X, MC_COEF = MC_VEC + 3072, MC_MS = MC_COEF + 512, MC_N = MC_MS + 64;
constexpr int MC_HP = 66;
__device__ __forceinline__ void ph_mlstm_c(const P& p, int l, LAS unsigned char* lds, int wg, int G) {
    const int tid = opaque_tid(), lane = tid & 63, wave = __builtin_amdgcn_readfirstlane(tid >> 6), r = lane & 31, h = lane >> 5;
    const bf16* proj = (const bf16*)(p.ws + WS_PROJ); const bf16* qkt = (const bf16*)(p.ws + WS_QKT); const float* gates = (const float*)(p.ws + WS_GATES); bf16* mixcat = (bf16*)(p.ws + WS_MIXCAT);
    const bf16* DC = (const bf16*)(p.ws + WS_DC); const float* DN = (const float*)(p.ws + WS_DN); const float* DS = (const float*)(p.ws + WS_DS);
    LAS float* nvecS = (LAS float*)(lds + MC_N); LAS float* vfs = (LAS float*)(lds + MC_VEC); LAS float* vM = vfs + 256; LAS float* vb = vfs + 512;
    LAS float* coefS = (LAS float*)(lds + MC_COEF); LAS float* mS = (LAS float*)(lds + MC_MS);
    LAS unsigned short* hbuf = (LAS unsigned short*)lds;
    for (int ui = 0, u4; (u4 = unit_of(wg, G, ui, 256)) < 256; ++ui) {
        const int b = u4 >> 4, head = (u4 >> 2) & 3, c0 = (u4 & 3) * 4, ubase = (b * 4 + head) * 16;
        u32x4 dcr[18]; float dnr[18];
        { const f32x2c dsv = *(const f32x2c*)(DS + (size_t)((ubase + (lane & 15)) * 2 + (wave & 1)) * 2);
#pragma unroll
          for (int i = 0; i < 18; ++i) { const int dj = i >= c0 + 3 ? 1 : 0, j = dj ? i - 2 : i;
              dcr[i] = *(const u32x4*)(DC + (size_t)((ubase + j) * 2 + dj) * 4096 + tid * 8);
              dnr[i] = DN[(size_t)((ubase + j) * 2 + dj) * 64 + lane]; }
          const int dir = wave & 1, chunk = c0 + (wave >> 1), n = dir == 0 ? chunk : 15 - chunk;
          const bool in16 = lane < 16, valid = in16 && (dir == 0 ? lane < chunk : lane > chunk);
          const float bLv = in16 ? dsv[0] : 0.f, mlv = dsv[1];
          const float Pf = wave_scan_sum(bLv);
          const float Pc1 = __shfl(Pf, chunk > 0 ? chunk - 1 : 0), Pc = __shfl(Pf, chunk), P15 = __shfl(Pf, 15);
          const float Si = dir == 0 ? Pc1 - Pf : (Pf - bLv) - Pc, Sall = dir == 0 ? Pc1 : P15 - Pc;
          const float cand = valid ? mlv + Si : -3.0e38f;
          const float m = n > 0 ? fmaxf(Sall, wave_max(cand)) : 0.f;
          if (in16) coefS[wave * 16 + lane] = valid ? __expf(cand - m) : 0.f;
          if (lane == 0) mS[wave] = m; }
        __syncthreads();
        { float acc[4][8], accn[4];
#pragma unroll
          for (int k = 0; k < 4; ++k) { accn[k] = 0.f;
#pragma unroll
              for (int e = 0; e < 8; ++e) acc[k][e] = 0.f; }
#pragma unroll
          for (int i = 0; i < 18; ++i) { const int dj = i >= c0 + 3 ? 1 : 0, j = dj ? i - 2 : i;
              float x[8];
#pragma unroll
              for (int q = 0; q < 4; ++q) { x[2 * q] = bflo(dcr[i][q]); x[2 * q + 1] = bfhi(dcr[i][q]); }
#pragma unroll
              for (int k = 0; k < 4; ++k) { const float cf = coefS[(k * 2 + dj) * 16 + j]; accn[k] += cf * dnr[i];
#pragma unroll
                  for (int e = 0; e < 8; ++e) acc[k][e] += cf * x[e]; }
              if (i == 17 || ((i == 2 || i == 6 || i == 10 || i == 14) && i == c0 + 2)) { const int dd = i == 17 ? 1 : 0;
#pragma unroll
                  for (int k = 0; k < 4; ++k) { u32x4 o;
#pragma unroll
                      for (int q = 0; q < 4; ++q) o[q] = pk2(acc[k][2 * q], acc[k][2 * q + 1]);
                      *(LAS u32x4*)(lds + MC_C + ((k * 2 + dd) * 64 + (tid >> 3)) * MC_PITCH + (tid & 7) * 16) = o;
                      if (tid < 64) nvecS[(k * 2 + dd) * 64 + tid] = accn[k];
                      accn[k] = 0.f;
#pragma unroll
                      for (int e = 0; e < 8; ++e) acc[k][e] = 0.f; } } } }
#pragma unroll 1
        for (int kc = 0; kc < 4; ++kc) { const int chunk = c0 + kc; const size_t m0 = (size_t)b * SEQ + chunk * 128;
        const GateRaw graw = gate_loads(gates, m0, head, wave & 1, lane);
        u32x4 stg[6];
#pragma unroll
        for (int i = 0; i < 6; ++i) { const int id = i * 512 + tid, arr = id >> 10, rem = id & 1023, row = rem >> 3, chn = rem & 7;
            const bf16* src = arr == 2 ? proj + (m0 + row) * PN + C_MV + head * 64 + chn * 8 : qkt + (m0 + row) * 512 + arr * 256 + head * 64 + chn * 8;
            stg[i] = *(const u32x4*)src; }
        u32x4 mopre[2];
#pragma unroll
        for (int i = 0; i < 2; ++i) { const int id = i * 512 + tid; mopre[i] = *(const u32x4*)(proj + (m0 + (id >> 3)) * PN + C_MO + head * 64 + (id & 7) * 8); }
        if (wave < 2) { const int dir = wave; const GateVec gv = gate_vectors(graw, dir, lane);
            vfs[dir * 128 + gv.ta] = gv.fs0; vfs[dir * 128 + gv.tb] = gv.fs1;
            vM[dir * 128 + gv.ta] = gv.pm0; vM[dir * 128 + gv.tb] = gv.pm1;
            vb[dir * 128 + gv.ta] = gv.b0; vb[dir * 128 + gv.tb] = gv.b1; }
#pragma unroll
        for (int i = 0; i < 6; ++i) { const int id = i * 512 + tid, arr = id >> 10, rem = id & 1023, row = rem >> 3, chn = rem & 7;
            *(LAS u32x4*)(lds + arr * 128 * MC_PITCH + row * MC_PITCH + chn * 16) = stg[i]; }
        __syncthreads();
        const int dir = wave >> 2, tt = wave & 3, t = tt * 32 + r;
        const LAS unsigned char* Cs = lds + MC_C + (kc * 2 + dir) * 64 * MC_PITCH; const LAS float* nvec = nvecS + (kc * 2 + dir) * 64; const float mC = mS[kc * 2 + dir];
        f32x16 nS0, nS1, nI0, nI1; for (int i = 0; i < 16; ++i) { nS0[i] = 0.f; nS1[i] = 0.f; nI0[i] = 0.f; nI1[i] = 0.f; }
        float dinv, iw;
        {
            bf16x8 qf[4];
#pragma unroll
            for (int s = 0; s < 4; ++s) qf[s] = *(const LAS bf16x8*)(lds + MC_Q + t * MC_PITCH + (s * 16 + 8 * h) * 2);
            const float Mt = fmaxf(mC, vM[dir * 128 + t]); float rowsum = 0.f;
#pragma unroll 1
            for (int st = 0; st < 4; ++st) { if (dir == 0 ? st > tt : st < tt) continue;
                f32x16 sT; for (int i = 0; i < 16; ++i) sT[i] = 0.f;
#pragma unroll
                for (int s = 0; s < 4; ++s) { const bf16x8 kf = *(const LAS bf16x8*)(lds + MC_K + (st * 32 + r) * MC_PITCH + (s * 16 + 8 * h) * 2); sT = MFMA32(kf, qf[s], sT); }
                float pv[16];
#pragma unroll
                for (int rg = 0; rg < 4; ++rg) { const f32x4 f4 = *(const LAS f32x4*)(vfs + dir * 128 + st * 32 + 8 * rg + 4 * h);
#pragma unroll
                    for (int k = 0; k < 4; ++k) { const int si = st * 32 + 8 * rg + 4 * h + k; const bool ok = dir == 0 ? si <= t : si >= t;
                        const float dv = ok ? __expf(f4[k] - Mt) : 0.f; pv[4 * rg + k] = sT[4 * rg + k] * dv; rowsum += pv[4 * rg + k]; } }
                const bf16x8 pf0 = pack8(pv[0], pv[1], pv[2], pv[3], pv[4], pv[5], pv[6], pv[7]), pf1 = pack8(pv[8], pv[9], pv[10], pv[11], pv[12], pv[13], pv[14], pv[15]);
                const int G4 = lane >> 4, i16 = lane & 15, q4 = i16 >> 2, p4 = i16 & 3;
                const LAS unsigned char* vbp = lds + MC_V + (st * 32 + 4 * (G4 >> 1) + q4) * MC_PITCH + (16 * (G4 & 1) + 4 * p4) * 2;
#pragma unroll
                for (int s = 0; s < 2; ++s) { const bf16x8 pf = s ? pf1 : pf0;
                    const bf16x8 va0 = cat8(tr_read(vbp + (16 * s) * MC_PITCH), tr_read(vbp + (16 * s + 8) * MC_PITCH));
                    const bf16x8 va1 = cat8(tr_read(vbp + (16 * s) * MC_PITCH + 64), tr_read(vbp + (16 * s + 8) * MC_PITCH + 64));
                    nS0 = MFMA32(va0, pf, nS0); nS1 = MFMA32(va1, pf, nS1); }
            }
            float nq = 0.f;
#pragma unroll
            for (int s = 0; s < 4; ++s) { const bf16x8 cc0 = *(const LAS bf16x8*)(Cs + r * MC_PITCH + (s * 16 + 8 * h) * 2), cc1 = *(const LAS bf16x8*)(Cs + (32 + r) * MC_PITCH + (s * 16 + 8 * h) * 2);
                nI0 = MFMA32(cc0, qf[s], nI0); nI1 = MFMA32(cc1, qf[s], nI1);
#pragma unroll
                for (int j = 0; j < 8; ++j) nq += nvec[s * 16 + 8 * h + j] * bf2f((unsigned short)qf[s][j]); }
            nq += __shfl_xor(nq, 32); rowsum += __shfl_xor(rowsum, 32);
            iw = __expf(mC - Mt);
            const float den = rowsum + iw * nq, lower = __expf(-(vb[dir * 128 + t] + Mt));
            dinv = 1.0f / fmaxf(fabsf(den), lower);
        }
        __syncthreads();
#pragma unroll
        for (int reg = 0; reg < 16; ++reg) { const int e = crow(reg, h);
            hbuf[(dir * 128 + t) * MC_HP + e] = f2bf((nS0[reg] + iw * nI0[reg]) * dinv); hbuf[(dir * 128 + t) * MC_HP + 32 + e] = f2bf((nS1[reg] + iw * nI1[reg]) * dinv); }
        __syncthreads();
#pragma unroll
        for (int i = 0; i < 2; ++i) { const int id = i * 512 + tid, tq = id >> 3, e0 = (id & 7) * 8; float o[8];
#pragma unroll
            for (int k = 0; k < 4; ++k) { const unsigned wf = *(const LAS unsigned*)(hbuf + tq * MC_HP + e0 + 2 * k), wb = *(const LAS unsigned*)(hbuf + (128 + tq) * MC_HP + e0 + 2 * k);
                o[2 * k] = sigmoid_f(bflo(mopre[i][k])) * (bflo(wf) + bflo(wb)); o[2 * k + 1] = sigmoid_f(bfhi(mopre[i][k])) * (bfhi(wf) + bfhi(wb)); }
            u32x4 w; w.x = pk2(o[0], o[1]); w.y = pk2(o[2], o[3]); w.z = pk2(o[4], o[5]); w.w = pk2(o[6], o[7]);
            *(u32x4*)(mixcat + (m0 + tq) * DM + 512 + head * 64 + e0) = w; }
        __syncthreads();
        }
    }
}

typedef GAS unsigned gu32;
#define RLX_AGENT __ATOMIC_RELAXED, __HIP_MEMORY_SCOPE_AGENT
#define XB_TMO      128
#define XB_XCNT(j)  (256  + 64 * (j))
#define XB_XSUB(j)  (1280 + 64 * (j))
#define XB_XGEN(j)  (2304 + 64 * (j))
#define XB_TOP      3328
#define XB_TOPGEN   3392
#define XCD_BAR_WORDS 3456
#define XB_SPIN_CAP (1u << 18)

__device__ __forceinline__ unsigned xb_ld(unsigned* p)              { return __hip_atomic_load(p, __ATOMIC_RELAXED, __HIP_MEMORY_SCOPE_AGENT); }
__device__ __forceinline__ unsigned xb_add(unsigned* p, unsigned v) { return __hip_atomic_fetch_add(p, v, __ATOMIC_RELAXED, __HIP_MEMORY_SCOPE_AGENT); }
__device__ __forceinline__ unsigned xb_xcc_id() { return (unsigned)__builtin_amdgcn_s_getreg((3 << 11) | 20) & 0xFu; }
#define XB_SPIN(cond, bar) do { unsigned _sp = 0; while (cond) { __builtin_amdgcn_s_sleep(1); \
    if ((++_sp & 255u) == 0u) { if (xb_ld(&(bar)[XB_TMO])) break; if (_sp > XB_SPIN_CAP) { atomicAdd(&(bar)[XB_TMO], 1u); break; } } } } while (0)

struct XcdBarrier {
    unsigned* bar; unsigned x;
    volatile LAS unsigned* st;
};

__device__ __forceinline__ XcdBarrier xcd_barrier_post(unsigned* bar, volatile LAS unsigned* st) {
    XcdBarrier b; b.bar = bar; b.x = xb_xcc_id(); b.st = st;
    if (threadIdx.x == 0) (void)xb_add(&bar[XB_XCNT(b.x)], 1u);
    return b;
}
__device__ __forceinline__ void xcd_barrier_complete(unsigned* bar, unsigned x, unsigned& nloc, unsigned& nx) {
    const unsigned G = gridDim.x * gridDim.y * gridDim.z;
    unsigned sum, cnt, mine, sp = 0u;
    for (;;) {
        sum = 0u; cnt = 0u; mine = 0u;
#pragma unroll
        for (unsigned j = 0; j < 16; ++j) { const unsigned c = xb_ld(&bar[XB_XCNT(j)]); sum += c; cnt += (c > 0u) ? 1u : 0u; mine = (j == x) ? c : mine; }
        if (sum == G) break;
        __builtin_amdgcn_s_sleep(1);
        if ((++sp & 255u) == 0u) { if (xb_ld(&bar[XB_TMO])) break; if (sp > XB_SPIN_CAP) { atomicAdd(&bar[XB_TMO], 1u); break; } }
    }
    nloc = mine > 0u ? mine : 1u; nx = cnt > 0u ? cnt : 1u;
}

__device__ __forceinline__ void xcd_barrier(const XcdBarrier& b) {
    asm volatile("s_waitcnt vmcnt(0)" ::: "memory");
    __syncthreads();
    if (threadIdx.x == 0) {
        unsigned* bar = b.bar;
        __builtin_amdgcn_s_waitcnt(0);
        unsigned nloc = b.st[0], nx = b.st[1];
        if (nloc == 0u) { xcd_barrier_complete(bar, b.x, nloc, nx); b.st[0] = nloc; b.st[1] = nx; }
        const unsigned old = xb_add(&bar[XB_XSUB(b.x)], 1u);
        const unsigned gen = old / nloc;
        if (old + 1u == (gen + 1u) * nloc) {
            __builtin_amdgcn_fence(__ATOMIC_RELEASE, "agent");
            asm volatile("s_waitcnt vmcnt(0)" ::: "memory");
            const unsigned og = xb_add(&bar[XB_TOP], 1u);
            const unsigned tg = og / nx;
            if (og + 1u == (tg + 1u) * nx) xb_add(&bar[XB_TOPGEN], 1u);
            else XB_SPIN(xb_ld(&bar[XB_TOPGEN]) == tg, bar);
            __builtin_amdgcn_fence(__ATOMIC_ACQUIRE, "agent");
            xb_add(&bar[XB_XGEN(b.x)], 1u);
            asm volatile("s_waitcnt vmcnt(0)" ::: "memory");
        } else {
            XB_SPIN(xb_ld(&bar[XB_XGEN(b.x)]) == gen, bar);
            __builtin_amdgcn_fence(__ATOMIC_ACQUIRE, "agent");
            asm volatile("s_waitcnt vmcnt(0)" ::: "memory");
        }
    }
    __syncthreads();
}


constexpr int CW_Q = 8192;
__device__ __forceinline__ bool conv_batch(const P& p, int ql, volatile LAS unsigned* wl, LAS unsigned char* L) {
    const int tid = opaque_tid(), lane = tid & 63, wave = __builtin_amdgcn_readfirstlane(tid >> 6);
    if (tid == 0) wl[3] = __hip_atomic_fetch_add((unsigned*)(p.ws + WS_CTL) + CW_Q + 64 * ql, 8u, __ATOMIC_RELAXED, __HIP_MEMORY_SCOPE_AGENT);
    __syncthreads();
    const unsigned base = wl[3];
    if (base + wave < (unsigned)ITM) convert_item(p, ql, ITS + (int)base + wave, (LAS float*)L + wave * (64 * 33), lane);
    __syncthreads();
    return base + 8u < (unsigned)ITM;
}
__device__ __forceinline__ void conv_drain(const P& p, int& qa, int upto, volatile LAS unsigned* wl, LAS unsigned char* L) { while (qa <= upto) { if (!conv_batch(p, qa, wl, L)) ++qa; } }
__device__ __forceinline__ void xcd_barrier_work(const XcdBarrier& b, const P& p, int& qa, volatile LAS unsigned* wl, LAS unsigned char* L) {
    asm volatile("s_waitcnt vmcnt(0)" ::: "memory");
    __syncthreads();
    if (threadIdx.x == 0) {
        unsigned* bar = b.bar;
        __builtin_amdgcn_s_waitcnt(0);
        unsigned nloc = b.st[0], nx = b.st[1];
        if (nloc == 0u) { xcd_barrier_complete(bar, b.x, nloc, nx); b.st[0] = nloc; b.st[1] = nx; }
        const unsigned old = xb_add(&bar[XB_XSUB(b.x)], 1u);
        const unsigned gen = old / nloc;
        if (old + 1u == (gen + 1u) * nloc) {
            __builtin_amdgcn_fence(__ATOMIC_RELEASE, "agent");
            asm volatile("s_waitcnt vmcnt(0)" ::: "memory");
            const unsigned og = xb_add(&bar[XB_TOP], 1u);
            const unsigned tg = og / nx;
            if (og + 1u == (tg + 1u) * nx) { xb_add(&bar[XB_TOPGEN], 1u); wl[0] = 2u; }
            else { wl[0] = 1u; wl[1] = tg; }
        } else { wl[0] = 0u; wl[1] = gen; }
    }
    unsigned polls = 0u;
    for (;;) {
        if (threadIdx.x == 0) { unsigned* bar = b.bar; const unsigned role = wl[0], want = wl[1];
            bool done = role == 2u || (role == 1u ? xb_ld(&bar[XB_TOPGEN]) != want : xb_ld(&bar[XB_XGEN(b.x)]) != want);
            if (!done && (++polls & 255u) == 0u) { if (xb_ld(&bar[XB_TMO])) done = true; else if (polls > XB_SPIN_CAP) { atomicAdd(&bar[XB_TMO], 1u); done = true; } }
            wl[2] = done ? 1u : 0u; }
        __syncthreads();
        const bool done = wl[2] != 0u;
        __syncthreads();
        if (done) break;
        if (qa < DEPTH) { if (!conv_batch(p, qa, wl, L)) ++qa; } else __builtin_amdgcn_s_sleep(2);
    }
    if (threadIdx.x == 0) { unsigned* bar = b.bar;
        if (wl[0] != 0u) { __builtin_amdgcn_fence(__ATOMIC_ACQUIRE, "agent"); xb_add(&bar[XB_XGEN(b.x)], 1u); asm volatile("s_waitcnt vmcnt(0)" ::: "memory"); }
        else { __builtin_amdgcn_fence(__ATOMIC_ACQUIRE, "agent"); asm volatile("s_waitcnt vmcnt(0)" ::: "memory"); }
    }
    __syncthreads();
}

__device__ __forceinline__ void ph_mod(const P& p, LAS unsigned char* lds, int wg, int G) {
    const int tid = opaque_tid(), lane = tid & 63, wave = __builtin_amdgcn_readfirstlane(tid >> 6);
    LAS float* sc = (LAS float*)lds;
    LAS float* red = (LAS float*)(lds + 65536);
    if (wg >= 384) return;
    for (int i = tid; i < 16 * DM; i += 512) { const int b = i >> 10, k = i & 1023; sc[k * 16 + b] = silu_acc(p.c[i]); }
    __syncthreads();
    float* mod = (float*)(p.ws + WS_MOD);
    for (int u = wg; u < 384; u += G) { const int l = u / 96, n0 = (u % 96) * 64;
        const float* w = p.w_ada + (size_t)l * DM * 6144 + (size_t)(wave * 128) * 6144 + n0 + lane;
        float acc[16];
#pragma unroll
        for (int b = 0; b < 16; ++b) acc[b] = 0.f;
#pragma unroll 4
        for (int k = 0; k < 128; ++k) { const float wv = w[(size_t)k * 6144]; const LAS f32x4* s4 = (const LAS f32x4*)(sc + (wave * 128 + k) * 16);
#pragma unroll
            for (int q = 0; q < 4; ++q) { const f32x4 s = s4[q]; acc[4 * q] += s[0] * wv; acc[4 * q + 1] += s[1] * wv; acc[4 * q + 2] += s[2] * wv; acc[4 * q + 3] += s[3] * wv; } }
#pragma unroll
        for (int b = 0; b < 16; ++b) red[(wave * 16 + b) * 64 + lane] = acc[b];
        __syncthreads();
        for (int i = tid; i < 1024; i += 512) { const int b = i >> 6, c = i & 63; float s = p.b_ada[l * 6144 + n0 + c];
#pragma unroll
            for (int wv = 0; wv < 8; ++wv) s += red[(wv * 16 + b) * 64 + c];
            mod[((size_t)l * 16 + b) * 6144 + n0 + c] = s; }
        __syncthreads();
    }
}

constexpr int LDS_MAIN = 131072, LDS_TOTAL = 147456, MISC_OFF = LDS_MAIN + 320;
constexpr int CW_BAR = 4096;
constexpr size_t CTL_ZERO = 65536;
constexpr int NSEQ = 2 + 9 * DEPTH;
struct Args { P p; int lo, hi; };
typedef const __attribute__((address_space(4))) Args* kargs_t;
__global__ void __launch_bounds__(512, 2) mk_fwd(Args a) {
    extern __shared__ __attribute__((aligned(16))) unsigned char lds_raw[];
    LAS unsigned char* L = (LAS unsigned char*)lds_raw;
    kargs_t ap0 = (kargs_t)__builtin_amdgcn_kernarg_segment_ptr();
#define LOADP() kargs_t ap_ = ap0; asm volatile("" : "+s"(ap_)); const P p = {ap_->p.x, ap_->p.c, ap_->p.w_ada, ap_->p.b_ada, ap_->p.w_in, ap_->p.conv_w, ap_->p.conv_b, ap_->p.gate_b, ap_->p.sink, ap_->p.rel_bias, ap_->p.w_s, ap_->p.b_s, ap_->p.w_out, ap_->p.w_router, ap_->p.w_gate, ap_->p.w_up, ap_->p.w_down, ap_->p.ln_g, ap_->p.ln_b, ap_->p.out, ap_->p.ws}; unsigned char* ws = p.ws
    const int wg = blockIdx.x, G = gridDim.x;
    { const int tid = opaque_tid(); for (int i = tid; i < (LDS_TOTAL - LDS_MAIN) / 4; i += 512) ((LAS unsigned*)(L + LDS_MAIN))[i] = 0u; }
    __syncthreads();
    XcdBarrier bar;
    { LOADP(); bar = xcd_barrier_post((unsigned*)(ws + WS_CTL) + CW_BAR, (volatile LAS unsigned*)(L + MISC_OFF) + 8); }
    int seq = 0; int qa = 0;
#ifndef DUPM
#define DUPM 0
#endif
#define DUP(i) for (int rep_ = 0; rep_ < ((DUPM >> (i)) & 1); ++rep_)
#ifndef PHM
#define PHM 0xfffff
#endif
#define RUN() (seq >= a.lo && seq < a.hi)
#define SEAM() do { if (seq + 1 < a.hi) xcd_barrier_work(bar, p, qa, (volatile LAS unsigned*)(L + MISC_OFF) + 16, L); } while (0)
    if (((PHM >> 0) & 1) && RUN()) {
        LOADP(); ph_mod(p, L, wg, G);
        const int tid = opaque_tid(), lane = tid & 63, wave = __builtin_amdgcn_readfirstlane(tid >> 6), gw = wg * 8 + wave, ngw = G * 8;
        { LAS float* scr = (LAS float*)L + wave * (64 * 33); for (int it = gw; it < DEPTH * ITS; it += ngw) convert_item(p, it / ITS, it % ITS, scr, lane); }
        { bf16* wsb = (bf16*)(ws + WS_WS); for (int i = wg * 512 + tid; i < DEPTH * 4 * 128 * 128; i += G * 512) wsb[i] = (bf16)f2bf(p.w_s[i]); }
        SEAM(); }
    ++seq;
    if (((PHM >> 1) & 1) && RUN()) { LOADP(); rows_entry_simple(p, wg, G); SEAM(); }
    ++seq;
#pragma unroll 1
    for (int l = 0; l < DEPTH; ++l) {
        if (((PHM >> 2) & 1) && RUN()) { LOADP();
            pg8::Gemm g{(const bf16*)(ws + WS_H), (const bf16*)(ws + WS_WIN) + (size_t)l * PNW * DM, NTOK, PNW, DM}; pg8::EpiProj E{(bf16*)(ws + WS_PROJ), (float*)(ws + WS_GATES), p.gate_b + l * 16};
            pg8::StaticOrder S; S.init(NTOK, PNW, G, wg);
            pg8::gemm_phase<pg8::EpiProj, pg8::StaticOrder, true, true>(L, g, S, E); SEAM(); }
        ++seq;
        if (((PHM >> 3) & 1) && RUN()) { LOADP(); DUP(2) ph_attn(p, l, L, wg, G); ph_attn(p, l, L, wg, G); DUP(3) ph_gmlp(p, l, L, wg, G); ph_gmlp(p, l, L, wg, G); DUP(4) ph_mlstm_a(p, l, L, wg, G); ph_mlstm_a(p, l, L, wg, G); SEAM(); }
        ++seq;
        if (((PHM >> 4) & 1) && RUN()) { LOADP(); DUP(5) ph_mlstm_c(p, l, L, wg, G); ph_mlstm_c(p, l, L, wg, G); SEAM(); }
        ++seq;
        if (((PHM >> 5) & 1) && RUN()) { LOADP();
            pg8::Gemm g{(const bf16*)(ws + WS_MIXCAT), (const bf16*)(ws + WS_WOUT) + (size_t)l * DM * DM, NTOK, DM, DM}; pg8::EpiBf16 E{(bf16*)(ws + WS_MIX), DM};
            pg8::StaticOrder S; S.init(NTOK, DM, G, wg);
            pg8::gemm_phase<pg8::EpiBf16, pg8::StaticOrder, true, true>(L, g, S, E); SEAM(); }
        ++seq;
        if (((PHM >> 6) & 1) && RUN()) { LOADP(); DUP(9) rows_phase<1>(p, l, l == 0 ? p.x : (const float*)(ws + WS_XA), L, wg, G, true); rows_phase<1>(p, l, l == 0 ? p.x : (const float*)(ws + WS_XA), L, wg, G); SEAM(); }
        ++seq;
        if (((PHM >> 7) & 1) && RUN()) { LOADP(); ph_topk(p, L, wg, G); conv_drain(p, qa, l, (volatile LAS unsigned*)(L + MISC_OFF) + 16, L); SEAM(); }
        ++seq;
        if (((PHM >> 8) & 1) && RUN()) { LOADP();
            pg8::Gemm g{(const bf16*)(ws + WS_H8), (const bf16*)(ws + WS_WGU + (size_t)l * NE * 4096 * DM), NGRP * 256, 4096, DM, SC_A1, SC_B1}; pg8::EpiSwiGLU8 E{ws + WS_HID};
            pg8::MoeOrder1 S; S.G = G; S.c = wg; S.idx = (const unsigned short*)(ws + WS_IDX);
            pg8::gemm_phase<pg8::EpiSwiGLU8, pg8::MoeOrder1, true, true, true, true>(L, g, S, E); SEAM(); }
        ++seq;
        if (((PHM >> 9) & 1) && RUN()) { LOADP();
            pg8::Gemm g{(const bf16*)(ws + WS_HID), (const bf16*)(ws + WS_WD + (size_t)l * NE * DM * DE), NGRP * 256, DM, DE, SC_A2, SC_B2}; pg8::EpiScaleBf16 E{(bf16*)(ws + WS_YE), (const float*)(ws + WS_GATEV)};
            pg8::MoeOrder2 S; S.G = G; S.c = wg;
            pg8::gemm_phase<pg8::EpiScaleBf16, pg8::MoeOrder2, true, true, true>(L, g, S, E); SEAM(); }
        ++seq;
        if (((PHM >> 10) & 1) && RUN()) { LOADP(); DUP(10) rows_phase<2>(p, l, (const float*)(ws + WS_XA), L, wg, G, true); rows_phase<2>(p, l, (const float*)(ws + WS_XA), L, wg, G); SEAM(); }
        ++seq;
    }
#undef RUN
#undef SEAM
#undef LOADP
}

#ifndef MK_PER_PHASE
#define MK_PER_PHASE 0
#endif
extern "C" void kernel_launch(void* const* d_in, const int* in_sizes, int n_in, void* d_out, int out_size, void* d_ws, size_t ws_size, hipStream_t stream) {
    static int grid = 0;
    if (grid == 0) {
        if (n_in != 19 || in_sizes[0] != NTOK * DM || out_size != NTOK * DM || ws_size < WS_END) {
            fprintf(stderr, "kernel_launch: unexpected shapes: n_in %d in0 %d out %d ws %zu (need %zu)\n", n_in, n_in > 0 ? in_sizes[0] : -1, out_size, ws_size, (size_t)WS_END); grid = -1; return; }
        int dev = 0, cus = 0, per_cu = 0;
        if (hipGetDevice(&dev) != hipSuccess || hipDeviceGetAttribute(&cus, hipDeviceAttributeMultiprocessorCount, dev) != hipSuccess) { fprintf(stderr, "kernel_launch: device query failed\n"); grid = -1; return; }
        if (hipFuncSetAttribute((const void*)mk_fwd, hipFuncAttributeMaxDynamicSharedMemorySize, LDS_TOTAL) != hipSuccess) { fprintf(stderr, "kernel_launch: hipFuncSetAttribute failed\n"); grid = -1; return; }
        if (hipOccupancyMaxActiveBlocksPerMultiprocessor(&per_cu, (const void*)mk_fwd, 512, LDS_TOTAL) != hipSuccess || per_cu < 1) { fprintf(stderr, "kernel_launch: occupancy query reports %d blocks per CU\n", per_cu); }
        (void)hipGetLastError();
        grid = cus;
    }
    if (grid < 0) return;
    if (hipMemsetAsync((char*)d_ws + WS_CTL, 0, CTL_ZERO, stream) != hipSuccess) { fprintf(stderr, "kernel_launch: memset failed\n"); return; }
    Args a{};
    const float** pf = (const float**)&a.p;
    for (int i = 0; i < 19; ++i) pf[i] = (const float*)d_in[i];
    a.p.out = (float*)d_out; a.p.ws = (unsigned char*)d_ws;
#if MK_PER_PHASE
    for (int s = 0; s < NSEQ; ++s) { a.lo = s; a.hi = s + 1; hipLaunchKernelGGL(mk_fwd, dim3(grid), dim3(512), LDS_TOTAL, stream, a); }
#else
    a.lo = 0; a.hi = NSEQ;
    hipLaunchKernelGGL(mk_fwd, dim3(grid), dim3(512), LDS_TOTAL, stream, a);
#endif
    const hipError_t le = hipPeekAtLastError();
    if (le != hipSuccess) fprintf(stderr, "kernel_launch: launch failed: %s\n", hipGetErrorName(le));
}
```

```cpp
#include <hip/hip_runtime.h>
#include <cstdio>
#include <cstdint>
__device__ __forceinline__ int opaque_tid() { int t = threadIdx.x; asm volatile("" : "+v"(t)); return t; }
namespace pg8 {
#define PG8_LAS __attribute__((address_space(3)))
typedef unsigned short bf16_t;
typedef short bf16x8 __attribute__((ext_vector_type(8)));
typedef float f32x4 __attribute__((ext_vector_type(4)));
typedef unsigned u32x4 __attribute__((ext_vector_type(4)));
constexpr int BM = 256, BK = 64, HALF = 128, HTB = HALF * BK * 2  , STAGE_BYTES = 8 * HTB, NXCD = 8, WGM = 8;

__host__ __device__ __forceinline__ int lds_byte(int r, int c) { const int st = (r >> 4) * 2 + (c >> 5), rr = r & 15, cc = c & 31, ob = rr * 64 + cc * 2; return st * 1024 + (ob ^ (((ob >> 9) & 1) << 5)); }
__host__ __device__ __forceinline__ void stage_rc(int b, int& R, int& C) { const int st = b / 1024, sb = b % 1024, swz = sb ^ (((sb >> 9) & 1) << 5); R = (st >> 1) * 16 + swz / 64; C = (st & 1) * 32 + (swz % 64) / 2; }
__host__ __device__ __forceinline__ int perm32(int rho) { const int n = rho >> 4, i = rho & 15; return 8 * (i >> 2) + 4 * n + (i & 3); }

struct Unit { int pm, pn; };
struct Gemm { const bf16_t* A; const bf16_t* Bt; int M, N, K; int sa, sb; };
typedef int v4i_t __attribute__((ext_vector_type(4)));
typedef int v8i_t __attribute__((ext_vector_type(8)));
__device__ __forceinline__ v8i_t cat32(bf16x8 lo, bf16x8 hi) { const v4i_t a = __builtin_bit_cast(v4i_t, lo), b = __builtin_bit_cast(v4i_t, hi); return __builtin_shufflevector(a, b, 0, 1, 2, 3, 4, 5, 6, 7); }

struct StaticOrder {
    int nM, nN, nwg, G, c;
    __host__ __device__ void init(int M, int N, int G_, int c_) { nM = M / BM; nN = N / BM; nwg = nM * nN; G = G_; c = c_; }
    __host__ __device__ bool next(int i, Unit& u) const {
        const long L = (long)i * G + c; if (L >= nwg) return false;
        int wgid = (int)L; { const int q = nwg / NXCD, r = nwg % NXCD, xcd = wgid % NXCD, off = wgid / NXCD; wgid = (xcd < r ? xcd * (q + 1) : r * (q + 1) + (xcd - r) * q) + off; }
        const int nig = WGM * nN, gid = wgid / nig, fm = gid * WGM, gsz = (nM - fm) < WGM ? (nM - fm) : WGM;
        u.pm = fm + ((wgid % nig) % gsz); u.pn = (wgid % nig) / gsz; return true;
    }
    __device__ __forceinline__ void a_ready(const Unit&) const {}
    __device__ __forceinline__ void done(const Unit&) const {}
    __device__ __forceinline__ unsigned a_rowoff_unused() const { return 0u; }
};

typedef float f32x2p __attribute__((ext_vector_type(2))); typedef __bf16 bf16x2p __attribute__((ext_vector_type(2)));
__device__ __forceinline__ unsigned cvt_pk_bf16(float lo, float hi) { const f32x2p v = {lo, hi}; return __builtin_bit_cast(unsigned, __builtin_convertvector(v, bf16x2p)); }
__device__ __forceinline__ float silu_f(float x) { return x * __builtin_amdgcn_rcpf(1.0f + __builtin_amdgcn_exp2f(x * -1.4426950408889634f)); }

struct EpiBf16 {
    static constexpr bool PERM = true, AFTER_DRAIN = false;
    bf16_t* O; int ldc;
    __device__ __forceinline__ void operator()(const f32x4 (&acc)[2][2][4][2], const Unit& u, int wr, int wc, int fr, int fq) const {
        const int row0 = u.pm * BM + wr * 64 + fr, col0 = u.pn * BM + wc * 32 + 8 * fq;
#pragma unroll
        for (int ai = 0; ai < 2; ++ai)
#pragma unroll
            for (int m = 0; m < 4; ++m) { bf16_t* rowp = O + (size_t)(row0 + ai * HALF + m * 16) * ldc + col0;
#pragma unroll
                for (int bj = 0; bj < 2; ++bj) { const f32x4 v0 = acc[ai][bj][m][0], v1 = acc[ai][bj][m][1];
                    u32x4 w; w.x = cvt_pk_bf16(v0[0], v0[1]); w.y = cvt_pk_bf16(v0[2], v0[3]); w.z = cvt_pk_bf16(v1[0], v1[1]); w.w = cvt_pk_bf16(v1[2], v1[3]);
                    *(u32x4*)(rowp + bj * HALF) = w; } }
    }
};
struct EpiProj {
    static constexpr bool PERM = true, AFTER_DRAIN = false;
    bf16_t* O; float* gates; const float* gate_b;
    __device__ __forceinline__ void operator()(const f32x4 (&acc)[2][2][4][2], const Unit& u, int wr, int wc, int fr, int fq) const {
        const int row0 = u.pm * BM + wr * 64 + fr;
        if (u.pn < 9) { const int col0 = u.pn * BM + wc * 32 + 8 * fq;
#pragma unroll
            for (int ai = 0; ai < 2; ++ai)
#pragma unroll
                for (int m = 0; m < 4; ++m) { bf16_t* rowp = O + (size_t)(row0 + ai * HALF + m * 16) * 2304 + col0;
#pragma unroll
                    for (int bj = 0; bj < 2; ++bj) { const f32x4 v0 = acc[ai][bj][m][0], v1 = acc[ai][bj][m][1];
                        u32x4 w; w.x = cvt_pk_bf16(v0[0], v0[1]); w.y = cvt_pk_bf16(v0[2], v0[3]); w.z = cvt_pk_bf16(v1[0], v1[1]); w.w = cvt_pk_bf16(v1[2], v1[3]);
                        *(u32x4*)(rowp + bj * HALF) = w; } }
        } else if (wc == 0 && fq < 2) { const f32x4 g0 = *(const f32x4*)(gate_b + 8 * fq), g1 = *(const f32x4*)(gate_b + 8 * fq + 4);
#pragma unroll
            for (int ai = 0; ai < 2; ++ai)
#pragma unroll
                for (int m = 0; m < 4; ++m) { float* gp = gates + (size_t)(row0 + ai * HALF + m * 16) * 16 + 8 * fq;
                    *(f32x4*)gp = acc[ai][0][m][0] + g0; *(f32x4*)(gp + 4) = acc[ai][0][m][1] + g1; } }
    }
};
struct EpiSwiGLU {
    static constexpr bool PERM = true, AFTER_DRAIN = false;
    bf16_t* H;
    __device__ __forceinline__ void operator()(const f32x4 (&acc)[2][2][4][2], const Unit& u, int wr, int wc, int fr, int fq) const {
        const int row0 = u.pm * BM + wr * 64 + fr, col0 = (u.pn & 15) * 128 + wc * 32 + 8 * fq;
#pragma unroll
        for (int ai = 0; ai < 2; ++ai)
#pragma unroll
            for (int m = 0; m < 4; ++m) { bf16_t* rowp = H + (size_t)(row0 + ai * HALF + m * 16) * 2048 + col0;
                const f32x4 g0 = acc[ai][0][m][0], g1 = acc[ai][0][m][1], u0 = acc[ai][1][m][0], u1 = acc[ai][1][m][1];
                u32x4 w; w.x = cvt_pk_bf16(silu_f(g0[0]) * u0[0], silu_f(g0[1]) * u0[1]); w.y = cvt_pk_bf16(silu_f(g0[2]) * u0[2], silu_f(g0[3]) * u0[3]);
                w.z = cvt_pk_bf16(silu_f(g1[0]) * u1[0], silu_f(g1[1]) * u1[1]); w.w = cvt_pk_bf16(silu_f(g1[2]) * u1[2], silu_f(g1[3]) * u1[3]);
                *(u32x4*)rowp = w; }
    }
};
__device__ __forceinline__ unsigned pk4_fp8(float a, float b, float c, float d) {
    a = __builtin_amdgcn_fmed3f(a, -448.f, 448.f); b = __builtin_amdgcn_fmed3f(b, -448.f, 448.f); c = __builtin_amdgcn_fmed3f(c, -448.f, 448.f); d = __builtin_amdgcn_fmed3f(d, -448.f, 448.f);
    int w = 0; w = __builtin_amdgcn_cvt_pk_fp8_f32(a, b, w, false); w = __builtin_amdgcn_cvt_pk_fp8_f32(c, d, w, true); return (unsigned)w; }
constexpr float HID_SCALE = 4.0f;
typedef unsigned u32x2e __attribute__((ext_vector_type(2)));
struct EpiSwiGLU8 {
    static constexpr bool PERM = true, AFTER_DRAIN = false;
    unsigned char* H;
    __device__ __forceinline__ void operator()(const f32x4 (&acc)[2][2][4][2], const Unit& u, int wr, int wc, int fr, int fq) const {
        const int row0 = u.pm * BM + wr * 64 + fr, col0 = (u.pn & 15) * 128 + wc * 32 + 8 * fq;
#pragma unroll
        for (int ai = 0; ai < 2; ++ai)
#pragma unroll
            for (int m = 0; m < 4; ++m) { unsigned char* rowp = H + (size_t)(row0 + ai * HALF + m * 16) * 2048 + col0;
                const f32x4 g0 = acc[ai][0][m][0], g1 = acc[ai][0][m][1], u0 = acc[ai][1][m][0], u1 = acc[ai][1][m][1];
                u32x2e w; w.x = pk4_fp8(silu_f(g0[0]) * u0[0] * HID_SCALE, silu_f(g0[1]) * u0[1] * HID_SCALE, silu_f(g0[2]) * u0[2] * HID_SCALE, silu_f(g0[3]) * u0[3] * HID_SCALE);
                w.y = pk4_fp8(silu_f(g1[0]) * u1[0] * HID_SCALE, silu_f(g1[1]) * u1[1] * HID_SCALE, silu_f(g1[2]) * u1[2] * HID_SCALE, silu_f(g1[3]) * u1[3] * HID_SCALE);
                *(u32x2e*)rowp = w; }
    }
};
struct EpiScaleBf16 {
    static constexpr bool PERM = true, AFTER_DRAIN = false;
    bf16_t* Y; const float* gate;
    __device__ __forceinline__ void operator()(const f32x4 (&acc)[2][2][4][2], const Unit& u, int wr, int wc, int fr, int fq) const {
        const int row0 = u.pm * BM + wr * 64 + fr, col0 = (u.pn & 3) * BM + wc * 32 + 8 * fq;
#pragma unroll
        for (int ai = 0; ai < 2; ++ai)
#pragma unroll
            for (int m = 0; m < 4; ++m) { const int r = row0 + ai * HALF + m * 16; const float gv = gate[r]; bf16_t* rowp = Y + (size_t)r * 1024 + col0;
#pragma unroll
                for (int bj = 0; bj < 2; ++bj) { const f32x4 v0 = acc[ai][bj][m][0] * gv, v1 = acc[ai][bj][m][1] * gv;
                    u32x4 w; w.x = cvt_pk_bf16(v0[0], v0[1]); w.y = cvt_pk_bf16(v0[2], v0[3]); w.z = cvt_pk_bf16(v1[0], v1[1]); w.w = cvt_pk_bf16(v1[2], v1[3]);
                    *(u32x4*)(rowp + bj * HALF) = w; } }
    }
};
constexpr float YE_SCALE = 256.0f;
struct EpiScaleFp8 {
    static constexpr bool PERM = true, AFTER_DRAIN = false;
    unsigned char* Y; const float* gate;
    __device__ __forceinline__ void operator()(const f32x4 (&acc)[2][2][4][2], const Unit& u, int wr, int wc, int fr, int fq) const {
        const int row0 = u.pm * BM + wr * 64 + fr, pcol = (u.pn & 3) * BM + 16 * (wc * 4 + fq);
#pragma unroll
        for (int ai = 0; ai < 2; ++ai)
#pragma unroll
            for (int m = 0; m < 4; ++m) { const int r = row0 + ai * HALF + m * 16; const float gv = gate[r] * YE_SCALE; u32x4 w;
#pragma unroll
                for (int bj = 0; bj < 2; ++bj) { const f32x4 v0 = acc[ai][bj][m][0] * gv, v1 = acc[ai][bj][m][1] * gv;
                    w[2 * bj] = pk4_fp8(v0[0], v0[1], v0[2], v0[3]); w[2 * bj + 1] = pk4_fp8(v1[0], v1[1], v1[2], v1[3]); }
                *(u32x4*)(Y + (size_t)r * 1024 + pcol) = w; }
    }
};
struct MoeOrder1 {
    int G, c; const unsigned short* idx;
    __device__ __forceinline__ int a_rowtok(const Unit& u, int r) const { return idx[((u.pm * 2 + (r >> 7)) * 64 + (r & 63)) * 2 + ((r >> 6) & 1)]; }
    __device__ __forceinline__ unsigned a_rowoff(const Unit& u, int r) const { return (unsigned)(((u.pm & 15) * 2048 + a_rowtok(u, r)) * 1024); }
    __device__ __forceinline__ unsigned a_rowpair(const Unit& u, int hh, int r0) const { return *(const unsigned*)(idx + ((u.pm * 2 + hh) * 64 + r0) * 2); }
    __device__ __forceinline__ unsigned a_rowoff_tok(const Unit& u, int tok) const { return (unsigned)(((u.pm & 15) * 2048 + tok) * 1024); }
    __device__ __forceinline__ bool next(int i, Unit& u) const {
        const long L = (long)i * G + c; if (L >= 4096) return false;
        const int e = (int)(L >> 8), rem = (int)(L & 255), x = rem & 7, v = rem >> 3;
        const int b = 4 * (x >> 1) + (v >> 3), j = 8 * (x & 1) + (v & 7);
        u.pm = e * 16 + b; u.pn = e * 16 + j; return true;
    }
    __device__ __forceinline__ void a_ready(const Unit&) const {}
    __device__ __forceinline__ void done(const Unit&) const {}
    __device__ __forceinline__ unsigned a_rowoff_unused() const { return 0u; }
};
struct MoeOrder2 {
    int G, c;
    __device__ __forceinline__ bool next(int i, Unit& u) const {
        const long L = (long)i * G + c; if (L >= 1024) return false;
        const int rnd = (int)(L >> 8), rem = (int)(L & 255), x = rem & 7, v = rem >> 3;
        const int e = rnd * 4 + (x >> 1), b = 8 * (x & 1) + (v >> 2), j = v & 3;
        u.pm = e * 16 + b; u.pn = e * 4 + j; return true;
    }
    __device__ __forceinline__ void a_ready(const Unit&) const {}
    __device__ __forceinline__ void done(const Unit&) const {}
    __device__ __forceinline__ unsigned a_rowoff_unused() const { return 0u; }
};

template <class Epi, class Sched, bool ALIGN_EPI = false, bool SP2 = false, bool F8 = false, bool GATH = false>
__device__ __forceinline__ void gemm_phase(PG8_LAS unsigned char* lds, const Gemm g, const Sched& S, const Epi& E) {
    const int tid = opaque_tid(), wid = __builtin_amdgcn_readfirstlane(tid >> 6), lane = tid & 63, wr = wid >> 2, wc = wid & 3, fr = lane & 15, fq = lane >> 4;
    const int K = g.K, RB = F8 ? K : 2 * K, nt = RB / 128;
    unsigned voffA[2], voffB[2];
#pragma unroll
    for (int i = 0; i < 2; ++i) { int R, C; stage_rc(tid * 16 + i * 8192, R, C); const int Rb = Epi::PERM ? ((R & ~31) + perm32(R & 31)) : R;
        voffA[i] = (unsigned)(R * RB + C * 2); voffB[i] = (unsigned)(Rb * RB + C * 2); }
    const __amdgpu_buffer_rsrc_t rsA = __builtin_amdgcn_make_buffer_rsrc((void*)g.A, 0, 0x7fffffff, 0x00020000), rsB = __builtin_amdgcn_make_buffer_rsrc((void*)g.Bt, 0, 0x7fffffff, 0x00020000);
    const size_t kstep = (size_t)(BK * 2);
    const size_t hstep = (size_t)HALF * RB;
    const size_t tstep = 2 * hstep;
    const unsigned ldsw = (unsigned)wid * 1024u;
    const int aoff = lds_byte(wr * 64 + fr, fq * 8), boff = lds_byte(wc * 32 + fr, fq * 8);
#define PG8_SA(b, h) (((b) * 2 + (h)) * HTB)
#define PG8_SB(b, h) ((4 + (b) * 2 + (h)) * HTB)
#define PG8_STAGE(bufoff, gbase, voff, rs, base) do { if constexpr (F8) { const int so_ = __builtin_amdgcn_readfirstlane((int)((const char*)(gbase) - (const char*)(base))); _Pragma("unroll") for (int _i = 0; _i < 2; ++_i) \
        __builtin_amdgcn_raw_ptr_buffer_load_lds(rs, (PG8_LAS void*)(lds + (bufoff) + ldsw + _i * 8192), 16, (int)(voff)[_i], so_, 0, 0); } \
        else { _Pragma("unroll") for (int _i = 0; _i < 2; ++_i) \
        __builtin_amdgcn_global_load_lds((const unsigned*)((const char*)(gbase) + (voff)[_i]), (PG8_LAS unsigned*)(lds + (bufoff) + ldsw + _i * 8192), 16, 0, 0); } } while (0)
#define PG8_STAGEA(bufoff, gptr, half, usenext) do { if constexpr (GATH) { const int so_ = __builtin_amdgcn_readfirstlane((int)((const char*)(gptr) - (const char*)g.A)); _Pragma("unroll") for (int _i = 0; _i < 2; ++_i) \
        __builtin_amdgcn_raw_ptr_buffer_load_lds(rsA, (PG8_LAS void*)(lds + (bufoff) + ldsw + _i * 8192), 16, (int)vAc[half][_i], so_, 0, 0); } \
        else { PG8_STAGE(bufoff, (gptr) + (half) * hstep, voffA, rsA, g.A); } } while (0)
#define PG8_GSWITCH do { if constexpr (GATH) { if (un) {   \
        asm volatile("" : "+v"(tpk[0]), "+v"(tpk[1]));     \
        _Pragma("unroll") for (int hh = 0; hh < 2; ++hh) _Pragma("unroll") for (int i = 0; i < 2; ++i) { int R, C; stage_rc(opaque_tid() * 16 + i * 8192, R, C); vAc[hh][i] = S.a_rowoff_tok(nxt, (int)((tpk[hh] >> (16 * i)) & 0xffffu)) + (unsigned)(C * 2); } } } } while (0)
#define PG8_LDA(dst, b, h) do { if constexpr (F8) { _Pragma("unroll") for (int m = 0; m < 4; ++m) dst##8[m] = cat32(*(const PG8_LAS bf16x8*)(lds + PG8_SA(b, h) + aoff + m * 2048), *(const PG8_LAS bf16x8*)(lds + PG8_SA(b, h) + aoff + m * 2048 + 1024)); } \
        else { _Pragma("unroll") for (int m = 0; m < 4; ++m) _Pragma("unroll") for (int k = 0; k < 2; ++k) dst[m][k] = *(const PG8_LAS bf16x8*)(lds + PG8_SA(b, h) + aoff + m * 2048 + k * 1024); } } while (0)
#define PG8_LDB(dst, b, h) do { if constexpr (F8) { _Pragma("unroll") for (int n = 0; n < 2; ++n) dst##8[n] = cat32(*(const PG8_LAS bf16x8*)(lds + PG8_SB(b, h) + boff + n * 2048), *(const PG8_LAS bf16x8*)(lds + PG8_SB(b, h) + boff + n * 2048 + 1024)); } \
        else { _Pragma("unroll") for (int n = 0; n < 2; ++n) _Pragma("unroll") for (int k = 0; k < 2; ++k) dst[n][k] = *(const PG8_LAS bf16x8*)(lds + PG8_SB(b, h) + boff + n * 2048 + k * 1024); } } while (0)
#define PG8_MMA(ai, bj, At, Bt) do { __builtin_amdgcn_s_setprio(1); _Pragma("unroll") for (int m = 0; m < 4; ++m) _Pragma("unroll") for (int n = 0; n < 2; ++n) { \
        if constexpr (F8) { acc[ai][bj][m][n] = __builtin_amdgcn_mfma_scale_f32_16x16x128_f8f6f4(Bt##8[n], At##8[m], acc[ai][bj][m][n], 0, 0, 0, g.sb, 0, g.sa); } \
        else { _Pragma("unroll") for (int k = 0; k < 2; ++k) acc[ai][bj][m][n] = __builtin_amdgcn_mfma_f32_16x16x32_bf16(Bt[n][k], At[m][k], acc[ai][bj][m][n], 0, 0, 0); } } __builtin_amdgcn_s_setprio(0); } while (0)
#define PG8_WAIT_V(n) asm volatile("s_waitcnt vmcnt(" #n ")" ::: "memory")
#define PG8_WAIT_L(n) asm volatile("s_waitcnt lgkmcnt(" #n ")" ::: "memory")
#define PG8_BAR __builtin_amdgcn_s_barrier()
#define PG8_SCHED __builtin_amdgcn_sched_barrier(0)
    Unit cur, nxt; int ui = 0;
    if (!S.next(0, cur)) return;
    f32x4 acc[2][2][4][2];
#pragma unroll
    for (int a = 0; a < 2; ++a)
#pragma unroll
        for (int b = 0; b < 2; ++b)
#pragma unroll
            for (int m = 0; m < 4; ++m)
#pragma unroll
                for (int n = 0; n < 2; ++n) acc[a][b][m][n] = (f32x4){0.f, 0.f, 0.f, 0.f};
    bf16x8 At[4][2], B0[2][2], B1[2][2];
    v8i_t At8[4], B08[2], B18[2];
    const char* cA = (const char*)g.A + (GATH ? (size_t)0 : (size_t)cur.pm * tstep); const char* cB = (const char*)g.Bt + (size_t)cur.pn * tstep;
    unsigned vAc[2][2];
    if constexpr (GATH) {
#pragma unroll
        for (int hh = 0; hh < 2; ++hh)
#pragma unroll
            for (int i = 0; i < 2; ++i) { int R, C; stage_rc(tid * 16 + i * 8192, R, C); vAc[hh][i] = S.a_rowoff(cur, hh * HALF + R) + (unsigned)(C * 2); } }
    S.a_ready(cur);
    if constexpr (SP2) {
        PG8_STAGE(PG8_SB(0, 0), cB, voffB, rsB, g.Bt); PG8_STAGE(PG8_SB(0, 1), cB + hstep, voffB, rsB, g.Bt); PG8_STAGEA(PG8_SA(0, 0), cA, 0, false); PG8_STAGEA(PG8_SA(0, 1), cA, 1, false);
        if (wr == 1) PG8_BAR;
        PG8_WAIT_V(2); PG8_BAR;
        PG8_STAGE(PG8_SB(1, 0), cB + kstep, voffB, rsB, g.Bt); PG8_STAGEA(PG8_SA(1, 0), cA + kstep, 0, false); PG8_STAGE(PG8_SB(1, 1), cB + hstep + kstep, voffB, rsB, g.Bt);
        PG8_WAIT_V(6); PG8_BAR;
    } else {
        PG8_STAGE(PG8_SB(0, 0), cB, voffB, rsB, g.Bt); PG8_STAGEA(PG8_SA(0, 0), cA, 0, false); PG8_STAGE(PG8_SB(0, 1), cB + hstep, voffB, rsB, g.Bt); PG8_STAGEA(PG8_SA(0, 1), cA, 1, false);
        if (wr == 1) PG8_BAR;
        PG8_WAIT_V(4); PG8_BAR;
        PG8_STAGE(PG8_SB(1, 0), cB + kstep, voffB, rsB, g.Bt); PG8_STAGEA(PG8_SA(1, 0), cA + kstep, 0, false); PG8_STAGE(PG8_SB(1, 1), cB + hstep + kstep, voffB, rsB, g.Bt);
        PG8_WAIT_V(6); PG8_BAR;
    }
    unsigned tpk[2] = {0u, 0u};
    if constexpr (GATH) { Unit n1; if (S.next(1, n1)) {
#pragma unroll
        for (int hh = 0; hh < 2; ++hh) { int R0, C0; stage_rc(opaque_tid() * 16, R0, C0); tpk[hh] = S.a_rowpair(n1, hh, R0); } } }
    for (;;) {
        const bool has_next = S.next(ui + 1, nxt);
        const char* nA = (has_next && !GATH) ? (const char*)g.A + (size_t)nxt.pm * tstep : cA; const char* nB = has_next ? (const char*)g.Bt + (size_t)nxt.pn * tstep : cB;

#pragma unroll 1
        for (int t = 0; t < nt; t += 2) {
            const bool last = (t == nt - 2); const bool un = last && has_next;

            const char* a1 = cA + (size_t)(t + 1) * kstep;
            const char* a2 = last ? nA : cA + (size_t)(t + 2) * kstep; const char* b2 = last ? nB : cB + (size_t)(t + 2) * kstep;
            const char* a3 = a2 + kstep; const char* b3 = b2 + kstep;
            if (last && has_next) S.a_ready(nxt);
            if constexpr (SP2) {
            PG8_LDB(B0, 0, 0); PG8_LDB(B1, 0, 1); PG8_SCHED; PG8_LDA(At, 0, 0); PG8_STAGEA(PG8_SA(1, 1), a1, 1, false); PG8_GSWITCH;
            PG8_WAIT_V(8); PG8_WAIT_L(0); PG8_BAR; PG8_MMA(0, 0, At, B0); PG8_MMA(0, 1, At, B1); PG8_BAR; PG8_SCHED;
            PG8_LDA(At, 0, 1); PG8_STAGE(PG8_SB(0, 0), b2, voffB, rsB, g.Bt); PG8_STAGE(PG8_SB(0, 1), b2 + hstep, voffB, rsB, g.Bt); PG8_STAGEA(PG8_SA(0, 0), a2, 0, un);
            PG8_WAIT_V(8); PG8_WAIT_L(0); PG8_BAR; PG8_MMA(1, 0, At, B0); PG8_MMA(1, 1, At, B1); PG8_BAR; PG8_SCHED;
            PG8_LDB(B0, 1, 0); PG8_LDB(B1, 1, 1); PG8_SCHED; PG8_LDA(At, 1, 0); PG8_STAGEA(PG8_SA(0, 1), a2, 1, un);
            PG8_WAIT_V(8); PG8_WAIT_L(0); PG8_BAR; PG8_MMA(0, 0, At, B0); PG8_MMA(0, 1, At, B1); PG8_BAR; PG8_SCHED;
            PG8_LDA(At, 1, 1); PG8_STAGE(PG8_SB(1, 0), b3, voffB, rsB, g.Bt); PG8_STAGE(PG8_SB(1, 1), b3 + hstep, voffB, rsB, g.Bt); PG8_STAGEA(PG8_SA(1, 0), a3, 0, un);
            PG8_WAIT_V(8); PG8_WAIT_L(0); PG8_BAR; PG8_MMA(1, 0, At, B0); PG8_MMA(1, 1, At, B1); PG8_BAR; PG8_SCHED;
            } else {
            PG8_LDB(B0, 0, 0); PG8_SCHED; PG8_LDA(At, 0, 0); PG8_STAGEA(PG8_SA(1, 1), a1, 1, false); PG8_GSWITCH;
            PG8_WAIT_L(8); PG8_BAR; PG8_WAIT_L(0); PG8_MMA(0, 0, At, B0); PG8_BAR; PG8_SCHED;
            PG8_LDB(B1, 0, 1); PG8_STAGE(PG8_SB(0, 0), b2, voffB, rsB, g.Bt);
            PG8_BAR; PG8_WAIT_L(0); PG8_MMA(0, 1, At, B1); PG8_BAR;
            PG8_LDA(At, 0, 1); PG8_STAGEA(PG8_SA(0, 0), a2, 0, un);
            PG8_BAR; PG8_WAIT_L(0); PG8_MMA(1, 0, At, B0); PG8_BAR; PG8_SCHED;
            PG8_STAGE(PG8_SB(0, 1), b2 + hstep, voffB, rsB, g.Bt);
            PG8_WAIT_V(6); PG8_BAR; PG8_MMA(1, 1, At, B1); PG8_BAR;
            PG8_LDB(B0, 1, 0); PG8_SCHED; PG8_LDA(At, 1, 0); PG8_STAGEA(PG8_SA(0, 1), a2, 1, un);
            PG8_WAIT_L(8); PG8_BAR; PG8_WAIT_L(0); PG8_MMA(0, 0, At, B0); PG8_BAR; PG8_SCHED;
            PG8_LDB(B1, 1, 1); PG8_STAGE(PG8_SB(1, 0), b3, voffB, rsB, g.Bt);
            PG8_BAR; PG8_WAIT_L(0); PG8_MMA(0, 1, At, B1); PG8_BAR;
            PG8_LDA(At, 1, 1); PG8_STAGEA(PG8_SA(1, 0), a3, 0, un);
            PG8_BAR; PG8_WAIT_L(0); PG8_MMA(1, 0, At, B0); PG8_BAR; PG8_SCHED;
            PG8_STAGE(PG8_SB(1, 1), b3 + hstep, voffB, rsB, g.Bt);
            PG8_WAIT_V(6); PG8_BAR; PG8_MMA(1, 1, At, B1); PG8_BAR;
            }
        }
        if constexpr (ALIGN_EPI) { if (wr == 0) PG8_BAR; }
        unsigned tpk2[2] = {0u, 0u};
        if constexpr (GATH) { Unit n2; if (S.next(ui + 2, n2)) {
#pragma unroll
            for (int hh = 0; hh < 2; ++hh) { int R0, C0; stage_rc(opaque_tid() * 16, R0, C0); tpk2[hh] = S.a_rowpair(n2, hh, R0); } } }
        if constexpr (!Epi::AFTER_DRAIN) { const int t2 = opaque_tid(), w2 = __builtin_amdgcn_readfirstlane(t2 >> 6), l2 = t2 & 63; E(acc, cur, w2 >> 2, w2 & 3, l2 & 15, l2 >> 4); S.done(cur); }
        if (!has_next) break;
#pragma unroll
        for (int a = 0; a < 2; ++a)
#pragma unroll
            for (int b = 0; b < 2; ++b)
#pragma unroll
                for (int m = 0; m < 4; ++m)
#pragma unroll
                    for (int n = 0; n < 2; ++n) acc[a][b][m][n] = (f32x4){0.f, 0.f, 0.f, 0.f};
        cur = nxt; cA = nA; cB = nB; ++ui;
        if constexpr (GATH) { asm volatile("" : "+v"(tpk2[0]), "+v"(tpk2[1]));
            tpk[0] = tpk2[0]; tpk[1] = tpk2[1]; }

        if constexpr (ALIGN_EPI) { if (wr == 1) PG8_BAR; }
    }
    PG8_WAIT_V(0);
    if constexpr (!ALIGN_EPI) { if (wr == 0) PG8_BAR; }
    PG8_BAR;
    if constexpr (Epi::AFTER_DRAIN) { E.fused(acc, cur, wr, wc, fr, fq, lds, wid, lane); S.done(cur); }
#undef PG8_SA
#undef PG8_SB
#undef PG8_STAGE
#undef PG8_LDA
#undef PG8_LDB
#undef PG8_MMA
#undef PG8_WAIT_V
#undef PG8_WAIT_L
#undef PG8_BAR
#undef PG8_SCHED
}
}

#define GAS __attribute__((address_space(1)))
#define LAS __attribute__((address_space(3)))
typedef unsigned short bf16;
typedef float f32x4 __attribute__((ext_vector_type(4)));
typedef unsigned u32x4 __attribute__((ext_vector_type(4)));
typedef unsigned u32x2 __attribute__((ext_vector_type(2)));
typedef short bf16x8 __attribute__((ext_vector_type(8)));

constexpr int DM = 1024, BATCH = 16, SEQ = 2048, DEPTH = 4, NTOK = BATCH * SEQ;
constexpr int PW_IN = 2320, PN = 2304, PNW = 2560;
constexpr int C_AQ = 0, C_AK = 512, C_AV = 640, C_MQ = 768, C_MK = 1024, C_MV = 1280, C_MO = 1536, C_GU = 1792, C_GV = 2048;
constexpr int NE = 16, CAP = 256, DE = 2048, NGRP = 256;
constexpr float DN_ALPHA = 1.6817928305074290f;
constexpr float LN_EPS = 1e-5f;

constexpr size_t MiB = 1u << 20;
constexpr size_t WS_CTL = 0, CTL_BYTES = 1 * MiB;
constexpr size_t WS_MOD = 1 * MiB;
constexpr size_t WS_WIN = 1520 * MiB;
constexpr size_t WS_WOUT = 22 * MiB;
constexpr size_t WS_WS = 30 * MiB;
constexpr size_t WS_GATES = 32 * MiB;
constexpr size_t WS_AFF = 34 * MiB;
constexpr size_t WS_SLOT = 36 * MiB;
constexpr size_t WS_IDX = 37 * MiB;
constexpr size_t WS_GATEV = 38 * MiB;
constexpr size_t WS_DC = 40 * MiB;
constexpr size_t WS_DN = 72 * MiB;
constexpr size_t WS_DS = 73 * MiB;
constexpr size_t WS_QKT = 80 * MiB;
constexpr size_t WS_H = 128 * MiB;
constexpr size_t WS_XA = 192 * MiB;
constexpr size_t WS_PROJ = 320 * MiB;
constexpr size_t WS_MIXCAT = 464 * MiB;
constexpr size_t WS_MIX = 528 * MiB;
constexpr size_t WS_XG = 592 * MiB;
constexpr size_t WS_HID = 720 * MiB;
constexpr size_t WS_YE = 976 * MiB;
constexpr size_t WS_WGU = 1104 * MiB;
constexpr size_t WS_WD = 1360 * MiB;
constexpr size_t WS_H8 = 1488 * MiB;
constexpr size_t WS_END = 1540 * MiB;
constexpr float W1_SCALE = 128.f, W2_SCALE = 512.f, ACT_SCALE = 8.f;
constexpr int SC_A1 = 0x7C7C7C7C, SC_B1 = 0x78787878, SC_A2 = 0x7D7D7D7D, SC_B2 = 0x76767676;
constexpr size_t WS_HFB = WS_HID;
constexpr size_t WS_VN = WS_HID + 64 * MiB;

struct P {
    const float *x, *c, *w_ada, *b_ada, *w_in, *conv_w, *conv_b, *gate_b, *sink, *rel_bias, *w_s, *b_s, *w_out, *w_router, *w_gate, *w_up, *w_down, *ln_g, *ln_b;
    float* out; unsigned char* ws;
};

typedef float f32x2c __attribute__((ext_vector_type(2))); typedef __bf16 bf16x2c __attribute__((ext_vector_type(2)));
__device__ __forceinline__ unsigned pk2(float lo, float hi) { const f32x2c v = {lo, hi}; return __builtin_bit_cast(unsigned, __builtin_convertvector(v, bf16x2c)); }
__device__ __forceinline__ unsigned f2bf(float f) { return pk2(f, 0.f) & 0xffffu; }
__device__ __forceinline__ float bf2f(unsigned short b) { return __builtin_bit_cast(float, (unsigned)b << 16); }
__device__ __forceinline__ float bflo(unsigned w) { return __builtin_bit_cast(float, w << 16); }
__device__ __forceinline__ float bfhi(unsigned w) { return __builtin_bit_cast(float, w & 0xffff0000u); }
__device__ __forceinline__ float sigmoid_f(float x) { return __builtin_amdgcn_rcpf(1.0f + __builtin_amdgcn_exp2f(x * -1.4426950408889634f)); }
__device__ __forceinline__ float silu_acc(float x) { return x * __builtin_amdgcn_rcpf(1.0f + __builtin_amdgcn_exp2f(x * -1.4426950408889634f)); }
__device__ __forceinline__ float gelu_erf(float x) { return 0.5f * x * (1.0f + erff(x * 0.70710678118654752f)); }
__device__ __forceinline__ float logsigmoid_f(float x) { return fminf(x, 0.f) - __logf(1.0f + __expf(-fabsf(x))); }
__device__ __forceinline__ int t5_bucket(int rel) {
    const int n = rel < 0 ? -rel : rel;
    int bk = n < 8 ? n : n < 12 ? 8 : n < 16 ? 9 : n < 23 ? 10 : n < 32 ? 11 : n < 46 ? 12 : n < 64 ? 13 : n < 91 ? 14 : 15;
    return bk + (rel > 0 ? 16 : 0);
}

__device__ __forceinline__ int unit_of(int wg, int G, int i, int N) {
    if (G == 256) { const int per = N >> 8; if (i >= per) return N; return ((((wg & 7) << 5) | (wg >> 3)) * per) + i; }
    const int u = wg + i * G; return u < N ? u : N;
}
template <int CTRL> __device__ __forceinline__ float dpp_f(float v) { return __builtin_bit_cast(float, __builtin_amdgcn_update_dpp(0, __builtin_bit_cast(int, v), CTRL, 0xf, 0xf, true)); }
#define DPP_X1 0xB1
#define DPP_X2 0x4E
#define DPP_HM 0x141
#define DPP_RM 0x140
__device__ __forceinline__ float r16_sum(float v) { v += dpp_f<DPP_X1>(v); v += dpp_f<DPP_X2>(v); v += dpp_f<DPP_HM>(v); v += dpp_f<DPP_RM>(v); return v; }
__device__ __forceinline__ float r16_max(float v) { v = fmaxf(v, dpp_f<DPP_X1>(v)); v = fmaxf(v, dpp_f<DPP_X2>(v)); v = fmaxf(v, dpp_f<DPP_HM>(v)); v = fmaxf(v, dpp_f<DPP_RM>(v)); return v; }
__device__ __forceinline__ float wave_sum(float v) {
#pragma unroll
    for (int o = 1; o < 64; o <<= 1) v += __shfl_xor(v, o);
    return v;
}
constexpr int RB_PITCH = 2080;
constexpr int RB_W = 0, RB_ST = 16 * RB_PITCH, RW_VEC = 100352;
__device__ __forceinline__ void r16_ln(f32x4 (&v)[16]) {
    float s = 0.f;
#pragma unroll
    for (int k = 0; k < 16; ++k) s += (v[k][0] + v[k][1]) + (v[k][2] + v[k][3]);
    const float mean = r16_sum(s) * (1.f / DM); float q = 0.f;
#pragma unroll
    for (int k = 0; k < 16; ++k) { v[k] = v[k] - mean; q += (v[k][0] * v[k][0] + v[k][1] * v[k][1]) + (v[k][2] * v[k][2] + v[k][3] * v[k][3]); }
    const float rstd = 1.0f / sqrtf(r16_sum(q) * (1.f / DM) + LN_EPS);
#pragma unroll
    for (int k = 0; k < 16; ++k) v[k] = v[k] * rstd;
}
__device__ __forceinline__ float r16_fold(const float (&acc)[16], int c) {
    float a8[8], a4[4], a2[2];
    { const bool hi = c >= 8;
#pragma unroll
      for (int e = 0; e < 8; ++e) { const float send = hi ? acc[e] : acc[e + 8], keep = hi ? acc[e + 8] : acc[e]; a8[e] = keep + dpp_f<DPP_RM>(send); } }
    { const bool hi = (c & 7) >= 4;
#pragma unroll
      for (int e = 0; e < 4; ++e) { const float send = hi ? a8[e] : a8[e + 4], keep = hi ? a8[e + 4] : a8[e]; a4[e] = keep + dpp_f<DPP_HM>(send); } }
    { const bool hi = (c & 2) != 0;
#pragma unroll
      for (int e = 0; e < 2; ++e) { const float send = hi ? a4[e] : a4[e + 2], keep = hi ? a4[e + 2] : a4[e]; a2[e] = keep + dpp_f<DPP_X2>(send); } }
    const bool hi = (c & 1) != 0; const float send = hi ? a2[0] : a2[1], keep = hi ? a2[1] : a2[0];
    return keep + dpp_f<DPP_X1>(send);
}
__device__ __forceinline__ void r16_matvec2(const f32x4 (&v0)[16], const f32x4 (&v1)[16], const LAS float* wT, int c, float& r0, float& r1) {
    float a0[16], a1[16];
    asm volatile("" ::: "memory");
#pragma unroll
    for (int e = 0; e < 16; ++e) { float s0 = 0.f, s1 = 0.f;
#pragma unroll
        for (int k = 0; k < 16; ++k) { const f32x4 w = *(const LAS f32x4*)(wT + e * DM + 64 * k + 4 * c);
            s0 += (v0[k][0] * w[0] + v0[k][1] * w[1]) + (v0[k][2] * w[2] + v0[k][3] * w[3]); s1 += (v1[k][0] * w[0] + v1[k][1] * w[1]) + (v1[k][2] * w[2] + v1[k][3] * w[3]); }
        a0[e] = s0; a1[e] = s1; }
    r0 = r16_fold(a0, c); r1 = r16_fold(a1, c);
}
#define RC(k) (128 * ((k) >> 1) + 8 * c + 4 * ((k) & 1))
__device__ __forceinline__ int rpos(int col) { return (col & ~127) | (((col >> 2) & 1) << 6) | (((col & 127) >> 3) << 2) | (col & 3); }
__device__ __forceinline__ f32x4 bf4lo(u32x4 w) { return (f32x4){bflo(w.x), bfhi(w.x), bflo(w.y), bfhi(w.y)}; }
__device__ __forceinline__ f32x4 bf4hi(u32x4 w) { return (f32x4){bflo(w.z), bfhi(w.z), bflo(w.w), bfhi(w.w)}; }
typedef float f32x2q __attribute__((ext_vector_type(2)));
__device__ __forceinline__ f32x4 fp8x4(unsigned w) { const f32x2q lo = __builtin_amdgcn_cvt_pk_f32_fp8((int)w, false), hi = __builtin_amdgcn_cvt_pk_f32_fp8((int)w, true); return (f32x4){lo[0], lo[1], hi[0], hi[1]}; }
__device__ __forceinline__ void r16_store_bf16(bf16* rowp, int c, const f32x4 (&v)[16]) {
#pragma unroll
    for (int kk = 0; kk < 8; ++kk) { u32x4 w; w.x = pk2(v[2 * kk][0], v[2 * kk][1]); w.y = pk2(v[2 * kk][2], v[2 * kk][3]); w.z = pk2(v[2 * kk + 1][0], v[2 * kk + 1][1]); w.w = pk2(v[2 * kk + 1][2], v[2 * kk + 1][3]);
        *(u32x4*)(rowp + 128 * kk + 8 * c) = w; }
}
__device__ __forceinline__ void fill_wrouter(LAS unsigned char* wb, const float* src, int tid) {
#pragma unroll
    for (int j = 0; j < 2; ++j) { const int d = tid + 512 * j; const float* sp = src + (size_t)d * 16;
        const f32x4 a0 = *(const f32x4*)sp, a1 = *(const f32x4*)(sp + 4), a2 = *(const f32x4*)(sp + 8), a3 = *(const f32x4*)(sp + 12);
#pragma unroll
        for (int k = 0; k < 4; ++k) { *(LAS bf16*)(wb + k * RB_PITCH + 2 * d) = (bf16)f2bf(a0[k]); *(LAS bf16*)(wb + (4 + k) * RB_PITCH + 2 * d) = (bf16)f2bf(a1[k]);
            *(LAS bf16*)(wb + (8 + k) * RB_PITCH + 2 * d) = (bf16)f2bf(a2[k]); *(LAS bf16*)(wb + (12 + k) * RB_PITCH + 2 * d) = (bf16)f2bf(a3[k]); } }
}
__device__ __forceinline__ void fill_vec(LAS float* dst, const float* src, int tid) {
    *(LAS f32x4*)(dst + rpos(4 * (tid & 255))) = *(const f32x4*)(src + 4 * (tid & 255));
}
__device__ __forceinline__ void rows_entry_simple(const P& p, int wg, int G) {
    const int tid = opaque_tid(), lane = tid & 63, gw = wg * 8 + (tid >> 6), ngw = G * 8;
    const float* mod = (const float*)(p.ws + WS_MOD); bf16* H = (bf16*)(p.ws + WS_H);
    for (int m = gw; m < NTOK; m += ngw) { const int b = m / SEQ; const float* mb = mod + (size_t)b * 6 * DM; const float* xr = p.x + (size_t)m * DM;
        f32x4 v[4]; float s = 0.f;
#pragma unroll
        for (int j = 0; j < 4; ++j) { v[j] = *(const f32x4*)(xr + 256 * j + 4 * lane); s += (v[j][0] + v[j][1]) + (v[j][2] + v[j][3]); }
        const float mean = wave_sum(s) * (1.f / DM); float q = 0.f;
#pragma unroll
        for (int j = 0; j < 4; ++j) { v[j] = v[j] - mean; q += (v[j][0] * v[j][0] + v[j][1] * v[j][1]) + (v[j][2] * v[j][2] + v[j][3] * v[j][3]); }
        const float rstd = 1.0f / sqrtf(wave_sum(q) * (1.f / DM) + LN_EPS);
#pragma unroll
        for (int j = 0; j < 4; ++j) { const f32x4 sc = *(const f32x4*)(mb + DM + 256 * j + 4 * lane), sh = *(const f32x4*)(mb + 256 * j + 4 * lane); const f32x4 o = v[j] * rstd * (sc + 1.0f) + sh;
            u32x2 w; w.x = pk2(o[0], o[1]); w.y = pk2(o[2], o[3]); *(u32x2*)(H + (size_t)m * DM + 256 * j + 4 * lane) = w; }
    }
}
template <int WHICH>
__device__ __forceinline__ void rows_phase(const P& p, int l, const float* xin, LAS unsigned char* L, int wg, int G, bool dummy = false) {
    const int tid = opaque_tid(), lane = tid & 63, wave = __builtin_amdgcn_readfirstlane(tid >> 6), q = lane >> 4, c = lane & 15;
    LAS float* vec = (LAS float*)(L + RW_VEC);
    const float* modl = (const float*)(p.ws + WS_MOD) + (size_t)l * BATCH * 6 * DM;
    bf16* H = (bf16*)(p.ws + (dummy ? WS_HID : WS_H)); bf16* xa = (bf16*)(p.ws + (dummy ? WS_XG : WS_XA));
    const bool xbf = (WHICH == 2) || (l != 0);
    float* affo = (float*)(p.ws + (dummy ? WS_HID + 128 * MiB : WS_AFF)); float* gato = (float*)(p.ws + (dummy ? WS_HID + 130 * MiB : WS_GATES));
    const bool last = (WHICH == 2) && (l == DEPTH - 1);
    if (WHICH == 1) fill_wrouter(L + RB_W, p.w_router + (size_t)l * DM * 16, tid);
    for (int bi = 0, blk; (blk = unit_of(wg, G, bi, NTOK / 128)) < NTOK / 128; ++bi) {
        const int b = (blk * 128) / SEQ; const float* mb = modl + (size_t)b * 6 * DM;
        __syncthreads();
        { const int half = tid >> 8;
          if (WHICH == 0) { fill_vec(vec + half * DM, mb + (half ? 0 : 1) * DM, tid); }
          if (WHICH == 1) { fill_vec(vec + half * DM, half ? p.ln_g + (size_t)(l * 2) * DM : mb + 2 * DM, tid); fill_vec(vec + (2 + half) * DM, half ? mb + 4 * DM : p.ln_b + (size_t)(l * 2) * DM, tid); if (half == 0) fill_vec(vec + 4 * DM, mb + 3 * DM, tid); }
          if (WHICH == 2) { fill_vec(vec + half * DM, half ? p.ln_g + (size_t)(l * 2 + 1) * DM : mb + 5 * DM, tid); if (half == 0) fill_vec(vec + 2 * DM, p.ln_b + (size_t)(l * 2 + 1) * DM, tid);
              if (!last) { const float* mbn = mb + (size_t)BATCH * 6 * DM; fill_vec(vec + (3 + half) * DM, mbn + (half ? 0 : 1) * DM, tid); } } }
        __syncthreads();
#pragma unroll 1
        for (int it = 0; it < 4; ++it) {
            asm volatile("" ::: "memory");
            const int m = blk * 128 + wave * 16 + it * 4 + q;
            f32x4 v[16];
            if (!xbf) {
#pragma unroll
                for (int k = 0; k < 16; ++k) v[k] = *(const f32x4*)(xin + (size_t)m * DM + RC(k)); }
            else { const bf16* xb = (const bf16*)xin + (size_t)m * DM;
#pragma unroll
                for (int kk = 0; kk < 8; ++kk) { const u32x4 w = *(const u32x4*)(xb + 128 * kk + 8 * c); v[2 * kk] = bf4lo(w); v[2 * kk + 1] = bf4hi(w); } }
            if (WHICH == 1) {
                const bf16* mix = (const bf16*)(p.ws + WS_MIX) + (size_t)m * DM;
                u32x4 mw[8];
#pragma unroll
                for (int kk = 0; kk < 8; ++kk) mw[kk] = *(const u32x4*)(mix + 128 * kk + 8 * c);
#pragma unroll
                for (int k = 0; k < 16; ++k) { const f32x4 g1 = *(const LAS f32x4*)(vec + 64 * k + 4 * c); const f32x4 mx = (k & 1) ? bf4hi(mw[k >> 1]) : bf4lo(mw[k >> 1]);
                    v[k] = v[k] * DN_ALPHA + (g1 + 1.0f) * mx; }
            }
            if (WHICH == 2) {
                const unsigned char* ye = p.ws + WS_YE; const short* slot = (const short*)(p.ws + WS_SLOT);
                const int t = m % SEQ; const int sl = slot[((size_t)b * 16 + c) * SEQ + t];
                const unsigned long long bal = __ballot(sl >= 0);
                unsigned rem = (unsigned)(bal >> (16 * q)) & 0xffffu;
                const int c0 = __popcll(bal & 0xffffull), c1 = __popcll(bal & 0xffff0000ull), c2 = __popcll(bal & 0xffff00000000ull), c3 = __popcll(bal & 0xffff000000000000ull);
                const int m01 = c0 > c1 ? c0 : c1, m23 = c2 > c3 ? c2 : c3, maxc = m01 > m23 ? m01 : m23;
                f32x4 y[16];
#pragma unroll
                for (int k = 0; k < 16; ++k) y[k] = (f32x4){0.f, 0.f, 0.f, 0.f};
                for (int kk = 0; kk < maxc; kk += 2) {
                    const bool va = rem != 0u; const int ea = va ? __builtin_ctz(rem) : 0; rem &= rem - 1u;
                    const bool vb = rem != 0u; const int eb = vb ? __builtin_ctz(rem) : 0; rem &= rem - 1u;
                    const int sa = __shfl(sl, (lane & 48) | ea), sb = __shfl(sl, (lane & 48) | eb);
                    const unsigned char* ra = ye + ((size_t)(ea * 16 + b) * CAP + (va ? sa : 0)) * DM; const unsigned char* rb = ye + ((size_t)(eb * 16 + b) * CAP + (vb ? sb : 0)) * DM;
                    u32x4 wa[4], wb[4];
#pragma unroll
                    for (int j2 = 0; j2 < 4; ++j2) { wa[j2] = *(const u32x4*)(ra + 256 * j2 + 16 * c); wb[j2] = *(const u32x4*)(rb + 256 * j2 + 16 * c); }
                    const float fa = va ? 1.f / pg8::YE_SCALE : 0.f, fb = vb ? 1.f / pg8::YE_SCALE : 0.f;
#pragma unroll
                    for (int k = 0; k < 16; ++k) { y[k] = y[k] + fp8x4(wa[k >> 2][k & 3]) * fa + fp8x4(wb[k >> 2][k & 3]) * fb; }
                }
#pragma unroll
                for (int k = 0; k < 16; ++k) { const f32x4 g2 = *(const LAS f32x4*)(vec + 64 * k + 4 * c); v[k] = v[k] * DN_ALPHA + (g2 + 1.0f) * y[k]; }
            }
            if (WHICH != 0) {
                r16_ln(v);
                const bool of32 = last && !dummy;
#pragma unroll
                for (int k = 0; k < 16; ++k) { const f32x4 gg = *(const LAS f32x4*)(vec + DM + 64 * k + 4 * c), bb = *(const LAS f32x4*)(vec + 2 * DM + 64 * k + 4 * c); v[k] = v[k] * gg + bb; }
                if (of32) {
#pragma unroll
                    for (int k = 0; k < 16; ++k) *(f32x4*)(p.out + (size_t)m * DM + RC(k)) = v[k]; }
                else r16_store_bf16(xa + (size_t)m * DM, c, v);
            }
            if (!last) {
                r16_ln(v);
                const int o_sc = WHICH == 0 ? 0 : 3, o_sh = WHICH == 0 ? 1 : 4;
#pragma unroll
                for (int k = 0; k < 16; ++k) { const f32x4 sc = *(const LAS f32x4*)(vec + o_sc * DM + 64 * k + 4 * c), sh = *(const LAS f32x4*)(vec + o_sh * DM + 64 * k + 4 * c); v[k] = v[k] * (sc + 1.0f) + sh; }
                if (WHICH == 1) { unsigned char* h8 = p.ws + (dummy ? WS_HID : WS_H8) + (size_t)m * DM;
#pragma unroll
                    for (int kk = 0; kk < 8; ++kk) { u32x2 w; w.x = pg8::pk4_fp8(v[2 * kk][0] * ACT_SCALE, v[2 * kk][1] * ACT_SCALE, v[2 * kk][2] * ACT_SCALE, v[2 * kk][3] * ACT_SCALE); w.y = pg8::pk4_fp8(v[2 * kk + 1][0] * ACT_SCALE, v[2 * kk + 1][1] * ACT_SCALE, v[2 * kk + 1][2] * ACT_SCALE, v[2 * kk + 1][3] * ACT_SCALE);
                        *(u32x2*)(h8 + 128 * kk + 8 * c) = w; } }
                else r16_store_bf16(H + (size_t)m * DM, c, v);
                if (WHICH == 1) {
                    LAS unsigned char* st = L + RB_ST + wave * (4 * RB_PITCH);
#pragma unroll
                    for (int kk = 0; kk < 8; ++kk) { u32x4 w; w.x = pk2(v[2 * kk][0], v[2 * kk][1]); w.y = pk2(v[2 * kk][2], v[2 * kk][3]); w.z = pk2(v[2 * kk + 1][0], v[2 * kk + 1][1]); w.w = pk2(v[2 * kk + 1][2], v[2 * kk + 1][3]);
                        *(LAS u32x4*)(st + q * RB_PITCH + (128 * kk + 8 * c) * 2) = w; }
                    f32x4 lg = (f32x4){0.f, 0.f, 0.f, 0.f};
                    const LAS unsigned char* ap = st + (lane & 3) * RB_PITCH + (lane >> 4) * 16; const LAS unsigned char* bp = L + RB_W + (lane & 15) * RB_PITCH + (lane >> 4) * 16;
#pragma unroll 8
                    for (int ks = 0; ks < 32; ++ks) lg = __builtin_amdgcn_mfma_f32_16x16x32_bf16(*(const LAS bf16x8*)(ap + ks * 64), *(const LAS bf16x8*)(bp + ks * 64), lg, 0, 0, 0);
                    float pr[4];
#pragma unroll
                    for (int rr = 0; rr < 4; ++rr) { const float mx = r16_max(lg[rr]), ex = __expf(lg[rr] - mx), sm = r16_sum(ex); pr[rr] = ex / sm; }
                    const float mine = q == 0 ? pr[0] : q == 1 ? pr[1] : q == 2 ? pr[2] : pr[3];
                    affo[(size_t)m * 16 + c] = mine; }
            }
        }
    }
    __syncthreads();
}

__device__ __forceinline__ void transpose_item(const float* src, size_t ld_src, bf16* dst, size_t ld_dst, LAS float* scr, int lane, int nvalid = 32) {
    if (nvalid > 0) { const int kr = lane >> 3, nc = 4 * (lane & 7);
        f32x4 t[8];
#pragma unroll
        for (int i = 0; i < 8; ++i) t[i] = *(const f32x4*)(src + (size_t)(8 * i + kr) * ld_src + nc);
#pragma unroll
        for (int i = 0; i < 8; ++i) { LAS float* d = scr + (8 * i + kr) * 33 + nc; d[0] = t[i][0]; d[1] = t[i][1]; d[2] = t[i][2]; d[3] = t[i][3]; }
    }
    asm volatile("s_waitcnt lgkmcnt(0)" ::: "memory");
    const int c = lane & 7;
#pragma unroll
    for (int j = 0; j < 4; ++j) { const int n = (lane >> 3) + 8 * j; const LAS float* s = scr + (8 * c) * 33 + n;
        u32x4 o; o.x = pk2(s[0 * 33], s[1 * 33]); o.y = pk2(s[2 * 33], s[3 * 33]); o.z = pk2(s[4 * 33], s[5 * 33]); o.w = pk2(s[6 * 33], s[7 * 33]);
        if (n >= nvalid) o = (u32x4){0u, 0u, 0u, 0u};
        *(u32x4*)(dst + (size_t)n * ld_dst + 8 * c) = o; }
    asm volatile("s_waitcnt lgkmcnt(0)" ::: "memory");
}
__device__ __forceinline__ void transpose_item8(const float* src, size_t ld_src, unsigned char* dst, size_t ld_dst, float scale, LAS float* scr, int lane) {
    { const int kr = lane >> 3, nc = 4 * (lane & 7);
        f32x4 t[8];
#pragma unroll
        for (int i = 0; i < 8; ++i) t[i] = *(const f32x4*)(src + (size_t)(8 * i + kr) * ld_src + nc);
#pragma unroll
        for (int i = 0; i < 8; ++i) { LAS float* d = scr + (8 * i + kr) * 33 + nc; d[0] = t[i][0]; d[1] = t[i][1]; d[2] = t[i][2]; d[3] = t[i][3]; } }
    asm volatile("s_waitcnt lgkmcnt(0)" ::: "memory");
    const int c = lane & 3;
#pragma unroll
    for (int j = 0; j < 2; ++j) { const int n = (lane >> 2) + 16 * j; const LAS float* s = scr + (16 * c) * 33 + n;
        u32x4 o;
#pragma unroll
        for (int q = 0; q < 4; ++q) o[q] = pg8::pk4_fp8(s[(4 * q) * 33] * scale, s[(4 * q + 1) * 33] * scale, s[(4 * q + 2) * 33] * scale, s[(4 * q + 3) * 33] * scale);
        *(u32x4*)(dst + (size_t)n * ld_dst + 16 * c) = o; }
    asm volatile("s_waitcnt lgkmcnt(0)" ::: "memory");
}
constexpr int ITL_WIN = 16 * 80, ITL_WOUT = 16 * 32, ITL_WGU = NE * 16 * 128, ITL_WD = NE * 32 * 32, ITL = ITL_WIN + ITL_WOUT + ITL_WGU + ITL_WD;
constexpr int ITS = ITL_WIN + ITL_WOUT, ITM = ITL_WGU + ITL_WD;
__device__ __forceinline__ void convert_item(const P& p, int l, int it, LAS float* scr, int lane) {
    if (it < ITL_WIN) { const int kb = it / 80, nb = it % 80, n0 = 32 * nb;
        const int sc = n0 < 1792 ? n0 : n0 < 2304 ? n0 + 16 : 1792, nvalid = n0 < 2304 ? 32 : n0 == 2304 ? 16 : 0;
        transpose_item(p.w_in + (size_t)l * DM * PW_IN + (size_t)(64 * kb) * PW_IN + sc, PW_IN, (bf16*)(p.ws + WS_WIN) + (size_t)l * PNW * DM + (size_t)n0 * DM + 64 * kb, DM, scr, lane, nvalid); return; }
    it -= ITL_WIN;
    if (it < ITL_WOUT) { const int kb = it / 32, nb = it % 32;
        transpose_item(p.w_out + (size_t)l * DM * DM + (size_t)(64 * kb) * DM + 32 * nb, DM, (bf16*)(p.ws + WS_WOUT) + (size_t)l * DM * DM + (size_t)(32 * nb) * DM + 64 * kb, DM, scr, lane); return; }
    it -= ITL_WOUT;
    if (it < ITL_WGU) { const int le = l * NE + it / (16 * 128), r = it % (16 * 128), kb = r / 128, nb = r % 128, n0 = 32 * nb, pn = n0 >> 8, w = n0 & 255;
        const float* src = (w < 128 ? p.w_gate : p.w_up) + (size_t)le * DM * DE + (size_t)(64 * kb) * DE + pn * 128 + (w & 127);
        transpose_item8(src, DE, p.ws + WS_WGU + (size_t)le * 4096 * DM + (size_t)n0 * DM + 64 * kb, DM, W1_SCALE, scr, lane); return; }
    it -= ITL_WGU;
    { const int le = l * NE + it / (32 * 32), r = it % (32 * 32), kb = r / 32, nb = r % 32;
        transpose_item8(p.w_down + (size_t)le * DE * DM + (size_t)(64 * kb) * DM + 32 * nb, DM, p.ws + WS_WD + (size_t)le * DM * DE + (size_t)(32 * nb) * DE + 64 * kb, DE, W2_SCALE, scr, lane); }
}

typedef short s16x4 __attribute__((ext_vector_type(4)));
typedef float f32x16 __attribute__((ext_vector_type(16)));
#define MFMA32(a, b, c) __builtin_amdgcn_mfma_f32_32x32x16_bf16((a), (b), (c), 0, 0, 0)
__device__ __forceinline__ int crow(int reg, int h) { return (reg & 3) + 8 * (reg >> 2) + 4 * h; }
__device__ __forceinline__ unsigned cvtpk(float lo, float hi) { return pk2(lo, hi); }
__device__ __forceinline__ bf16x8 pack8(float a0, float a1, float a2, float a3, float a4, float a5, float a6, float a7) {
    u32x4 w; w.x = cvtpk(a0, a1); w.y = cvtpk(a2, a3); w.z = cvtpk(a4, a5); w.w = cvtpk(a6, a7); return __builtin_bit_cast(bf16x8, w); }
__device__ __forceinline__ s16x4 tr_read(const LAS unsigned char* p) { typedef short v4i16_t __attribute__((ext_vector_type(4))); return __builtin_bit_cast(s16x4, __builtin_amdgcn_ds_read_tr16_b64_v4i16((LAS v4i16_t*)p)); }
__device__ __forceinline__ bf16x8 cat8(s16x4 lo, s16x4 hi) { return (bf16x8){lo[0], lo[1], lo[2], lo[3], hi[0], hi[1], hi[2], hi[3]}; }
__device__ __forceinline__ int wave_sum_i(int v) {
#pragma unroll
    for (int o = 1; o < 64; o <<= 1) v += __shfl_xor(v, o);
    return v;
}
__device__ __forceinline__ float wave_max(float v) {
#pragma unroll
    for (int o = 1; o < 64; o <<= 1) v = fmaxf(v, __shfl_xor(v, o));
    return v;
}

template <int CTRL, int RMASK> __device__ __forceinline__ float dpp_id(float ident, float v) { return __builtin_bit_cast(float, __builtin_amdgcn_update_dpp(__builtin_bit_cast(int, ident), __builtin_bit_cast(int, v), CTRL, RMASK, 0xf, false)); }
__device__ __forceinline__ float wave_scan_sum(float v) {
    v += dpp_id<0x111, 0xf>(0.f, v); v += dpp_id<0x112, 0xf>(0.f, v); v += dpp_id<0x114, 0xf>(0.f, v); v += dpp_id<0x118, 0xf>(0.f, v);
    v += dpp_id<0x142, 0xa>(0.f, v); v += dpp_id<0x143, 0xc>(0.f, v); return v; }
__device__ __forceinline__ float wave_scan_max(float v) { const float NI = -3.0e38f;
    v = fmaxf(v, dpp_id<0x111, 0xf>(NI, v)); v = fmaxf(v, dpp_id<0x112, 0xf>(NI, v)); v = fmaxf(v, dpp_id<0x114, 0xf>(NI, v)); v = fmaxf(v, dpp_id<0x118, 0xf>(NI, v));
    v = fmaxf(v, dpp_id<0x142, 0xa>(NI, v)); v = fmaxf(v, dpp_id<0x143, 0xc>(NI, v)); return v; }
__device__ __forceinline__ void ph_topk(const P& p, LAS unsigned char* lds, int wg, int G) {
    const int tid = opaque_tid(), lane = tid & 63, wave = __builtin_amdgcn_readfirstlane(tid >> 6);
    LAS unsigned* hist = (LAS unsigned*)lds;
    LAS unsigned* cnt = hist + 1024;
    const float* affp = (const float*)(p.ws + WS_AFF);
    for (int ui = 0, u; (u = unit_of(wg, G, ui, 256)) < 256; ++ui) {
        const int b = u >> 4, e = u & 15, g = e * 16 + b;
        unsigned key[4];
#pragma unroll
        for (int i = 0; i < 4; ++i) key[i] = __builtin_bit_cast(unsigned, affp[((size_t)b * SEQ + i * 512 + tid) * 16 + e]);
        hist[tid] = 0u; hist[512 + tid] = 0u;
        __syncthreads();
        unsigned thr = 0u; int need = CAP;
#pragma unroll
        for (int ps = 0; ps < 4; ++ps) { const int sh = 24 - 8 * ps;
#pragma unroll
            for (int i = 0; i < 4; ++i) { const bool in = ps == 0 || (key[i] >> (sh + 8)) == (thr >> (sh + 8));
                if (in) __hip_atomic_fetch_add(hist + ps * 256 + ((key[i] >> sh) & 255u), 1u, __ATOMIC_RELAXED, __HIP_MEMORY_SCOPE_WORKGROUP); }
            __syncthreads();
            const int lp = 63 - lane; const u32x4 h4 = *(const LAS u32x4*)(hist + ps * 256 + 4 * lp);
            const int s4 = (int)(h4.x + h4.y + h4.z + h4.w), incl = (int)wave_scan_sum((float)s4), excl = incl - s4;
            const int Ls = __builtin_ctzll(__ballot(incl >= need));
            const int c3 = excl + (int)h4.w, c2 = c3 + (int)h4.z, c1 = c2 + (int)h4.y;
            const int Bl = 4 * lp + (c3 >= need ? 3 : c2 >= need ? 2 : c1 >= need ? 1 : 0), ab = c3 >= need ? excl : c2 >= need ? c3 : c1 >= need ? c2 : c1;
            thr |= (unsigned)__builtin_amdgcn_readlane(Bl, Ls) << sh; need -= __builtin_amdgcn_readlane(ab, Ls); }
        const unsigned long long lt = (1ull << lane) - 1ull;
        unsigned long long beq[4], bsel[4];
#pragma unroll
        for (int i = 0; i < 4; ++i) { beq[i] = __ballot(key[i] == thr); if (lane == 0) cnt[i * 8 + wave] = (unsigned)__popcll(beq[i]); }
        __syncthreads();
        { const float c = lane < 32 ? (float)cnt[lane & 31] : 0.f; const float ex = wave_scan_sum(c) - c;
#pragma unroll
          for (int i = 0; i < 4; ++i) { const int eqrank = (int)__builtin_bit_cast(float, __builtin_amdgcn_readlane(__builtin_bit_cast(int, ex), i * 8 + wave)) + __popcll(beq[i] & lt);
              const bool sel = key[i] > thr || (key[i] == thr && eqrank < need);
              bsel[i] = __ballot(sel); if (lane == 0) cnt[32 + i * 8 + wave] = (unsigned)__popcll(bsel[i]); } }
        __syncthreads();
        { const float c = lane < 32 ? (float)cnt[32 + (lane & 31)] : 0.f; const float ex = wave_scan_sum(c) - c;
          unsigned short* idx = (unsigned short*)(p.ws + WS_IDX) + g * CAP; float* gv = (float*)(p.ws + WS_GATEV) + g * CAP; short* slot = (short*)(p.ws + WS_SLOT) + ((size_t)b * 16 + e) * SEQ;
#pragma unroll
          for (int i = 0; i < 4; ++i) { const int sl = (int)__builtin_bit_cast(float, __builtin_amdgcn_readlane(__builtin_bit_cast(int, ex), i * 8 + wave)) + __popcll(bsel[i] & lt); const int tok = i * 512 + tid;
              const bool sel = (bsel[i] >> lane) & 1ull;
              if (sel) { idx[(((sl >> 7) * 64 + (sl & 63)) << 1) + ((sl >> 6) & 1)] = (unsigned short)tok; gv[sl] = __builtin_bit_cast(float, key[i]); }
              slot[tok] = sel ? (short)sl : (short)-1; } }
        __syncthreads();
    }
}

__device__ __forceinline__ float gelu_as(float v) {
    const float t = __builtin_amdgcn_rcpf(fabsf(v) * 0.2316418882f + 1.0f);
    float q = t * 0.5307027145f + (-0.7265760135f); q = q * t + 0.7107068705f; q = q * t + (-0.142248368f); q = q * t + 0.127414796f; q = q * t;
    const float m = v * (q * __builtin_amdgcn_exp2f(v * v * (-0.72134752044f)));
    return v < 0.f ? m : v - m;
}
constexpr int GM_PITCH = 264;
__device__ __forceinline__ void ph_gmlp(const P& p, int l, LAS unsigned char* lds, int wg, int G) {
    const int tid = opaque_tid(), lane = tid & 63, wave = __builtin_amdgcn_readfirstlane(tid >> 6), r = lane & 31, h = lane >> 5, q = lane >> 4, c = lane & 15;
    const bf16* proj = (const bf16*)(p.ws + WS_PROJ); bf16* mixcat = (bf16*)(p.ws + WS_MIXCAT);
    const bf16* wsb = (const bf16*)(p.ws + WS_WS) + (size_t)l * 4 * 128 * 128;
    for (int ui = 0, u; (u = unit_of(wg, G, ui, 256)) < 256; ++ui) {
        const size_t m0 = (size_t)u * 128;
#pragma unroll
        for (int it = 0; it < 4; ++it) { const int t = wave * 16 + it * 4 + q;
            const bf16* src = proj + (m0 + t) * PN + C_GV + 8 * c; const u32x4 x0 = *(const u32x4*)src, x1 = *(const u32x4*)(src + 128);
            float v[16];
#pragma unroll
            for (int i = 0; i < 4; ++i) { v[2 * i] = gelu_as(bflo(x0[i])); v[2 * i + 1] = gelu_as(bfhi(x0[i])); v[8 + 2 * i] = gelu_as(bflo(x1[i])); v[8 + 2 * i + 1] = gelu_as(bfhi(x1[i])); }
            float s = 0.f;
#pragma unroll
            for (int i = 0; i < 16; ++i) s += v[i];
            const float mean = r16_sum(s) * (1.f / 256.f); float qq = 0.f;
#pragma unroll
            for (int i = 0; i < 16; ++i) { v[i] -= mean; qq += v[i] * v[i]; }
            const float rstd = 1.0f / sqrtf(r16_sum(qq) * (1.f / 256.f) + LN_EPS);
            u32x4 o0, o1;
#pragma unroll
            for (int i = 0; i < 4; ++i) { o0[i] = pk2(v[2 * i] * rstd, v[2 * i + 1] * rstd); o1[i] = pk2(v[8 + 2 * i] * rstd, v[8 + 2 * i + 1] * rstd); }
            *(LAS u32x4*)(lds + (t * GM_PITCH + 8 * c) * 2) = o0; *(LAS u32x4*)(lds + (t * GM_PITCH + 128 + 8 * c) * 2) = o1; }
        __syncthreads();
        const int tt = wave & 3, ch = wave >> 2, t = tt * 32 + r;
        u32x2 uu[4][4];
#pragma unroll
        for (int ti = 0; ti < 4; ++ti)
#pragma unroll
            for (int rg = 0; rg < 4; ++rg) uu[ti][rg] = *(const u32x2*)(proj + (m0 + t) * PN + C_GU + ch * 128 + ti * 32 + 8 * rg + 4 * h);
        const int G4 = lane >> 4, q4 = c >> 2, p4 = c & 3;
#pragma unroll
        for (int gi = 0; gi < 2; ++gi) { const int g = ch * 2 + gi;
            bf16x8 wf[8];
#pragma unroll
            for (int ks = 0; ks < 8; ++ks) wf[ks] = *(const bf16x8*)(wsb + ((size_t)g * 128 + t) * 128 + ks * 16 + 8 * h);
            const float bias = p.b_s[(l * 4 + g) * 128 + t];
#pragma unroll
            for (int ci = 0; ci < 2; ++ci) { const int c0 = g * 64 + ci * 32, ti = gi * 2 + ci;
                f32x16 acc; for (int i = 0; i < 16; ++i) acc[i] = 0.f;
                const LAS unsigned char* vb = lds + ((8 * (G4 >> 1) + q4) * GM_PITCH + c0 + 16 * (G4 & 1) + 4 * p4) * 2;
#pragma unroll
                for (int ks = 0; ks < 8; ++ks) { const bf16x8 af = cat8(tr_read(vb + (ks * 16) * GM_PITCH * 2), tr_read(vb + (ks * 16 + 4) * GM_PITCH * 2)); acc = MFMA32(af, wf[ks], acc); }
                bf16* op = mixcat + (m0 + t) * DM + 768 + c0;
#pragma unroll
                for (int rg = 0; rg < 4; ++rg) { const u32x2 w = uu[ti][rg]; u32x2 o;
                    o.x = pk2(gelu_as(bflo(w.x)) * (acc[4 * rg] + bias), gelu_as(bfhi(w.x)) * (acc[4 * rg + 1] + bias));
                    o.y = pk2(gelu_as(bflo(w.y)) * (acc[4 * rg + 2] + bias), gelu_as(bfhi(w.y)) * (acc[4 * rg + 3] + bias));
                    *(u32x2*)(op + 8 * rg + 4 * h) = o; } } }
        __syncthreads();
    }
}

constexpr int AT_PITCH = 144;
constexpr int AT_K = 0, AT_V = 384 * AT_PITCH, AT_BIAS = 2 * 384 * AT_PITCH, AT_BYTES = AT_BIAS + 8 * 257 * 4;
#define AT_SOFTMAX(st, bth_, mrun_, lsum_, oa_, ob_, l2_) do { float mt_ = -3.0e38f; \
        if (diag) { _Pragma("unroll") for (int reg = 0; reg < 16; ++reg) { const int band = band0 + crow(reg, h), rel = band - 128 - qloc; const bool ok = (rel >= -128) && (rel <= 128); \
                const float bias = (bth_)[ok ? band : 128 + qloc]; l2_[reg] = (st[reg] * (0.125f * L2E) + bias) + (ok ? 0.f : -3.0e38f); mt_ = fmaxf(mt_, l2_[reg]); } }   \
        else { _Pragma("unroll") for (int reg = 0; reg < 16; ++reg) { l2_[reg] = st[reg] * (0.125f * L2E) + (bth_)[band0 + crow(reg, h)]; mt_ = fmaxf(mt_, l2_[reg]); } } \
        { const auto rr_ = __builtin_amdgcn_permlane32_swap(__float_as_uint(mt_), __float_as_uint(mt_), false, false); mt_ = fmaxf(__uint_as_float(rr_[0]), __uint_as_float(rr_[1])); } \
        const float mnew_ = fmaxf(mrun_, mt_); \
        if (__any(mnew_ > mrun_)) { const float f_ = __builtin_amdgcn_exp2f(mrun_ - mnew_); lsum_ *= f_; _Pragma("unroll") for (int i = 0; i < 16; ++i) { oa_[i] *= f_; ob_[i] *= f_; } mrun_ = mnew_; } \
        float ps_ = 0.f; _Pragma("unroll") for (int reg = 0; reg < 16; ++reg) { l2_[reg] = __builtin_amdgcn_exp2f(l2_[reg] - mrun_); ps_ += l2_[reg]; } \
        lsum_ += ps_; } while (0)
__device__ __forceinline__ void ph_attn(const P& p, int l, LAS unsigned char* lds, int wg, int G) {
    const int tid = opaque_tid(), lane = tid & 63, wave = __builtin_amdgcn_readfirstlane(tid >> 6), r = lane & 31, h = lane >> 5;
    const bf16* proj = (const bf16*)(p.ws + WS_PROJ); bf16* mixcat = (bf16*)(p.ws + WS_MIXCAT);
    LAS float* bt = (LAS float*)(lds + AT_BIAS);
    const float L2E = 1.4426950408889634f;
    for (int i = tid; i < 8 * 257; i += 512) { const int hd = i / 257, rr = i - hd * 257; bt[i] = p.rel_bias[t5_bucket(rr - 128) * 8 + hd] * L2E; }
    for (int ui = 0, u; (u = unit_of(wg, G, ui, 512)) < 512; ++ui) {
        const int b = u >> 5, n = (u >> 1) & 15, hk = u & 1;
        { u32x4 kv[6], vv[6];
#pragma unroll
          for (int i = 0; i < 6; ++i) { const int id = i * 512 + tid, row = id >> 3, chn = id & 7; int pos = (n - 1) * 128 + row; pos = pos < 0 ? 0 : (pos > SEQ - 1 ? SEQ - 1 : pos);
              const bf16* src = proj + ((size_t)b * SEQ + pos) * PN + hk * 64 + chn * 8; kv[i] = *(const u32x4*)(src + C_AK); vv[i] = *(const u32x4*)(src + C_AV); }
#pragma unroll
          for (int i = 0; i < 6; ++i) { const int id = i * 512 + tid, row = id >> 3, chn = id & 7;
              *(LAS u32x4*)(lds + AT_K + row * AT_PITCH + chn * 16) = kv[i]; *(LAS u32x4*)(lds + AT_V + row * AT_PITCH + chn * 16) = vv[i]; } }
        const int tq = wave & 3, hh0 = (wave >> 2) * 2, qloc = tq * 32 + r; const size_t m = (size_t)b * SEQ + n * 128 + qloc;
        bf16x8 qa[4], qb[4];
#pragma unroll
        for (int s = 0; s < 4; ++s) { qa[s] = *(const bf16x8*)(proj + m * PN + C_AQ + (hk * 4 + hh0) * 64 + s * 16 + 8 * h); qb[s] = *(const bf16x8*)(proj + m * PN + C_AQ + (hk * 4 + hh0 + 1) * 64 + s * 16 + 8 * h); }
        const float sinka = p.sink[l * 8 + hk * 4 + hh0] * L2E, sinkb = p.sink[l * 8 + hk * 4 + hh0 + 1] * L2E;
        __syncthreads();
        float mra = sinka, mrb = sinkb, lsa = 0.f, lsb = 0.f; f32x16 oa0, oa1, ob0, ob1; for (int i = 0; i < 16; ++i) { oa0[i] = 0.f; oa1[i] = 0.f; ob0[i] = 0.f; ob1[i] = 0.f; }
        const LAS float* btha = bt + (hk * 4 + hh0) * 257 - qloc; const LAS float* bthb = btha + 257;
        const int G4 = lane >> 4, i16 = lane & 15, q4 = i16 >> 2, p4 = i16 & 3;
#pragma unroll 1
        for (int kt = 0; kt < 12; ++kt) { const int kb = kt >> 2, tk = kt & 3;
            const int blk = n - 1 + kb; if (blk < 0 || blk > 15) continue;
            if (kb == 0 && tk < tq) continue; if (kb == 2 && tk > tq) continue;
            const bool diag = (kb != 1) && (tk == tq);
            const int band0 = kb * 128 + tk * 32;
            f32x16 sa, sb; for (int i = 0; i < 16; ++i) { sa[i] = 0.f; sb[i] = 0.f; }
#pragma unroll
            for (int s = 0; s < 4; ++s) { const bf16x8 kf = *(const LAS bf16x8*)(lds + AT_K + (band0 + r) * AT_PITCH + (s * 16 + 8 * h) * 2); sa = MFMA32(kf, qa[s], sa); sb = MFMA32(kf, qb[s], sb); }
            float la[16], lb[16];
            AT_SOFTMAX(sa, btha, mra, lsa, oa0, oa1, la);
            AT_SOFTMAX(sb, bthb, mrb, lsb, ob0, ob1, lb);
            const bf16x8 pa0 = pack8(la[0], la[1], la[2], la[3], la[4], la[5], la[6], la[7]), pa1 = pack8(la[8], la[9], la[10], la[11], la[12], la[13], la[14], la[15]);
            const bf16x8 pb0 = pack8(lb[0], lb[1], lb[2], lb[3], lb[4], lb[5], lb[6], lb[7]), pb1 = pack8(lb[8], lb[9], lb[10], lb[11], lb[12], lb[13], lb[14], lb[15]);
            const LAS unsigned char* vb = lds + AT_V + (band0 + 4 * (G4 >> 1) + q4) * AT_PITCH + (16 * (G4 & 1) + 4 * p4) * 2;
#pragma unroll
            for (int s = 0; s < 2; ++s) {
                const bf16x8 va0 = cat8(tr_read(vb + (16 * s) * AT_PITCH), tr_read(vb + (16 * s + 8) * AT_PITCH));
                const bf16x8 va1 = cat8(tr_read(vb + (16 * s) * AT_PITCH + 64), tr_read(vb + (16 * s + 8) * AT_PITCH + 64));
                oa0 = MFMA32(va0, s ? pa1 : pa0, oa0); oa1 = MFMA32(va1, s ? pa1 : pa0, oa1); ob0 = MFMA32(va0, s ? pb1 : pb0, ob0); ob1 = MFMA32(va1, s ? pb1 : pb0, ob1); }
        }
#pragma unroll
        for (int x = 0; x < 2; ++x) { float ls = x ? lsb : lsa; const float mr = x ? mrb : mra, sk = x ? sinkb : sinka;
            ls += __shfl_xor(ls, 32); ls += __builtin_amdgcn_exp2f(sk - mr);
            const float inv = 1.0f / ls; const f32x16 o0 = x ? ob0 : oa0, o1 = x ? ob1 : oa1;
            bf16* op = mixcat + m * DM + (hk * 4 + hh0 + x) * 64;
#pragma unroll
            for (int rg = 0; rg < 4; ++rg) { u32x2 w0, w1;
                w0.x = cvtpk(o0[4 * rg] * inv, o0[4 * rg + 1] * inv); w0.y = cvtpk(o0[4 * rg + 2] * inv, o0[4 * rg + 3] * inv);
                w1.x = cvtpk(o1[4 * rg] * inv, o1[4 * rg + 1] * inv); w1.y = cvtpk(o1[4 * rg + 2] * inv, o1[4 * rg + 3] * inv);
                *(u32x2*)(op + 8 * rg + 4 * h) = w0; *(u32x2*)(op + 32 + 8 * rg + 4 * h) = w1; } }
        __syncthreads();
    }
}
#undef AT_SOFTMAX

struct GateVec { int ta, tb; float b0, b1, fs0, fs1, pm0, pm1, total, mx; };
struct GateRaw { float ig0, ig1, f0, f1; };
__device__ __forceinline__ GateRaw gate_loads(const float* gates, size_t m0, int head, int dir, int lane) {
    const int ta = dir == 0 ? 2 * lane : 127 - 2 * lane, tb = dir == 0 ? ta + 1 : ta - 1;
    const float* ga = gates + (m0 + ta) * 16 + dir * 8 + head; const float* gb = gates + (m0 + tb) * 16 + dir * 8 + head;
    GateRaw g; g.ig0 = ga[0]; g.ig1 = gb[0]; g.f0 = ga[4]; g.f1 = gb[4]; return g; }
__device__ __forceinline__ GateVec gate_vectors(const GateRaw& g, int dir, int lane) {
    GateVec r; r.ta = dir == 0 ? 2 * lane : 127 - 2 * lane; r.tb = dir == 0 ? r.ta + 1 : r.ta - 1;
    const float ig0 = g.ig0, ig1 = g.ig1, lf0 = logsigmoid_f(g.f0), lf1 = logsigmoid_f(g.f1);
    const float s = lf0 + lf1, incl = wave_scan_sum(s), excl = incl - s;
    r.total = __builtin_bit_cast(float, __builtin_amdgcn_readlane(__builtin_bit_cast(int, incl), 63));
    r.b0 = excl + lf0; r.b1 = r.b0 + lf1; r.fs0 = ig0 - r.b0; r.fs1 = ig1 - r.b1;
    const float pi = wave_scan_max(fmaxf(r.fs0, r.fs1)), pe = dpp_id<0x138, 0xf>(-3.0e38f, pi);
    r.pm0 = fmaxf(pe, r.fs0); r.pm1 = fmaxf(r.pm0, r.fs1);
    r.mx = __builtin_bit_cast(float, __builtin_amdgcn_readlane(__builtin_bit_cast(int, pi), 63));
    return r;
}
constexpr int MA_P = 144;
constexpr int MA_K = 0, MA_VW = 128 * MA_P, MA_WEXP = 3 * 128 * MA_P, MA_BYTES = MA_WEXP + 1024;
__device__ __forceinline__ void ph_mlstm_a(const P& p, int l, LAS unsigned char* lds, int wg, int G) {
    const int tid = opaque_tid(), lane = tid & 63, wave = __builtin_amdgcn_readfirstlane(tid >> 6), r = lane & 31, h = lane >> 5;
    const bf16* proj = (const bf16*)(p.ws + WS_PROJ); bf16* qkt = (bf16*)(p.ws + WS_QKT); const float* gates = (const float*)(p.ws + WS_GATES);
    bf16* DC = (bf16*)(p.ws + WS_DC); float* DN = (float*)(p.ws + WS_DN); float* DS = (float*)(p.ws + WS_DS);
    LAS float* wexp = (LAS float*)(lds + MA_WEXP);
    const int c8 = tid & 7, isk = (tid >> 3) & 1, tq = tid >> 4, tv = tid >> 3;
    for (int ui = 0, u; (u = unit_of(wg, G, ui, 1024)) < 1024; ++ui) {
        const int b = u >> 6, head = (u >> 4) & 3, chunk = u & 15; const size_t m0 = (size_t)b * SEQ + chunk * 128;
        const GateRaw graw = gate_loads(gates, m0, head, wave & 1, lane);
        f32x4 wv[8];
        { const float* cwp = p.conv_w + (size_t)l * 3 * 512 + isk * 256 + head * 64 + c8 * 8; const float* cbp = p.conv_b + l * 512 + isk * 256 + head * 64 + c8 * 8;
#pragma unroll
          for (int tap = 0; tap < 3; ++tap) { wv[2 * tap] = *(const f32x4*)(cwp + tap * 512); wv[2 * tap + 1] = *(const f32x4*)(cwp + tap * 512 + 4); }
          wv[6] = *(const f32x4*)cbp; wv[7] = *(const f32x4*)(cbp + 4); }
        u32x4 xl[3][4];
#pragma unroll
        for (int i = 0; i < 4; ++i) { const int t = tq + 32 * i, tpos = chunk * 128 + t; const bf16* pr = proj + (m0 + t) * PN + (isk ? C_MK : C_MQ) + head * 64 + c8 * 8;
            xl[1][i] = *(const u32x4*)pr; xl[0][i] = *(const u32x4*)(tpos > 0 ? pr - PN : pr); xl[2][i] = *(const u32x4*)(tpos < SEQ - 1 ? pr + PN : pr); }
        u32x4 vpre[2];
#pragma unroll
        for (int i = 0; i < 2; ++i) vpre[i] = *(const u32x4*)(proj + (m0 + tv + 64 * i) * PN + C_MV + head * 64 + c8 * 8);
        if (wave < 2) { const int dir = wave; const GateVec gv = gate_vectors(graw, dir, lane);
            wexp[dir * 128 + gv.ta] = __expf(gv.fs0 - gv.mx); wexp[dir * 128 + gv.tb] = __expf(gv.fs1 - gv.mx);
            if (lane == 0) { DS[(size_t)(u * 2 + dir) * 2] = gv.total; DS[(size_t)(u * 2 + dir) * 2 + 1] = gv.total + gv.mx; } }
        { const float sc = isk ? 0.125f : 1.0f;
#pragma unroll
          for (int i = 0; i < 4; ++i) { const int t = tq + 32 * i, tpos = chunk * 128 + t; const bool hp = tpos > 0, hn = tpos < SEQ - 1;
              const u32x4 z = (u32x4){0u, 0u, 0u, 0u}; const u32x4 x0 = hp ? xl[0][i] : z, x1 = xl[1][i], x2 = hn ? xl[2][i] : z;
              float y[8];
#pragma unroll
              for (int q = 0; q < 4; ++q) { const int c = 2 * q;
                  y[c] = wv[6 + (c >> 2)][c & 3] + wv[c >> 2][c & 3] * bflo(x0[q]) + wv[2 + (c >> 2)][c & 3] * bflo(x1[q]) + wv[4 + (c >> 2)][c & 3] * bflo(x2[q]);
                  y[c + 1] = wv[6 + (c >> 2)][(c & 3) + 1] + wv[c >> 2][(c & 3) + 1] * bfhi(x0[q]) + wv[2 + (c >> 2)][(c & 3) + 1] * bfhi(x1[q]) + wv[4 + (c >> 2)][(c & 3) + 1] * bfhi(x2[q]); }
#pragma unroll
              for (int k = 0; k < 8; ++k) y[k] = silu_acc(y[k]) * sc;
              u32x4 o; o.x = pk2(y[0], y[1]); o.y = pk2(y[2], y[3]); o.z = pk2(y[4], y[5]); o.w = pk2(y[6], y[7]);
              *(u32x4*)(qkt + (m0 + t) * 512 + isk * 256 + head * 64 + c8 * 8) = o;
              if (isk) *(LAS u32x4*)(lds + MA_K + t * MA_P + c8 * 16) = o; } }
        __syncthreads();
#pragma unroll
        for (int i = 0; i < 2; ++i) { const int t = tv + 64 * i; const float wf = wexp[t], wb = wexp[128 + t]; const u32x4 x = vpre[i]; u32x4 of, ob;
#pragma unroll
            for (int q = 0; q < 4; ++q) { const float lo = bflo(x[q]), hi = bfhi(x[q]); of[q] = pk2(lo * wf, hi * wf); ob[q] = pk2(lo * wb, hi * wb); }
            *(LAS u32x4*)(lds + MA_VW + t * MA_P + c8 * 16) = of; *(LAS u32x4*)(lds + MA_VW + (128 + t) * MA_P + c8 * 16) = ob; }
        __syncthreads();
        { const int dir = wave >> 2, et = (wave >> 1) & 1, dt = wave & 1;
          const int G4 = lane >> 4, i16 = lane & 15, q4 = i16 >> 2, p4 = i16 & 3;
          const LAS unsigned char* ab = lds + MA_VW + (dir * 128 + 4 * (G4 >> 1) + q4) * MA_P + (et * 32 + 16 * (G4 & 1) + 4 * p4) * 2;
          const LAS unsigned char* bb = lds + MA_K + (4 * (G4 >> 1) + q4) * MA_P + (dt * 32 + 16 * (G4 & 1) + 4 * p4) * 2;
          f32x16 acc, accn; for (int i = 0; i < 16; ++i) { acc[i] = 0.f; accn[i] = 0.f; }
#pragma unroll
          for (int ks = 0; ks < 8; ++ks) { const bf16x8 af = cat8(tr_read(ab + (16 * ks) * MA_P), tr_read(ab + (16 * ks + 8) * MA_P)), kf = cat8(tr_read(bb + (16 * ks) * MA_P), tr_read(bb + (16 * ks + 8) * MA_P));
              acc = MFMA32(af, kf, acc);
              if (et == 0) { const f32x4 w0 = *(const LAS f32x4*)(wexp + dir * 128 + 16 * ks + 4 * h), w1 = *(const LAS f32x4*)(wexp + dir * 128 + 16 * ks + 8 + 4 * h);
                  const bool r0 = r == 0; const bf16x8 wa = pack8(r0 ? w0[0] : 0.f, r0 ? w0[1] : 0.f, r0 ? w0[2] : 0.f, r0 ? w0[3] : 0.f, r0 ? w1[0] : 0.f, r0 ? w1[1] : 0.f, r0 ? w1[2] : 0.f, r0 ? w1[3] : 0.f);
                  accn = MFMA32(wa, kf, accn); } }
          bf16* dc = DC + (size_t)(u * 2 + dir) * 4096;
#pragma unroll
          for (int reg = 0; reg < 16; ++reg) dc[(et * 32 + crow(reg, h)) * 64 + dt * 32 + r] = (bf16)f2bf(acc[reg]);
          if (et == 0 && h == 0) DN[(size_t)(u * 2 + dir) * 64 + dt * 32 + r] = accn[0]; }
        __syncthreads();
    }
}
constexpr int MC_PITCH = 144;
constexpr int MC_Q = 0, MC_K = 128 * MC_PITCH, MC_V = 2 * 128 * MC_PITCH, MC_C = 3 * 128 * MC_PITCH;
constexpr int MC_X = 131072 + 1024;
constexpr int MC_VEC = MC_X, MC_COEF = MC_VEC + 3072, MC_MS = MC_COEF + 512, MC_N = MC_MS + 64;
constexpr int MC_HP = 66;
__device__ __forceinline__ void ph_mlstm_c(const P& p, int l, LAS unsigned char* lds, int wg, int G) {
    const int tid = opaque_tid(), lane = tid & 63, wave = __builtin_amdgcn_readfirstlane(tid >> 6), r = lane & 31, h = lane >> 5;
    const bf16* proj = (const bf16*)(p.ws + WS_PROJ); const bf16* qkt = (const bf16*)(p.ws + WS_QKT); const float* gates = (const float*)(p.ws + WS_GATES); bf16* mixcat = (bf16*)(p.ws + WS_MIXCAT);
    const bf16* DC = (const bf16*)(p.ws + WS_DC); const float* DN = (const float*)(p.ws + WS_DN); const float* DS = (const float*)(p.ws + WS_DS);
    LAS float* nvecS = (LAS float*)(lds + MC_N); LAS float* vfs = (LAS float*)(lds + MC_VEC); LAS float* vM = vfs + 256; LAS float* vb = vfs + 512;
    LAS float* coefS = (LAS float*)(lds + MC_COEF); LAS float* mS = (LAS float*)(lds + MC_MS);
    LAS unsigned short* hbuf = (LAS unsigned short*)lds;
    for (int ui = 0, u4; (u4 = unit_of(wg, G, ui, 256)) < 256; ++ui) {
        const int b = u4 >> 4, head = (u4 >> 2) & 3, c0 = (u4 & 3) * 4, ubase = (b * 4 + head) * 16;
        u32x4 dcr[18]; float dnr[18];
        { const f32x2c dsv = *(const f32x2c*)(DS + (size_t)((ubase + (lane & 15)) * 2 + (wave & 1)) * 2);
#pragma unroll
          for (int i = 0; i < 18; ++i) { const int dj = i >= c0 + 3 ? 1 : 0, j = dj ? i - 2 : i;
              dcr[i] = *(const u32x4*)(DC + (size_t)((ubase + j) * 2 + dj) * 4096 + tid * 8);
              dnr[i] = DN[(size_t)((ubase + j) * 2 + dj) * 64 + lane]; }
          const int dir = wave & 1, chunk = c0 + (wave >> 1), n = dir == 0 ? chunk : 15 - chunk;
          const bool in16 = lane < 16, valid = in16 && (dir == 0 ? lane < chunk : lane > chunk);
          const float bLv = in16 ? dsv[0] : 0.f, mlv = dsv[1];
          const float Pf = wave_scan_sum(bLv);
          const float Pc1 = __shfl(Pf, chunk > 0 ? chunk - 1 : 0), Pc = __shfl(Pf, chunk), P15 = __shfl(Pf, 15);
          const float Si = dir == 0 ? Pc1 - Pf : (Pf - bLv) - Pc, Sall = dir == 0 ? Pc1 : P15 - Pc;
          const float cand = valid ? mlv + Si : -3.0e38f;
          const float m = n > 0 ? fmaxf(Sall, wave_max(cand)) : 0.f;
          if (in16) coefS[wave * 16 + lane] = valid ? __expf(cand - m) : 0.f;
          if (lane == 0) mS[wave] = m; }
        __syncthreads();
        { float acc[4][8], accn[4];
#pragma unroll
          for (int k = 0; k < 4; ++k) { accn[k] = 0.f;
#pragma unroll
              for (int e = 0; e < 8; ++e) acc[k][e] = 0.f; }
#pragma unroll
          for (int i = 0; i < 18; ++i) { const int dj = i >= c0 + 3 ? 1 : 0, j = dj ? i - 2 : i;
              float x[8];
#pragma unroll
              for (int q = 0; q < 4; ++q) { x[2 * q] = bflo(dcr[i][q]); x[2 * q + 1] = bfhi(dcr[i][q]); }
#pragma unroll
              for (int k = 0; k < 4; ++k) { const float cf = coefS[(k * 2 + dj) * 16 + j]; accn[k] += cf * dnr[i];
#pragma unroll
                  for (int e = 0; e < 8; ++e) acc[k][e] += cf * x[e]; }
              if (i == 17 || ((i == 2 || i == 6 || i == 10 || i == 14) && i == c0 + 2)) { const int dd = i == 17 ? 1 : 0;
#pragma unroll
                  for (int k = 0; k < 4; ++k) { u32x4 o;
#pragma unroll
                      for (int q = 0; q < 4; ++q) o[q] = pk2(acc[k][2 * q], acc[k][2 * q + 1]);
                      *(LAS u32x4*)(lds + MC_C + ((k * 2 + dd) * 64 + (tid >> 3)) * MC_PITCH + (tid & 7) * 16) = o;
                      if (tid < 64) nvecS[(k * 2 + dd) * 64 + tid] = accn[k];
                      accn[k] = 0.f;
#pragma unroll
                      for (int e = 0; e < 8; ++e) acc[k][e] = 0.f; } } } }
#pragma unroll 1
        for (int kc = 0; kc < 4; ++kc) { const int chunk = c0 + kc; const size_t m0 = (size_t)b * SEQ + chunk * 128;
        const GateRaw graw = gate_loads(gates, m0, head, wave & 1, lane);
        u32x4 stg[6];
#pragma unroll
        for (int i = 0; i < 6; ++i) { const int id = i * 512 + tid, arr = id >> 10, rem = id & 1023, row = rem >> 3, chn = rem & 7;
            const bf16* src = arr == 2 ? proj + (m0 + row) * PN + C_MV + head * 64 + chn * 8 : qkt + (m0 + row) * 512 + arr * 256 + head * 64 + chn * 8;
            stg[i] = *(const u32x4*)src; }
        u32x4 mopre[2];
#pragma unroll
        for (int i = 0; i < 2; ++i) { const int id = i * 512 + tid; mopre[i] = *(const u32x4*)(proj + (m0 + (id >> 3)) * PN + C_MO + head * 64 + (id & 7) * 8); }
        if (wave < 2) { const int dir = wave; const GateVec gv = gate_vectors(graw, dir, lane);
            vfs[dir * 128 + gv.ta] = gv.fs0; vfs[dir * 128 + gv.tb] = gv.fs1;
            vM[dir * 128 + gv.ta] = gv.pm0; vM[dir * 128 + gv.tb] = gv.pm1;
            vb[dir * 128 + gv.ta] = gv.b0; vb[dir * 128 + gv.tb] = gv.b1; }
#pragma unroll
        for (int i = 0; i < 6; ++i) { const int id = i * 512 + tid, arr = id >> 10, rem = id & 1023, row = rem >> 3, chn = rem & 7;
            *(LAS u32x4*)(lds + arr * 128 * MC_PITCH + row * MC_PITCH + chn * 16) = stg[i]; }
        __syncthreads();
        const int dir = wave >> 2, tt = wave & 3, t = tt * 32 + r;
        const LAS unsigned char* Cs = lds + MC_C + (kc * 2 + dir) * 64 * MC_PITCH; const LAS float* nvec = nvecS + (kc * 2 + dir) * 64; const float mC = mS[kc * 2 + dir];
        f32x16 nS0, nS1, nI0, nI1; for (int i = 0; i < 16; ++i) { nS0[i] = 0.f; nS1[i] = 0.f; nI0[i] = 0.f; nI1[i] = 0.f; }
        float dinv, iw;
        {
            bf16x8 qf[4];
#pragma unroll
            for (int s = 0; s < 4; ++s) qf[s] = *(const LAS bf16x8*)(lds + MC_Q + t * MC_PITCH + (s * 16 + 8 * h) * 2);
            const float Mt = fmaxf(mC, vM[dir * 128 + t]); float rowsum = 0.f;
#pragma unroll 1
            for (int st = 0; st < 4; ++st) { if (dir == 0 ? st > tt : st < tt) continue;
                f32x16 sT; for (int i = 0; i < 16; ++i) sT[i] = 0.f;
#pragma unroll
                for (int s = 0; s < 4; ++s) { const bf16x8 kf = *(const LAS bf16x8*)(lds + MC_K + (st * 32 + r) * MC_PITCH + (s * 16 + 8 * h) * 2); sT = MFMA32(kf, qf[s], sT); }
                float pv[16];
#pragma unroll
                for (int rg = 0; rg < 4; ++rg) { const f32x4 f4 = *(const LAS f32x4*)(vfs + dir * 128 + st * 32 + 8 * rg + 4 * h);
#pragma unroll
                    for (int k = 0; k < 4; ++k) { const int si = st * 32 + 8 * rg + 4 * h + k; const bool ok = dir == 0 ? si <= t : si >= t;
                        const float dv = ok ? __expf(f4[k] - Mt) : 0.f; pv[4 * rg + k] = sT[4 * rg + k] * dv; rowsum += pv[4 * rg + k]; } }
                const bf16x8 pf0 = pack8(pv[0], pv[1], pv[2], pv[3], pv[4], pv[5], pv[6], pv[7]), pf1 = pack8(pv[8], pv[9], pv[10], pv[11], pv[12], pv[13], pv[14], pv[15]);
                const int G4 = lane >> 4, i16 = lane & 15, q4 = i16 >> 2, p4 = i16 & 3;
                const LAS unsigned char* vbp = lds + MC_V + (st * 32 + 4 * (G4 >> 1) + q4) * MC_PITCH + (16 * (G4 & 1) + 4 * p4) * 2;
#pragma unroll
                for (int s = 0; s < 2; ++s) { const bf16x8 pf = s ? pf1 : pf0;
                    const bf16x8 va0 = cat8(tr_read(vbp + (16 * s) * MC_PITCH), tr_read(vbp + (16 * s + 8) * MC_PITCH));
                    const bf16x8 va1 = cat8(tr_read(vbp + (16 * s) * MC_PITCH + 64), tr_read(vbp + (16 * s + 8) * MC_PITCH + 64));
                    nS0 = MFMA32(va0, pf, nS0); nS1 = MFMA32(va1, pf, nS1); }
            }
            float nq = 0.f;
#pragma unroll
            for (int s = 0; s < 4; ++s) { const bf16x8 cc0 = *(const LAS bf16x8*)(Cs + r * MC_PITCH + (s * 16 + 8 * h) * 2), cc1 = *(const LAS bf16x8*)(Cs + (32 + r) * MC_PITCH + (s * 16 + 8 * h) * 2);
                nI0 = MFMA32(cc0, qf[s], nI0); nI1 = MFMA32(cc1, qf[s], nI1);
#pragma unroll
                for (int j = 0; j < 8; ++j) nq += nvec[s * 16 + 8 * h + j] * bf2f((unsigned short)qf[s][j]); }
            nq += __shfl_xor(nq, 32); rowsum += __shfl_xor(rowsum, 32);
            iw = __expf(mC - Mt);
            const float den = rowsum + iw * nq, lower = __expf(-(vb[dir * 128 + t] + Mt));
            dinv = 1.0f / fmaxf(fabsf(den), lower);
        }
        __syncthreads();
#pragma unroll
        for (int reg = 0; reg < 16; ++reg) { const int e = crow(reg, h);
            hbuf[(dir * 128 + t) * MC_HP + e] = f2bf((nS0[reg] + iw * nI0[reg]) * dinv); hbuf[(dir * 128 + t) * MC_HP + 32 + e] = f2bf((nS1[reg] + iw * nI1[reg]) * dinv); }
        __syncthreads();
#pragma unroll
        for (int i = 0; i < 2; ++i) { const int id = i * 512 + tid, tq = id >> 3, e0 = (id & 7) * 8; float o[8];
#pragma unroll
            for (int k = 0; k < 4; ++k) { const unsigned wf = *(const LAS unsigned*)(hbuf + tq * MC_HP + e0 + 2 * k), wb = *(const LAS unsigned*)(hbuf + (128 + tq) * MC_HP + e0 + 2 * k);
                o[2 * k] = sigmoid_f(bflo(mopre[i][k])) * (bflo(wf) + bflo(wb)); o[2 * k + 1] = sigmoid_f(bfhi(mopre[i][k])) * (bfhi(wf) + bfhi(wb)); }
            u32x4 w; w.x = pk2(o[0], o[1]); w.y = pk2(o[2], o[3]); w.z = pk2(o[4], o[5]); w.w = pk2(o[6], o[7]);
            *(u32x4*)(mixcat + (m0 + tq) * DM + 512 + head * 64 + e0) = w; }
        __syncthreads();
        }
    }
}

typedef GAS unsigned gu32;
#define RLX_AGENT __ATOMIC_RELAXED, __HIP_MEMORY_SCOPE_AGENT
#define XB_TMO      128
#define XB_XCNT(j)  (256  + 64 * (j))
#define XB_XSUB(j)  (1280 + 64 * (j))
#define XB_XGEN(j)  (2304 + 64 * (j))
#define XB_TOP      3328
#define XB_TOPGEN   3392
#define XCD_BAR_WORDS 3456
#define XB_SPIN_CAP (1u << 18)

__device__ __forceinline__ unsigned xb_ld(unsigned* p)              { return __hip_atomic_load(p, __ATOMIC_RELAXED, __HIP_MEMORY_SCOPE_AGENT); }
__device__ __forceinline__ unsigned xb_add(unsigned* p, unsigned v) { return __hip_atomic_fetch_add(p, v, __ATOMIC_RELAXED, __HIP_MEMORY_SCOPE_AGENT); }
__device__ __forceinline__ unsigned xb_xcc_id() { return (unsigned)__builtin_amdgcn_s_getreg((3 << 11) | 20) & 0xFu; }
#define XB_SPIN(cond, bar) do { unsigned _sp = 0; while (cond) { __builtin_amdgcn_s_sleep(1); \
    if ((++_sp & 255u) == 0u) { if (xb_ld(&(bar)[XB_TMO])) break; if (_sp > XB_SPIN_CAP) { atomicAdd(&(bar)[XB_TMO], 1u); break; } } } } while (0)

struct XcdBarrier {
    unsigned* bar; unsigned x;
    volatile LAS unsigned* st;
};

__device__ __forceinline__ XcdBarrier xcd_barrier_post(unsigned* bar, volatile LAS unsigned* st) {
    XcdBarrier b; b.bar = bar; b.x = xb_xcc_id(); b.st = st;
    if (threadIdx.x == 0) (void)xb_add(&bar[XB_XCNT(b.x)], 1u);
    return b;
}
__device__ __forceinline__ void xcd_barrier_complete(unsigned* bar, unsigned x, unsigned& nloc, unsigned& nx) {
    const unsigned G = gridDim.x * gridDim.y * gridDim.z;
    unsigned sum, cnt, mine, sp = 0u;
    for (;;) {
        sum = 0u; cnt = 0u; mine = 0u;
#pragma unroll
        for (unsigned j = 0; j < 16; ++j) { const unsigned c = xb_ld(&bar[XB_XCNT(j)]); sum += c; cnt += (c > 0u) ? 1u : 0u; mine = (j == x) ? c : mine; }
        if (sum == G) break;
        __builtin_amdgcn_s_sleep(1);
        if ((++sp & 255u) == 0u) { if (xb_ld(&bar[XB_TMO])) break; if (sp > XB_SPIN_CAP) { atomicAdd(&bar[XB_TMO], 1u); break; } }
    }
    nloc = mine > 0u ? mine : 1u; nx = cnt > 0u ? cnt : 1u;
}

__device__ __forceinline__ void xcd_barrier(const XcdBarrier& b) {
    asm volatile("s_waitcnt vmcnt(0)" ::: "memory");
    __syncthreads();
    if (threadIdx.x == 0) {
        unsigned* bar = b.bar;
        __builtin_amdgcn_s_waitcnt(0);
        unsigned nloc = b.st[0], nx = b.st[1];
        if (nloc == 0u) { xcd_barrier_complete(bar, b.x, nloc, nx); b.st[0] = nloc; b.st[1] = nx; }
        const unsigned old = xb_add(&bar[XB_XSUB(b.x)], 1u);
        const unsigned gen = old / nloc;
        if (old + 1u == (gen + 1u) * nloc) {
            __builtin_amdgcn_fence(__ATOMIC_RELEASE, "agent");
            asm volatile("s_waitcnt vmcnt(0)" ::: "memory");
            const unsigned og = xb_add(&bar[XB_TOP], 1u);
            const unsigned tg = og / nx;
            if (og + 1u == (tg + 1u) * nx) xb_add(&bar[XB_TOPGEN], 1u);
            else XB_SPIN(xb_ld(&bar[XB_TOPGEN]) == tg, bar);
            __builtin_amdgcn_fence(__ATOMIC_ACQUIRE, "agent");
            xb_add(&bar[XB_XGEN(b.x)], 1u);
            asm volatile("s_waitcnt vmcnt(0)" ::: "memory");
        } else {
            XB_SPIN(xb_ld(&bar[XB_XGEN(b.x)]) == gen, bar);
            __builtin_amdgcn_fence(__ATOMIC_ACQUIRE, "agent");
            asm volatile("s_waitcnt vmcnt(0)" ::: "memory");
        }
    }
    __syncthreads();
}


constexpr int CW_Q = 8192;
__device__ __forceinline__ bool conv_batch(const P& p, int ql, volatile LAS unsigned* wl, LAS unsigned char* L) {
    const int tid = opaque_tid(), lane = tid & 63, wave = __builtin_amdgcn_readfirstlane(tid >> 6);
    if (tid == 0) wl[3] = __hip_atomic_fetch_add((unsigned*)(p.ws + WS_CTL) + CW_Q + 64 * ql, 8u, __ATOMIC_RELAXED, __HIP_MEMORY_SCOPE_AGENT);
    __syncthreads();
    const unsigned base = wl[3];
    if (base + wave < (unsigned)ITM) convert_item(p, ql, ITS + (int)base + wave, (LAS float*)L + wave * (64 * 33), lane);
    __syncthreads();
    return base + 8u < (unsigned)ITM;
}
__device__ __forceinline__ void conv_drain(const P& p, int& qa, int upto, volatile LAS unsigned* wl, LAS unsigned char* L) { while (qa <= upto) { if (!conv_batch(p, qa, wl, L)) ++qa; } }
__device__ __forceinline__ void xcd_barrier_work(const XcdBarrier& b, const P& p, int& qa, volatile LAS unsigned* wl, LAS unsigned char* L) {
    asm volatile("s_waitcnt vmcnt(0)" ::: "memory");
    __syncthreads();
    if (threadIdx.x == 0) {
        unsigned* bar = b.bar;
        __builtin_amdgcn_s_waitcnt(0);
        unsigned nloc = b.st[0], nx = b.st[1];
        if (nloc == 0u) { xcd_barrier_complete(bar, b.x, nloc, nx); b.st[0] = nloc; b.st[1] = nx; }
        const unsigned old = xb_add(&bar[XB_XSUB(b.x)], 1u);
        const unsigned gen = old / nloc;
        if (old + 1u == (gen + 1u) * nloc) {
            __builtin_amdgcn_fence(__ATOMIC_RELEASE, "agent");
            asm volatile("s_waitcnt vmcnt(0)" ::: "memory");
            const unsigned og = xb_add(&bar[XB_TOP], 1u);
            const unsigned tg = og / nx;
            if (og + 1u == (tg + 1u) * nx) { xb_add(&bar[XB_TOPGEN], 1u); wl[0] = 2u; }
            else { wl[0] = 1u; wl[1] = tg; }
        } else { wl[0] = 0u; wl[1] = gen; }
    }
    unsigned polls = 0u;
    for (;;) {
        if (threadIdx.x == 0) { unsigned* bar = b.bar; const unsigned role = wl[0], want = wl[1];
            bool done = role == 2u || (role == 1u ? xb_ld(&bar[XB_TOPGEN]) != want : xb_ld(&bar[XB_XGEN(b.x)]) != want);
            if (!done && (++polls & 255u) == 0u) { if (xb_ld(&bar[XB_TMO])) done = true; else if (polls > XB_SPIN_CAP) { atomicAdd(&bar[XB_TMO], 1u); done = true; } }
            wl[2] = done ? 1u : 0u; }
        __syncthreads();
        const bool done = wl[2] != 0u;
        __syncthreads();
        if (done) break;
        if (qa < DEPTH) { if (!conv_batch(p, qa, wl, L)) ++qa; } else __builtin_amdgcn_s_sleep(2);
    }
    if (threadIdx.x == 0) { unsigned* bar = b.bar;
        if (wl[0] != 0u) { __builtin_amdgcn_fence(__ATOMIC_ACQUIRE, "agent"); xb_add(&bar[XB_XGEN(b.x)], 1u); asm volatile("s_waitcnt vmcnt(0)" ::: "memory"); }
        else { __builtin_amdgcn_fence(__ATOMIC_ACQUIRE, "agent"); asm volatile("s_waitcnt vmcnt(0)" ::: "memory"); }
    }
    __syncthreads();
}

__device__ __forceinline__ void ph_mod(const P& p, LAS unsigned char* lds, int wg, int G) {
    const int tid = opaque_tid(), lane = tid & 63, wave = __builtin_amdgcn_readfirstlane(tid >> 6);
    LAS float* sc = (LAS float*)lds;
    LAS float* red = (LAS float*)(lds + 65536);
    if (wg >= 384) return;
    for (int i = tid; i < 16 * DM; i += 512) { const int b = i >> 10, k = i & 1023; sc[k * 16 + b] = silu_acc(p.c[i]); }
    __syncthreads();
    float* mod = (float*)(p.ws + WS_MOD);
    for (int u = wg; u < 384; u += G) { const int l = u / 96, n0 = (u % 96) * 64;
        const float* w = p.w_ada + (size_t)l * DM * 6144 + (size_t)(wave * 128) * 6144 + n0 + lane;
        float acc[16];
#pragma unroll
        for (int b = 0; b < 16; ++b) acc[b] = 0.f;
#pragma unroll 4
        for (int k = 0; k < 128; ++k) { const float wv = w[(size_t)k * 6144]; const LAS f32x4* s4 = (const LAS f32x4*)(sc + (wave * 128 + k) * 16);
#pragma unroll
            for (int q = 0; q < 4; ++q) { const f32x4 s = s4[q]; acc[4 * q] += s[0] * wv; acc[4 * q + 1] += s[1] * wv; acc[4 * q + 2] += s[2] * wv; acc[4 * q + 3] += s[3] * wv; } }
#pragma unroll
        for (int b = 0; b < 16; ++b) red[(wave * 16 + b) * 64 + lane] = acc[b];
        __syncthreads();
        for (int i = tid; i < 1024; i += 512) { const int b = i >> 6, c = i & 63; float s = p.b_ada[l * 6144 + n0 + c];
#pragma unroll
            for (int wv = 0; wv < 8; ++wv) s += red[(wv * 16 + b) * 64 + c];
            mod[((size_t)l * 16 + b) * 6144 + n0 + c] = s; }
        __syncthreads();
    }
}

constexpr int LDS_MAIN = 131072, LDS_TOTAL = 147456, MISC_OFF = LDS_MAIN + 320;
constexpr int CW_BAR = 4096;
constexpr size_t CTL_ZERO = 65536;
constexpr int NSEQ = 2 + 9 * DEPTH;
struct Args { P p; int lo, hi; };
typedef const __attribute__((address_space(4))) Args* kargs_t;
__global__ void __launch_bounds__(512, 2) mk_fwd(Args a) {
    extern __shared__ __attribute__((aligned(16))) unsigned char lds_raw[];
    LAS unsigned char* L = (LAS unsigned char*)lds_raw;
    kargs_t ap0 = (kargs_t)__builtin_amdgcn_kernarg_segment_ptr();
#define LOADP() kargs_t ap_ = ap0; asm volatile("" : "+s"(ap_)); const P p = {ap_->p.x, ap_->p.c, ap_->p.w_ada, ap_->p.b_ada, ap_->p.w_in, ap_->p.conv_w, ap_->p.conv_b, ap_->p.gate_b, ap_->p.sink, ap_->p.rel_bias, ap_->p.w_s, ap_->p.b_s, ap_->p.w_out, ap_->p.w_router, ap_->p.w_gate, ap_->p.w_up, ap_->p.w_down, ap_->p.ln_g, ap_->p.ln_b, ap_->p.out, ap_->p.ws}; unsigned char* ws = p.ws
    const int wg = blockIdx.x, G = gridDim.x;
    { const int tid = opaque_tid(); for (int i = tid; i < (LDS_TOTAL - LDS_MAIN) / 4; i += 512) ((LAS unsigned*)(L + LDS_MAIN))[i] = 0u; }
    __syncthreads();
    XcdBarrier bar;
    { LOADP(); bar = xcd_barrier_post((unsigned*)(ws + WS_CTL) + CW_BAR, (volatile LAS unsigned*)(L + MISC_OFF) + 8); }
    int seq = 0; int qa = 0;
#ifndef DUPM
#define DUPM 0
#endif
#define DUP(i) for (int rep_ = 0; rep_ < ((DUPM >> (i)) & 1); ++rep_)
#ifndef PHM
#define PHM 0xfffff
#endif
#define RUN() (seq >= a.lo && seq < a.hi)
#define SEAM() do { if (seq + 1 < a.hi) xcd_barrier_work(bar, p, qa, (volatile LAS unsigned*)(L + MISC_OFF) + 16, L); } while (0)
    if (((PHM >> 0) & 1) && RUN()) {
        LOADP(); ph_mod(p, L, wg, G);
        const int tid = opaque_tid(), lane = tid & 63, wave = __builtin_amdgcn_readfirstlane(tid >> 6), gw = wg * 8 + wave, ngw = G * 8;
        { LAS float* scr = (LAS float*)L + wave * (64 * 33); for (int it = gw; it < DEPTH * ITS; it += ngw) convert_item(p, it / ITS, it % ITS, scr, lane); }
        { bf16* wsb = (bf16*)(ws + WS_WS); for (int i = wg * 512 + tid; i < DEPTH * 4 * 128 * 128; i += G * 512) wsb[i] = (bf16)f2bf(p.w_s[i]); }
        SEAM(); }
    ++seq;
    if (((PHM >> 1) & 1) && RUN()) { LOADP(); rows_entry_simple(p, wg, G); SEAM(); }
    ++seq;
#pragma unroll 1
    for (int l = 0; l < DEPTH; ++l) {
        if (((PHM >> 2) & 1) && RUN()) { LOADP();
            pg8::Gemm g{(const bf16*)(ws + WS_H), (const bf16*)(ws + WS_WIN) + (size_t)l * PNW * DM, NTOK, PNW, DM}; pg8::EpiProj E{(bf16*)(ws + WS_PROJ), (float*)(ws + WS_GATES), p.gate_b + l * 16};
            pg8::StaticOrder S; S.init(NTOK, PNW, G, wg);
            pg8::gemm_phase<pg8::EpiProj, pg8::StaticOrder, true, true>(L, g, S, E); SEAM(); }
        ++seq;
        if (((PHM >> 3) & 1) && RUN()) { LOADP(); DUP(2) ph_attn(p, l, L, wg, G); ph_attn(p, l, L, wg, G); DUP(3) ph_gmlp(p, l, L, wg, G); ph_gmlp(p, l, L, wg, G); DUP(4) ph_mlstm_a(p, l, L, wg, G); ph_mlstm_a(p, l, L, wg, G); SEAM(); }
        ++seq;
        if (((PHM >> 4) & 1) && RUN()) { LOADP(); DUP(5) ph_mlstm_c(p, l, L, wg, G); ph_mlstm_c(p, l, L, wg, G); SEAM(); }
        ++seq;
        if (((PHM >> 5) & 1) && RUN()) { LOADP();
            pg8::Gemm g{(const bf16*)(ws + WS_MIXCAT), (const bf16*)(ws + WS_WOUT) + (size_t)l * DM * DM, NTOK, DM, DM}; pg8::EpiBf16 E{(bf16*)(ws + WS_MIX), DM};
            pg8::StaticOrder S; S.init(NTOK, DM, G, wg);
            pg8::gemm_phase<pg8::EpiBf16, pg8::StaticOrder, true, true>(L, g, S, E); SEAM(); }
        ++seq;
        if (((PHM >> 6) & 1) && RUN()) { LOADP(); DUP(9) rows_phase<1>(p, l, l == 0 ? p.x : (const float*)(ws + WS_XA), L, wg, G, true); rows_phase<1>(p, l, l == 0 ? p.x : (const float*)(ws + WS_XA), L, wg, G); SEAM(); }
        ++seq;
        if (((PHM >> 7) & 1) && RUN()) { LOADP(); ph_topk(p, L, wg, G); conv_drain(p, qa, l, (volatile LAS unsigned*)(L + MISC_OFF) + 16, L); SEAM(); }
        ++seq;
        if (((PHM >> 8) & 1) && RUN()) { LOADP();
            pg8::Gemm g{(const bf16*)(ws + WS_H8), (const bf16*)(ws + WS_WGU + (size_t)l * NE * 4096 * DM), NGRP * 256, 4096, DM, SC_A1, SC_B1}; pg8::EpiSwiGLU8 E{ws + WS_HID};
            pg8::MoeOrder1 S; S.G = G; S.c = wg; S.idx = (const unsigned short*)(ws + WS_IDX);
            pg8::gemm_phase<pg8::EpiSwiGLU8, pg8::MoeOrder1, true, true, true, true>(L, g, S, E); SEAM(); }
        ++seq;
        if (((PHM >> 9) & 1) && RUN()) { LOADP();
            pg8::Gemm g{(const bf16*)(ws + WS_HID), (const bf16*)(ws + WS_WD + (size_t)l * NE * DM * DE), NGRP * 256, DM, DE, SC_A2, SC_B2}; pg8::EpiScaleFp8 E{ws + WS_YE, (const float*)(ws + WS_GATEV)};
            pg8::MoeOrder2 S; S.G = G; S.c = wg;
            pg8::gemm_phase<pg8::EpiScaleFp8, pg8::MoeOrder2, true, true, true>(L, g, S, E); SEAM(); }
        ++seq;
        if (((PHM >> 10) & 1) && RUN()) { LOADP(); DUP(10) rows_phase<2>(p, l, (const float*)(ws + WS_XA), L, wg, G, true); rows_phase<2>(p, l, (const float*)(ws + WS_XA), L, wg, G); SEAM(); }
        ++seq;
    }
#undef RUN
#undef SEAM
#undef LOADP
}

#ifndef MK_PER_PHASE
#define MK_PER_PHASE 0
#endif
extern "C" void kernel_launch(void* const* d_in, const int* in_sizes, int n_in, void* d_out, int out_size, void* d_ws, size_t ws_size, hipStream_t stream) {
    static int grid = 0;
    if (grid == 0) {
        if (n_in != 19 || in_sizes[0] != NTOK * DM || out_size != NTOK * DM || ws_size < WS_END) {
            fprintf(stderr, "kernel_launch: unexpected shapes: n_in %d in0 %d out %d ws %zu (need %zu)\n", n_in, n_in > 0 ? in_sizes[0] : -1, out_size, ws_size, (size_t)WS_END); grid = -1; return; }
        int dev = 0, cus = 0, per_cu = 0;
        if (hipGetDevice(&dev) != hipSuccess || hipDeviceGetAttribute(&cus, hipDeviceAttributeMultiprocessorCount, dev) != hipSuccess) { fprintf(stderr, "kernel_launch: device query failed\n"); grid = -1; return; }
        if (hipFuncSetAttribute((const void*)mk_fwd, hipFuncAttributeMaxDynamicSharedMemorySize, LDS_TOTAL) != hipSuccess) { fprintf(stderr, "kernel_launch: hipFuncSetAttribute failed\n"); grid = -1; return; }
        if (hipOccupancyMaxActiveBlocksPerMultiprocessor(&per_cu, (const void*)mk_fwd, 512, LDS_TOTAL) != hipSuccess || per_cu < 1) { fprintf(stderr, "kernel_launch: occupancy query reports %d blocks per CU\n", per_cu); }
        (void)hipGetLastError();
        grid = cus;
    }
    if (grid < 0) return;
    if (hipMemsetAsync((char*)d_ws + WS_CTL, 0, CTL_ZERO, stream) != hipSuccess) { fprintf(stderr, "kernel_launch: memset failed\n"); return; }
    Args a{};
    const float** pf = (const float**)&a.p;
    for (int i = 0; i < 19; ++i) pf[i] = (const float*)d_in[i];
    a.p.out = (float*)d_out; a.p.ws = (unsigned char*)d_ws;
#if MK_PER_PHASE
    for (int s = 0; s < NSEQ; ++s) { a.lo = s; a.hi = s + 1; hipLaunchKernelGGL(mk_fwd, dim3(grid), dim3(512), LDS_TOTAL, stream, a); }
#else
    a.lo = 0; a.hi = NSEQ;
    hipLaunchKernelGGL(mk_fwd, dim3(grid), dim3(512), LDS_TOTAL, stream, a);
#endif
    const hipError_t le = hipPeekAtLastError();
    if (le != hipSuccess) fprintf(stderr, "kernel_launch: launch failed: %s\n", hipGetErrorName(le));
}
```

```cpp
#include <hip/hip_runtime.h>
#include <cstdio>
#include <cstdint>
__device__ __forceinline__ int opaque_tid() { int t = threadIdx.x; asm volatile("" : "+v"(t)); return t; }
namespace pg8 {
#define PG8_LAS __attribute__((address_space(3)))
typedef unsigned short bf16_t;
typedef short bf16x8 __attribute__((ext_vector_type(8)));
typedef float f32x4 __attribute__((ext_vector_type(4)));
typedef unsigned u32x4 __attribute__((ext_vector_type(4)));
constexpr int BM = 256, BK = 64, HALF = 128, HTB = HALF * BK * 2  , STAGE_BYTES = 8 * HTB, NXCD = 8, WGM = 8;

__host__ __device__ __forceinline__ int lds_byte(int r, int c) { const int st = (r >> 4) * 2 + (c >> 5), rr = r & 15, cc = c & 31, ob = rr * 64 + cc * 2; return st * 1024 + (ob ^ (((ob >> 9) & 1) << 5)); }
__host__ __device__ __forceinline__ void stage_rc(int b, int& R, int& C) { const int st = b / 1024, sb = b % 1024, swz = sb ^ (((sb >> 9) & 1) << 5); R = (st >> 1) * 16 + swz / 64; C = (st & 1) * 32 + (swz % 64) / 2; }
__host__ __device__ __forceinline__ int perm32(int rho) { const int n = rho >> 4, i = rho & 15; return 8 * (i >> 2) + 4 * n + (i & 3); }

struct Unit { int pm, pn; };
struct Gemm { const bf16_t* A; const bf16_t* Bt; int M, N, K; int sa, sb; };
typedef int v4i_t __attribute__((ext_vector_type(4)));
typedef int v8i_t __attribute__((ext_vector_type(8)));
__device__ __forceinline__ v8i_t cat32(bf16x8 lo, bf16x8 hi) { const v4i_t a = __builtin_bit_cast(v4i_t, lo), b = __builtin_bit_cast(v4i_t, hi); return __builtin_shufflevector(a, b, 0, 1, 2, 3, 4, 5, 6, 7); }

struct StaticOrder {
    int nM, nN, nwg, G, c;
    __host__ __device__ void init(int M, int N, int G_, int c_) { nM = M / BM; nN = N / BM; nwg = nM * nN; G = G_; c = c_; }
    __host__ __device__ bool next(int i, Unit& u) const {
        const long L = (long)i * G + c; if (L >= nwg) return false;
        int wgid = (int)L; { const int q = nwg / NXCD, r = nwg % NXCD, xcd = wgid % NXCD, off = wgid / NXCD; wgid = (xcd < r ? xcd * (q + 1) : r * (q + 1) + (xcd - r) * q) + off; }
        const int nig = WGM * nN, gid = wgid / nig, fm = gid * WGM, gsz = (nM - fm) < WGM ? (nM - fm) : WGM;
        u.pm = fm + ((wgid % nig) % gsz); u.pn = (wgid % nig) / gsz; return true;
    }
    __device__ __forceinline__ void a_ready(const Unit&) const {}
    __device__ __forceinline__ void done(const Unit&) const {}
    __device__ __forceinline__ unsigned a_rowoff_unused() const { return 0u; }
};

typedef float f32x2p __attribute__((ext_vector_type(2))); typedef __bf16 bf16x2p __attribute__((ext_vector_type(2)));
__device__ __forceinline__ unsigned cvt_pk_bf16(float lo, float hi) { const f32x2p v = {lo, hi}; return __builtin_bit_cast(unsigned, __builtin_convertvector(v, bf16x2p)); }
__device__ __forceinline__ float silu_f(float x) { return x * __builtin_amdgcn_rcpf(1.0f + __builtin_amdgcn_exp2f(x * -1.4426950408889634f)); }

struct EpiBf16 {
    static constexpr bool PERM = true, AFTER_DRAIN = false;
    bf16_t* O; int ldc;
    __device__ __forceinline__ void operator()(const f32x4 (&acc)[2][2][4][2], const Unit& u, int wr, int wc, int fr, int fq) const {
        const int row0 = u.pm * BM + wr * 64 + fr, col0 = u.pn * BM + wc * 32 + 8 * fq;
#pragma unroll
        for (int ai = 0; ai < 2; ++ai)
#pragma unroll
            for (int m = 0; m < 4; ++m) { bf16_t* rowp = O + (size_t)(row0 + ai * HALF + m * 16) * ldc + col0;
#pragma unroll
                for (int bj = 0; bj < 2; ++bj) { const f32x4 v0 = acc[ai][bj][m][0], v1 = acc[ai][bj][m][1];
                    u32x4 w; w.x = cvt_pk_bf16(v0[0], v0[1]); w.y = cvt_pk_bf16(v0[2], v0[3]); w.z = cvt_pk_bf16(v1[0], v1[1]); w.w = cvt_pk_bf16(v1[2], v1[3]);
                    *(u32x4*)(rowp + bj * HALF) = w; } }
    }
};
struct EpiProj {
    static constexpr bool PERM = true, AFTER_DRAIN = false;
    bf16_t* O; float* gates; const float* gate_b;
    __device__ __forceinline__ void operator()(const f32x4 (&acc)[2][2][4][2], const Unit& u, int wr, int wc, int fr, int fq) const {
        const int row0 = u.pm * BM + wr * 64 + fr;
        if (u.pn < 9) { const int col0 = u.pn * BM + wc * 32 + 8 * fq;
#pragma unroll
            for (int ai = 0; ai < 2; ++ai)
#pragma unroll
                for (int m = 0; m < 4; ++m) { bf16_t* rowp = O + (size_t)(row0 + ai * HALF + m * 16) * 2304 + col0;
#pragma unroll
                    for (int bj = 0; bj < 2; ++bj) { const f32x4 v0 = acc[ai][bj][m][0], v1 = acc[ai][bj][m][1];
                        u32x4 w; w.x = cvt_pk_bf16(v0[0], v0[1]); w.y = cvt_pk_bf16(v0[2], v0[3]); w.z = cvt_pk_bf16(v1[0], v1[1]); w.w = cvt_pk_bf16(v1[2], v1[3]);
                        *(u32x4*)(rowp + bj * HALF) = w; } }
        } else if (wc == 0 && fq < 2) { const f32x4 g0 = *(const f32x4*)(gate_b + 8 * fq), g1 = *(const f32x4*)(gate_b + 8 * fq + 4);
#pragma unroll
            for (int ai = 0; ai < 2; ++ai)
#pragma unroll
                for (int m = 0; m < 4; ++m) { float* gp = gates + (size_t)(row0 + ai * HALF + m * 16) * 16 + 8 * fq;
                    *(f32x4*)gp = acc[ai][0][m][0] + g0; *(f32x4*)(gp + 4) = acc[ai][0][m][1] + g1; } }
    }
};
struct EpiSwiGLU {
    static constexpr bool PERM = true, AFTER_DRAIN = false;
    bf16_t* H;
    __device__ __forceinline__ void operator()(const f32x4 (&acc)[2][2][4][2], const Unit& u, int wr, int wc, int fr, int fq) const {
        const int row0 = u.pm * BM + wr * 64 + fr, col0 = (u.pn & 15) * 128 + wc * 32 + 8 * fq;
#pragma unroll
        for (int ai = 0; ai < 2; ++ai)
#pragma unroll
            for (int m = 0; m < 4; ++m) { bf16_t* rowp = H + (size_t)(row0 + ai * HALF + m * 16) * 2048 + col0;
                const f32x4 g0 = acc[ai][0][m][0], g1 = acc[ai][0][m][1], u0 = acc[ai][1][m][0], u1 = acc[ai][1][m][1];
                u32x4 w; w.x = cvt_pk_bf16(silu_f(g0[0]) * u0[0], silu_f(g0[1]) * u0[1]); w.y = cvt_pk_bf16(silu_f(g0[2]) * u0[2], silu_f(g0[3]) * u0[3]);
                w.z = cvt_pk_bf16(silu_f(g1[0]) * u1[0], silu_f(g1[1]) * u1[1]); w.w = cvt_pk_bf16(silu_f(g1[2]) * u1[2], silu_f(g1[3]) * u1[3]);
                *(u32x4*)rowp = w; }
    }
};
__device__ __forceinline__ unsigned pk4_fp8(float a, float b, float c, float d) {
    a = __builtin_amdgcn_fmed3f(a, -448.f, 448.f); b = __builtin_amdgcn_fmed3f(b, -448.f, 448.f); c = __builtin_amdgcn_fmed3f(c, -448.f, 448.f); d = __builtin_amdgcn_fmed3f(d, -448.f, 448.f);
    int w = 0; w = __builtin_amdgcn_cvt_pk_fp8_f32(a, b, w, false); w = __builtin_amdgcn_cvt_pk_fp8_f32(c, d, w, true); return (unsigned)w; }
constexpr float HID_SCALE = 4.0f;
typedef unsigned u32x2e __attribute__((ext_vector_type(2)));
struct EpiSwiGLU8 {
    static constexpr bool PERM = true, AFTER_DRAIN = false;
    unsigned char* H;
    __device__ __forceinline__ void operator()(const f32x4 (&acc)[2][2][4][2], const Unit& u, int wr, int wc, int fr, int fq) const {
        const int row0 = u.pm * BM + wr * 64 + fr, col0 = (u.pn & 15) * 128 + wc * 32 + 8 * fq;
#pragma unroll
        for (int ai = 0; ai < 2; ++ai)
#pragma unroll
            for (int m = 0; m < 4; ++m) { unsigned char* rowp = H + (size_t)(row0 + ai * HALF + m * 16) * 2048 + col0;
                const f32x4 g0 = acc[ai][0][m][0], g1 = acc[ai][0][m][1], u0 = acc[ai][1][m][0], u1 = acc[ai][1][m][1];
                u32x2e w; w.x = pk4_fp8(silu_f(g0[0]) * u0[0] * HID_SCALE, silu_f(g0[1]) * u0[1] * HID_SCALE, silu_f(g0[2]) * u0[2] * HID_SCALE, silu_f(g0[3]) * u0[3] * HID_SCALE);
                w.y = pk4_fp8(silu_f(g1[0]) * u1[0] * HID_SCALE, silu_f(g1[1]) * u1[1] * HID_SCALE, silu_f(g1[2]) * u1[2] * HID_SCALE, silu_f(g1[3]) * u1[3] * HID_SCALE);
                *(u32x2e*)rowp = w; }
    }
};
struct EpiScaleBf16 {
    static constexpr bool PERM = true, AFTER_DRAIN = false;
    bf16_t* Y; const float* gate;
    __device__ __forceinline__ void operator()(const f32x4 (&acc)[2][2][4][2], const Unit& u, int wr, int wc, int fr, int fq) const {
        const int row0 = u.pm * BM + wr * 64 + fr, col0 = (u.pn & 3) * BM + wc * 32 + 8 * fq;
#pragma unroll
        for (int ai = 0; ai < 2; ++ai)
#pragma unroll
            for (int m = 0; m < 4; ++m) { const int r = row0 + ai * HALF + m * 16; const float gv = gate[r]; bf16_t* rowp = Y + (size_t)r * 1024 + col0;
#pragma unroll
                for (int bj = 0; bj < 2; ++bj) { const f32x4 v0 = acc[ai][bj][m][0] * gv, v1 = acc[ai][bj][m][1] * gv;
                    u32x4 w; w.x = cvt_pk_bf16(v0[0], v0[1]); w.y = cvt_pk_bf16(v0[2], v0[3]); w.z = cvt_pk_bf16(v1[0], v1[1]); w.w = cvt_pk_bf16(v1[2], v1[3]);
                    *(u32x4*)(rowp + bj * HALF) = w; } }
    }
};
constexpr float YE_SCALE = 256.0f;
struct EpiScaleFp8 {
    static constexpr bool PERM = true, AFTER_DRAIN = false;
    unsigned char* Y; const float* gate;
    __device__ __forceinline__ void operator()(const f32x4 (&acc)[2][2][4][2], const Unit& u, int wr, int wc, int fr, int fq) const {
        const int row0 = u.pm * BM + wr * 64 + fr, pcol = (u.pn & 3) * BM + 16 * (wc * 4 + fq);
#pragma unroll
        for (int ai = 0; ai < 2; ++ai)
#pragma unroll
            for (int m = 0; m < 4; ++m) { const int r = row0 + ai * HALF + m * 16; const float gv = gate[r] * YE_SCALE; u32x4 w;
#pragma unroll
                for (int bj = 0; bj < 2; ++bj) { const f32x4 v0 = acc[ai][bj][m][0] * gv, v1 = acc[ai][bj][m][1] * gv;
                    w[2 * bj] = pk4_fp8(v0[0], v0[1], v0[2], v0[3]); w[2 * bj + 1] = pk4_fp8(v1[0], v1[1], v1[2], v1[3]); }
                *(u32x4*)(Y + (size_t)r * 1024 + pcol) = w; }
    }
};
struct MoeOrder1 {
    int G, c; const unsigned short* idx;
    __device__ __forceinline__ int a_rowtok(const Unit& u, int r) const { return idx[((u.pm * 2 + (r >> 7)) * 64 + (r & 63)) * 2 + ((r >> 6) & 1)]; }
    __device__ __forceinline__ unsigned a_rowoff(const Unit& u, int r) const { return (unsigned)(((u.pm & 15) * 2048 + a_rowtok(u, r)) * 1024); }
    __device__ __forceinline__ unsigned a_rowpair(const Unit& u, int hh, int r0) const { return *(const unsigned*)(idx + ((u.pm * 2 + hh) * 64 + r0) * 2); }
    __device__ __forceinline__ unsigned a_rowoff_tok(const Unit& u, int tok) const { return (unsigned)(((u.pm & 15) * 2048 + tok) * 1024); }
    __device__ __forceinline__ bool next(int i, Unit& u) const {
        const long L = (long)i * G + c; if (L >= 4096) return false;
        const int e = (int)(L >> 8), rem = (int)(L & 255), x = rem & 7, v = rem >> 3;
        const int b = 4 * (x >> 1) + (v >> 3), j = 8 * (x & 1) + (v & 7);
        u.pm = e * 16 + b; u.pn = e * 16 + j; return true;
    }
    __device__ __forceinline__ void a_ready(const Unit&) const {}
    __device__ __forceinline__ void done(const Unit&) const {}
    __device__ __forceinline__ unsigned a_rowoff_unused() const { return 0u; }
};
struct MoeOrder2 {
    int G, c;
    __device__ __forceinline__ bool next(int i, Unit& u) const {
        const long L = (long)i * G + c; if (L >= 1024) return false;
        const int rnd = (int)(L >> 8), rem = (int)(L & 255), x = rem & 7, v = rem >> 3;
        const int e = rnd * 4 + (x >> 1), b = 8 * (x & 1) + (v >> 2), j = v & 3;
        u.pm = e * 16 + b; u.pn = e * 4 + j; return true;
    }
    __device__ __forceinline__ void a_ready(const Unit&) const {}
    __device__ __forceinline__ void done(const Unit&) const {}
    __device__ __forceinline__ unsigned a_rowoff_unused() const { return 0u; }
};

template <class Epi, class Sched, bool ALIGN_EPI = false, bool SP2 = false, bool F8 = false, bool GATH = false>
__device__ __forceinline__ void gemm_phase(PG8_LAS unsigned char* lds, const Gemm g, const Sched& S, const Epi& E) {
    const int tid = opaque_tid(), wid = __builtin_amdgcn_readfirstlane(tid >> 6), lane = tid & 63, wr = wid >> 2, wc = wid & 3, fr = lane & 15, fq = lane >> 4;
    const int K = g.K, RB = F8 ? K : 2 * K, nt = RB / 128;
    unsigned voffA[2], voffB[2];
#pragma unroll
    for (int i = 0; i < 2; ++i) { int R, C; stage_rc(tid * 16 + i * 8192, R, C); const int Rb = Epi::PERM ? ((R & ~31) + perm32(R & 31)) : R;
        voffA[i] = (unsigned)(R * RB + C * 2); voffB[i] = (unsigned)(Rb * RB + C * 2); }
    const __amdgpu_buffer_rsrc_t rsA = __builtin_amdgcn_make_buffer_rsrc((void*)g.A, 0, 0x7fffffff, 0x00020000), rsB = __builtin_amdgcn_make_buffer_rsrc((void*)g.Bt, 0, 0x7fffffff, 0x00020000);
    const size_t kstep = (size_t)(BK * 2);
    const size_t hstep = (size_t)HALF * RB;
    const size_t tstep = 2 * hstep;
    const unsigned ldsw = (unsigned)wid * 1024u;
    const int aoff = lds_byte(wr * 64 + fr, fq * 8), boff = lds_byte(wc * 32 + fr, fq * 8);
#define PG8_SA(b, h) (((b) * 2 + (h)) * HTB)
#define PG8_SB(b, h) ((4 + (b) * 2 + (h)) * HTB)
#define PG8_STAGE(bufoff, gbase, voff, rs, base) do { if constexpr (F8) { const int so_ = __builtin_amdgcn_readfirstlane((int)((const char*)(gbase) - (const char*)(base))); _Pragma("unroll") for (int _i = 0; _i < 2; ++_i) \
        __builtin_amdgcn_raw_ptr_buffer_load_lds(rs, (PG8_LAS void*)(lds + (bufoff) + ldsw + _i * 8192), 16, (int)(voff)[_i], so_, 0, 0); } \
        else { _Pragma("unroll") for (int _i = 0; _i < 2; ++_i) \
        __builtin_amdgcn_global_load_lds((const unsigned*)((const char*)(gbase) + (voff)[_i]), (PG8_LAS unsigned*)(lds + (bufoff) + ldsw + _i * 8192), 16, 0, 0); } } while (0)
#define PG8_STAGEA(bufoff, gptr, half, usenext) do { if constexpr (GATH) { const int so_ = __builtin_amdgcn_readfirstlane((int)((const char*)(gptr) - (const char*)g.A)); _Pragma("unroll") for (int _i = 0; _i < 2; ++_i) \
        __builtin_amdgcn_raw_ptr_buffer_load_lds(rsA, (PG8_LAS void*)(lds + (bufoff) + ldsw + _i * 8192), 16, (int)vAc[half][_i], so_, 0, 0); } \
        else { PG8_STAGE(bufoff, (gptr) + (half) * hstep, voffA, rsA, g.A); } } while (0)
#define PG8_GSWITCH do { if constexpr (GATH) { if (un) {   \
        asm volatile("" : "+v"(tpk[0]), "+v"(tpk[1]));     \
        _Pragma("unroll") for (int hh = 0; hh < 2; ++hh) _Pragma("unroll") for (int i = 0; i < 2; ++i) { int R, C; stage_rc(opaque_tid() * 16 + i * 8192, R, C); vAc[hh][i] = S.a_rowoff_tok(nxt, (int)((tpk[hh] >> (16 * i)) & 0xffffu)) + (unsigned)(C * 2); } } } } while (0)
#define PG8_LDA(dst, b, h) do { if constexpr (F8) { _Pragma("unroll") for (int m = 0; m < 4; ++m) dst##8[m] = cat32(*(const PG8_LAS bf16x8*)(lds + PG8_SA(b, h) + aoff + m * 2048), *(const PG8_LAS bf16x8*)(lds + PG8_SA(b, h) + aoff + m * 2048 + 1024)); } \
        else { _Pragma("unroll") for (int m = 0; m < 4; ++m) _Pragma("unroll") for (int k = 0; k < 2; ++k) dst[m][k] = *(const PG8_LAS bf16x8*)(lds + PG8_SA(b, h) + aoff + m * 2048 + k * 1024); } } while (0)
#define PG8_LDB(dst, b, h) do { if constexpr (F8) { _Pragma("unroll") for (int n = 0; n < 2; ++n) dst##8[n] = cat32(*(const PG8_LAS bf16x8*)(lds + PG8_SB(b, h) + boff + n * 2048), *(const PG8_LAS bf16x8*)(lds + PG8_SB(b, h) + boff + n * 2048 + 1024)); } \
        else { _Pragma("unroll") for (int n = 0; n < 2; ++n) _Pragma("unroll") for (int k = 0; k < 2; ++k) dst[n][k] = *(const PG8_LAS bf16x8*)(lds + PG8_SB(b, h) + boff + n * 2048 + k * 1024); } } while (0)
#define PG8_MMA(ai, bj, At, Bt) do { __builtin_amdgcn_s_setprio(1); _Pragma("unroll") for (int m = 0; m < 4; ++m) _Pragma("unroll") for (int n = 0; n < 2; ++n) { \
        if constexpr (F8) { acc[ai][bj][m][n] = __builtin_amdgcn_mfma_scale_f32_16x16x128_f8f6f4(Bt##8[n], At##8[m], acc[ai][bj][m][n], 0, 0, 0, g.sb, 0, g.sa); } \
        else { _Pragma("unroll") for (int k = 0; k < 2; ++k) acc[ai][bj][m][n] = __builtin_amdgcn_mfma_f32_16x16x32_bf16(Bt[n][k], At[m][k], acc[ai][bj][m][n], 0, 0, 0); } } __builtin_amdgcn_s_setprio(0); } while (0)
#define PG8_WAIT_V(n) asm volatile("s_waitcnt vmcnt(" #n ")" ::: "memory")
#define PG8_WAIT_L(n) asm volatile("s_waitcnt lgkmcnt(" #n ")" ::: "memory")
#define PG8_BAR __builtin_amdgcn_s_barrier()
#define PG8_SCHED __builtin_amdgcn_sched_barrier(0)
    Unit cur, nxt; int ui = 0;
    if (!S.next(0, cur)) return;
    f32x4 acc[2][2][4][2];
#pragma unroll
    for (int a = 0; a < 2; ++a)
#pragma unroll
        for (int b = 0; b < 2; ++b)
#pragma unroll
            for (int m = 0; m < 4; ++m)
#pragma unroll
                for (int n = 0; n < 2; ++n) acc[a][b][m][n] = (f32x4){0.f, 0.f, 0.f, 0.f};
    bf16x8 At[4][2], B0[2][2], B1[2][2];
    v8i_t At8[4], B08[2], B18[2];
    const char* cA = (const char*)g.A + (GATH ? (size_t)0 : (size_t)cur.pm * tstep); const char* cB = (const char*)g.Bt + (size_t)cur.pn * tstep;
    unsigned vAc[2][2];
    if constexpr (GATH) {
#pragma unroll
        for (int hh = 0; hh < 2; ++hh)
#pragma unroll
            for (int i = 0; i < 2; ++i) { int R, C; stage_rc(tid * 16 + i * 8192, R, C); vAc[hh][i] = S.a_rowoff(cur, hh * HALF + R) + (unsigned)(C * 2); } }
    S.a_ready(cur);
    if constexpr (SP2) {
        PG8_STAGE(PG8_SB(0, 0), cB, voffB, rsB, g.Bt); PG8_STAGE(PG8_SB(0, 1), cB + hstep, voffB, rsB, g.Bt); PG8_STAGEA(PG8_SA(0, 0), cA, 0, false); PG8_STAGEA(PG8_SA(0, 1), cA, 1, false);
        if (wr == 1) PG8_BAR;
        PG8_WAIT_V(2); PG8_BAR;
        PG8_STAGE(PG8_SB(1, 0), cB + kstep, voffB, rsB, g.Bt); PG8_STAGEA(PG8_SA(1, 0), cA + kstep, 0, false); PG8_STAGE(PG8_SB(1, 1), cB + hstep + kstep, voffB, rsB, g.Bt);
        PG8_WAIT_V(6); PG8_BAR;
    } else {
        PG8_STAGE(PG8_SB(0, 0), cB, voffB, rsB, g.Bt); PG8_STAGEA(PG8_SA(0, 0), cA, 0, false); PG8_STAGE(PG8_SB(0, 1), cB + hstep, voffB, rsB, g.Bt); PG8_STAGEA(PG8_SA(0, 1), cA, 1, false);
        if (wr == 1) PG8_BAR;
        PG8_WAIT_V(4); PG8_BAR;
        PG8_STAGE(PG8_SB(1, 0), cB + kstep, voffB, rsB, g.Bt); PG8_STAGEA(PG8_SA(1, 0), cA + kstep, 0, false); PG8_STAGE(PG8_SB(1, 1), cB + hstep + kstep, voffB, rsB, g.Bt);
        PG8_WAIT_V(6); PG8_BAR;
    }
    unsigned tpk[2] = {0u, 0u};
    if constexpr (GATH) { Unit n1; if (S.next(1, n1)) {
#pragma unroll
        for (int hh = 0; hh < 2; ++hh) { int R0, C0; stage_rc(opaque_tid() * 16, R0, C0); tpk[hh] = S.a_rowpair(n1, hh, R0); } } }
    for (;;) {
        const bool has_next = S.next(ui + 1, nxt);
        const char* nA = (has_next && !GATH) ? (const char*)g.A + (size_t)nxt.pm * tstep : cA; const char* nB = has_next ? (const char*)g.Bt + (size_t)nxt.pn * tstep : cB;

#pragma unroll 1
        for (int t = 0; t < nt; t += 2) {
            const bool last = (t == nt - 2); const bool un = last && has_next;

            const char* a1 = cA + (size_t)(t + 1) * kstep;
            const char* a2 = last ? nA : cA + (size_t)(t + 2) * kstep; const char* b2 = last ? nB : cB + (size_t)(t + 2) * kstep;
            const char* a3 = a2 + kstep; const char* b3 = b2 + kstep;
            if (last && has_next) S.a_ready(nxt);
            if constexpr (SP2) {
            PG8_LDB(B0, 0, 0); PG8_LDB(B1, 0, 1); PG8_SCHED; PG8_LDA(At, 0, 0); PG8_STAGEA(PG8_SA(1, 1), a1, 1, false); PG8_GSWITCH;
            PG8_WAIT_V(8); PG8_WAIT_L(0); PG8_BAR; PG8_MMA(0, 0, At, B0); PG8_MMA(0, 1, At, B1); PG8_BAR; PG8_SCHED;
            PG8_LDA(At, 0, 1); PG8_STAGE(PG8_SB(0, 0), b2, voffB, rsB, g.Bt); PG8_STAGE(PG8_SB(0, 1), b2 + hstep, voffB, rsB, g.Bt); PG8_STAGEA(PG8_SA(0, 0), a2, 0, un);
            PG8_WAIT_V(8); PG8_WAIT_L(0); PG8_BAR; PG8_MMA(1, 0, At, B0); PG8_MMA(1, 1, At, B1); PG8_BAR; PG8_SCHED;
            PG8_LDB(B0, 1, 0); PG8_LDB(B1, 1, 1); PG8_SCHED; PG8_LDA(At, 1, 0); PG8_STAGEA(PG8_SA(0, 1), a2, 1, un);
            PG8_WAIT_V(8); PG8_WAIT_L(0); PG8_BAR; PG8_MMA(0, 0, At, B0); PG8_MMA(0, 1, At, B1); PG8_BAR; PG8_SCHED;
            PG8_LDA(At, 1, 1); PG8_STAGE(PG8_SB(1, 0), b3, voffB, rsB, g.Bt); PG8_STAGE(PG8_SB(1, 1), b3 + hstep, voffB, rsB, g.Bt); PG8_STAGEA(PG8_SA(1, 0), a3, 0, un);
            PG8_WAIT_V(8); PG8_WAIT_L(0); PG8_BAR; PG8_MMA(1, 0, At, B0); PG8_MMA(1, 1, At, B1); PG8_BAR; PG8_SCHED;
            } else {
            PG8_LDB(B0, 0, 0); PG8_SCHED; PG8_LDA(At, 0, 0); PG8_STAGEA(PG8_SA(1, 1), a1, 1, false); PG8_GSWITCH;
            PG8_WAIT_L(8); PG8_BAR; PG8_WAIT_L(0); PG8_MMA(0, 0, At, B0); PG8_BAR; PG8_SCHED;
            PG8_LDB(B1, 0, 1); PG8_STAGE(PG8_SB(0, 0), b2, voffB, rsB, g.Bt);
            PG8_BAR; PG8_WAIT_L(0); PG8_MMA(0, 1, At, B1); PG8_BAR;
            PG8_LDA(At, 0, 1); PG8_STAGEA(PG8_SA(0, 0), a2, 0, un);
            PG8_BAR; PG8_WAIT_L(0); PG8_MMA(1, 0, At, B0); PG8_BAR; PG8_SCHED;
            PG8_STAGE(PG8_SB(0, 1), b2 + hstep, voffB, rsB, g.Bt);
            PG8_WAIT_V(6); PG8_BAR; PG8_MMA(1, 1, At, B1); PG8_BAR;
            PG8_LDB(B0, 1, 0); PG8_SCHED; PG8_LDA(At, 1, 0); PG8_STAGEA(PG8_SA(0, 1), a2, 1, un);
            PG8_WAIT_L(8); PG8_BAR; PG8_WAIT_L(0); PG8_MMA(0, 0, At, B0); PG8_BAR; PG8_SCHED;
            PG8_LDB(B1, 1, 1); PG8_STAGE(PG8_SB(1, 0), b3, voffB, rsB, g.Bt);
            PG8_BAR; PG8_WAIT_L(0); PG8_MMA(0, 1, At, B1); PG8_BAR;
            PG8_LDA(At, 1, 1); PG8_STAGEA(PG8_SA(1, 0), a3, 0, un);
            PG8_BAR; PG8_WAIT_L(0); PG8_MMA(1, 0, At, B0); PG8_BAR; PG8_SCHED;
            PG8_STAGE(PG8_SB(1, 1), b3 + hstep, voffB, rsB, g.Bt);
            PG8_WAIT_V(6); PG8_BAR; PG8_MMA(1, 1, At, B1); PG8_BAR;
            }
        }
        if constexpr (ALIGN_EPI) { if (wr == 0) PG8_BAR; }
        unsigned tpk2[2] = {0u, 0u};
        if constexpr (GATH) { Unit n2; if (S.next(ui + 2, n2)) {
#pragma unroll
            for (int hh = 0; hh < 2; ++hh) { int R0, C0; stage_rc(opaque_tid() * 16, R0, C0); tpk2[hh] = S.a_rowpair(n2, hh, R0); } } }
        if constexpr (!Epi::AFTER_DRAIN) { const int t2 = opaque_tid(), w2 = __builtin_amdgcn_readfirstlane(t2 >> 6), l2 = t2 & 63; E(acc, cur, w2 >> 2, w2 & 3, l2 & 15, l2 >> 4); S.done(cur); }
        if (!has_next) break;
#pragma unroll
        for (int a = 0; a < 2; ++a)
#pragma unroll
            for (int b = 0; b < 2; ++b)
#pragma unroll
                for (int m = 0; m < 4; ++m)
#pragma unroll
                    for (int n = 0; n < 2; ++n) acc[a][b][m][n] = (f32x4){0.f, 0.f, 0.f, 0.f};
        cur = nxt; cA = nA; cB = nB; ++ui;
        if constexpr (GATH) { asm volatile("" : "+v"(tpk2[0]), "+v"(tpk2[1]));
            tpk[0] = tpk2[0]; tpk[1] = tpk2[1]; }

        if constexpr (ALIGN_EPI) { if (wr == 1) PG8_BAR; }
    }
    PG8_WAIT_V(0);
    if constexpr (!ALIGN_EPI) { if (wr == 0) PG8_BAR; }
    PG8_BAR;
    if constexpr (Epi::AFTER_DRAIN) { E.fused(acc, cur, wr, wc, fr, fq, lds, wid, lane); S.done(cur); }
#undef PG8_SA
#undef PG8_SB
#undef PG8_STAGE
#undef PG8_LDA
#undef PG8_LDB
#undef PG8_MMA
#undef PG8_WAIT_V
#undef PG8_WAIT_L
#undef PG8_BAR
#undef PG8_SCHED
}
}

#define GAS __attribute__((address_space(1)))
#define LAS __attribute__((address_space(3)))
typedef unsigned short bf16;
typedef float f32x4 __attribute__((ext_vector_type(4)));
typedef unsigned u32x4 __attribute__((ext_vector_type(4)));
typedef unsigned u32x2 __attribute__((ext_vector_type(2)));
typedef short bf16x8 __attribute__((ext_vector_type(8)));

constexpr int DM = 1024, BATCH = 16, SEQ = 2048, DEPTH = 4, NTOK = BATCH * SEQ;
constexpr int PW_IN = 2320, PN = 2304, PNW = 2560;
constexpr int C_AQ = 0, C_AK = 512, C_AV = 640, C_MQ = 768, C_MK = 1024, C_MV = 1280, C_MO = 1536, C_GU = 1792, C_GV = 2048;
constexpr int NE = 16, CAP = 256, DE = 2048, NGRP = 256;
constexpr float DN_ALPHA = 1.6817928305074290f;
constexpr float LN_EPS = 1e-5f;

constexpr size_t MiB = 1u << 20;
constexpr size_t WS_CTL = 0, CTL_BYTES = 1 * MiB;
constexpr size_t WS_MOD = 1 * MiB;
constexpr size_t WS_WIN = 1520 * MiB;
constexpr size_t WS_WOUT = 22 * MiB;
constexpr size_t WS_WS = 30 * MiB;
constexpr size_t WS_GATES = 32 * MiB;
constexpr size_t WS_AFF = 34 * MiB;
constexpr size_t WS_SLOT = 36 * MiB;
constexpr size_t WS_IDX = 37 * MiB;
constexpr size_t WS_GATEV = 38 * MiB;
constexpr size_t WS_DC = 40 * MiB;
constexpr size_t WS_DN = 72 * MiB;
constexpr size_t WS_DS = 73 * MiB;
constexpr size_t WS_QKT = 80 * MiB;
constexpr size_t WS_H = 128 * MiB;
constexpr size_t WS_XA = 192 * MiB;
constexpr size_t WS_PROJ = 320 * MiB;
constexpr size_t WS_MIXCAT = 464 * MiB;
constexpr size_t WS_MIX = 528 * MiB;
constexpr size_t WS_XG = 592 * MiB;
constexpr size_t WS_HID = 720 * MiB;
constexpr size_t WS_YE = 976 * MiB;
constexpr size_t WS_WGU = 1104 * MiB;
constexpr size_t WS_WD = 1360 * MiB;
constexpr size_t WS_H8 = 1488 * MiB;
constexpr size_t WS_END = 1540 * MiB;
constexpr float W1_SCALE = 128.f, W2_SCALE = 512.f, ACT_SCALE = 8.f;
constexpr int SC_A1 = 0x7C7C7C7C, SC_B1 = 0x78787878, SC_A2 = 0x7D7D7D7D, SC_B2 = 0x76767676;
constexpr size_t WS_HFB = WS_HID;
constexpr size_t WS_VN = WS_HID + 64 * MiB;

struct P {
    const float *x, *c, *w_ada, *b_ada, *w_in, *conv_w, *conv_b, *gate_b, *sink, *rel_bias, *w_s, *b_s, *w_out, *w_router, *w_gate, *w_up, *w_down, *ln_g, *ln_b;
    float* out; unsigned char* ws;
};

typedef float f32x2c __attribute__((ext_vector_type(2))); typedef __bf16 bf16x2c __attribute__((ext_vector_type(2)));
__device__ __forceinline__ unsigned pk2(float lo, float hi) { const f32x2c v = {lo, hi}; return __builtin_bit_cast(unsigned, __builtin_convertvector(v, bf16x2c)); }
__device__ __forceinline__ unsigned f2bf(float f) { return pk2(f, 0.f) & 0xffffu; }
__device__ __forceinline__ float bf2f(unsigned short b) { return __builtin_bit_cast(float, (unsigned)b << 16); }
__device__ __forceinline__ float bflo(unsigned w) { return __builtin_bit_cast(float, w << 16); }
__device__ __forceinline__ float bfhi(unsigned w) { return __builtin_bit_cast(float, w & 0xffff0000u); }
__device__ __forceinline__ float sigmoid_f(float x) { return __builtin_amdgcn_rcpf(1.0f + __builtin_amdgcn_exp2f(x * -1.4426950408889634f)); }
__device__ __forceinline__ float silu_acc(float x) { return x * __builtin_amdgcn_rcpf(1.0f + __builtin_amdgcn_exp2f(x * -1.4426950408889634f)); }
__device__ __forceinline__ float gelu_erf(float x) { return 0.5f * x * (1.0f + erff(x * 0.70710678118654752f)); }
__device__ __forceinline__ float logsigmoid_f(float x) { return fminf(x, 0.f) - __logf(1.0f + __expf(-fabsf(x))); }
__device__ __forceinline__ int t5_bucket(int rel) {
    const int n = rel < 0 ? -rel : rel;
    int bk = n < 8 ? n : n < 12 ? 8 : n < 16 ? 9 : n < 23 ? 10 : n < 32 ? 11 : n < 46 ? 12 : n < 64 ? 13 : n < 91 ? 14 : 15;
    return bk + (rel > 0 ? 16 : 0);
}

__device__ __forceinline__ int unit_of(int wg, int G, int i, int N) {
    if (G == 256) { const int per = N >> 8; if (i >= per) return N; return ((((wg & 7) << 5) | (wg >> 3)) * per) + i; }
    const int u = wg + i * G; return u < N ? u : N;
}
template <int CTRL> __device__ __forceinline__ float dpp_f(float v) { return __builtin_bit_cast(float, __builtin_amdgcn_update_dpp(0, __builtin_bit_cast(int, v), CTRL, 0xf, 0xf, true)); }
#define DPP_X1 0xB1
#define DPP_X2 0x4E
#define DPP_HM 0x141
#define DPP_RM 0x140
__device__ __forceinline__ float r16_sum(float v) { v += dpp_f<DPP_X1>(v); v += dpp_f<DPP_X2>(v); v += dpp_f<DPP_HM>(v); v += dpp_f<DPP_RM>(v); return v; }
__device__ __forceinline__ float r16_max(float v) { v = fmaxf(v, dpp_f<DPP_X1>(v)); v = fmaxf(v, dpp_f<DPP_X2>(v)); v = fmaxf(v, dpp_f<DPP_HM>(v)); v = fmaxf(v, dpp_f<DPP_RM>(v)); return v; }
__device__ __forceinline__ float wave_sum(float v) {
#pragma unroll
    for (int o = 1; o < 64; o <<= 1) v += __shfl_xor(v, o);
    return v;
}
constexpr int RB_PITCH = 2080;
constexpr int RB_W = 0, RB_ST = 16 * RB_PITCH, RW_VEC = 100352;
__device__ __forceinline__ void r16_ln(f32x4 (&v)[16]) {
    float s = 0.f;
#pragma unroll
    for (int k = 0; k < 16; ++k) s += (v[k][0] + v[k][1]) + (v[k][2] + v[k][3]);
    const float mean = r16_sum(s) * (1.f / DM); float q = 0.f;
#pragma unroll
    for (int k = 0; k < 16; ++k) { v[k] = v[k] - mean; q += (v[k][0] * v[k][0] + v[k][1] * v[k][1]) + (v[k][2] * v[k][2] + v[k][3] * v[k][3]); }
    const float rstd = 1.0f / sqrtf(r16_sum(q) * (1.f / DM) + LN_EPS);
#pragma unroll
    for (int k = 0; k < 16; ++k) v[k] = v[k] * rstd;
}
__device__ __forceinline__ float r16_fold(const float (&acc)[16], int c) {
    float a8[8], a4[4], a2[2];
    { const bool hi = c >= 8;
#pragma unroll
      for (int e = 0; e < 8; ++e) { const float send = hi ? acc[e] : acc[e + 8], keep = hi ? acc[e + 8] : acc[e]; a8[e] = keep + dpp_f<DPP_RM>(send); } }
    { const bool hi = (c & 7) >= 4;
#pragma unroll
      for (int e = 0; e < 4; ++e) { const float send = hi ? a8[e] : a8[e + 4], keep = hi ? a8[e + 4] : a8[e]; a4[e] = keep + dpp_f<DPP_HM>(send); } }
    { const bool hi = (c & 2) != 0;
#pragma unroll
      for (int e = 0; e < 2; ++e) { const float send = hi ? a4[e] : a4[e + 2], keep = hi ? a4[e + 2] : a4[e]; a2[e] = keep + dpp_f<DPP_X2>(send); } }
    const bool hi = (c & 1) != 0; const float send = hi ? a2[0] : a2[1], keep = hi ? a2[1] : a2[0];
    return keep + dpp_f<DPP_X1>(send);
}
__device__ __forceinline__ void r16_matvec2(const f32x4 (&v0)[16], const f32x4 (&v1)[16], const LAS float* wT, int c, float& r0, float& r1) {
    float a0[16], a1[16];
    asm volatile("" ::: "memory");
#pragma unroll
    for (int e = 0; e < 16; ++e) { float s0 = 0.f, s1 = 0.f;
#pragma unroll
        for (int k = 0; k < 16; ++k) { const f32x4 w = *(const LAS f32x4*)(wT + e * DM + 64 * k + 4 * c);
            s0 += (v0[k][0] * w[0] + v0[k][1] * w[1]) + (v0[k][2] * w[2] + v0[k][3] * w[3]); s1 += (v1[k][0] * w[0] + v1[k][1] * w[1]) + (v1[k][2] * w[2] + v1[k][3] * w[3]); }
        a0[e] = s0; a1[e] = s1; }
    r0 = r16_fold(a0, c); r1 = r16_fold(a1, c);
}
#define RC(k) (128 * ((k) >> 1) + 8 * c + 4 * ((k) & 1))
__device__ __forceinline__ int rpos(int col) { return (col & ~127) | (((col >> 2) & 1) << 6) | (((col & 127) >> 3) << 2) | (col & 3); }
__device__ __forceinline__ f32x4 bf4lo(u32x4 w) { return (f32x4){bflo(w.x), bfhi(w.x), bflo(w.y), bfhi(w.y)}; }
__device__ __forceinline__ f32x4 bf4hi(u32x4 w) { return (f32x4){bflo(w.z), bfhi(w.z), bflo(w.w), bfhi(w.w)}; }
typedef float f32x2q __attribute__((ext_vector_type(2)));
__device__ __forceinline__ f32x4 fp8x4(unsigned w) { const f32x2q lo = __builtin_amdgcn_cvt_pk_f32_fp8((int)w, false), hi = __builtin_amdgcn_cvt_pk_f32_fp8((int)w, true); return (f32x4){lo[0], lo[1], hi[0], hi[1]}; }
__device__ __forceinline__ void r16_store_bf16(bf16* rowp, int c, const f32x4 (&v)[16]) {
#pragma unroll
    for (int kk = 0; kk < 8; ++kk) { u32x4 w; w.x = pk2(v[2 * kk][0], v[2 * kk][1]); w.y = pk2(v[2 * kk][2], v[2 * kk][3]); w.z = pk2(v[2 * kk + 1][0], v[2 * kk + 1][1]); w.w = pk2(v[2 * kk + 1][2], v[2 * kk + 1][3]);
        *(u32x4*)(rowp + 128 * kk + 8 * c) = w; }
}
__device__ __forceinline__ void fill_wrouter(LAS unsigned char* wb, const float* src, int tid) {
#pragma unroll
    for (int j = 0; j < 2; ++j) { const int d = tid + 512 * j; const float* sp = src + (size_t)d * 16;
        const f32x4 a0 = *(const f32x4*)sp, a1 = *(const f32x4*)(sp + 4), a2 = *(const f32x4*)(sp + 8), a3 = *(const f32x4*)(sp + 12);
#pragma unroll
        for (int k = 0; k < 4; ++k) { *(LAS bf16*)(wb + k * RB_PITCH + 2 * d) = (bf16)f2bf(a0[k]); *(LAS bf16*)(wb + (4 + k) * RB_PITCH + 2 * d) = (bf16)f2bf(a1[k]);
            *(LAS bf16*)(wb + (8 + k) * RB_PITCH + 2 * d) = (bf16)f2bf(a2[k]); *(LAS bf16*)(wb + (12 + k) * RB_PITCH + 2 * d) = (bf16)f2bf(a3[k]); } }
}
__device__ __forceinline__ void fill_vec(LAS float* dst, const float* src, int tid) {
    *(LAS f32x4*)(dst + rpos(4 * (tid & 255))) = *(const f32x4*)(src + 4 * (tid & 255));
}
__device__ __forceinline__ void rows_entry_simple(const P& p, int wg, int G) {
    const int tid = opaque_tid(), lane = tid & 63, gw = wg * 8 + (tid >> 6), ngw = G * 8;
    const float* mod = (const float*)(p.ws + WS_MOD); bf16* H = (bf16*)(p.ws + WS_H);
    for (int m = gw; m < NTOK; m += ngw) { const int b = m / SEQ; const float* mb = mod + (size_t)b * 6 * DM; const float* xr = p.x + (size_t)m * DM;
        f32x4 v[4]; float s = 0.f;
#pragma unroll
        for (int j = 0; j < 4; ++j) { v[j] = *(const f32x4*)(xr + 256 * j + 4 * lane); s += (v[j][0] + v[j][1]) + (v[j][2] + v[j][3]); }
        const float mean = wave_sum(s) * (1.f / DM); float q = 0.f;
#pragma unroll
        for (int j = 0; j < 4; ++j) { v[j] = v[j] - mean; q += (v[j][0] * v[j][0] + v[j][1] * v[j][1]) + (v[j][2] * v[j][2] + v[j][3] * v[j][3]); }
        const float rstd = 1.0f / sqrtf(wave_sum(q) * (1.f / DM) + LN_EPS);
#pragma unroll
        for (int j = 0; j < 4; ++j) { const f32x4 sc = *(const f32x4*)(mb + DM + 256 * j + 4 * lane), sh = *(const f32x4*)(mb + 256 * j + 4 * lane); const f32x4 o = v[j] * rstd * (sc + 1.0f) + sh;
            u32x2 w; w.x = pk2(o[0], o[1]); w.y = pk2(o[2], o[3]); *(u32x2*)(H + (size_t)m * DM + 256 * j + 4 * lane) = w; }
    }
}
template <int WHICH>
__device__ __forceinline__ void rows_phase(const P& p, int l, const float* xin, LAS unsigned char* L, int wg, int G, bool dummy = false) {
    const int tid = opaque_tid(), lane = tid & 63, wave = __builtin_amdgcn_readfirstlane(tid >> 6), q = lane >> 4, c = lane & 15;
    LAS float* vec = (LAS float*)(L + RW_VEC);
    const float* modl = (const float*)(p.ws + WS_MOD) + (size_t)l * BATCH * 6 * DM;
    bf16* H = (bf16*)(p.ws + (dummy ? WS_HID : WS_H)); bf16* xa = (bf16*)(p.ws + (dummy ? WS_XG : WS_XA));
    const bool xbf = (WHICH == 2) || (l != 0);
    float* affo = (float*)(p.ws + (dummy ? WS_HID + 128 * MiB : WS_AFF)); float* gato = (float*)(p.ws + (dummy ? WS_HID + 130 * MiB : WS_GATES));
    const bool last = (WHICH == 2) && (l == DEPTH - 1);
    if (WHICH == 1) fill_wrouter(L + RB_W, p.w_router + (size_t)l * DM * 16, tid);
    for (int bi = 0, blk; (blk = unit_of(wg, G, bi, NTOK / 128)) < NTOK / 128; ++bi) {
        const int b = (blk * 128) / SEQ; const float* mb = modl + (size_t)b * 6 * DM;
        __syncthreads();
        { const int half = tid >> 8;
          if (WHICH == 0) { fill_vec(vec + half * DM, mb + (half ? 0 : 1) * DM, tid); }
          if (WHICH == 1) { fill_vec(vec + half * DM, half ? p.ln_g + (size_t)(l * 2) * DM : mb + 2 * DM, tid); fill_vec(vec + (2 + half) * DM, half ? mb + 4 * DM : p.ln_b + (size_t)(l * 2) * DM, tid); if (half == 0) fill_vec(vec + 4 * DM, mb + 3 * DM, tid); }
          if (WHICH == 2) { fill_vec(vec + half * DM, half ? p.ln_g + (size_t)(l * 2 + 1) * DM : mb + 5 * DM, tid); if (half == 0) fill_vec(vec + 2 * DM, p.ln_b + (size_t)(l * 2 + 1) * DM, tid);
              if (!last) { const float* mbn = mb + (size_t)BATCH * 6 * DM; fill_vec(vec + (3 + half) * DM, mbn + (half ? 0 : 1) * DM, tid); } } }
        __syncthreads();
#pragma unroll 1
        for (int it = 0; it < 4; ++it) {
            asm volatile("" ::: "memory");
            const int m = blk * 128 + wave * 16 + it * 4 + q;
            f32x4 v[16];
            if (!xbf) {
#pragma unroll
                for (int k = 0; k < 16; ++k) v[k] = *(const f32x4*)(xin + (size_t)m * DM + RC(k)); }
            else { const bf16* xb = (const bf16*)xin + (size_t)m * DM;
#pragma unroll
                for (int kk = 0; kk < 8; ++kk) { const u32x4 w = *(const u32x4*)(xb + 128 * kk + 8 * c); v[2 * kk] = bf4lo(w); v[2 * kk + 1] = bf4hi(w); } }
            if (WHICH == 1) {
                const bf16* mix = (const bf16*)(p.ws + WS_MIX) + (size_t)m * DM;
                u32x4 mw[8];
#pragma unroll
                for (int kk = 0; kk < 8; ++kk) mw[kk] = *(const u32x4*)(mix + 128 * kk + 8 * c);
#pragma unroll
                for (int k = 0; k < 16; ++k) { const f32x4 g1 = *(const LAS f32x4*)(vec + 64 * k + 4 * c); const f32x4 mx = (k & 1) ? bf4hi(mw[k >> 1]) : bf4lo(mw[k >> 1]);
                    v[k] = v[k] * DN_ALPHA + (g1 + 1.0f) * mx; }
            }
            if (WHICH == 2) {
                const unsigned char* ye = p.ws + WS_YE; const short* slot = (const short*)(p.ws + WS_SLOT);
                const int t = m % SEQ; const int sl = slot[((size_t)b * 16 + c) * SEQ + t];
                const unsigned long long bal = __ballot(sl >= 0);
                unsigned rem = (unsigned)(bal >> (16 * q)) & 0xffffu;
                const int c0 = __popcll(bal & 0xffffull), c1 = __popcll(bal & 0xffff0000ull), c2 = __popcll(bal & 0xffff00000000ull), c3 = __popcll(bal & 0xffff000000000000ull);
                const int m01 = c0 > c1 ? c0 : c1, m23 = c2 > c3 ? c2 : c3, maxc = m01 > m23 ? m01 : m23;
                f32x4 y[16];
#pragma unroll
                for (int k = 0; k < 16; ++k) y[k] = (f32x4){0.f, 0.f, 0.f, 0.f};
                for (int kk = 0; kk < maxc; kk += 2) {
                    const bool va = rem != 0u; const int ea = va ? __builtin_ctz(rem) : 0; rem &= rem - 1u;
                    const bool vb = rem != 0u; const int eb = vb ? __builtin_ctz(rem) : 0; rem &= rem - 1u;
                    const int sa = __shfl(sl, (lane & 48) | ea), sb = __shfl(sl, (lane & 48) | eb);
                    const unsigned char* ra = ye + ((size_t)(ea * 16 + b) * CAP + (va ? sa : 0)) * DM; const unsigned char* rb = ye + ((size_t)(eb * 16 + b) * CAP + (vb ? sb : 0)) * DM;
                    u32x4 wa[4], wb[4];
#pragma unroll
                    for (int j2 = 0; j2 < 4; ++j2) { wa[j2] = *(const u32x4*)(ra + 256 * j2 + 16 * c); wb[j2] = *(const u32x4*)(rb + 256 * j2 + 16 * c); }
                    const float fa = va ? 1.f / pg8::YE_SCALE : 0.f, fb = vb ? 1.f / pg8::YE_SCALE : 0.f;
#pragma unroll
                    for (int k = 0; k < 16; ++k) { y[k] = y[k] + fp8x4(wa[k >> 2][k & 3]) * fa + fp8x4(wb[k >> 2][k & 3]) * fb; }
                }
#pragma unroll
                for (int k = 0; k < 16; ++k) { const f32x4 g2 = *(const LAS f32x4*)(vec + 64 * k + 4 * c); v[k] = v[k] * DN_ALPHA + (g2 + 1.0f) * y[k]; }
            }
            if (WHICH != 0) {
                r16_ln(v);
                const bool of32 = last && !dummy;
#pragma unroll
                for (int k = 0; k < 16; ++k) { const f32x4 gg = *(const LAS f32x4*)(vec + DM + 64 * k + 4 * c), bb = *(const LAS f32x4*)(vec + 2 * DM + 64 * k + 4 * c); v[k] = v[k] * gg + bb; }
                if (of32) {
#pragma unroll
                    for (int k = 0; k < 16; ++k) *(f32x4*)(p.out + (size_t)m * DM + RC(k)) = v[k]; }
                else r16_store_bf16(xa + (size_t)m * DM, c, v);
            }
            if (!last) {
                r16_ln(v);
                const int o_sc = WHICH == 0 ? 0 : 3, o_sh = WHICH == 0 ? 1 : 4;
#pragma unroll
                for (int k = 0; k < 16; ++k) { const f32x4 sc = *(const LAS f32x4*)(vec + o_sc * DM + 64 * k + 4 * c), sh = *(const LAS f32x4*)(vec + o_sh * DM + 64 * k + 4 * c); v[k] = v[k] * (sc + 1.0f) + sh; }
                if (WHICH == 1) { unsigned char* h8 = p.ws + (dummy ? WS_HID : WS_H8) + (size_t)m * DM;
#pragma unroll
                    for (int kk = 0; kk < 8; ++kk) { u32x2 w; w.x = pg8::pk4_fp8(v[2 * kk][0] * ACT_SCALE, v[2 * kk][1] * ACT_SCALE, v[2 * kk][2] * ACT_SCALE, v[2 * kk][3] * ACT_SCALE); w.y = pg8::pk4_fp8(v[2 * kk + 1][0] * ACT_SCALE, v[2 * kk + 1][1] * ACT_SCALE, v[2 * kk + 1][2] * ACT_SCALE, v[2 * kk + 1][3] * ACT_SCALE);
                        *(u32x2*)(h8 + 128 * kk + 8 * c) = w; } }
                else r16_store_bf16(H + (size_t)m * DM, c, v);
                if (WHICH == 1) {
                    LAS unsigned char* st = L + RB_ST + wave * (4 * RB_PITCH);
#pragma unroll
                    for (int kk = 0; kk < 8; ++kk) { u32x4 w; w.x = pk2(v[2 * kk][0], v[2 * kk][1]); w.y = pk2(v[2 * kk][2], v[2 * kk][3]); w.z = pk2(v[2 * kk + 1][0], v[2 * kk + 1][1]); w.w = pk2(v[2 * kk + 1][2], v[2 * kk + 1][3]);
                        *(LAS u32x4*)(st + q * RB_PITCH + (128 * kk + 8 * c) * 2) = w; }
                    f32x4 lg = (f32x4){0.f, 0.f, 0.f, 0.f};
                    const LAS unsigned char* ap = st + (lane & 3) * RB_PITCH + (lane >> 4) * 16; const LAS unsigned char* bp = L + RB_W + (lane & 15) * RB_PITCH + (lane >> 4) * 16;
#pragma unroll 8
                    for (int ks = 0; ks < 32; ++ks) lg = __builtin_amdgcn_mfma_f32_16x16x32_bf16(*(const LAS bf16x8*)(ap + ks * 64), *(const LAS bf16x8*)(bp + ks * 64), lg, 0, 0, 0);
                    float pr[4];
#pragma unroll
                    for (int rr = 0; rr < 4; ++rr) { const float mx = r16_max(lg[rr]), ex = __expf(lg[rr] - mx), sm = r16_sum(ex); pr[rr] = ex / sm; }
                    const float mine = q == 0 ? pr[0] : q == 1 ? pr[1] : q == 2 ? pr[2] : pr[3];
                    affo[(size_t)m * 16 + c] = mine; }
            }
        }
    }
    __syncthreads();
}

__device__ __forceinline__ void transpose_item(const float* src, size_t ld_src, bf16* dst, size_t ld_dst, LAS float* scr, int lane, int nvalid = 32) {
    if (nvalid > 0) { const int kr = lane >> 3, nc = 4 * (lane & 7);
        f32x4 t[8];
#pragma unroll
        for (int i = 0; i < 8; ++i) t[i] = *(const f32x4*)(src + (size_t)(8 * i + kr) * ld_src + nc);
#pragma unroll
        for (int i = 0; i < 8; ++i) { LAS float* d = scr + (8 * i + kr) * 33 + nc; d[0] = t[i][0]; d[1] = t[i][1]; d[2] = t[i][2]; d[3] = t[i][3]; }
    }
    asm volatile("s_waitcnt lgkmcnt(0)" ::: "memory");
    const int c = lane & 7;
#pragma unroll
    for (int j = 0; j < 4; ++j) { const int n = (lane >> 3) + 8 * j; const LAS float* s = scr + (8 * c) * 33 + n;
        u32x4 o; o.x = pk2(s[0 * 33], s[1 * 33]); o.y = pk2(s[2 * 33], s[3 * 33]); o.z = pk2(s[4 * 33], s[5 * 33]); o.w = pk2(s[6 * 33], s[7 * 33]);
        if (n >= nvalid) o = (u32x4){0u, 0u, 0u, 0u};
        *(u32x4*)(dst + (size_t)n * ld_dst + 8 * c) = o; }
    asm volatile("s_waitcnt lgkmcnt(0)" ::: "memory");
}
__device__ __forceinline__ void transpose_item8(const float* src, size_t ld_src, unsigned char* dst, size_t ld_dst, float scale, LAS float* scr, int lane) {
    { const int kr = lane >> 3, nc = 4 * (lane & 7);
        f32x4 t[8];
#pragma unroll
        for (int i = 0; i < 8; ++i) t[i] = *(const f32x4*)(src + (size_t)(8 * i + kr) * ld_src + nc);
#pragma unroll
        for (int i = 0; i < 8; ++i) { LAS float* d = scr + (8 * i + kr) * 33 + nc; d[0] = t[i][0]; d[1] = t[i][1]; d[2] = t[i][2]; d[3] = t[i][3]; } }
    asm volatile("s_waitcnt lgkmcnt(0)" ::: "memory");
    const int c = lane & 3;
#pragma unroll
    for (int j = 0; j < 2; ++j) { const int n = (lane >> 2) + 16 * j; const LAS float* s = scr + (16 * c) * 33 + n;
        u32x4 o;
#pragma unroll
        for (int q = 0; q < 4; ++q) o[q] = pg8::pk4_fp8(s[(4 * q) * 33] * scale, s[(4 * q + 1) * 33] * scale, s[(4 * q + 2) * 33] * scale, s[(4 * q + 3) * 33] * scale);
        *(u32x4*)(dst + (size_t)n * ld_dst + 16 * c) = o; }
    asm volatile("s_waitcnt lgkmcnt(0)" ::: "memory");
}
constexpr int ITL_WIN = 16 * 80, ITL_WOUT = 16 * 32, ITL_WGU = NE * 16 * 128, ITL_WD = NE * 32 * 32, ITL = ITL_WIN + ITL_WOUT + ITL_WGU + ITL_WD;
constexpr int ITS = ITL_WIN + ITL_WOUT, ITM = ITL_WGU + ITL_WD;
__device__ __forceinline__ void convert_item(const P& p, int l, int it, LAS float* scr, int lane) {
    if (it < ITL_WIN) { const int kb = it / 80, nb = it % 80, n0 = 32 * nb;
        const int sc = n0 < 1792 ? n0 : n0 < 2304 ? n0 + 16 : 1792, nvalid = n0 < 2304 ? 32 : n0 == 2304 ? 16 : 0;
        transpose_item(p.w_in + (size_t)l * DM * PW_IN + (size_t)(64 * kb) * PW_IN + sc, PW_IN, (bf16*)(p.ws + WS_WIN) + (size_t)l * PNW * DM + (size_t)n0 * DM + 64 * kb, DM, scr, lane, nvalid); return; }
    it -= ITL_WIN;
    if (it < ITL_WOUT) { const int kb = it / 32, nb = it % 32;
        transpose_item(p.w_out + (size_t)l * DM * DM + (size_t)(64 * kb) * DM + 32 * nb, DM, (bf16*)(p.ws + WS_WOUT) + (size_t)l * DM * DM + (size_t)(32 * nb) * DM + 64 * kb, DM, scr, lane); return; }
    it -= ITL_WOUT;
    if (it < ITL_WGU) { const int le = l * NE + it / (16 * 128), r = it % (16 * 128), kb = r / 128, nb = r % 128, n0 = 32 * nb, pn = n0 >> 8, w = n0 & 255;
        const float* src = (w < 128 ? p.w_gate : p.w_up) + (size_t)le * DM * DE + (size_t)(64 * kb) * DE + pn * 128 + (w & 127);
        transpose_item8(src, DE, p.ws + WS_WGU + (size_t)le * 4096 * DM + (size_t)n0 * DM + 64 * kb, DM, W1_SCALE, scr, lane); return; }
    it -= ITL_WGU;
    { const int le = l * NE + it / (32 * 32), r = it % (32 * 32), kb = r / 32, nb = r % 32;
        transpose_item8(p.w_down + (size_t)le * DE * DM + (size_t)(64 * kb) * DM + 32 * nb, DM, p.ws + WS_WD + (size_t)le * DM * DE + (size_t)(32 * nb) * DE + 64 * kb, DE, W2_SCALE, scr, lane); }
}

typedef short s16x4 __attribute__((ext_vector_type(4)));
typedef float f32x16 __attribute__((ext_vector_type(16)));
#define MFMA32(a, b, c) __builtin_amdgcn_mfma_f32_32x32x16_bf16((a), (b), (c), 0, 0, 0)
__device__ __forceinline__ int crow(int reg, int h) { return (reg & 3) + 8 * (reg >> 2) + 4 * h; }
__device__ __forceinline__ unsigned cvtpk(float lo, float hi) { return pk2(lo, hi); }
__device__ __forceinline__ bf16x8 pack8(float a0, float a1, float a2, float a3, float a4, float a5, float a6, float a7) {
    u32x4 w; w.x = cvtpk(a0, a1); w.y = cvtpk(a2, a3); w.z = cvtpk(a4, a5); w.w = cvtpk(a6, a7); return __builtin_bit_cast(bf16x8, w); }
__device__ __forceinline__ s16x4 tr_read(const LAS unsigned char* p) { typedef short v4i16_t __attribute__((ext_vector_type(4))); return __builtin_bit_cast(s16x4, __builtin_amdgcn_ds_read_tr16_b64_v4i16((LAS v4i16_t*)p)); }
__device__ __forceinline__ bf16x8 cat8(s16x4 lo, s16x4 hi) { return (bf16x8){lo[0], lo[1], lo[2], lo[3], hi[0], hi[1], hi[2], hi[3]}; }
__device__ __forceinline__ int wave_sum_i(int v) {
#pragma unroll
    for (int o = 1; o < 64; o <<= 1) v += __shfl_xor(v, o);
    return v;
}
__device__ __forceinline__ float wave_max(float v) {
#pragma unroll
    for (int o = 1; o < 64; o <<= 1) v = fmaxf(v, __shfl_xor(v, o));
    return v;
}

template <int CTRL, int RMASK> __device__ __forceinline__ float dpp_id(float ident, float v) { return __builtin_bit_cast(float, __builtin_amdgcn_update_dpp(__builtin_bit_cast(int, ident), __builtin_bit_cast(int, v), CTRL, RMASK, 0xf, false)); }
__device__ __forceinline__ float wave_scan_sum(float v) {
    v += dpp_id<0x111, 0xf>(0.f, v); v += dpp_id<0x112, 0xf>(0.f, v); v += dpp_id<0x114, 0xf>(0.f, v); v += dpp_id<0x118, 0xf>(0.f, v);
    v += dpp_id<0x142, 0xa>(0.f, v); v += dpp_id<0x143, 0xc>(0.f, v); return v; }
__device__ __forceinline__ float wave_scan_max(float v) { const float NI = -3.0e38f;
    v = fmaxf(v, dpp_id<0x111, 0xf>(NI, v)); v = fmaxf(v, dpp_id<0x112, 0xf>(NI, v)); v = fmaxf(v, dpp_id<0x114, 0xf>(NI, v)); v = fmaxf(v, dpp_id<0x118, 0xf>(NI, v));
    v = fmaxf(v, dpp_id<0x142, 0xa>(NI, v)); v = fmaxf(v, dpp_id<0x143, 0xc>(NI, v)); return v; }
__device__ __forceinline__ void ph_topk(const P& p, LAS unsigned char* lds, int wg, int G) {
    const int tid = opaque_tid(), lane = tid & 63, wave = __builtin_amdgcn_readfirstlane(tid >> 6);
    LAS unsigned* hist = (LAS unsigned*)lds;
    LAS unsigned* cnt = hist + 1024;
    const float* affp = (const float*)(p.ws + WS_AFF);
    for (int ui = 0, u; (u = unit_of(wg, G, ui, 256)) < 256; ++ui) {
        const int b = u >> 4, e = u & 15, g = e * 16 + b;
        unsigned key[4];
#pragma unroll
        for (int i = 0; i < 4; ++i) key[i] = __builtin_bit_cast(unsigned, affp[((size_t)b * SEQ + i * 512 + tid) * 16 + e]);
        hist[tid] = 0u; hist[512 + tid] = 0u;
        __syncthreads();
        unsigned thr = 0u; int need = CAP;
#pragma unroll
        for (int ps = 0; ps < 4; ++ps) { const int sh = 24 - 8 * ps;
#pragma unroll
            for (int i = 0; i < 4; ++i) { const bool in = ps == 0 || (key[i] >> (sh + 8)) == (thr >> (sh + 8));
                if (in) __hip_atomic_fetch_add(hist + ps * 256 + ((key[i] >> sh) & 255u), 1u, __ATOMIC_RELAXED, __HIP_MEMORY_SCOPE_WORKGROUP); }
            __syncthreads();
            const int lp = 63 - lane; const u32x4 h4 = *(const LAS u32x4*)(hist + ps * 256 + 4 * lp);
            const int s4 = (int)(h4.x + h4.y + h4.z + h4.w), incl = (int)wave_scan_sum((float)s4), excl = incl - s4;
            const int Ls = __builtin_ctzll(__ballot(incl >= need));
            const int c3 = excl + (int)h4.w, c2 = c3 + (int)h4.z, c1 = c2 + (int)h4.y;
            const int Bl = 4 * lp + (c3 >= need ? 3 : c2 >= need ? 2 : c1 >= need ? 1 : 0), ab = c3 >= need ? excl : c2 >= need ? c3 : c1 >= need ? c2 : c1;
            thr |= (unsigned)__builtin_amdgcn_readlane(Bl, Ls) << sh; need -= __builtin_amdgcn_readlane(ab, Ls); }
        const unsigned long long lt = (1ull << lane) - 1ull;
        unsigned long long beq[4], bsel[4];
#pragma unroll
        for (int i = 0; i < 4; ++i) { beq[i] = __ballot(key[i] == thr); if (lane == 0) cnt[i * 8 + wave] = (unsigned)__popcll(beq[i]); }
        __syncthreads();
        { const float c = lane < 32 ? (float)cnt[lane & 31] : 0.f; const float ex = wave_scan_sum(c) - c;
#pragma unroll
          for (int i = 0; i < 4; ++i) { const int eqrank = (int)__builtin_bit_cast(float, __builtin_amdgcn_readlane(__builtin_bit_cast(int, ex), i * 8 + wave)) + __popcll(beq[i] & lt);
              const bool sel = key[i] > thr || (key[i] == thr && eqrank < need);
              bsel[i] = __ballot(sel); if (lane == 0) cnt[32 + i * 8 + wave] = (unsigned)__popcll(bsel[i]); } }
        __syncthreads();
        { const float c = lane < 32 ? (float)cnt[32 + (lane & 31)] : 0.f; const float ex = wave_scan_sum(c) - c;
          unsigned short* idx = (unsigned short*)(p.ws + WS_IDX) + g * CAP; float* gv = (float*)(p.ws + WS_GATEV) + g * CAP; short* slot = (short*)(p.ws + WS_SLOT) + ((size_t)b * 16 + e) * SEQ;
#pragma unroll
          for (int i = 0; i < 4; ++i) { const int sl = (int)__builtin_bit_cast(float, __builtin_amdgcn_readlane(__builtin_bit_cast(int, ex), i * 8 + wave)) + __popcll(bsel[i] & lt); const int tok = i * 512 + tid;
              const bool sel = (bsel[i] >> lane) & 1ull;
              if (sel) { idx[(((sl >> 7) * 64 + (sl & 63)) << 1) + ((sl >> 6) & 1)] = (unsigned short)tok; gv[sl] = __builtin_bit_cast(float, key[i]); }
              slot[tok] = sel ? (short)sl : (short)-1; } }
        __syncthreads();
    }
}

__device__ __forceinline__ float gelu_as(float v) {
    const float t = __builtin_amdgcn_rcpf(fabsf(v) * 0.2316418882f + 1.0f);
    float q = t * 0.5307027145f + (-0.7265760135f); q = q * t + 0.7107068705f; q = q * t + (-0.142248368f); q = q * t + 0.127414796f; q = q * t;
    const float m = v * (q * __builtin_amdgcn_exp2f(v * v * (-0.72134752044f)));
    return v < 0.f ? m : v - m;
}
constexpr int GM_PITCH = 264;
__device__ __forceinline__ void ph_gmlp(const P& p, int l, LAS unsigned char* lds, int wg, int G) {
    const int tid = opaque_tid(), lane = tid & 63, wave = __builtin_amdgcn_readfirstlane(tid >> 6), r = lane & 31, h = lane >> 5, q = lane >> 4, c = lane & 15;
    const bf16* proj = (const bf16*)(p.ws + WS_PROJ); bf16* mixcat = (bf16*)(p.ws + WS_MIXCAT);
    const bf16* wsb = (const bf16*)(p.ws + WS_WS) + (size_t)l * 4 * 128 * 128;
    for (int ui = 0, u; (u = unit_of(wg, G, ui, 256)) < 256; ++ui) {
        const size_t m0 = (size_t)u * 128;
#pragma unroll
        for (int it = 0; it < 4; ++it) { const int t = wave * 16 + it * 4 + q;
            const bf16* src = proj + (m0 + t) * PN + C_GV + 8 * c; const u32x4 x0 = *(const u32x4*)src, x1 = *(const u32x4*)(src + 128);
            float v[16];
#pragma unroll
            for (int i = 0; i < 4; ++i) { v[2 * i] = gelu_as(bflo(x0[i])); v[2 * i + 1] = gelu_as(bfhi(x0[i])); v[8 + 2 * i] = gelu_as(bflo(x1[i])); v[8 + 2 * i + 1] = gelu_as(bfhi(x1[i])); }
            float s = 0.f;
#pragma unroll
            for (int i = 0; i < 16; ++i) s += v[i];
            const float mean = r16_sum(s) * (1.f / 256.f); float qq = 0.f;
#pragma unroll
            for (int i = 0; i < 16; ++i) { v[i] -= mean; qq += v[i] * v[i]; }
            const float rstd = 1.0f / sqrtf(r16_sum(qq) * (1.f / 256.f) + LN_EPS);
            u32x4 o0, o1;
#pragma unroll
            for (int i = 0; i < 4; ++i) { o0[i] = pk2(v[2 * i] * rstd, v[2 * i + 1] * rstd); o1[i] = pk2(v[8 + 2 * i] * rstd, v[8 + 2 * i + 1] * rstd); }
            *(LAS u32x4*)(lds + (t * GM_PITCH + 8 * c) * 2) = o0; *(LAS u32x4*)(lds + (t * GM_PITCH + 128 + 8 * c) * 2) = o1; }
        __syncthreads();
        const int tt = wave & 3, ch = wave >> 2, t = tt * 32 + r;
        u32x2 uu[4][4];
#pragma unroll
        for (int ti = 0; ti < 4; ++ti)
#pragma unroll
            for (int rg = 0; rg < 4; ++rg) uu[ti][rg] = *(const u32x2*)(proj + (m0 + t) * PN + C_GU + ch * 128 + ti * 32 + 8 * rg + 4 * h);
        const int G4 = lane >> 4, q4 = c >> 2, p4 = c & 3;
#pragma unroll
        for (int gi = 0; gi < 2; ++gi) { const int g = ch * 2 + gi;
            bf16x8 wf[8];
#pragma unroll
            for (int ks = 0; ks < 8; ++ks) wf[ks] = *(const bf16x8*)(wsb + ((size_t)g * 128 + t) * 128 + ks * 16 + 8 * h);
            const float bias = p.b_s[(l * 4 + g) * 128 + t];
#pragma unroll
            for (int ci = 0; ci < 2; ++ci) { const int c0 = g * 64 + ci * 32, ti = gi * 2 + ci;
                f32x16 acc; for (int i = 0; i < 16; ++i) acc[i] = 0.f;
                const LAS unsigned char* vb = lds + ((8 * (G4 >> 1) + q4) * GM_PITCH + c0 + 16 * (G4 & 1) + 4 * p4) * 2;
#pragma unroll
                for (int ks = 0; ks < 8; ++ks) { const bf16x8 af = cat8(tr_read(vb + (ks * 16) * GM_PITCH * 2), tr_read(vb + (ks * 16 + 4) * GM_PITCH * 2)); acc = MFMA32(af, wf[ks], acc); }
                bf16* op = mixcat + (m0 + t) * DM + 768 + c0;
#pragma unroll
                for (int rg = 0; rg < 4; ++rg) { const u32x2 w = uu[ti][rg]; u32x2 o;
                    o.x = pk2(gelu_as(bflo(w.x)) * (acc[4 * rg] + bias), gelu_as(bfhi(w.x)) * (acc[4 * rg + 1] + bias));
                    o.y = pk2(gelu_as(bflo(w.y)) * (acc[4 * rg + 2] + bias), gelu_as(bfhi(w.y)) * (acc[4 * rg + 3] + bias));
                    *(u32x2*)(op + 8 * rg + 4 * h) = o; } } }
        __syncthreads();
    }
}

constexpr int AT_PITCH = 144;
constexpr int AT_K = 0, AT_V = 384 * AT_PITCH, AT_BIAS = 2 * 384 * AT_PITCH, AT_BYTES = AT_BIAS + 8 * 257 * 4;
#define AT_SOFTMAX(st, bth_, mrun_, lsum_, oa_, ob_, l2_) do { float mt_ = -3.0e38f; \
        if (diag) { _Pragma("unroll") for (int reg = 0; reg < 16; ++reg) { const int band = band0 + crow(reg, h), rel = band - 128 - qloc; const bool ok = (rel >= -128) && (rel <= 128); \
                const float bias = (bth_)[ok ? band : 128 + qloc]; l2_[reg] = (st[reg] * (0.125f * L2E) + bias) + (ok ? 0.f : -3.0e38f); mt_ = fmaxf(mt_, l2_[reg]); } }   \
        else { _Pragma("unroll") for (int reg = 0; reg < 16; ++reg) { l2_[reg] = st[reg] * (0.125f * L2E) + (bth_)[band0 + crow(reg, h)]; mt_ = fmaxf(mt_, l2_[reg]); } } \
        { const auto rr_ = __builtin_amdgcn_permlane32_swap(__float_as_uint(mt_), __float_as_uint(mt_), false, false); mt_ = fmaxf(__uint_as_float(rr_[0]), __uint_as_float(rr_[1])); } \
        const float mnew_ = fmaxf(mrun_, mt_); \
        if (__any(mnew_ > mrun_)) { const float f_ = __builtin_amdgcn_exp2f(mrun_ - mnew_); lsum_ *= f_; _Pragma("unroll") for (int i = 0; i < 16; ++i) { oa_[i] *= f_; ob_[i] *= f_; } mrun_ = mnew_; } \
        float ps_ = 0.f; _Pragma("unroll") for (int reg = 0; reg < 16; ++reg) { l2_[reg] = __builtin_amdgcn_exp2f(l2_[reg] - mrun_); ps_ += l2_[reg]; } \
        lsum_ += ps_; } while (0)
__device__ __forceinline__ void ph_attn(const P& p, int l, LAS unsigned char* lds, int wg, int G) {
    const int tid = opaque_tid(), lane = tid & 63, wave = __builtin_amdgcn_readfirstlane(tid >> 6), r = lane & 31, h = lane >> 5;
    const bf16* proj = (const bf16*)(p.ws + WS_PROJ); bf16* mixcat = (bf16*)(p.ws + WS_MIXCAT);
    LAS float* bt = (LAS float*)(lds + AT_BIAS);
    const float L2E = 1.4426950408889634f;
    for (int i = tid; i < 8 * 257; i += 512) { const int hd = i / 257, rr = i - hd * 257; bt[i] = p.rel_bias[t5_bucket(rr - 128) * 8 + hd] * L2E; }
    for (int ui = 0, u; (u = unit_of(wg, G, ui, 512)) < 512; ++ui) {
        const int b = u >> 5, n = (u >> 1) & 15, hk = u & 1;
        { u32x4 kv[6], vv[6];
#pragma unroll
          for (int i = 0; i < 6; ++i) { const int id = i * 512 + tid, row = id >> 3, chn = id & 7; int pos = (n - 1) * 128 + row; pos = pos < 0 ? 0 : (pos > SEQ - 1 ? SEQ - 1 : pos);
              const bf16* src = proj + ((size_t)b * SEQ + pos) * PN + hk * 64 + chn * 8; kv[i] = *(const u32x4*)(src + C_AK); vv[i] = *(const u32x4*)(src + C_AV); }
#pragma unroll
          for (int i = 0; i < 6; ++i) { const int id = i * 512 + tid, row = id >> 3, chn = id & 7;
              *(LAS u32x4*)(lds + AT_K + row * AT_PITCH + chn * 16) = kv[i]; *(LAS u32x4*)(lds + AT_V + row * AT_PITCH + chn * 16) = vv[i]; } }
        const int tq = wave & 3, hh0 = (wave >> 2) * 2, qloc = tq * 32 + r; const size_t m = (size_t)b * SEQ + n * 128 + qloc;
        bf16x8 qa[4], qb[4];
#pragma unroll
        for (int s = 0; s < 4; ++s) { qa[s] = *(const bf16x8*)(proj + m * PN + C_AQ + (hk * 4 + hh0) * 64 + s * 16 + 8 * h); qb[s] = *(const bf16x8*)(proj + m * PN + C_AQ + (hk * 4 + hh0 + 1) * 64 + s * 16 + 8 * h); }
        const float sinka = p.sink[l * 8 + hk * 4 + hh0] * L2E, sinkb = p.sink[l * 8 + hk * 4 + hh0 + 1] * L2E;
        __syncthreads();
        const int G4 = lane >> 4, i16 = lane & 15, q4 = i16 >> 2, p4 = i16 & 3;
        const int kt_lo = n == 0 ? 4 : tq, kt_hi = n == 15 ? 7 : 8 + tq;
#pragma unroll
        for (int x = 0; x < 2; ++x) {
            float mr = x ? sinkb : sinka, ls = 0.f; f32x16 o0, o1; for (int i = 0; i < 16; ++i) { o0[i] = 0.f; o1[i] = 0.f; }
            const LAS float* bth = bt + (hk * 4 + hh0 + x) * 257 - qloc;
            f32x16 sc; for (int i = 0; i < 16; ++i) sc[i] = 0.f;
            { const int band0 = (kt_lo >> 2) * 128 + (kt_lo & 3) * 32;
#pragma unroll
              for (int s = 0; s < 4; ++s) { const bf16x8 kf = *(const LAS bf16x8*)(lds + AT_K + (band0 + r) * AT_PITCH + (s * 16 + 8 * h) * 2); sc = MFMA32(kf, x ? qb[s] : qa[s], sc); } }
#pragma unroll 1
            for (int kt = kt_lo; kt <= kt_hi; ++kt) { const int kb = kt >> 2, tk = kt & 3;
                const bool diag = (kb != 1) && (tk == tq);
                const int band0 = kb * 128 + tk * 32;
                const int ktn = kt < kt_hi ? kt + 1 : kt_hi, band0n = (ktn >> 2) * 128 + (ktn & 3) * 32;
                f32x16 sn; for (int i = 0; i < 16; ++i) sn[i] = 0.f;
#pragma unroll
                for (int s = 0; s < 4; ++s) { const bf16x8 kf = *(const LAS bf16x8*)(lds + AT_K + (band0n + r) * AT_PITCH + (s * 16 + 8 * h) * 2); sn = MFMA32(kf, x ? qb[s] : qa[s], sn); }
                float lp[16];
                AT_SOFTMAX(sc, bth, mr, ls, o0, o1, lp);
                const bf16x8 p0 = pack8(lp[0], lp[1], lp[2], lp[3], lp[4], lp[5], lp[6], lp[7]), p1 = pack8(lp[8], lp[9], lp[10], lp[11], lp[12], lp[13], lp[14], lp[15]);
                const LAS unsigned char* vb = lds + AT_V + (band0 + 4 * (G4 >> 1) + q4) * AT_PITCH + (16 * (G4 & 1) + 4 * p4) * 2;
#pragma unroll
                for (int s = 0; s < 2; ++s) {
                    const bf16x8 va0 = cat8(tr_read(vb + (16 * s) * AT_PITCH), tr_read(vb + (16 * s + 8) * AT_PITCH));
                    const bf16x8 va1 = cat8(tr_read(vb + (16 * s) * AT_PITCH + 64), tr_read(vb + (16 * s + 8) * AT_PITCH + 64));
                    o0 = MFMA32(va0, s ? p1 : p0, o0); o1 = MFMA32(va1, s ? p1 : p0, o1); }
                sc = sn;
            }
            { const float sk = x ? sinkb : sinka;
              ls += __shfl_xor(ls, 32); ls += __builtin_amdgcn_exp2f(sk - mr);
              const float inv = 1.0f / ls;
              bf16* op = mixcat + m * DM + (hk * 4 + hh0 + x) * 64;
#pragma unroll
              for (int rg = 0; rg < 4; ++rg) { u32x2 w0, w1;
                  w0.x = cvtpk(o0[4 * rg] * inv, o0[4 * rg + 1] * inv); w0.y = cvtpk(o0[4 * rg + 2] * inv, o0[4 * rg + 3] * inv);
                  w1.x = cvtpk(o1[4 * rg] * inv, o1[4 * rg + 1] * inv); w1.y = cvtpk(o1[4 * rg + 2] * inv, o1[4 * rg + 3] * inv);
                  *(u32x2*)(op + 8 * rg + 4 * h) = w0; *(u32x2*)(op + 32 + 8 * rg + 4 * h) = w1; } }
        }
        __syncthreads();
    }
}
#undef AT_SOFTMAX

struct GateVec { int ta, tb; float b0, b1, fs0, fs1, pm0, pm1, total, mx; };
struct GateRaw { float ig0, ig1, f0, f1; };
__device__ __forceinline__ GateRaw gate_loads(const float* gates, size_t m0, int head, int dir, int lane) {
    const int ta = dir == 0 ? 2 * lane : 127 - 2 * lane, tb = dir == 0 ? ta + 1 : ta - 1;
    const float* ga = gates + (m0 + ta) * 16 + dir * 8 + head; const float* gb = gates + (m0 + tb) * 16 + dir * 8 + head;
    GateRaw g; g.ig0 = ga[0]; g.ig1 = gb[0]; g.f0 = ga[4]; g.f1 = gb[4]; return g; }
__device__ __forceinline__ GateVec gate_vectors(const GateRaw& g, int dir, int lane) {
    GateVec r; r.ta = dir == 0 ? 2 * lane : 127 - 2 * lane; r.tb = dir == 0 ? r.ta + 1 : r.ta - 1;
    const float ig0 = g.ig0, ig1 = g.ig1, lf0 = logsigmoid_f(g.f0), lf1 = logsigmoid_f(g.f1);
    const float s = lf0 + lf1, incl = wave_scan_sum(s), excl = incl - s;
    r.total = __builtin_bit_cast(float, __builtin_amdgcn_readlane(__builtin_bit_cast(int, incl), 63));
    r.b0 = excl + lf0; r.b1 = r.b0 + lf1; r.fs0 = ig0 - r.b0; r.fs1 = ig1 - r.b1;
    const float pi = wave_scan_max(fmaxf(r.fs0, r.fs1)), pe = dpp_id<0x138, 0xf>(-3.0e38f, pi);
    r.pm0 = fmaxf(pe, r.fs0); r.pm1 = fmaxf(r.pm0, r.fs1);
    r.mx = __builtin_bit_cast(float, __builtin_amdgcn_readlane(__builtin_bit_cast(int, pi), 63));
    return r;
}
constexpr int MA_P = 144;
constexpr int MA_K = 0, MA_VW = 128 * MA_P, MA_WEXP = 3 * 128 * MA_P, MA_BYTES = MA_WEXP + 1024;
__device__ __forceinline__ void ph_mlstm_a(const P& p, int l, LAS unsigned char* lds, int wg, int G) {
    const int tid = opaque_tid(), lane = tid & 63, wave = __builtin_amdgcn_readfirstlane(tid >> 6), r = lane & 31, h = lane >> 5;
    const bf16* proj = (const bf16*)(p.ws + WS_PROJ); bf16* qkt = (bf16*)(p.ws + WS_QKT); const float* gates = (const float*)(p.ws + WS_GATES);
    bf16* DC = (bf16*)(p.ws + WS_DC); float* DN = (float*)(p.ws + WS_DN); float* DS = (float*)(p.ws + WS_DS);
    LAS float* wexp = (LAS float*)(lds + MA_WEXP);
    const int c8 = tid & 7, isk = (tid >> 3) & 1, tq = tid >> 4, tv = tid >> 3;
    for (int ui = 0, u; (u = unit_of(wg, G, ui, 1024)) < 1024; ++ui) {
        const int b = u >> 6, head = (u >> 4) & 3, chunk = u & 15; const size_t m0 = (size_t)b * SEQ + chunk * 128;
        const GateRaw graw = gate_loads(gates, m0, head, wave & 1, lane);
        f32x4 wv[8];
        { const float* cwp = p.conv_w + (size_t)l * 3 * 512 + isk * 256 + head * 64 + c8 * 8; const float* cbp = p.conv_b + l * 512 + isk * 256 + head * 64 + c8 * 8;
#pragma unroll
          for (int tap = 0; tap < 3; ++tap) { wv[2 * tap] = *(const f32x4*)(cwp + tap * 512); wv[2 * tap + 1] = *(const f32x4*)(cwp + tap * 512 + 4); }
          wv[6] = *(const f32x4*)cbp; wv[7] = *(const f32x4*)(cbp + 4); }
        u32x4 xl[3][4];
#pragma unroll
        for (int i = 0; i < 4; ++i) { const int t = tq + 32 * i, tpos = chunk * 128 + t; const bf16* pr = proj + (m0 + t) * PN + (isk ? C_MK : C_MQ) + head * 64 + c8 * 8;
            xl[1][i] = *(const u32x4*)pr; xl[0][i] = *(const u32x4*)(tpos > 0 ? pr - PN : pr); xl[2][i] = *(const u32x4*)(tpos < SEQ - 1 ? pr + PN : pr); }
        u32x4 vpre[2];
#pragma unroll
        for (int i = 0; i < 2; ++i) vpre[i] = *(const u32x4*)(proj + (m0 + tv + 64 * i) * PN + C_MV + head * 64 + c8 * 8);
        if (wave < 2) { const int dir = wave; const GateVec gv = gate_vectors(graw, dir, lane);
            wexp[dir * 128 + gv.ta] = __expf(gv.fs0 - gv.mx); wexp[dir * 128 + gv.tb] = __expf(gv.fs1 - gv.mx);
            if (lane == 0) { DS[(size_t)(u * 2 + dir) * 2] = gv.total; DS[(size_t)(u * 2 + dir) * 2 + 1] = gv.total + gv.mx; } }
        { const float sc = isk ? 0.125f : 1.0f;
#pragma unroll
          for (int i = 0; i < 4; ++i) { const int t = tq + 32 * i, tpos = chunk * 128 + t; const bool hp = tpos > 0, hn = tpos < SEQ - 1;
              const u32x4 z = (u32x4){0u, 0u, 0u, 0u}; const u32x4 x0 = hp ? xl[0][i] : z, x1 = xl[1][i], x2 = hn ? xl[2][i] : z;
              float y[8];
#pragma unroll
              for (int q = 0; q < 4; ++q) { const int c = 2 * q;
                  y[c] = wv[6 + (c >> 2)][c & 3] + wv[c >> 2][c & 3] * bflo(x0[q]) + wv[2 + (c >> 2)][c & 3] * bflo(x1[q]) + wv[4 + (c >> 2)][c & 3] * bflo(x2[q]);
                  y[c + 1] = wv[6 + (c >> 2)][(c & 3) + 1] + wv[c >> 2][(c & 3) + 1] * bfhi(x0[q]) + wv[2 + (c >> 2)][(c & 3) + 1] * bfhi(x1[q]) + wv[4 + (c >> 2)][(c & 3) + 1] * bfhi(x2[q]); }
#pragma unroll
              for (int k = 0; k < 8; ++k) y[k] = silu_acc(y[k]) * sc;
              u32x4 o; o.x = pk2(y[0], y[1]); o.y = pk2(y[2], y[3]); o.z = pk2(y[4], y[5]); o.w = pk2(y[6], y[7]);
              *(u32x4*)(qkt + (m0 + t) * 512 + isk * 256 + head * 64 + c8 * 8) = o;
              if (isk) *(LAS u32x4*)(lds + MA_K + t * MA_P + c8 * 16) = o; } }
        __syncthreads();
#pragma unroll
        for (int i = 0; i < 2; ++i) { const int t = tv + 64 * i; const float wf = wexp[t], wb = wexp[128 + t]; const u32x4 x = vpre[i]; u32x4 of, ob;
#pragma unroll
            for (int q = 0; q < 4; ++q) { const float lo = bflo(x[q]), hi = bfhi(x[q]); of[q] = pk2(lo * wf, hi * wf); ob[q] = pk2(lo * wb, hi * wb); }
            *(LAS u32x4*)(lds + MA_VW + t * MA_P + c8 * 16) = of; *(LAS u32x4*)(lds + MA_VW + (128 + t) * MA_P + c8 * 16) = ob; }
        __syncthreads();
        { const int dir = wave >> 2, et = (wave >> 1) & 1, dt = wave & 1;
          const int G4 = lane >> 4, i16 = lane & 15, q4 = i16 >> 2, p4 = i16 & 3;
          const LAS unsigned char* ab = lds + MA_VW + (dir * 128 + 4 * (G4 >> 1) + q4) * MA_P + (et * 32 + 16 * (G4 & 1) + 4 * p4) * 2;
          const LAS unsigned char* bb = lds + MA_K + (4 * (G4 >> 1) + q4) * MA_P + (dt * 32 + 16 * (G4 & 1) + 4 * p4) * 2;
          f32x16 acc, accn; for (int i = 0; i < 16; ++i) { acc[i] = 0.f; accn[i] = 0.f; }
#pragma unroll
          for (int ks = 0; ks < 8; ++ks) { const bf16x8 af = cat8(tr_read(ab + (16 * ks) * MA_P), tr_read(ab + (16 * ks + 8) * MA_P)), kf = cat8(tr_read(bb + (16 * ks) * MA_P), tr_read(bb + (16 * ks + 8) * MA_P));
              acc = MFMA32(af, kf, acc);
              if (et == 0) { const f32x4 w0 = *(const LAS f32x4*)(wexp + dir * 128 + 16 * ks + 4 * h), w1 = *(const LAS f32x4*)(wexp + dir * 128 + 16 * ks + 8 + 4 * h);
                  const bool r0 = r == 0; const bf16x8 wa = pack8(r0 ? w0[0] : 0.f, r0 ? w0[1] : 0.f, r0 ? w0[2] : 0.f, r0 ? w0[3] : 0.f, r0 ? w1[0] : 0.f, r0 ? w1[1] : 0.f, r0 ? w1[2] : 0.f, r0 ? w1[3] : 0.f);
                  accn = MFMA32(wa, kf, accn); } }
          bf16* dc = DC + (size_t)(u * 2 + dir) * 4096;
#pragma unroll
          for (int reg = 0; reg < 16; ++reg) dc[(et * 32 + crow(reg, h)) * 64 + dt * 32 + r] = (bf16)f2bf(acc[reg]);
          if (et == 0 && h == 0) DN[(size_t)(u * 2 + dir) * 64 + dt * 32 + r] = accn[0]; }
        __syncthreads();
    }
}
constexpr int MC_PITCH = 144;
constexpr int MC_Q = 0, MC_K = 128 * MC_PITCH, MC_V = 2 * 128 * MC_PITCH, MC_C = 3 * 128 * MC_PITCH;
constexpr int MC_X = 131072 + 1024;
constexpr int MC_VEC = MC_X, MC_COEF = MC_VEC + 3072, MC_MS = MC_COEF + 512, MC_N = MC_MS + 64;
constexpr int MC_HP = 66;
__device__ __forceinline__ void ph_mlstm_c(const P& p, int l, LAS unsigned char* lds, int wg, int G) {
    const int tid = opaque_tid(), lane = tid & 63, wave = __builtin_amdgcn_readfirstlane(tid >> 6), r = lane & 31, h = lane >> 5;
    const bf16* proj = (const bf16*)(p.ws + WS_PROJ); const bf16* qkt = (const bf16*)(p.ws + WS_QKT); const float* gates = (const float*)(p.ws + WS_GATES); bf16* mixcat = (bf16*)(p.ws + WS_MIXCAT);
    const bf16* DC = (const bf16*)(p.ws + WS_DC); const float* DN = (const float*)(p.ws + WS_DN); const float* DS = (const float*)(p.ws + WS_DS);
    LAS float* nvecS = (LAS float*)(lds + MC_N); LAS float* vfs = (LAS float*)(lds + MC_VEC); LAS float* vM = vfs + 256; LAS float* vb = vfs + 512;
    LAS float* coefS = (LAS float*)(lds + MC_COEF); LAS float* mS = (LAS float*)(lds + MC_MS);
    LAS unsigned short* hbuf = (LAS unsigned short*)lds;
    for (int ui = 0, u4; (u4 = unit_of(wg, G, ui, 256)) < 256; ++ui) {
        const int b = u4 >> 4, head = (u4 >> 2) & 3, c0 = (u4 & 3) * 4, ubase = (b * 4 + head) * 16;
        u32x4 dcr[18]; float dnr[18];
        { const f32x2c dsv = *(const f32x2c*)(DS + (size_t)((ubase + (lane & 15)) * 2 + (wave & 1)) * 2);
#pragma unroll
          for (int i = 0; i < 18; ++i) { const int dj = i >= c0 + 3 ? 1 : 0, j = dj ? i - 2 : i;
              dcr[i] = *(const u32x4*)(DC + (size_t)((ubase + j) * 2 + dj) * 4096 + tid * 8);
              dnr[i] = DN[(size_t)((ubase + j) * 2 + dj) * 64 + lane]; }
          const int dir = wave & 1, chunk = c0 + (wave >> 1), n = dir == 0 ? chunk : 15 - chunk;
          const bool in16 = lane < 16, valid = in16 && (dir == 0 ? lane < chunk : lane > chunk);
          const float bLv = in16 ? dsv[0] : 0.f, mlv = dsv[1];
          const float Pf = wave_scan_sum(bLv);
          const float Pc1 = __shfl(Pf, chunk > 0 ? chunk - 1 : 0), Pc = __shfl(Pf, chunk), P15 = __shfl(Pf, 15);
          const float Si = dir == 0 ? Pc1 - Pf : (Pf - bLv) - Pc, Sall = dir == 0 ? Pc1 : P15 - Pc;
          const float cand = valid ? mlv + Si : -3.0e38f;
          const float m = n > 0 ? fmaxf(Sall, wave_max(cand)) : 0.f;
          if (in16) coefS[wave * 16 + lane] = valid ? __expf(cand - m) : 0.f;
          if (lane == 0) mS[wave] = m; }
        __syncthreads();
        { float acc[4][8], accn[4];
#pragma unroll
          for (int k = 0; k < 4; ++k) { accn[k] = 0.f;
#pragma unroll
              for (int e = 0; e < 8; ++e) acc[k][e] = 0.f; }
#pragma unroll
          for (int i = 0; i < 18; ++i) { const int dj = i >= c0 + 3 ? 1 : 0, j = dj ? i - 2 : i;
              float x[8];
#pragma unroll
              for (int q = 0; q < 4; ++q) { x[2 * q] = bflo(dcr[i][q]); x[2 * q + 1] = bfhi(dcr[i][q]); }
#pragma unroll
              for (int k = 0; k < 4; ++k) { const float cf = coefS[(k * 2 + dj) * 16 + j]; accn[k] += cf * dnr[i];
#pragma unroll
                  for (int e = 0; e < 8; ++e) acc[k][e] += cf * x[e]; }
              if (i == 17 || ((i == 2 || i == 6 || i == 10 || i == 14) && i == c0 + 2)) { const int dd = i == 17 ? 1 : 0;
#pragma unroll
                  for (int k = 0; k < 4; ++k) { u32x4 o;
#pragma unroll
                      for (int q = 0; q < 4; ++q) o[q] = pk2(acc[k][2 * q], acc[k][2 * q + 1]);
                      *(LAS u32x4*)(lds + MC_C + ((k * 2 + dd) * 64 + (tid >> 3)) * MC_PITCH + (tid & 7) * 16) = o;
                      if (tid < 64) nvecS[(k * 2 + dd) * 64 + tid] = accn[k];
                      accn[k] = 0.f;
#pragma unroll
                      for (int e = 0; e < 8; ++e) acc[k][e] = 0.f; } } } }
#pragma unroll 1
        for (int kc = 0; kc < 4; ++kc) { const int chunk = c0 + kc; const size_t m0 = (size_t)b * SEQ + chunk * 128;
        const GateRaw graw = gate_loads(gates, m0, head, wave & 1, lane);
        u32x4 stg[6];
#pragma unroll
        for (int i = 0; i < 6; ++i) { const int id = i * 512 + tid, arr = id >> 10, rem = id & 1023, row = rem >> 3, chn = rem & 7;
            const bf16* src = arr == 2 ? proj + (m0 + row) * PN + C_MV + head * 64 + chn * 8 : qkt + (m0 + row) * 512 + arr * 256 + head * 64 + chn * 8;
            stg[i] = *(const u32x4*)src; }
        u32x4 mopre[2];
#pragma unroll
        for (int i = 0; i < 2; ++i) { const int id = i * 512 + tid; mopre[i] = *(const u32x4*)(proj + (m0 + (id >> 3)) * PN + C_MO + head * 64 + (id & 7) * 8); }
        if (wave < 2) { const int dir = wave; const GateVec gv = gate_vectors(graw, dir, lane);
            vfs[dir * 128 + gv.ta] = gv.fs0; vfs[dir * 128 + gv.tb] = gv.fs1;
            vM[dir * 128 + gv.ta] = gv.pm0; vM[dir * 128 + gv.tb] = gv.pm1;
            vb[dir * 128 + gv.ta] = gv.b0; vb[dir * 128 + gv.tb] = gv.b1; }
#pragma unroll
        for (int i = 0; i < 6; ++i) { const int id = i * 512 + tid, arr = id >> 10, rem = id & 1023, row = rem >> 3, chn = rem & 7;
            *(LAS u32x4*)(lds + arr * 128 * MC_PITCH + row * MC_PITCH + chn * 16) = stg[i]; }
        __syncthreads();
        const int dir = wave >> 2, tt = wave & 3, t = tt * 32 + r;
        const LAS unsigned char* Cs = lds + MC_C + (kc * 2 + dir) * 64 * MC_PITCH; const LAS float* nvec = nvecS + (kc * 2 + dir) * 64; const float mC = mS[kc * 2 + dir];
        f32x16 nS0, nS1, nI0, nI1; for (int i = 0; i < 16; ++i) { nS0[i] = 0.f; nS1[i] = 0.f; nI0[i] = 0.f; nI1[i] = 0.f; }
        float dinv, iw;
        {
            bf16x8 qf[4];
#pragma unroll
            for (int s = 0; s < 4; ++s) qf[s] = *(const LAS bf16x8*)(lds + MC_Q + t * MC_PITCH + (s * 16 + 8 * h) * 2);
            const float Mt = fmaxf(mC, vM[dir * 128 + t]); float rowsum = 0.f;
#pragma unroll 1
            for (int st = 0; st < 4; ++st) { if (dir == 0 ? st > tt : st < tt) continue;
                f32x16 sT; for (int i = 0; i < 16; ++i) sT[i] = 0.f;
#pragma unroll
                for (int s = 0; s < 4; ++s) { const bf16x8 kf = *(const LAS bf16x8*)(lds + MC_K + (st * 32 + r) * MC_PITCH + (s * 16 + 8 * h) * 2); sT = MFMA32(kf, qf[s], sT); }
                float pv[16];
#pragma unroll
                for (int rg = 0; rg < 4; ++rg) { const f32x4 f4 = *(const LAS f32x4*)(vfs + dir * 128 + st * 32 + 8 * rg + 4 * h);
#pragma unroll
                    for (int k = 0; k < 4; ++k) { const int si = st * 32 + 8 * rg + 4 * h + k; const bool ok = dir == 0 ? si <= t : si >= t;
                        const float dv = ok ? __expf(f4[k] - Mt) : 0.f; pv[4 * rg + k] = sT[4 * rg + k] * dv; rowsum += pv[4 * rg + k]; } }
                const bf16x8 pf0 = pack8(pv[0], pv[1], pv[2], pv[3], pv[4], pv[5], pv[6], pv[7]), pf1 = pack8(pv[8], pv[9], pv[10], pv[11], pv[12], pv[13], pv[14], pv[15]);
                const int G4 = lane >> 4, i16 = lane & 15, q4 = i16 >> 2, p4 = i16 & 3;
                const LAS unsigned char* vbp = lds + MC_V + (st * 32 + 4 * (G4 >> 1) + q4) * MC_PITCH + (16 * (G4 & 1) + 4 * p4) * 2;
#pragma unroll
                for (int s = 0; s < 2; ++s) { const bf16x8 pf = s ? pf1 : pf0;
                    const bf16x8 va0 = cat8(tr_read(vbp + (16 * s) * MC_PITCH), tr_read(vbp + (16 * s + 8) * MC_PITCH));
                    const bf16x8 va1 = cat8(tr_read(vbp + (16 * s) * MC_PITCH + 64), tr_read(vbp + (16 * s + 8) * MC_PITCH + 64));
                    nS0 = MFMA32(va0, pf, nS0); nS1 = MFMA32(va1, pf, nS1); }
            }
            float nq = 0.f;
#pragma unroll
            for (int s = 0; s < 4; ++s) { const bf16x8 cc0 = *(const LAS bf16x8*)(Cs + r * MC_PITCH + (s * 16 + 8 * h) * 2), cc1 = *(const LAS bf16x8*)(Cs + (32 + r) * MC_PITCH + (s * 16 + 8 * h) * 2);
                nI0 = MFMA32(cc0, qf[s], nI0); nI1 = MFMA32(cc1, qf[s], nI1);
#pragma unroll
                for (int j = 0; j < 8; ++j) nq += nvec[s * 16 + 8 * h + j] * bf2f((unsigned short)qf[s][j]); }
            nq += __shfl_xor(nq, 32); rowsum += __shfl_xor(rowsum, 32);
            iw = __expf(mC - Mt);
            const float den = rowsum + iw * nq, lower = __expf(-(vb[dir * 128 + t] + Mt));
            dinv = 1.0f / fmaxf(fabsf(den), lower);
        }
        __syncthreads();
#pragma unroll
        for (int reg = 0; reg < 16; ++reg) { const int e = crow(reg, h);
            hbuf[(dir * 128 + t) * MC_HP + e] = f2bf((nS0[reg] + iw * nI0[reg]) * dinv); hbuf[(dir * 128 + t) * MC_HP + 32 + e] = f2bf((nS1[reg] + iw * nI1[reg]) * dinv); }
        __syncthreads();
#pragma unroll
        for (int i = 0; i < 2; ++i) { const int id = i * 512 + tid, tq = id >> 3, e0 = (id & 7) * 8; float o[8];
#pragma unroll
            for (int k = 0; k < 4; ++k) { const unsigned wf = *(const LAS unsigned*)(hbuf + tq * MC_HP + e0 + 2 * k), wb = *(const LAS unsigned*)(hbuf + (128 + tq) * MC_HP + e0 + 2 * k);
                o[2 * k] = sigmoid_f(bflo(mopre[i][k])) * (bflo(wf) + bflo(wb)); o[2 * k + 1] = sigmoid_f(bfhi(mopre[i][k])) * (bfhi(wf) + bfhi(wb)); }
            u32x4 w; w.x = pk2(o[0], o[1]); w.y = pk2(o[2], o[3]); w.z = pk2(o[4], o[5]); w.w = pk2(o[6], o[7]);
            *(u32x4*)(mixcat + (m0 + tq) * DM + 512 + head * 64 + e0) = w; }
        __syncthreads();
        }
    }
}

typedef GAS unsigned gu32;
#define RLX_AGENT __ATOMIC_RELAXED, __HIP_MEMORY_SCOPE_AGENT
#define XB_TMO      128
#define XB_XCNT(j)  (256  + 64 * (j))
#define XB_XSUB(j)  (1280 + 64 * (j))
#define XB_XGEN(j)  (2304 + 64 * (j))
#define XB_TOP      3328
#define XB_TOPGEN   3392
#define XCD_BAR_WORDS 3456
#define XB_SPIN_CAP (1u << 18)

__device__ __forceinline__ unsigned xb_ld(unsigned* p)              { return __hip_atomic_load(p, __ATOMIC_RELAXED, __HIP_MEMORY_SCOPE_AGENT); }
__device__ __forceinline__ unsigned xb_add(unsigned* p, unsigned v) { return __hip_atomic_fetch_add(p, v, __ATOMIC_RELAXED, __HIP_MEMORY_SCOPE_AGENT); }
__device__ __forceinline__ unsigned xb_xcc_id() { return (unsigned)__builtin_amdgcn_s_getreg((3 << 11) | 20) & 0xFu; }
#define XB_SPIN(cond, bar) do { unsigned _sp = 0; while (cond) { __builtin_amdgcn_s_sleep(1); \
    if ((++_sp & 255u) == 0u) { if (xb_ld(&(bar)[XB_TMO])) break; if (_sp > XB_SPIN_CAP) { atomicAdd(&(bar)[XB_TMO], 1u); break; } } } } while (0)

struct XcdBarrier {
    unsigned* bar; unsigned x;
    volatile LAS unsigned* st;
};

__device__ __forceinline__ XcdBarrier xcd_barrier_post(unsigned* bar, volatile LAS unsigned* st) {
    XcdBarrier b; b.bar = bar; b.x = xb_xcc_id(); b.st = st;
    if (threadIdx.x == 0) (void)xb_add(&bar[XB_XCNT(b.x)], 1u);
    return b;
}
__device__ __forceinline__ void xcd_barrier_complete(unsigned* bar, unsigned x, unsigned& nloc, unsigned& nx) {
    const unsigned G = gridDim.x * gridDim.y * gridDim.z;
    unsigned sum, cnt, mine, sp = 0u;
    for (;;) {
        sum = 0u; cnt = 0u; mine = 0u;
#pragma unroll
        for (unsigned j = 0; j < 16; ++j) { const unsigned c = xb_ld(&bar[XB_XCNT(j)]); sum += c; cnt += (c > 0u) ? 1u : 0u; mine = (j == x) ? c : mine; }
        if (sum == G) break;
        __builtin_amdgcn_s_sleep(1);
        if ((++sp & 255u) == 0u) { if (xb_ld(&bar[XB_TMO])) break; if (sp > XB_SPIN_CAP) { atomicAdd(&bar[XB_TMO], 1u); break; } }
    }
    nloc = mine > 0u ? mine : 1u; nx = cnt > 0u ? cnt : 1u;
}

__device__ __forceinline__ void xcd_barrier(const XcdBarrier& b) {
    asm volatile("s_waitcnt vmcnt(0)" ::: "memory");
    __syncthreads();
    if (threadIdx.x == 0) {
        unsigned* bar = b.bar;
        __builtin_amdgcn_s_waitcnt(0);
        unsigned nloc = b.st[0], nx = b.st[1];
        if (nloc == 0u) { xcd_barrier_complete(bar, b.x, nloc, nx); b.st[0] = nloc; b.st[1] = nx; }
        const unsigned old = xb_add(&bar[XB_XSUB(b.x)], 1u);
        const unsigned gen = old / nloc;
        if (old + 1u == (gen + 1u) * nloc) {
            __builtin_amdgcn_fence(__ATOMIC_RELEASE, "agent");
            asm volatile("s_waitcnt vmcnt(0)" ::: "memory");
            const unsigned og = xb_add(&bar[XB_TOP], 1u);
            const unsigned tg = og / nx;
            if (og + 1u == (tg + 1u) * nx) xb_add(&bar[XB_TOPGEN], 1u);
            else XB_SPIN(xb_ld(&bar[XB_TOPGEN]) == tg, bar);
            __builtin_amdgcn_fence(__ATOMIC_ACQUIRE, "agent");
            xb_add(&bar[XB_XGEN(b.x)], 1u);
            asm volatile("s_waitcnt vmcnt(0)" ::: "memory");
        } else {
            XB_SPIN(xb_ld(&bar[XB_XGEN(b.x)]) == gen, bar);
            __builtin_amdgcn_fence(__ATOMIC_ACQUIRE, "agent");
            asm volatile("s_waitcnt vmcnt(0)" ::: "memory");
        }
    }
    __syncthreads();
}


constexpr int CW_Q = 8192;
__device__ __forceinline__ bool conv_batch(const P& p, int ql, volatile LAS unsigned* wl, LAS unsigned char* L) {
    const int tid = opaque_tid(), lane = tid & 63, wave = __builtin_amdgcn_readfirstlane(tid >> 6);
    if (tid == 0) wl[3] = __hip_atomic_fetch_add((unsigned*)(p.ws + WS_CTL) + CW_Q + 64 * ql, 8u, __ATOMIC_RELAXED, __HIP_MEMORY_SCOPE_AGENT);
    __syncthreads();
    const unsigned base = wl[3];
    if (base + wave < (unsigned)ITM) convert_item(p, ql, ITS + (int)base + wave, (LAS float*)L + wave * (64 * 33), lane);
    __syncthreads();
    return base + 8u < (unsigned)ITM;
}
__device__ __forceinline__ void conv_drain(const P& p, int& qa, int upto, volatile LAS unsigned* wl, LAS unsigned char* L) { while (qa <= upto) { if (!conv_batch(p, qa, wl, L)) ++qa; } }
__device__ __forceinline__ void xcd_barrier_work(const XcdBarrier& b, const P& p, int& qa, volatile LAS unsigned* wl, LAS unsigned char* L) {
    asm volatile("s_waitcnt vmcnt(0)" ::: "memory");
    __syncthreads();
    if (threadIdx.x == 0) {
        unsigned* bar = b.bar;
        __builtin_amdgcn_s_waitcnt(0);
        unsigned nloc = b.st[0], nx = b.st[1];
        if (nloc == 0u) { xcd_barrier_complete(bar, b.x, nloc, nx); b.st[0] = nloc; b.st[1] = nx; }
        const unsigned old = xb_add(&bar[XB_XSUB(b.x)], 1u);
        const unsigned gen = old / nloc;
        if (old + 1u == (gen + 1u) * nloc) {
            __builtin_amdgcn_fence(__ATOMIC_RELEASE, "agent");
            asm volatile("s_waitcnt vmcnt(0)" ::: "memory");
            const unsigned og = xb_add(&bar[XB_TOP], 1u);
            const unsigned tg = og / nx;
            if (og + 1u == (tg + 1u) * nx) { xb_add(&bar[XB_TOPGEN], 1u); wl[0] = 2u; }
            else { wl[0] = 1u; wl[1] = tg; }
        } else { wl[0] = 0u; wl[1] = gen; }
    }
    unsigned polls = 0u;
    for (;;) {
        if (threadIdx.x == 0) { unsigned* bar = b.bar; const unsigned role = wl[0], want = wl[1];
            bool done = role == 2u || (role == 1u ? xb_ld(&bar[XB_TOPGEN]) != want : xb_ld(&bar[XB_XGEN(b.x)]) != want);
            if (!done && (++polls & 255u) == 0u) { if (xb_ld(&bar[XB_TMO])) done = true; else if (polls > XB_SPIN_CAP) { atomicAdd(&bar[XB_TMO], 1u); done = true; } }
            wl[2] = done ? 1u : 0u; }
        __syncthreads();
        const bool done = wl[2] != 0u;
        __syncthreads();
        if (done) break;
        if (qa < DEPTH) { if (!conv_batch(p, qa, wl, L)) ++qa; } else __builtin_amdgcn_s_sleep(2);
    }
    if (threadIdx.x == 0) { unsigned* bar = b.bar;
        if (wl[0] != 0u) { __builtin_amdgcn_fence(__ATOMIC_ACQUIRE, "agent"); xb_add(&bar[XB_XGEN(b.x)], 1u); asm volatile("s_waitcnt vmcnt(0)" ::: "memory"); }
        else { __builtin_amdgcn_fence(__ATOMIC_ACQUIRE, "agent"); asm volatile("s_waitcnt vmcnt(0)" ::: "memory"); }
    }
    __syncthreads();
}

__device__ __forceinline__ void ph_mod(const P& p, LAS unsigned char* lds, int wg, int G) {
    const int tid = opaque_tid(), lane = tid & 63, wave = __builtin_amdgcn_readfirstlane(tid >> 6);
    LAS float* sc = (LAS float*)lds;
    LAS float* red = (LAS float*)(lds + 65536);
    if (wg >= 384) return;
    for (int i = tid; i < 16 * DM; i += 512) { const int b = i >> 10, k = i & 1023; sc[k * 16 + b] = silu_acc(p.c[i]); }
    __syncthreads();
    float* mod = (float*)(p.ws + WS_MOD);
    for (int u = wg; u < 384; u += G) { const int l = u / 96, n0 = (u % 96) * 64;
        const float* w = p.w_ada + (size_t)l * DM * 6144 + (size_t)(wave * 128) * 6144 + n0 + lane;
        float acc[16];
#pragma unroll
        for (int b = 0; b < 16; ++b) acc[b] = 0.f;
#pragma unroll 4
        for (int k = 0; k < 128; ++k) { const float wv = w[(size_t)k * 6144]; const LAS f32x4* s4 = (const LAS f32x4*)(sc + (wave * 128 + k) * 16);
#pragma unroll
            for (int q = 0; q < 4; ++q) { const f32x4 s = s4[q]; acc[4 * q] += s[0] * wv; acc[4 * q + 1] += s[1] * wv; acc[4 * q + 2] += s[2] * wv; acc[4 * q + 3] += s[3] * wv; } }
#pragma unroll
        for (int b = 0; b < 16; ++b) red[(wave * 16 + b) * 64 + lane] = acc[b];
        __syncthreads();
        for (int i = tid; i < 1024; i += 512) { const int b = i >> 6, c = i & 63; float s = p.b_ada[l * 6144 + n0 + c];
#pragma unroll
            for (int wv = 0; wv < 8; ++wv) s += red[(wv * 16 + b) * 64 + c];
            mod[((size_t)l * 16 + b) * 6144 + n0 + c] = s; }
        __syncthreads();
    }
}

constexpr int LDS_MAIN = 131072, LDS_TOTAL = 147456, MISC_OFF = LDS_MAIN + 320;
constexpr int CW_BAR = 4096;
constexpr size_t CTL_ZERO = 65536;
constexpr int NSEQ = 2 + 9 * DEPTH;
struct Args { P p; int lo, hi; };
typedef const __attribute__((address_space(4))) Args* kargs_t;
__global__ void __launch_bounds__(512, 2) mk_fwd(Args a) {
    extern __shared__ __attribute__((aligned(16))) unsigned char lds_raw[];
    LAS unsigned char* L = (LAS unsigned char*)lds_raw;
    kargs_t ap0 = (kargs_t)__builtin_amdgcn_kernarg_segment_ptr();
#define LOADP() kargs_t ap_ = ap0; asm volatile("" : "+s"(ap_)); const P p = {ap_->p.x, ap_->p.c, ap_->p.w_ada, ap_->p.b_ada, ap_->p.w_in, ap_->p.conv_w, ap_->p.conv_b, ap_->p.gate_b, ap_->p.sink, ap_->p.rel_bias, ap_->p.w_s, ap_->p.b_s, ap_->p.w_out, ap_->p.w_router, ap_->p.w_gate, ap_->p.w_up, ap_->p.w_down, ap_->p.ln_g, ap_->p.ln_b, ap_->p.out, ap_->p.ws}; unsigned char* ws = p.ws
    const int wg = blockIdx.x, G = gridDim.x;
    { const int tid = opaque_tid(); for (int i = tid; i < (LDS_TOTAL - LDS_MAIN) / 4; i += 512) ((LAS unsigned*)(L + LDS_MAIN))[i] = 0u; }
    __syncthreads();
    XcdBarrier bar;
    { LOADP(); bar = xcd_barrier_post((unsigned*)(ws + WS_CTL) + CW_BAR, (volatile LAS unsigned*)(L + MISC_OFF) + 8); }
    int seq = 0; int qa = 0;
#ifndef DUPM
#define DUPM 0
#endif
#define DUP(i) for (int rep_ = 0; rep_ < ((DUPM >> (i)) & 1); ++rep_)
#ifndef PHM
#define PHM 0xfffff
#endif
#define RUN() (seq >= a.lo && seq < a.hi)
#define SEAM() do { if (seq + 1 < a.hi) xcd_barrier_work(bar, p, qa, (volatile LAS unsigned*)(L + MISC_OFF) + 16, L); } while (0)
    if (((PHM >> 0) & 1) && RUN()) {
        LOADP(); ph_mod(p, L, wg, G);
        const int tid = opaque_tid(), lane = tid & 63, wave = __builtin_amdgcn_readfirstlane(tid >> 6), gw = wg * 8 + wave, ngw = G * 8;
        { LAS float* scr = (LAS float*)L + wave * (64 * 33); for (int it = gw; it < DEPTH * ITS; it += ngw) convert_item(p, it / ITS, it % ITS, scr, lane); }
        { bf16* wsb = (bf16*)(ws + WS_WS); for (int i = wg * 512 + tid; i < DEPTH * 4 * 128 * 128; i += G * 512) wsb[i] = (bf16)f2bf(p.w_s[i]); }
        SEAM(); }
    ++seq;
    if (((PHM >> 1) & 1) && RUN()) { LOADP(); rows_entry_simple(p, wg, G); SEAM(); }
    ++seq;
#pragma unroll 1
    for (int l = 0; l < DEPTH; ++l) {
        if (((PHM >> 2) & 1) && RUN()) { LOADP();
            pg8::Gemm g{(const bf16*)(ws + WS_H), (const bf16*)(ws + WS_WIN) + (size_t)l * PNW * DM, NTOK, PNW, DM}; pg8::EpiProj E{(bf16*)(ws + WS_PROJ), (float*)(ws + WS_GATES), p.gate_b + l * 16};
            pg8::StaticOrder S; S.init(NTOK, PNW, G, wg);
            pg8::gemm_phase<pg8::EpiProj, pg8::StaticOrder, true, true>(L, g, S, E); SEAM(); }
        ++seq;
        if (((PHM >> 3) & 1) && RUN()) { LOADP(); DUP(2) ph_attn(p, l, L, wg, G); ph_attn(p, l, L, wg, G); DUP(3) ph_gmlp(p, l, L, wg, G); ph_gmlp(p, l, L, wg, G); DUP(4) ph_mlstm_a(p, l, L, wg, G); ph_mlstm_a(p, l, L, wg, G); SEAM(); }
        ++seq;
        if (((PHM >> 4) & 1) && RUN()) { LOADP(); DUP(5) ph_mlstm_c(p, l, L, wg, G); ph_mlstm_c(p, l, L, wg, G); SEAM(); }
        ++seq;
        if (((PHM >> 5) & 1) && RUN()) { LOADP();
            pg8::Gemm g{(const bf16*)(ws + WS_MIXCAT), (const bf16*)(ws + WS_WOUT) + (size_t)l * DM * DM, NTOK, DM, DM}; pg8::EpiBf16 E{(bf16*)(ws + WS_MIX), DM};
            pg8::StaticOrder S; S.init(NTOK, DM, G, wg);
            pg8::gemm_phase<pg8::EpiBf16, pg8::StaticOrder, true, true>(L, g, S, E); SEAM(); }
        ++seq;
        if (((PHM >> 6) & 1) && RUN()) { LOADP(); DUP(9) rows_phase<1>(p, l, l == 0 ? p.x : (const float*)(ws + WS_XA), L, wg, G, true); rows_phase<1>(p, l, l == 0 ? p.x : (const float*)(ws + WS_XA), L, wg, G); SEAM(); }
        ++seq;
        if (((PHM >> 7) & 1) && RUN()) { LOADP(); ph_topk(p, L, wg, G); conv_drain(p, qa, l, (volatile LAS unsigned*)(L + MISC_OFF) + 16, L); SEAM(); }
        ++seq;
        if (((PHM >> 8) & 1) && RUN()) { LOADP();
            pg8::Gemm g{(const bf16*)(ws + WS_H8), (const bf16*)(ws + WS_WGU + (size_t)l * NE * 4096 * DM), NGRP * 256, 4096, DM, SC_A1, SC_B1}; pg8::EpiSwiGLU8 E{ws + WS_HID};
            pg8::MoeOrder1 S; S.G = G; S.c = wg; S.idx = (const unsigned short*)(ws + WS_IDX);
            pg8::gemm_phase<pg8::EpiSwiGLU8, pg8::MoeOrder1, true, true, true, true>(L, g, S, E); SEAM(); }
        ++seq;
        if (((PHM >> 9) & 1) && RUN()) { LOADP();
            pg8::Gemm g{(const bf16*)(ws + WS_HID), (const bf16*)(ws + WS_WD + (size_t)l * NE * DM * DE), NGRP * 256, DM, DE, SC_A2, SC_B2}; pg8::EpiScaleFp8 E{ws + WS_YE, (const float*)(ws + WS_GATEV)};
            pg8::MoeOrder2 S; S.G = G; S.c = wg;
            pg8::gemm_phase<pg8::EpiScaleFp8, pg8::MoeOrder2, true, true, true>(L, g, S, E); SEAM(); }
        ++seq;
        if (((PHM >> 10) & 1) && RUN()) { LOADP(); DUP(10) rows_phase<2>(p, l, (const float*)(ws + WS_XA), L, wg, G, true); rows_phase<2>(p, l, (const float*)(ws + WS_XA), L, wg, G); SEAM(); }
        ++seq;
    }
#undef RUN
#undef SEAM
#undef LOADP
}

#ifndef MK_PER_PHASE
#define MK_PER_PHASE 0
#endif
extern "C" void kernel_launch(void* const* d_in, const int* in_sizes, int n_in, void* d_out, int out_size, void* d_ws, size_t ws_size, hipStream_t stream) {
    static int grid = 0;
    if (grid == 0) {
        if (n_in != 19 || in_sizes[0] != NTOK * DM || out_size != NTOK * DM || ws_size < WS_END) {
            fprintf(stderr, "kernel_launch: unexpected shapes: n_in %d in0 %d out %d ws %zu (need %zu)\n", n_in, n_in > 0 ? in_sizes[0] : -1, out_size, ws_size, (size_t)WS_END); grid = -1; return; }
        int dev = 0, cus = 0, per_cu = 0;
        if (hipGetDevice(&dev) != hipSuccess || hipDeviceGetAttribute(&cus, hipDeviceAttributeMultiprocessorCount, dev) != hipSuccess) { fprintf(stderr, "kernel_launch: device query failed\n"); grid = -1; return; }
        if (hipFuncSetAttribute((const void*)mk_fwd, hipFuncAttributeMaxDynamicSharedMemorySize, LDS_TOTAL) != hipSuccess) { fprintf(stderr, "kernel_launch: hipFuncSetAttribute failed\n"); grid = -1; return; }
        if (hipOccupancyMaxActiveBlocksPerMultiprocessor(&per_cu, (const void*)mk_fwd, 512, LDS_TOTAL) != hipSuccess || per_cu < 1) { fprintf(stderr, "kernel_launch: occupancy query reports %d blocks per CU\n", per_cu); }
        (void)hipGetLastError();
        grid = cus;
    }
    if (grid < 0) return;
    if (hipMemsetAsync((char*)d_ws + WS_CTL, 0, CTL_ZERO, stream) != hipSuccess) { fprintf(stderr, "kernel_launch: memset failed\n"); return; }
    Args a{};
    const float** pf = (const float**)&a.p;
    for (int i = 0; i < 19; ++i) pf[i] = (const float*)d_in[i];
    a.p.out = (float*)d_out; a.p.ws = (unsigned char*)d_ws;
#if MK_PER_PHASE
    for (int s = 0; s < NSEQ; ++s) { a.lo = s; a.hi = s + 1; hipLaunchKernelGGL(mk_fwd, dim3(grid), dim3(512), LDS_TOTAL, stream, a); }
#else
    a.lo = 0; a.hi = NSEQ;
    hipLaunchKernelGGL(mk_fwd, dim3(grid), dim3(512), LDS_TOTAL, stream, a);
#endif
    const hipError_t le = hipPeekAtLastError();
    if (le != hipSuccess) fprintf(stderr, "kernel_launch: launch failed: %s\n", hipGetErrorName(le));
}
```

```cpp
#include <hip/hip_runtime.h>
#include <cstdio>
#include <cstdint>
__device__ __forceinline__ int opaque_tid() { int t = threadIdx.x; asm volatile("" : "+v"(t)); return t; }
namespace pg8 {
#define PG8_LAS __attribute__((address_space(3)))
typedef unsigned short bf16_t;
typedef short bf16x8 __attribute__((ext_vector_type(8)));
typedef float f32x4 __attribute__((ext_vector_type(4)));
typedef unsigned u32x4 __attribute__((ext_vector_type(4)));
constexpr int BM = 256, BK = 64, HALF = 128, HTB = HALF * BK * 2  , STAGE_BYTES = 8 * HTB, NXCD = 8, WGM = 8;

__host__ __device__ __forceinline__ int lds_byte(int r, int c) { const int st = (r >> 4) * 2 + (c >> 5), rr = r & 15, cc = c & 31, ob = rr * 64 + cc * 2; return st * 1024 + (ob ^ (((ob >> 9) & 1) << 5)); }
__host__ __device__ __forceinline__ void stage_rc(int b, int& R, int& C) { const int st = b / 1024, sb = b % 1024, swz = sb ^ (((sb >> 9) & 1) << 5); R = (st >> 1) * 16 + swz / 64; C = (st & 1) * 32 + (swz % 64) / 2; }
__host__ __device__ __forceinline__ int perm32(int rho) { const int n = rho >> 4, i = rho & 15; return 8 * (i >> 2) + 4 * n + (i & 3); }

struct Unit { int pm, pn; };
struct Gemm { const bf16_t* A; const bf16_t* Bt; int M, N, K; int sa, sb; };
typedef int v4i_t __attribute__((ext_vector_type(4)));
typedef int v8i_t __attribute__((ext_vector_type(8)));
__device__ __forceinline__ v8i_t cat32(bf16x8 lo, bf16x8 hi) { const v4i_t a = __builtin_bit_cast(v4i_t, lo), b = __builtin_bit_cast(v4i_t, hi); return __builtin_shufflevector(a, b, 0, 1, 2, 3, 4, 5, 6, 7); }

struct StaticOrder {
    int nM, nN, nwg, G, c;
    __host__ __device__ void init(int M, int N, int G_, int c_) { nM = M / BM; nN = N / BM; nwg = nM * nN; G = G_; c = c_; }
    __host__ __device__ bool next(int i, Unit& u) const {
        const long L = (long)i * G + c; if (L >= nwg) return false;
        int wgid = (int)L; { const int q = nwg / NXCD, r = nwg % NXCD, xcd = wgid % NXCD, off = wgid / NXCD; wgid = (xcd < r ? xcd * (q + 1) : r * (q + 1) + (xcd - r) * q) + off; }
        const int nig = WGM * nN, gid = wgid / nig, fm = gid * WGM, gsz = (nM - fm) < WGM ? (nM - fm) : WGM;
        u.pm = fm + ((wgid % nig) % gsz); u.pn = (wgid % nig) / gsz; return true;
    }
    __device__ __forceinline__ void a_ready(const Unit&) const {}
    __device__ __forceinline__ void done(const Unit&) const {}
    __device__ __forceinline__ unsigned a_rowoff_unused() const { return 0u; }
};

typedef float f32x2p __attribute__((ext_vector_type(2))); typedef __bf16 bf16x2p __attribute__((ext_vector_type(2)));
__device__ __forceinline__ unsigned cvt_pk_bf16(float lo, float hi) { const f32x2p v = {lo, hi}; return __builtin_bit_cast(unsigned, __builtin_convertvector(v, bf16x2p)); }
__device__ __forceinline__ float silu_f(float x) { return x * __builtin_amdgcn_rcpf(1.0f + __builtin_amdgcn_exp2f(x * -1.4426950408889634f)); }

struct EpiBf16 {
    static constexpr bool PERM = true, AFTER_DRAIN = false;
    bf16_t* O; int ldc;
    __device__ __forceinline__ void operator()(const f32x4 (&acc)[2][2][4][2], const Unit& u, int wr, int wc, int fr, int fq) const {
        const int row0 = u.pm * BM + wr * 64 + fr, col0 = u.pn * BM + wc * 32 + 8 * fq;
#pragma unroll
        for (int ai = 0; ai < 2; ++ai)
#pragma unroll
            for (int m = 0; m < 4; ++m) { bf16_t* rowp = O + (size_t)(row0 + ai * HALF + m * 16) * ldc + col0;
#pragma unroll
                for (int bj = 0; bj < 2; ++bj) { const f32x4 v0 = acc[ai][bj][m][0], v1 = acc[ai][bj][m][1];
                    u32x4 w; w.x = cvt_pk_bf16(v0[0], v0[1]); w.y = cvt_pk_bf16(v0[2], v0[3]); w.z = cvt_pk_bf16(v1[0], v1[1]); w.w = cvt_pk_bf16(v1[2], v1[3]);
                    *(u32x4*)(rowp + bj * HALF) = w; } }
    }
};
struct EpiProj {
    static constexpr bool PERM = true, AFTER_DRAIN = false;
    bf16_t* O; float* gates; const float* gate_b;
    __device__ __forceinline__ void operator()(const f32x4 (&acc)[2][2][4][2], const Unit& u, int wr, int wc, int fr, int fq) const {
        const int row0 = u.pm * BM + wr * 64 + fr;
        if (u.pn < 9) { const int col0 = u.pn * BM + wc * 32 + 8 * fq;
#pragma unroll
            for (int ai = 0; ai < 2; ++ai)
#pragma unroll
                for (int m = 0; m < 4; ++m) { bf16_t* rowp = O + (size_t)(row0 + ai * HALF + m * 16) * 2304 + col0;
#pragma unroll
                    for (int bj = 0; bj < 2; ++bj) { const f32x4 v0 = acc[ai][bj][m][0], v1 = acc[ai][bj][m][1];
                        u32x4 w; w.x = cvt_pk_bf16(v0[0], v0[1]); w.y = cvt_pk_bf16(v0[2], v0[3]); w.z = cvt_pk_bf16(v1[0], v1[1]); w.w = cvt_pk_bf16(v1[2], v1[3]);
                        *(u32x4*)(rowp + bj * HALF) = w; } }
        } else if (wc == 0 && fq < 2) { const f32x4 g0 = *(const f32x4*)(gate_b + 8 * fq), g1 = *(const f32x4*)(gate_b + 8 * fq + 4);
#pragma unroll
            for (int ai = 0; ai < 2; ++ai)
#pragma unroll
                for (int m = 0; m < 4; ++m) { float* gp = gates + (size_t)(row0 + ai * HALF + m * 16) * 16 + 8 * fq;
                    *(f32x4*)gp = acc[ai][0][m][0] + g0; *(f32x4*)(gp + 4) = acc[ai][0][m][1] + g1; } }
    }
};
struct EpiSwiGLU {
    static constexpr bool PERM = true, AFTER_DRAIN = false;
    bf16_t* H;
    __device__ __forceinline__ void operator()(const f32x4 (&acc)[2][2][4][2], const Unit& u, int wr, int wc, int fr, int fq) const {
        const int row0 = u.pm * BM + wr * 64 + fr, col0 = (u.pn & 15) * 128 + wc * 32 + 8 * fq;
#pragma unroll
        for (int ai = 0; ai < 2; ++ai)
#pragma unroll
            for (int m = 0; m < 4; ++m) { bf16_t* rowp = H + (size_t)(row0 + ai * HALF + m * 16) * 2048 + col0;
                const f32x4 g0 = acc[ai][0][m][0], g1 = acc[ai][0][m][1], u0 = acc[ai][1][m][0], u1 = acc[ai][1][m][1];
                u32x4 w; w.x = cvt_pk_bf16(silu_f(g0[0]) * u0[0], silu_f(g0[1]) * u0[1]); w.y = cvt_pk_bf16(silu_f(g0[2]) * u0[2], silu_f(g0[3]) * u0[3]);
                w.z = cvt_pk_bf16(silu_f(g1[0]) * u1[0], silu_f(g1[1]) * u1[1]); w.w = cvt_pk_bf16(silu_f(g1[2]) * u1[2], silu_f(g1[3]) * u1[3]);
                *(u32x4*)rowp = w; }
    }
};
__device__ __forceinline__ unsigned pk4_fp8(float a, float b, float c, float d) {
    a = __builtin_amdgcn_fmed3f(a, -448.f, 448.f); b = __builtin_amdgcn_fmed3f(b, -448.f, 448.f); c = __builtin_amdgcn_fmed3f(c, -448.f, 448.f); d = __builtin_amdgcn_fmed3f(d, -448.f, 448.f);
    int w = 0; w = __builtin_amdgcn_cvt_pk_fp8_f32(a, b, w, false); w = __builtin_amdgcn_cvt_pk_fp8_f32(c, d, w, true); return (unsigned)w; }
constexpr float HID_SCALE = 4.0f;
typedef unsigned u32x2e __attribute__((ext_vector_type(2)));
struct EpiSwiGLU8 {
    static constexpr bool PERM = true, AFTER_DRAIN = false;
    unsigned char* H;
    __device__ __forceinline__ void operator()(const f32x4 (&acc)[2][2][4][2], const Unit& u, int wr, int wc, int fr, int fq) const {
        const int row0 = u.pm * BM + wr * 64 + fr, col0 = (u.pn & 15) * 128 + wc * 32 + 8 * fq;
#pragma unroll
        for (int ai = 0; ai < 2; ++ai)
#pragma unroll
            for (int m = 0; m < 4; ++m) { unsigned char* rowp = H + (size_t)(row0 + ai * HALF + m * 16) * 2048 + col0;
                const f32x4 g0 = acc[ai][0][m][0], g1 = acc[ai][0][m][1], u0 = acc[ai][1][m][0], u1 = acc[ai][1][m][1];
                u32x2e w; w.x = pk4_fp8(silu_f(g0[0]) * u0[0] * HID_SCALE, silu_f(g0[1]) * u0[1] * HID_SCALE, silu_f(g0[2]) * u0[2] * HID_SCALE, silu_f(g0[3]) * u0[3] * HID_SCALE);
                w.y = pk4_fp8(silu_f(g1[0]) * u1[0] * HID_SCALE, silu_f(g1[1]) * u1[1] * HID_SCALE, silu_f(g1[2]) * u1[2] * HID_SCALE, silu_f(g1[3]) * u1[3] * HID_SCALE);
                *(u32x2e*)rowp = w; }
    }
};
struct EpiScaleBf16 {
    static constexpr bool PERM = true, AFTER_DRAIN = false;
    bf16_t* Y; const float* gate;
    __device__ __forceinline__ void operator()(const f32x4 (&acc)[2][2][4][2], const Unit& u, int wr, int wc, int fr, int fq) const {
        const int row0 = u.pm * BM + wr * 64 + fr, col0 = (u.pn & 3) * BM + wc * 32 + 8 * fq;
#pragma unroll
        for (int ai = 0; ai < 2; ++ai)
#pragma unroll
            for (int m = 0; m < 4; ++m) { const int r = row0 + ai * HALF + m * 16; const float gv = gate[r]; bf16_t* rowp = Y + (size_t)r * 1024 + col0;
#pragma unroll
                for (int bj = 0; bj < 2; ++bj) { const f32x4 v0 = acc[ai][bj][m][0] * gv, v1 = acc[ai][bj][m][1] * gv;
                    u32x4 w; w.x = cvt_pk_bf16(v0[0], v0[1]); w.y = cvt_pk_bf16(v0[2], v0[3]); w.z = cvt_pk_bf16(v1[0], v1[1]); w.w = cvt_pk_bf16(v1[2], v1[3]);
                    *(u32x4*)(rowp + bj * HALF) = w; } }
    }
};
constexpr float YE_SCALE = 256.0f;
struct EpiScaleFp8 {
    static constexpr bool PERM = true, AFTER_DRAIN = false;
    unsigned char* Y; const float* gate;
    __device__ __forceinline__ void operator()(const f32x4 (&acc)[2][2][4][2], const Unit& u, int wr, int wc, int fr, int fq) const {
        const int row0 = u.pm * BM + wr * 64 + fr, pcol = (u.pn & 3) * BM + 16 * (wc * 4 + fq);
#pragma unroll
        for (int ai = 0; ai < 2; ++ai)
#pragma unroll
            for (int m = 0; m < 4; ++m) { const int r = row0 + ai * HALF + m * 16; const float gv = gate[r] * YE_SCALE; u32x4 w;
#pragma unroll
                for (int bj = 0; bj < 2; ++bj) { const f32x4 v0 = acc[ai][bj][m][0] * gv, v1 = acc[ai][bj][m][1] * gv;
                    w[2 * bj] = pk4_fp8(v0[0], v0[1], v0[2], v0[3]); w[2 * bj + 1] = pk4_fp8(v1[0], v1[1], v1[2], v1[3]); }
                *(u32x4*)(Y + (size_t)r * 1024 + pcol) = w; }
    }
};
struct MoeOrder1 {
    int G, c; const unsigned short* idx;
    __device__ __forceinline__ int a_rowtok(const Unit& u, int r) const { return idx[((u.pm * 2 + (r >> 7)) * 64 + (r & 63)) * 2 + ((r >> 6) & 1)]; }
    __device__ __forceinline__ unsigned a_rowoff(const Unit& u, int r) const { return (unsigned)(((u.pm & 15) * 2048 + a_rowtok(u, r)) * 1024); }
    __device__ __forceinline__ unsigned a_rowpair(const Unit& u, int hh, int r0) const { return *(const unsigned*)(idx + ((u.pm * 2 + hh) * 64 + r0) * 2); }
    __device__ __forceinline__ unsigned a_rowoff_tok(const Unit& u, int tok) const { return (unsigned)(((u.pm & 15) * 2048 + tok) * 1024); }
    __device__ __forceinline__ bool next(int i, Unit& u) const {
        const long L = (long)i * G + c; if (L >= 4096) return false;
        const int e = (int)(L >> 8), rem = (int)(L & 255), x = rem & 7, v = rem >> 3;
        const int b = 4 * (x >> 1) + (v >> 3), j = 8 * (x & 1) + (v & 7);
        u.pm = e * 16 + b; u.pn = e * 16 + j; return true;
    }
    __device__ __forceinline__ void a_ready(const Unit&) const {}
    __device__ __forceinline__ void done(const Unit&) const {}
    __device__ __forceinline__ unsigned a_rowoff_unused() const { return 0u; }
};
struct MoeOrder2 {
    int G, c;
    __device__ __forceinline__ bool next(int i, Unit& u) const {
        const long L = (long)i * G + c; if (L >= 1024) return false;
        const int rnd = (int)(L >> 8), rem = (int)(L & 255), x = rem & 7, v = rem >> 3;
        const int e = rnd * 4 + (x >> 1), b = 8 * (x & 1) + (v >> 2), j = v & 3;
        u.pm = e * 16 + b; u.pn = e * 4 + j; return true;
    }
    __device__ __forceinline__ void a_ready(const Unit&) const {}
    __device__ __forceinline__ void done(const Unit&) const {}
    __device__ __forceinline__ unsigned a_rowoff_unused() const { return 0u; }
};

template <class Epi, class Sched, bool ALIGN_EPI = false, bool SP2 = false, bool F8 = false, bool GATH = false>
__device__ __forceinline__ void gemm_phase(PG8_LAS unsigned char* lds, const Gemm g, const Sched& S, const Epi& E) {
    const int tid = opaque_tid(), wid = __builtin_amdgcn_readfirstlane(tid >> 6), lane = tid & 63, wr = wid >> 2, wc = wid & 3, fr = lane & 15, fq = lane >> 4;
    const int K = g.K, RB = F8 ? K : 2 * K, nt = RB / 128;
    unsigned voffA[2], voffB[2];
#pragma unroll
    for (int i = 0; i < 2; ++i) { int R, C; stage_rc(tid * 16 + i * 8192, R, C); const int Rb = Epi::PERM ? ((R & ~31) + perm32(R & 31)) : R;
        voffA[i] = (unsigned)(R * RB + C * 2); voffB[i] = (unsigned)(Rb * RB + C * 2); }
    const __amdgpu_buffer_rsrc_t rsA = __builtin_amdgcn_make_buffer_rsrc((void*)g.A, 0, 0x7fffffff, 0x00020000), rsB = __builtin_amdgcn_make_buffer_rsrc((void*)g.Bt, 0, 0x7fffffff, 0x00020000);
    const size_t kstep = (size_t)(BK * 2);
    const size_t hstep = (size_t)HALF * RB;
    const size_t tstep = 2 * hstep;
    const unsigned ldsw = (unsigned)wid * 1024u;
    const int aoff = lds_byte(wr * 64 + fr, fq * 8), boff = lds_byte(wc * 32 + fr, fq * 8);
#define PG8_SA(b, h) (((b) * 2 + (h)) * HTB)
#define PG8_SB(b, h) ((4 + (b) * 2 + (h)) * HTB)
#define PG8_STAGE(bufoff, gbase, voff, rs, base) do { if constexpr (F8) { const int so_ = __builtin_amdgcn_readfirstlane((int)((const char*)(gbase) - (const char*)(base))); _Pragma("unroll") for (int _i = 0; _i < 2; ++_i) \
        __builtin_amdgcn_raw_ptr_buffer_load_lds(rs, (PG8_LAS void*)(lds + (bufoff) + ldsw + _i * 8192), 16, (int)(voff)[_i], so_, 0, 0); } \
        else { _Pragma("unroll") for (int _i = 0; _i < 2; ++_i) \
        __builtin_amdgcn_global_load_lds((const unsigned*)((const char*)(gbase) + (voff)[_i]), (PG8_LAS unsigned*)(lds + (bufoff) + ldsw + _i * 8192), 16, 0, 0); } } while (0)
#define PG8_STAGEA(bufoff, gptr, half, usenext) do { if constexpr (GATH) { const int so_ = __builtin_amdgcn_readfirstlane((int)((const char*)(gptr) - (const char*)g.A)); _Pragma("unroll") for (int _i = 0; _i < 2; ++_i) \
        __builtin_amdgcn_raw_ptr_buffer_load_lds(rsA, (PG8_LAS void*)(lds + (bufoff) + ldsw + _i * 8192), 16, (int)vAc[half][_i], so_, 0, 0); } \
        else { PG8_STAGE(bufoff, (gptr) + (half) * hstep, voffA, rsA, g.A); } } while (0)
#define PG8_GSWITCH do { if constexpr (GATH) { if (un) {   \
        asm volatile("" : "+v"(tpk[0]), "+v"(tpk[1]));     \
        _Pragma("unroll") for (int hh = 0; hh < 2; ++hh) _Pragma("unroll") for (int i = 0; i < 2; ++i) { int R, C; stage_rc(opaque_tid() * 16 + i * 8192, R, C); vAc[hh][i] = S.a_rowoff_tok(nxt, (int)((tpk[hh] >> (16 * i)) & 0xffffu)) + (unsigned)(C * 2); } } } } while (0)
#define PG8_LDA(dst, b, h) do { if constexpr (F8) { _Pragma("unroll") for (int m = 0; m < 4; ++m) dst##8[m] = cat32(*(const PG8_LAS bf16x8*)(lds + PG8_SA(b, h) + aoff + m * 2048), *(const PG8_LAS bf16x8*)(lds + PG8_SA(b, h) + aoff + m * 2048 + 1024)); } \
        else { _Pragma("unroll") for (int m = 0; m < 4; ++m) _Pragma("unroll") for (int k = 0; k < 2; ++k) dst[m][k] = *(const PG8_LAS bf16x8*)(lds + PG8_SA(b, h) + aoff + m * 2048 + k * 1024); } } while (0)
#define PG8_LDB(dst, b, h) do { if constexpr (F8) { _Pragma("unroll") for (int n = 0; n < 2; ++n) dst##8[n] = cat32(*(const PG8_LAS bf16x8*)(lds + PG8_SB(b, h) + boff + n * 2048), *(const PG8_LAS bf16x8*)(lds + PG8_SB(b, h) + boff + n * 2048 + 1024)); } \
        else { _Pragma("unroll") for (int n = 0; n < 2; ++n) _Pragma("unroll") for (int k = 0; k < 2; ++k) dst[n][k] = *(const PG8_LAS bf16x8*)(lds + PG8_SB(b, h) + boff + n * 2048 + k * 1024); } } while (0)
#define PG8_MMA(ai, bj, At, Bt) do { __builtin_amdgcn_s_setprio(1); _Pragma("unroll") for (int m = 0; m < 4; ++m) _Pragma("unroll") for (int n = 0; n < 2; ++n) { \
        if constexpr (F8) { acc[ai][bj][m][n] = __builtin_amdgcn_mfma_scale_f32_16x16x128_f8f6f4(Bt##8[n], At##8[m], acc[ai][bj][m][n], 0, 0, 0, g.sb, 0, g.sa); } \
        else { _Pragma("unroll") for (int k = 0; k < 2; ++k) acc[ai][bj][m][n] = __builtin_amdgcn_mfma_f32_16x16x32_bf16(Bt[n][k], At[m][k], acc[ai][bj][m][n], 0, 0, 0); } } __builtin_amdgcn_s_setprio(0); } while (0)
#define PG8_WAIT_V(n) asm volatile("s_waitcnt vmcnt(" #n ")" ::: "memory")
#define PG8_WAIT_L(n) asm volatile("s_waitcnt lgkmcnt(" #n ")" ::: "memory")
#define PG8_BAR __builtin_amdgcn_s_barrier()
#define PG8_SCHED __builtin_amdgcn_sched_barrier(0)
    Unit cur, nxt; int ui = 0;
    if (!S.next(0, cur)) return;
    f32x4 acc[2][2][4][2];
#pragma unroll
    for (int a = 0; a < 2; ++a)
#pragma unroll
        for (int b = 0; b < 2; ++b)
#pragma unroll
            for (int m = 0; m < 4; ++m)
#pragma unroll
                for (int n = 0; n < 2; ++n) acc[a][b][m][n] = (f32x4){0.f, 0.f, 0.f, 0.f};
    bf16x8 At[4][2], B0[2][2], B1[2][2];
    v8i_t At8[4], B08[2], B18[2];
    const char* cA = (const char*)g.A + (GATH ? (size_t)0 : (size_t)cur.pm * tstep); const char* cB = (const char*)g.Bt + (size_t)cur.pn * tstep;
    unsigned vAc[2][2];
    if constexpr (GATH) {
#pragma unroll
        for (int hh = 0; hh < 2; ++hh)
#pragma unroll
            for (int i = 0; i < 2; ++i) { int R, C; stage_rc(tid * 16 + i * 8192, R, C); vAc[hh][i] = S.a_rowoff(cur, hh * HALF + R) + (unsigned)(C * 2); } }
    S.a_ready(cur);
    if constexpr (SP2) {
        PG8_STAGE(PG8_SB(0, 0), cB, voffB, rsB, g.Bt); PG8_STAGE(PG8_SB(0, 1), cB + hstep, voffB, rsB, g.Bt); PG8_STAGEA(PG8_SA(0, 0), cA, 0, false); PG8_STAGEA(PG8_SA(0, 1), cA, 1, false);
        if (wr == 1) PG8_BAR;
        PG8_WAIT_V(2); PG8_BAR;
        PG8_STAGE(PG8_SB(1, 0), cB + kstep, voffB, rsB, g.Bt); PG8_STAGEA(PG8_SA(1, 0), cA + kstep, 0, false); PG8_STAGE(PG8_SB(1, 1), cB + hstep + kstep, voffB, rsB, g.Bt);
        PG8_WAIT_V(6); PG8_BAR;
    } else {
        PG8_STAGE(PG8_SB(0, 0), cB, voffB, rsB, g.Bt); PG8_STAGEA(PG8_SA(0, 0), cA, 0, false); PG8_STAGE(PG8_SB(0, 1), cB + hstep, voffB, rsB, g.Bt); PG8_STAGEA(PG8_SA(0, 1), cA, 1, false);
        if (wr == 1) PG8_BAR;
        PG8_WAIT_V(4); PG8_BAR;
        PG8_STAGE(PG8_SB(1, 0), cB + kstep, voffB, rsB, g.Bt); PG8_STAGEA(PG8_SA(1, 0), cA + kstep, 0, false); PG8_STAGE(PG8_SB(1, 1), cB + hstep + kstep, voffB, rsB, g.Bt);
        PG8_WAIT_V(6); PG8_BAR;
    }
    unsigned tpk[2] = {0u, 0u};
    if constexpr (GATH) { Unit n1; if (S.next(1, n1)) {
#pragma unroll
        for (int hh = 0; hh < 2; ++hh) { int R0, C0; stage_rc(opaque_tid() * 16, R0, C0); tpk[hh] = S.a_rowpair(n1, hh, R0); } } }
    for (;;) {
        const bool has_next = S.next(ui + 1, nxt);
        const char* nA = (has_next && !GATH) ? (const char*)g.A + (size_t)nxt.pm * tstep : cA; const char* nB = has_next ? (const char*)g.Bt + (size_t)nxt.pn * tstep : cB;

#pragma unroll 1
        for (int t = 0; t < nt; t += 2) {
            const bool last = (t == nt - 2); const bool un = last && has_next;

            const char* a1 = cA + (size_t)(t + 1) * kstep;
            const char* a2 = last ? nA : cA + (size_t)(t + 2) * kstep; const char* b2 = last ? nB : cB + (size_t)(t + 2) * kstep;
            const char* a3 = a2 + kstep; const char* b3 = b2 + kstep;
            if (last && has_next) S.a_ready(nxt);
            if constexpr (SP2) {
            PG8_LDB(B0, 0, 0); PG8_LDB(B1, 0, 1); PG8_SCHED; PG8_LDA(At, 0, 0); PG8_STAGEA(PG8_SA(1, 1), a1, 1, false); PG8_GSWITCH;
            PG8_WAIT_V(8); PG8_WAIT_L(0); PG8_BAR; PG8_MMA(0, 0, At, B0); PG8_MMA(0, 1, At, B1); PG8_BAR; PG8_SCHED;
            PG8_LDA(At, 0, 1); PG8_STAGE(PG8_SB(0, 0), b2, voffB, rsB, g.Bt); PG8_STAGE(PG8_SB(0, 1), b2 + hstep, voffB, rsB, g.Bt); PG8_STAGEA(PG8_SA(0, 0), a2, 0, un);
            PG8_WAIT_V(8); PG8_WAIT_L(0); PG8_BAR; PG8_MMA(1, 0, At, B0); PG8_MMA(1, 1, At, B1); PG8_BAR; PG8_SCHED;
            PG8_LDB(B0, 1, 0); PG8_LDB(B1, 1, 1); PG8_SCHED; PG8_LDA(At, 1, 0); PG8_STAGEA(PG8_SA(0, 1), a2, 1, un);
            PG8_WAIT_V(8); PG8_WAIT_L(0); PG8_BAR; PG8_MMA(0, 0, At, B0); PG8_MMA(0, 1, At, B1); PG8_BAR; PG8_SCHED;
            PG8_LDA(At, 1, 1); PG8_STAGE(PG8_SB(1, 0), b3, voffB, rsB, g.Bt); PG8_STAGE(PG8_SB(1, 1), b3 + hstep, voffB, rsB, g.Bt); PG8_STAGEA(PG8_SA(1, 0), a3, 0, un);
            PG8_WAIT_V(8); PG8_WAIT_L(0); PG8_BAR; PG8_MMA(1, 0, At, B0); PG8_MMA(1, 1, At, B1); PG8_BAR; PG8_SCHED;
            } else {
            PG8_LDB(B0, 0, 0); PG8_SCHED; PG8_LDA(At, 0, 0); PG8_STAGEA(PG8_SA(1, 1), a1, 1, false); PG8_GSWITCH;
            PG8_WAIT_L(8); PG8_BAR; PG8_WAIT_L(0); PG8_MMA(0, 0, At, B0); PG8_BAR; PG8_SCHED;
            PG8_LDB(B1, 0, 1); PG8_STAGE(PG8_SB(0, 0), b2, voffB, rsB, g.Bt);
            PG8_BAR; PG8_WAIT_L(0); PG8_MMA(0, 1, At, B1); PG8_BAR;
            PG8_LDA(At, 0, 1); PG8_STAGEA(PG8_SA(0, 0), a2, 0, un);
            PG8_BAR; PG8_WAIT_L(0); PG8_MMA(1, 0, At, B0); PG8_BAR; PG8_SCHED;
            PG8_STAGE(PG8_SB(0, 1), b2 + hstep, voffB, rsB, g.Bt);
            PG8_WAIT_V(6); PG8_BAR; PG8_MMA(1, 1, At, B1); PG8_BAR;
            PG8_LDB(B0, 1, 0); PG8_SCHED; PG8_LDA(At, 1, 0); PG8_STAGEA(PG8_SA(0, 1), a2, 1, un);
            PG8_WAIT_L(8); PG8_BAR; PG8_WAIT_L(0); PG8_MMA(0, 0, At, B0); PG8_BAR; PG8_SCHED;
            PG8_LDB(B1, 1, 1); PG8_STAGE(PG8_SB(1, 0), b3, voffB, rsB, g.Bt);
            PG8_BAR; PG8_WAIT_L(0); PG8_MMA(0, 1, At, B1); PG8_BAR;
            PG8_LDA(At, 1, 1); PG8_STAGEA(PG8_SA(1, 0), a3, 0, un);
            PG8_BAR; PG8_WAIT_L(0); PG8_MMA(1, 0, At, B0); PG8_BAR; PG8_SCHED;
            PG8_STAGE(PG8_SB(1, 1), b3 + hstep, voffB, rsB, g.Bt);
            PG8_WAIT_V(6); PG8_BAR; PG8_MMA(1, 1, At, B1); PG8_BAR;
            }
        }
        if constexpr (ALIGN_EPI) { if (wr == 0) PG8_BAR; }
        unsigned tpk2[2] = {0u, 0u};
        if constexpr (GATH) { Unit n2; if (S.next(ui + 2, n2)) {
#pragma unroll
            for (int hh = 0; hh < 2; ++hh) { int R0, C0; stage_rc(opaque_tid() * 16, R0, C0); tpk2[hh] = S.a_rowpair(n2, hh, R0); } } }
        if constexpr (!Epi::AFTER_DRAIN) { const int t2 = opaque_tid(), w2 = __builtin_amdgcn_readfirstlane(t2 >> 6), l2 = t2 & 63; E(acc, cur, w2 >> 2, w2 & 3, l2 & 15, l2 >> 4); S.done(cur); }
        if (!has_next) break;
#pragma unroll
        for (int a = 0; a < 2; ++a)
#pragma unroll
            for (int b = 0; b < 2; ++b)
#pragma unroll
                for (int m = 0; m < 4; ++m)
#pragma unroll
                    for (int n = 0; n < 2; ++n) acc[a][b][m][n] = (f32x4){0.f, 0.f, 0.f, 0.f};
        cur = nxt; cA = nA; cB = nB; ++ui;
        if constexpr (GATH) { asm volatile("" : "+v"(tpk2[0]), "+v"(tpk2[1]));
            tpk[0] = tpk2[0]; tpk[1] = tpk2[1]; }

        if constexpr (ALIGN_EPI) { if (wr == 1) PG8_BAR; }
    }
    PG8_WAIT_V(0);
    if constexpr (!ALIGN_EPI) { if (wr == 0) PG8_BAR; }
    PG8_BAR;
    if constexpr (Epi::AFTER_DRAIN) { E.fused(acc, cur, wr, wc, fr, fq, lds, wid, lane); S.done(cur); }
#undef PG8_SA
#undef PG8_SB
#undef PG8_STAGE
#undef PG8_LDA
#undef PG8_LDB
#undef PG8_MMA
#undef PG8_WAIT_V
#undef PG8_WAIT_L
#undef PG8_BAR
#undef PG8_SCHED
}
}

#define GAS __attribute__((address_space(1)))
#define LAS __attribute__((address_space(3)))
typedef unsigned short bf16;
typedef float f32x4 __attribute__((ext_vector_type(4)));
typedef unsigned u32x4 __attribute__((ext_vector_type(4)));
typedef unsigned u32x2 __attribute__((ext_vector_type(2)));
typedef short bf16x8 __attribute__((ext_vector_type(8)));

constexpr int DM = 1024, BATCH = 16, SEQ = 2048, DEPTH = 4, NTOK = BATCH * SEQ;
constexpr int PW_IN = 2320, PN = 2304, PNW = 2560;
constexpr int C_AQ = 0, C_AK = 512, C_AV = 640, C_MQ = 768, C_MK = 1024, C_MV = 1280, C_MO = 1536, C_GU = 1792, C_GV = 2048;
constexpr int NE = 16, CAP = 256, DE = 2048, NGRP = 256;
constexpr float DN_ALPHA = 1.6817928305074290f;
constexpr float LN_EPS = 1e-5f;

constexpr size_t MiB = 1u << 20;
constexpr size_t WS_CTL = 0, CTL_BYTES = 1 * MiB;
constexpr size_t WS_MOD = 1 * MiB;
constexpr size_t WS_WIN = 1520 * MiB;
constexpr size_t WS_WOUT = 22 * MiB;
constexpr size_t WS_WS = 30 * MiB;
constexpr size_t WS_GATES = 32 * MiB;
constexpr size_t WS_AFF = 34 * MiB;
constexpr size_t WS_SLOT = 36 * MiB;
constexpr size_t WS_IDX = 37 * MiB;
constexpr size_t WS_GATEV = 38 * MiB;
constexpr size_t WS_DC = 40 * MiB;
constexpr size_t WS_DN = 72 * MiB;
constexpr size_t WS_DS = 73 * MiB;
constexpr size_t WS_QKT = 80 * MiB;
constexpr size_t WS_H = 128 * MiB;
constexpr size_t WS_XA = 192 * MiB;
constexpr size_t WS_PROJ = 320 * MiB;
constexpr size_t WS_MIXCAT = 464 * MiB;
constexpr size_t WS_MIX = 528 * MiB;
constexpr size_t WS_XG = 592 * MiB;
constexpr size_t WS_HID = 720 * MiB;
constexpr size_t WS_YE = 976 * MiB;
constexpr size_t WS_WGU = 1104 * MiB;
constexpr size_t WS_WD = 1360 * MiB;
constexpr size_t WS_H8 = 1488 * MiB;
constexpr size_t WS_END = 1540 * MiB;
constexpr float W1_SCALE = 128.f, W2_SCALE = 512.f, ACT_SCALE = 8.f;
constexpr int SC_A1 = 0x7C7C7C7C, SC_B1 = 0x78787878, SC_A2 = 0x7D7D7D7D, SC_B2 = 0x76767676;
constexpr size_t WS_HFB = WS_HID;
constexpr size_t WS_VN = WS_HID + 64 * MiB;

struct P {
    const float *x, *c, *w_ada, *b_ada, *w_in, *conv_w, *conv_b, *gate_b, *sink, *rel_bias, *w_s, *b_s, *w_out, *w_router, *w_gate, *w_up, *w_down, *ln_g, *ln_b;
    float* out; unsigned char* ws;
};

typedef float f32x2c __attribute__((ext_vector_type(2))); typedef __bf16 bf16x2c __attribute__((ext_vector_type(2)));
__device__ __forceinline__ unsigned pk2(float lo, float hi) { const f32x2c v = {lo, hi}; return __builtin_bit_cast(unsigned, __builtin_convertvector(v, bf16x2c)); }
__device__ __forceinline__ unsigned f2bf(float f) { return pk2(f, 0.f) & 0xffffu; }
__device__ __forceinline__ float bf2f(unsigned short b) { return __builtin_bit_cast(float, (unsigned)b << 16); }
__device__ __forceinline__ float bflo(unsigned w) { return __builtin_bit_cast(float, w << 16); }
__device__ __forceinline__ float bfhi(unsigned w) { return __builtin_bit_cast(float, w & 0xffff0000u); }
__device__ __forceinline__ float sigmoid_f(float x) { return __builtin_amdgcn_rcpf(1.0f + __builtin_amdgcn_exp2f(x * -1.4426950408889634f)); }
__device__ __forceinline__ float silu_acc(float x) { return x * __builtin_amdgcn_rcpf(1.0f + __builtin_amdgcn_exp2f(x * -1.4426950408889634f)); }
__device__ __forceinline__ float gelu_erf(float x) { return 0.5f * x * (1.0f + erff(x * 0.70710678118654752f)); }
__device__ __forceinline__ float logsigmoid_f(float x) { return fminf(x, 0.f) - __logf(1.0f + __expf(-fabsf(x))); }
__device__ __forceinline__ int t5_bucket(int rel) {
    const int n = rel < 0 ? -rel : rel;
    int bk = n < 8 ? n : n < 12 ? 8 : n < 16 ? 9 : n < 23 ? 10 : n < 32 ? 11 : n < 46 ? 12 : n < 64 ? 13 : n < 91 ? 14 : 15;
    return bk + (rel > 0 ? 16 : 0);
}

__device__ __forceinline__ int unit_of(int wg, int G, int i, int N) {
    if (G == 256) { const int per = N >> 8; if (i >= per) return N; return ((((wg & 7) << 5) | (wg >> 3)) * per) + i; }
    const int u = wg + i * G; return u < N ? u : N;
}
template <int CTRL> __device__ __forceinline__ float dpp_f(float v) { return __builtin_bit_cast(float, __builtin_amdgcn_update_dpp(0, __builtin_bit_cast(int, v), CTRL, 0xf, 0xf, true)); }
#define DPP_X1 0xB1
#define DPP_X2 0x4E
#define DPP_HM 0x141
#define DPP_RM 0x140
__device__ __forceinline__ float r16_sum(float v) { v += dpp_f<DPP_X1>(v); v += dpp_f<DPP_X2>(v); v += dpp_f<DPP_HM>(v); v += dpp_f<DPP_RM>(v); return v; }
__device__ __forceinline__ float r16_max(float v) { v = fmaxf(v, dpp_f<DPP_X1>(v)); v = fmaxf(v, dpp_f<DPP_X2>(v)); v = fmaxf(v, dpp_f<DPP_HM>(v)); v = fmaxf(v, dpp_f<DPP_RM>(v)); return v; }
__device__ __forceinline__ float wave_sum(float v) {
#pragma unroll
    for (int o = 1; o < 64; o <<= 1) v += __shfl_xor(v, o);
    return v;
}
constexpr int RB_PITCH = 2080;
constexpr int RB_W = 0, RB_ST = 16 * RB_PITCH, RW_VEC = 100352;
__device__ __forceinline__ void r16_ln(f32x4 (&v)[16]) {
    float s = 0.f;
#pragma unroll
    for (int k = 0; k < 16; ++k) s += (v[k][0] + v[k][1]) + (v[k][2] + v[k][3]);
    const float mean = r16_sum(s) * (1.f / DM); float q = 0.f;
#pragma unroll
    for (int k = 0; k < 16; ++k) { v[k] = v[k] - mean; q += (v[k][0] * v[k][0] + v[k][1] * v[k][1]) + (v[k][2] * v[k][2] + v[k][3] * v[k][3]); }
    const float rstd = 1.0f / sqrtf(r16_sum(q) * (1.f / DM) + LN_EPS);
#pragma unroll
    for (int k = 0; k < 16; ++k) v[k] = v[k] * rstd;
}
__device__ __forceinline__ float r16_fold(const float (&acc)[16], int c) {
    float a8[8], a4[4], a2[2];
    { const bool hi = c >= 8;
#pragma unroll
      for (int e = 0; e < 8; ++e) { const float send = hi ? acc[e] : acc[e + 8], keep = hi ? acc[e + 8] : acc[e]; a8[e] = keep + dpp_f<DPP_RM>(send); } }
    { const bool hi = (c & 7) >= 4;
#pragma unroll
      for (int e = 0; e < 4; ++e) { const float send = hi ? a8[e] : a8[e + 4], keep = hi ? a8[e + 4] : a8[e]; a4[e] = keep + dpp_f<DPP_HM>(send); } }
    { const bool hi = (c & 2) != 0;
#pragma unroll
      for (int e = 0; e < 2; ++e) { const float send = hi ? a4[e] : a4[e + 2], keep = hi ? a4[e + 2] : a4[e]; a2[e] = keep + dpp_f<DPP_X2>(send); } }
    const bool hi = (c & 1) != 0; const float send = hi ? a2[0] : a2[1], keep = hi ? a2[1] : a2[0];
    return keep + dpp_f<DPP_X1>(send);
}
__device__ __forceinline__ void r16_matvec2(const f32x4 (&v0)[16], const f32x4 (&v1)[16], const LAS float* wT, int c, float& r0, float& r1) {
    float a0[16], a1[16];
    asm volatile("" ::: "memory");
#pragma unroll
    for (int e = 0; e < 16; ++e) { float s0 = 0.f, s1 = 0.f;
#pragma unroll
        for (int k = 0; k < 16; ++k) { const f32x4 w = *(const LAS f32x4*)(wT + e * DM + 64 * k + 4 * c);
            s0 += (v0[k][0] * w[0] + v0[k][1] * w[1]) + (v0[k][2] * w[2] + v0[k][3] * w[3]); s1 += (v1[k][0] * w[0] + v1[k][1] * w[1]) + (v1[k][2] * w[2] + v1[k][3] * w[3]); }
        a0[e] = s0; a1[e] = s1; }
    r0 = r16_fold(a0, c); r1 = r16_fold(a1, c);
}
#define RC(k) (128 * ((k) >> 1) + 8 * c + 4 * ((k) & 1))
__device__ __forceinline__ int rpos(int col) { return (col & ~127) | (((col >> 2) & 1) << 6) | (((col & 127) >> 3) << 2) | (col & 3); }
__device__ __forceinline__ f32x4 bf4lo(u32x4 w) { return (f32x4){bflo(w.x), bfhi(w.x), bflo(w.y), bfhi(w.y)}; }
__device__ __forceinline__ f32x4 bf4hi(u32x4 w) { return (f32x4){bflo(w.z), bfhi(w.z), bflo(w.w), bfhi(w.w)}; }
typedef float f32x2q __attribute__((ext_vector_type(2)));
__device__ __forceinline__ f32x4 fp8x4(unsigned w) { const f32x2q lo = __builtin_amdgcn_cvt_pk_f32_fp8((int)w, false), hi = __builtin_amdgcn_cvt_pk_f32_fp8((int)w, true); return (f32x4){lo[0], lo[1], hi[0], hi[1]}; }
__device__ __forceinline__ void r16_store_bf16(bf16* rowp, int c, const f32x4 (&v)[16]) {
#pragma unroll
    for (int kk = 0; kk < 8; ++kk) { u32x4 w; w.x = pk2(v[2 * kk][0], v[2 * kk][1]); w.y = pk2(v[2 * kk][2], v[2 * kk][3]); w.z = pk2(v[2 * kk + 1][0], v[2 * kk + 1][1]); w.w = pk2(v[2 * kk + 1][2], v[2 * kk + 1][3]);
        *(u32x4*)(rowp + 128 * kk + 8 * c) = w; }
}
__device__ __forceinline__ void fill_wrouter(LAS unsigned char* wb, const float* src, int tid) {
#pragma unroll
    for (int j = 0; j < 2; ++j) { const int d = tid + 512 * j; const float* sp = src + (size_t)d * 16;
        const f32x4 a0 = *(const f32x4*)sp, a1 = *(const f32x4*)(sp + 4), a2 = *(const f32x4*)(sp + 8), a3 = *(const f32x4*)(sp + 12);
#pragma unroll
        for (int k = 0; k < 4; ++k) { *(LAS bf16*)(wb + k * RB_PITCH + 2 * d) = (bf16)f2bf(a0[k]); *(LAS bf16*)(wb + (4 + k) * RB_PITCH + 2 * d) = (bf16)f2bf(a1[k]);
            *(LAS bf16*)(wb + (8 + k) * RB_PITCH + 2 * d) = (bf16)f2bf(a2[k]); *(LAS bf16*)(wb + (12 + k) * RB_PITCH + 2 * d) = (bf16)f2bf(a3[k]); } }
}
__device__ __forceinline__ void fill_vec(LAS float* dst, const float* src, int tid) {
    *(LAS f32x4*)(dst + rpos(4 * (tid & 255))) = *(const f32x4*)(src + 4 * (tid & 255));
}
__device__ __forceinline__ void rows_entry_simple(const P& p, int wg, int G) {
    const int tid = opaque_tid(), lane = tid & 63, gw = wg * 8 + (tid >> 6), ngw = G * 8;
    const float* mod = (const float*)(p.ws + WS_MOD); bf16* H = (bf16*)(p.ws + WS_H);
    for (int m = gw; m < NTOK; m += ngw) { const int b = m / SEQ; const float* mb = mod + (size_t)b * 6 * DM; const float* xr = p.x + (size_t)m * DM;
        f32x4 v[4]; float s = 0.f;
#pragma unroll
        for (int j = 0; j < 4; ++j) { v[j] = *(const f32x4*)(xr + 256 * j + 4 * lane); s += (v[j][0] + v[j][1]) + (v[j][2] + v[j][3]); }
        const float mean = wave_sum(s) * (1.f / DM); float q = 0.f;
#pragma unroll
        for (int j = 0; j < 4; ++j) { v[j] = v[j] - mean; q += (v[j][0] * v[j][0] + v[j][1] * v[j][1]) + (v[j][2] * v[j][2] + v[j][3] * v[j][3]); }
        const float rstd = 1.0f / sqrtf(wave_sum(q) * (1.f / DM) + LN_EPS);
#pragma unroll
        for (int j = 0; j < 4; ++j) { const f32x4 sc = *(const f32x4*)(mb + DM + 256 * j + 4 * lane), sh = *(const f32x4*)(mb + 256 * j + 4 * lane); const f32x4 o = v[j] * rstd * (sc + 1.0f) + sh;
            u32x2 w; w.x = pk2(o[0], o[1]); w.y = pk2(o[2], o[3]); *(u32x2*)(H + (size_t)m * DM + 256 * j + 4 * lane) = w; }
    }
}
template <int WHICH>
__device__ __forceinline__ void rows_phase(const P& p, int l, const float* xin, LAS unsigned char* L, int wg, int G, bool dummy = false) {
    const int tid = opaque_tid(), lane = tid & 63, wave = __builtin_amdgcn_readfirstlane(tid >> 6), q = lane >> 4, c = lane & 15;
    LAS float* vec = (LAS float*)(L + RW_VEC);
    const float* modl = (const float*)(p.ws + WS_MOD) + (size_t)l * BATCH * 6 * DM;
    bf16* H = (bf16*)(p.ws + (dummy ? WS_HID : WS_H)); bf16* xa = (bf16*)(p.ws + (dummy ? WS_XG : WS_XA));
    const bool xbf = (WHICH == 2) || (l != 0);
    float* affo = (float*)(p.ws + (dummy ? WS_HID + 128 * MiB : WS_AFF)); float* gato = (float*)(p.ws + (dummy ? WS_HID + 130 * MiB : WS_GATES));
    const bool last = (WHICH == 2) && (l == DEPTH - 1);
    if (WHICH == 1) fill_wrouter(L + RB_W, p.w_router + (size_t)l * DM * 16, tid);
    for (int bi = 0, blk; (blk = unit_of(wg, G, bi, NTOK / 128)) < NTOK / 128; ++bi) {
        const int b = (blk * 128) / SEQ; const float* mb = modl + (size_t)b * 6 * DM;
        __syncthreads();
        { const int half = tid >> 8;
          if (WHICH == 0) { fill_vec(vec + half * DM, mb + (half ? 0 : 1) * DM, tid); }
          if (WHICH == 1) { fill_vec(vec + half * DM, half ? p.ln_g + (size_t)(l * 2) * DM : mb + 2 * DM, tid); fill_vec(vec + (2 + half) * DM, half ? mb + 4 * DM : p.ln_b + (size_t)(l * 2) * DM, tid); if (half == 0) fill_vec(vec + 4 * DM, mb + 3 * DM, tid); }
          if (WHICH == 2) { fill_vec(vec + half * DM, half ? p.ln_g + (size_t)(l * 2 + 1) * DM : mb + 5 * DM, tid); if (half == 0) fill_vec(vec + 2 * DM, p.ln_b + (size_t)(l * 2 + 1) * DM, tid);
              if (!last) { const float* mbn = mb + (size_t)BATCH * 6 * DM; fill_vec(vec + (3 + half) * DM, mbn + (half ? 0 : 1) * DM, tid); } } }
        __syncthreads();
#pragma unroll 1
        for (int it = 0; it < 4; ++it) {
            asm volatile("" ::: "memory");
            const int m = blk * 128 + wave * 16 + it * 4 + q;
            f32x4 v[16];
            if (!xbf) {
#pragma unroll
                for (int k = 0; k < 16; ++k) v[k] = *(const f32x4*)(xin + (size_t)m * DM + RC(k)); }
            else { const bf16* xb = (const bf16*)xin + (size_t)m * DM;
#pragma unroll
                for (int kk = 0; kk < 8; ++kk) { const u32x4 w = *(const u32x4*)(xb + 128 * kk + 8 * c); v[2 * kk] = bf4lo(w); v[2 * kk + 1] = bf4hi(w); } }
            if (WHICH == 1) {
                const bf16* mix = (const bf16*)(p.ws + WS_MIX) + (size_t)m * DM;
                u32x4 mw[8];
#pragma unroll
                for (int kk = 0; kk < 8; ++kk) mw[kk] = *(const u32x4*)(mix + 128 * kk + 8 * c);
#pragma unroll
                for (int k = 0; k < 16; ++k) { const f32x4 g1 = *(const LAS f32x4*)(vec + 64 * k + 4 * c); const f32x4 mx = (k & 1) ? bf4hi(mw[k >> 1]) : bf4lo(mw[k >> 1]);
                    v[k] = v[k] * DN_ALPHA + (g1 + 1.0f) * mx; }
            }
            if (WHICH == 2) {
                const unsigned char* ye = p.ws + WS_YE; const short* slot = (const short*)(p.ws + WS_SLOT);
                const int t = m % SEQ; const int sl = slot[((size_t)b * 16 + c) * SEQ + t];
                const unsigned long long bal = __ballot(sl >= 0);
                unsigned rem = (unsigned)(bal >> (16 * q)) & 0xffffu;
                const int c0 = __popcll(bal & 0xffffull), c1 = __popcll(bal & 0xffff0000ull), c2 = __popcll(bal & 0xffff00000000ull), c3 = __popcll(bal & 0xffff000000000000ull);
                const int m01 = c0 > c1 ? c0 : c1, m23 = c2 > c3 ? c2 : c3, maxc = m01 > m23 ? m01 : m23;
                f32x4 y[16];
#pragma unroll
                for (int k = 0; k < 16; ++k) y[k] = (f32x4){0.f, 0.f, 0.f, 0.f};
                for (int kk = 0; kk < maxc; kk += 2) {
                    const bool va = rem != 0u; const int ea = va ? __builtin_ctz(rem) : 0; rem &= rem - 1u;
                    const bool vb = rem != 0u; const int eb = vb ? __builtin_ctz(rem) : 0; rem &= rem - 1u;
                    const int sa = __shfl(sl, (lane & 48) | ea), sb = __shfl(sl, (lane & 48) | eb);
                    const unsigned char* ra = ye + ((size_t)(ea * 16 + b) * CAP + (va ? sa : 0)) * DM; const unsigned char* rb = ye + ((size_t)(eb * 16 + b) * CAP + (vb ? sb : 0)) * DM;
                    u32x4 wa[4], wb[4];
#pragma unroll
                    for (int j2 = 0; j2 < 4; ++j2) { wa[j2] = *(const u32x4*)(ra + 256 * j2 + 16 * c); wb[j2] = *(const u32x4*)(rb + 256 * j2 + 16 * c); }
                    const float fa = va ? 1.f / pg8::YE_SCALE : 0.f, fb = vb ? 1.f / pg8::YE_SCALE : 0.f;
#pragma unroll
                    for (int k = 0; k < 16; ++k) { y[k] = y[k] + fp8x4(wa[k >> 2][k & 3]) * fa + fp8x4(wb[k >> 2][k & 3]) * fb; }
                }
#pragma unroll
                for (int k = 0; k < 16; ++k) { const f32x4 g2 = *(const LAS f32x4*)(vec + 64 * k + 4 * c); v[k] = v[k] * DN_ALPHA + (g2 + 1.0f) * y[k]; }
            }
            if (WHICH != 0) {
                r16_ln(v);
                const bool of32 = last && !dummy;
#pragma unroll
                for (int k = 0; k < 16; ++k) { const f32x4 gg = *(const LAS f32x4*)(vec + DM + 64 * k + 4 * c), bb = *(const LAS f32x4*)(vec + 2 * DM + 64 * k + 4 * c); v[k] = v[k] * gg + bb; }
                if (of32) {
#pragma unroll
                    for (int k = 0; k < 16; ++k) *(f32x4*)(p.out + (size_t)m * DM + RC(k)) = v[k]; }
                else r16_store_bf16(xa + (size_t)m * DM, c, v);
            }
            if (!last) {
                r16_ln(v);
                const int o_sc = WHICH == 0 ? 0 : 3, o_sh = WHICH == 0 ? 1 : 4;
#pragma unroll
                for (int k = 0; k < 16; ++k) { const f32x4 sc = *(const LAS f32x4*)(vec + o_sc * DM + 64 * k + 4 * c), sh = *(const LAS f32x4*)(vec + o_sh * DM + 64 * k + 4 * c); v[k] = v[k] * (sc + 1.0f) + sh; }
                if (WHICH == 1) { unsigned char* h8 = p.ws + (dummy ? WS_HID : WS_H8) + (size_t)m * DM;
#pragma unroll
                    for (int kk = 0; kk < 8; ++kk) { u32x2 w; w.x = pg8::pk4_fp8(v[2 * kk][0] * ACT_SCALE, v[2 * kk][1] * ACT_SCALE, v[2 * kk][2] * ACT_SCALE, v[2 * kk][3] * ACT_SCALE); w.y = pg8::pk4_fp8(v[2 * kk + 1][0] * ACT_SCALE, v[2 * kk + 1][1] * ACT_SCALE, v[2 * kk + 1][2] * ACT_SCALE, v[2 * kk + 1][3] * ACT_SCALE);
                        *(u32x2*)(h8 + 128 * kk + 8 * c) = w; } }
                else r16_store_bf16(H + (size_t)m * DM, c, v);
                if (WHICH == 1) {
                    LAS unsigned char* st = L + RB_ST + wave * (4 * RB_PITCH);
#pragma unroll
                    for (int kk = 0; kk < 8; ++kk) { u32x4 w; w.x = pk2(v[2 * kk][0], v[2 * kk][1]); w.y = pk2(v[2 * kk][2], v[2 * kk][3]); w.z = pk2(v[2 * kk + 1][0], v[2 * kk + 1][1]); w.w = pk2(v[2 * kk + 1][2], v[2 * kk + 1][3]);
                        *(LAS u32x4*)(st + q * RB_PITCH + (128 * kk + 8 * c) * 2) = w; }
                    f32x4 lg = (f32x4){0.f, 0.f, 0.f, 0.f};
                    const LAS unsigned char* ap = st + (lane & 3) * RB_PITCH + (lane >> 4) * 16; const LAS unsigned char* bp = L + RB_W + (lane & 15) * RB_PITCH + (lane >> 4) * 16;
#pragma unroll 8
                    for (int ks = 0; ks < 32; ++ks) lg = __builtin_amdgcn_mfma_f32_16x16x32_bf16(*(const LAS bf16x8*)(ap + ks * 64), *(const LAS bf16x8*)(bp + ks * 64), lg, 0, 0, 0);
                    float pr[4];
#pragma unroll
                    for (int rr = 0; rr < 4; ++rr) { const float mx = r16_max(lg[rr]), ex = __expf(lg[rr] - mx), sm = r16_sum(ex); pr[rr] = ex / sm; }
                    const float mine = q == 0 ? pr[0] : q == 1 ? pr[1] : q == 2 ? pr[2] : pr[3];
                    affo[(size_t)m * 16 + c] = mine; }
            }
        }
    }
    __syncthreads();
}

__device__ __forceinline__ void transpose_item(const float* src, size_t ld_src, bf16* dst, size_t ld_dst, LAS float* scr, int lane, int nvalid = 32) {
    if (nvalid > 0) { const int kr = lane >> 3, nc = 4 * (lane & 7);
        f32x4 t[8];
#pragma unroll
        for (int i = 0; i < 8; ++i) t[i] = *(const f32x4*)(src + (size_t)(8 * i + kr) * ld_src + nc);
#pragma unroll
        for (int i = 0; i < 8; ++i) { LAS float* d = scr + (8 * i + kr) * 33 + nc; d[0] = t[i][0]; d[1] = t[i][1]; d[2] = t[i][2]; d[3] = t[i][3]; }
    }
    asm volatile("s_waitcnt lgkmcnt(0)" ::: "memory");
    const int c = lane & 7;
#pragma unroll
    for (int j = 0; j < 4; ++j) { const int n = (lane >> 3) + 8 * j; const LAS float* s = scr + (8 * c) * 33 + n;
        u32x4 o; o.x = pk2(s[0 * 33], s[1 * 33]); o.y = pk2(s[2 * 33], s[3 * 33]); o.z = pk2(s[4 * 33], s[5 * 33]); o.w = pk2(s[6 * 33], s[7 * 33]);
        if (n >= nvalid) o = (u32x4){0u, 0u, 0u, 0u};
        *(u32x4*)(dst + (size_t)n * ld_dst + 8 * c) = o; }
    asm volatile("s_waitcnt lgkmcnt(0)" ::: "memory");
}
__device__ __forceinline__ void transpose_item8(const float* src, size_t ld_src, unsigned char* dst, size_t ld_dst, float scale, LAS float* scr, int lane) {
    { const int kr = lane >> 3, nc = 4 * (lane & 7);
        f32x4 t[8];
#pragma unroll
        for (int i = 0; i < 8; ++i) t[i] = *(const f32x4*)(src + (size_t)(8 * i + kr) * ld_src + nc);
#pragma unroll
        for (int i = 0; i < 8; ++i) { LAS float* d = scr + (8 * i + kr) * 33 + nc; d[0] = t[i][0]; d[1] = t[i][1]; d[2] = t[i][2]; d[3] = t[i][3]; } }
    asm volatile("s_waitcnt lgkmcnt(0)" ::: "memory");
    const int c = lane & 3;
#pragma unroll
    for (int j = 0; j < 2; ++j) { const int n = (lane >> 2) + 16 * j; const LAS float* s = scr + (16 * c) * 33 + n;
        u32x4 o;
#pragma unroll
        for (int q = 0; q < 4; ++q) o[q] = pg8::pk4_fp8(s[(4 * q) * 33] * scale, s[(4 * q + 1) * 33] * scale, s[(4 * q + 2) * 33] * scale, s[(4 * q + 3) * 33] * scale);
        *(u32x4*)(dst + (size_t)n * ld_dst + 16 * c) = o; }
    asm volatile("s_waitcnt lgkmcnt(0)" ::: "memory");
}
constexpr int ITL_WIN = 16 * 80, ITL_WOUT = 16 * 32, ITL_WGU = NE * 16 * 128, ITL_WD = NE * 32 * 32, ITL = ITL_WIN + ITL_WOUT + ITL_WGU + ITL_WD;
constexpr int ITS = ITL_WIN + ITL_WOUT, ITM = ITL_WGU + ITL_WD;
__device__ __forceinline__ void convert_item(const P& p, int l, int it, LAS float* scr, int lane) {
    if (it < ITL_WIN) { const int kb = it / 80, nb = it % 80, n0 = 32 * nb;
        const int sc = n0 < 1792 ? n0 : n0 < 2304 ? n0 + 16 : 1792, nvalid = n0 < 2304 ? 32 : n0 == 2304 ? 16 : 0;
        transpose_item(p.w_in + (size_t)l * DM * PW_IN + (size_t)(64 * kb) * PW_IN + sc, PW_IN, (bf16*)(p.ws + WS_WIN) + (size_t)l * PNW * DM + (size_t)n0 * DM + 64 * kb, DM, scr, lane, nvalid); return; }
    it -= ITL_WIN;
    if (it < ITL_WOUT) { const int kb = it / 32, nb = it % 32;
        transpose_item(p.w_out + (size_t)l * DM * DM + (size_t)(64 * kb) * DM + 32 * nb, DM, (bf16*)(p.ws + WS_WOUT) + (size_t)l * DM * DM + (size_t)(32 * nb) * DM + 64 * kb, DM, scr, lane); return; }
    it -= ITL_WOUT;
    if (it < ITL_WGU) { const int le = l * NE + it / (16 * 128), r = it % (16 * 128), kb = r / 128, nb = r % 128, n0 = 32 * nb, pn = n0 >> 8, w = n0 & 255;
        const float* src = (w < 128 ? p.w_gate : p.w_up) + (size_t)le * DM * DE + (size_t)(64 * kb) * DE + pn * 128 + (w & 127);
        transpose_item8(src, DE, p.ws + WS_WGU + (size_t)le * 4096 * DM + (size_t)n0 * DM + 64 * kb, DM, W1_SCALE, scr, lane); return; }
    it -= ITL_WGU;
    { const int le = l * NE + it / (32 * 32), r = it % (32 * 32), kb = r / 32, nb = r % 32;
        transpose_item8(p.w_down + (size_t)le * DE * DM + (size_t)(64 * kb) * DM + 32 * nb, DM, p.ws + WS_WD + (size_t)le * DM * DE + (size_t)(32 * nb) * DE + 64 * kb, DE, W2_SCALE, scr, lane); }
}

typedef short s16x4 __attribute__((ext_vector_type(4)));
typedef float f32x16 __attribute__((ext_vector_type(16)));
#define MFMA32(a, b, c) __builtin_amdgcn_mfma_f32_32x32x16_bf16((a), (b), (c), 0, 0, 0)
__device__ __forceinline__ int crow(int reg, int h) { return (reg & 3) + 8 * (reg >> 2) + 4 * h; }
__device__ __forceinline__ unsigned cvtpk(float lo, float hi) { return pk2(lo, hi); }
__device__ __forceinline__ bf16x8 pack8(float a0, float a1, float a2, float a3, float a4, float a5, float a6, float a7) {
    u32x4 w; w.x = cvtpk(a0, a1); w.y = cvtpk(a2, a3); w.z = cvtpk(a4, a5); w.w = cvtpk(a6, a7); return __builtin_bit_cast(bf16x8, w); }
__device__ __forceinline__ s16x4 tr_read(const LAS unsigned char* p) { typedef short v4i16_t __attribute__((ext_vector_type(4))); return __builtin_bit_cast(s16x4, __builtin_amdgcn_ds_read_tr16_b64_v4i16((LAS v4i16_t*)p)); }
__device__ __forceinline__ bf16x8 cat8(s16x4 lo, s16x4 hi) { return (bf16x8){lo[0], lo[1], lo[2], lo[3], hi[0], hi[1], hi[2], hi[3]}; }
__device__ __forceinline__ int wave_sum_i(int v) {
#pragma unroll
    for (int o = 1; o < 64; o <<= 1) v += __shfl_xor(v, o);
    return v;
}
__device__ __forceinline__ float wave_max(float v) {
#pragma unroll
    for (int o = 1; o < 64; o <<= 1) v = fmaxf(v, __shfl_xor(v, o));
    return v;
}

template <int CTRL, int RMASK> __device__ __forceinline__ float dpp_id(float ident, float v) { return __builtin_bit_cast(float, __builtin_amdgcn_update_dpp(__builtin_bit_cast(int, ident), __builtin_bit_cast(int, v), CTRL, RMASK, 0xf, false)); }
__device__ __forceinline__ float wave_scan_sum(float v) {
    v += dpp_id<0x111, 0xf>(0.f, v); v += dpp_id<0x112, 0xf>(0.f, v); v += dpp_id<0x114, 0xf>(0.f, v); v += dpp_id<0x118, 0xf>(0.f, v);
    v += dpp_id<0x142, 0xa>(0.f, v); v += dpp_id<0x143, 0xc>(0.f, v); return v; }
__device__ __forceinline__ float wave_scan_max(float v) { const float NI = -3.0e38f;
    v = fmaxf(v, dpp_id<0x111, 0xf>(NI, v)); v = fmaxf(v, dpp_id<0x112, 0xf>(NI, v)); v = fmaxf(v, dpp_id<0x114, 0xf>(NI, v)); v = fmaxf(v, dpp_id<0x118, 0xf>(NI, v));
    v = fmaxf(v, dpp_id<0x142, 0xa>(NI, v)); v = fmaxf(v, dpp_id<0x143, 0xc>(NI, v)); return v; }
__device__ __forceinline__ void ph_topk(const P& p, LAS unsigned char* lds, int wg, int G) {
    const int tid = opaque_tid(), lane = tid & 63, wave = __builtin_amdgcn_readfirstlane(tid >> 6);
    LAS unsigned* hist = (LAS unsigned*)lds;
    LAS unsigned* cnt = hist + 1024;
    const float* affp = (const float*)(p.ws + WS_AFF);
    for (int ui = 0, u; (u = unit_of(wg, G, ui, 256)) < 256; ++ui) {
        const int b = u >> 4, e = u & 15, g = e * 16 + b;
        unsigned key[4];
#pragma unroll
        for (int i = 0; i < 4; ++i) key[i] = __builtin_bit_cast(unsigned, affp[((size_t)b * SEQ + i * 512 + tid) * 16 + e]);
        hist[tid] = 0u; hist[512 + tid] = 0u;
        __syncthreads();
        unsigned thr = 0u; int need = CAP;
#pragma unroll
        for (int ps = 0; ps < 4; ++ps) { const int sh = 24 - 8 * ps;
#pragma unroll
            for (int i = 0; i < 4; ++i) { const bool in = ps == 0 || (key[i] >> (sh + 8)) == (thr >> (sh + 8));
                if (in) __hip_atomic_fetch_add(hist + ps * 256 + ((key[i] >> sh) & 255u), 1u, __ATOMIC_RELAXED, __HIP_MEMORY_SCOPE_WORKGROUP); }
            __syncthreads();
            const int lp = 63 - lane; const u32x4 h4 = *(const LAS u32x4*)(hist + ps * 256 + 4 * lp);
            const int s4 = (int)(h4.x + h4.y + h4.z + h4.w), incl = (int)wave_scan_sum((float)s4), excl = incl - s4;
            const int Ls = __builtin_ctzll(__ballot(incl >= need));
            const int c3 = excl + (int)h4.w, c2 = c3 + (int)h4.z, c1 = c2 + (int)h4.y;
            const int Bl = 4 * lp + (c3 >= need ? 3 : c2 >= need ? 2 : c1 >= need ? 1 : 0), ab = c3 >= need ? excl : c2 >= need ? c3 : c1 >= need ? c2 : c1;
            thr |= (unsigned)__builtin_amdgcn_readlane(Bl, Ls) << sh; need -= __builtin_amdgcn_readlane(ab, Ls); }
        const unsigned long long lt = (1ull << lane) - 1ull;
        unsigned long long beq[4], bsel[4];
#pragma unroll
        for (int i = 0; i < 4; ++i) { beq[i] = __ballot(key[i] == thr); if (lane == 0) cnt[i * 8 + wave] = (unsigned)__popcll(beq[i]); }
        __syncthreads();
        { const float c = lane < 32 ? (float)cnt[lane & 31] : 0.f; const float ex = wave_scan_sum(c) - c;
#pragma unroll
          for (int i = 0; i < 4; ++i) { const int eqrank = (int)__builtin_bit_cast(float, __builtin_amdgcn_readlane(__builtin_bit_cast(int, ex), i * 8 + wave)) + __popcll(beq[i] & lt);
              const bool sel = key[i] > thr || (key[i] == thr && eqrank < need);
              bsel[i] = __ballot(sel); if (lane == 0) cnt[32 + i * 8 + wave] = (unsigned)__popcll(bsel[i]); } }
        __syncthreads();
        { const float c = lane < 32 ? (float)cnt[32 + (lane & 31)] : 0.f; const float ex = wave_scan_sum(c) - c;
          unsigned short* idx = (unsigned short*)(p.ws + WS_IDX) + g * CAP; float* gv = (float*)(p.ws + WS_GATEV) + g * CAP; short* slot = (short*)(p.ws + WS_SLOT) + ((size_t)b * 16 + e) * SEQ;
#pragma unroll
          for (int i = 0; i < 4; ++i) { const int sl = (int)__builtin_bit_cast(float, __builtin_amdgcn_readlane(__builtin_bit_cast(int, ex), i * 8 + wave)) + __popcll(bsel[i] & lt); const int tok = i * 512 + tid;
              const bool sel = (bsel[i] >> lane) & 1ull;
              if (sel) { idx[(((sl >> 7) * 64 + (sl & 63)) << 1) + ((sl >> 6) & 1)] = (unsigned short)tok; gv[sl] = __builtin_bit_cast(float, key[i]); }
              slot[tok] = sel ? (short)sl : (short)-1; } }
        __syncthreads();
    }
}

__device__ __forceinline__ float gelu_as(float v) {
    const float t = __builtin_amdgcn_rcpf(fabsf(v) * 0.2316418882f + 1.0f);
    float q = t * 0.5307027145f + (-0.7265760135f); q = q * t + 0.7107068705f; q = q * t + (-0.142248368f); q = q * t + 0.127414796f; q = q * t;
    const float m = v * (q * __builtin_amdgcn_exp2f(v * v * (-0.72134752044f)));
    return v < 0.f ? m : v - m;
}
constexpr int GM_PITCH = 264;
__device__ __forceinline__ void ph_gmlp(const P& p, int l, LAS unsigned char* lds, int wg, int G) {
    const int tid = opaque_tid(), lane = tid & 63, wave = __builtin_amdgcn_readfirstlane(tid >> 6), r = lane & 31, h = lane >> 5, q = lane >> 4, c = lane & 15;
    const bf16* proj = (const bf16*)(p.ws + WS_PROJ); bf16* mixcat = (bf16*)(p.ws + WS_MIXCAT);
    const bf16* wsb = (const bf16*)(p.ws + WS_WS) + (size_t)l * 4 * 128 * 128;
    for (int ui = 0, u; (u = unit_of(wg, G, ui, 256)) < 256; ++ui) {
        const size_t m0 = (size_t)u * 128;
#pragma unroll
        for (int it = 0; it < 4; ++it) { const int t = wave * 16 + it * 4 + q;
            const bf16* src = proj + (m0 + t) * PN + C_GV + 8 * c; const u32x4 x0 = *(const u32x4*)src, x1 = *(const u32x4*)(src + 128);
            float v[16];
#pragma unroll
            for (int i = 0; i < 4; ++i) { v[2 * i] = gelu_as(bflo(x0[i])); v[2 * i + 1] = gelu_as(bfhi(x0[i])); v[8 + 2 * i] = gelu_as(bflo(x1[i])); v[8 + 2 * i + 1] = gelu_as(bfhi(x1[i])); }
            float s = 0.f;
#pragma unroll
            for (int i = 0; i < 16; ++i) s += v[i];
            const float mean = r16_sum(s) * (1.f / 256.f); float qq = 0.f;
#pragma unroll
            for (int i = 0; i < 16; ++i) { v[i] -= mean; qq += v[i] * v[i]; }
            const float rstd = 1.0f / sqrtf(r16_sum(qq) * (1.f / 256.f) + LN_EPS);
            u32x4 o0, o1;
#pragma unroll
            for (int i = 0; i < 4; ++i) { o0[i] = pk2(v[2 * i] * rstd, v[2 * i + 1] * rstd); o1[i] = pk2(v[8 + 2 * i] * rstd, v[8 + 2 * i + 1] * rstd); }
            *(LAS u32x4*)(lds + (t * GM_PITCH + 8 * c) * 2) = o0; *(LAS u32x4*)(lds + (t * GM_PITCH + 128 + 8 * c) * 2) = o1; }
        __syncthreads();
        const int tt = wave & 3, ch = wave >> 2, t = tt * 32 + r;
        u32x2 uu[4][4];
#pragma unroll
        for (int ti = 0; ti < 4; ++ti)
#pragma unroll
            for (int rg = 0; rg < 4; ++rg) uu[ti][rg] = *(const u32x2*)(proj + (m0 + t) * PN + C_GU + ch * 128 + ti * 32 + 8 * rg + 4 * h);
        const int G4 = lane >> 4, q4 = c >> 2, p4 = c & 3;
#pragma unroll
        for (int gi = 0; gi < 2; ++gi) { const int g = ch * 2 + gi;
            bf16x8 wf[8];
#pragma unroll
            for (int ks = 0; ks < 8; ++ks) wf[ks] = *(const bf16x8*)(wsb + ((size_t)g * 128 + t) * 128 + ks * 16 + 8 * h);
            const float bias = p.b_s[(l * 4 + g) * 128 + t];
#pragma unroll
            for (int ci = 0; ci < 2; ++ci) { const int c0 = g * 64 + ci * 32, ti = gi * 2 + ci;
                f32x16 acc; for (int i = 0; i < 16; ++i) acc[i] = 0.f;
                const LAS unsigned char* vb = lds + ((8 * (G4 >> 1) + q4) * GM_PITCH + c0 + 16 * (G4 & 1) + 4 * p4) * 2;
#pragma unroll
                for (int ks = 0; ks < 8; ++ks) { const bf16x8 af = cat8(tr_read(vb + (ks * 16) * GM_PITCH * 2), tr_read(vb + (ks * 16 + 4) * GM_PITCH * 2)); acc = MFMA32(af, wf[ks], acc); }
                bf16* op = mixcat + (m0 + t) * DM + 768 + c0;
#pragma unroll
                for (int rg = 0; rg < 4; ++rg) { const u32x2 w = uu[ti][rg]; u32x2 o;
                    o.x = pk2(gelu_as(bflo(w.x)) * (acc[4 * rg] + bias), gelu_as(bfhi(w.x)) * (acc[4 * rg + 1] + bias));
                    o.y = pk2(gelu_as(bflo(w.y)) * (acc[4 * rg + 2] + bias), gelu_as(bfhi(w.y)) * (acc[4 * rg + 3] + bias));
                    *(u32x2*)(op + 8 * rg + 4 * h) = o; } } }
        __syncthreads();
    }
}

constexpr int AT_PITCH = 144;
constexpr int AT_K = 0, AT_V = 384 * AT_PITCH, AT_BIAS = 2 * 384 * AT_PITCH, AT_BT = 321, AT_BYTES = AT_BIAS + 8 * AT_BT * 4;
#define AT_SOFTMAX(st, bth_, mrun_, lsum_, oa_, ob_, l2_) do { float mt_ = -3.0e38f; \
        _Pragma("unroll") for (int reg = 0; reg < 16; ++reg) { l2_[reg] = st[reg] * (0.125f * L2E) + (bth_)[band0 + crow(reg, h)]; mt_ = fmaxf(mt_, l2_[reg]); }   \
        { const auto rr_ = __builtin_amdgcn_permlane32_swap(__float_as_uint(mt_), __float_as_uint(mt_), false, false); mt_ = fmaxf(__uint_as_float(rr_[0]), __uint_as_float(rr_[1])); } \
        const float mnew_ = fmaxf(mrun_, mt_); \
        if (__any(mnew_ > mrun_)) { const float f_ = __builtin_amdgcn_exp2f(mrun_ - mnew_); lsum_ *= f_; _Pragma("unroll") for (int i = 0; i < 16; ++i) { oa_[i] *= f_; ob_[i] *= f_; } mrun_ = mnew_; } \
        float ps_ = 0.f; _Pragma("unroll") for (int reg = 0; reg < 16; ++reg) { l2_[reg] = __builtin_amdgcn_exp2f(l2_[reg] - mrun_); ps_ += l2_[reg]; } \
        lsum_ += ps_; } while (0)
__device__ __forceinline__ void ph_attn(const P& p, int l, LAS unsigned char* lds, int wg, int G) {
    const int tid = opaque_tid(), lane = tid & 63, wave = __builtin_amdgcn_readfirstlane(tid >> 6), r = lane & 31, h = lane >> 5;
    const bf16* proj = (const bf16*)(p.ws + WS_PROJ); bf16* mixcat = (bf16*)(p.ws + WS_MIXCAT);
    LAS float* bt = (LAS float*)(lds + AT_BIAS);
    const float L2E = 1.4426950408889634f;
    for (int i = tid; i < 8 * AT_BT; i += 512) { const int hd = i / AT_BT, rr = i - hd * AT_BT - 32; const int rc = rr < 0 ? 0 : (rr > 256 ? 256 : rr); const float bv = p.rel_bias[t5_bucket(rc - 128) * 8 + hd] * L2E; bt[i] = (rr < 0 || rr > 256) ? -3.0e38f : bv; }
    for (int ui = 0, u; (u = unit_of(wg, G, ui, 512)) < 512; ++ui) {
        const int b = u >> 5, n = (u >> 1) & 15, hk = u & 1;
        { u32x4 kv[6], vv[6];
#pragma unroll
          for (int i = 0; i < 6; ++i) { const int id = i * 512 + tid, row = id >> 3, chn = id & 7; int pos = (n - 1) * 128 + row; pos = pos < 0 ? 0 : (pos > SEQ - 1 ? SEQ - 1 : pos);
              const bf16* src = proj + ((size_t)b * SEQ + pos) * PN + hk * 64 + chn * 8; kv[i] = *(const u32x4*)(src + C_AK); vv[i] = *(const u32x4*)(src + C_AV); }
#pragma unroll
          for (int i = 0; i < 6; ++i) { const int id = i * 512 + tid, row = id >> 3, chn = id & 7;
              *(LAS u32x4*)(lds + AT_K + row * AT_PITCH + chn * 16) = kv[i]; *(LAS u32x4*)(lds + AT_V + row * AT_PITCH + chn * 16) = vv[i]; } }
        const int tq = wave & 3, hh0 = (wave >> 2) * 2, qloc = tq * 32 + r; const size_t m = (size_t)b * SEQ + n * 128 + qloc;
        bf16x8 qa[4], qb[4];
#pragma unroll
        for (int s = 0; s < 4; ++s) { qa[s] = *(const bf16x8*)(proj + m * PN + C_AQ + (hk * 4 + hh0) * 64 + s * 16 + 8 * h); qb[s] = *(const bf16x8*)(proj + m * PN + C_AQ + (hk * 4 + hh0 + 1) * 64 + s * 16 + 8 * h); }
        const float sinka = p.sink[l * 8 + hk * 4 + hh0] * L2E, sinkb = p.sink[l * 8 + hk * 4 + hh0 + 1] * L2E;
        __syncthreads();
        float mra = sinka, mrb = sinkb, lsa = 0.f, lsb = 0.f; f32x16 oa0, oa1, ob0, ob1; for (int i = 0; i < 16; ++i) { oa0[i] = 0.f; oa1[i] = 0.f; ob0[i] = 0.f; ob1[i] = 0.f; }
        const LAS float* btha = bt + (hk * 4 + hh0) * AT_BT + 32 - qloc; const LAS float* bthb = btha + AT_BT;
        const int G4 = lane >> 4, i16 = lane & 15, q4 = i16 >> 2, p4 = i16 & 3;
#pragma unroll 1
        for (int kt = 0; kt < 12; ++kt) { const int kb = kt >> 2, tk = kt & 3;
            const int blk = n - 1 + kb; if (blk < 0 || blk > 15) continue;
            if (kb == 0 && tk < tq) continue; if (kb == 2 && tk > tq) continue;
            const int band0 = kb * 128 + tk * 32;
            f32x16 sa, sb; for (int i = 0; i < 16; ++i) { sa[i] = 0.f; sb[i] = 0.f; }
#pragma unroll
            for (int s = 0; s < 4; ++s) { const bf16x8 kf = *(const LAS bf16x8*)(lds + AT_K + (band0 + r) * AT_PITCH + (s * 16 + 8 * h) * 2); sa = MFMA32(kf, qa[s], sa); sb = MFMA32(kf, qb[s], sb); }
            float la[16], lb[16];
            AT_SOFTMAX(sa, btha, mra, lsa, oa0, oa1, la);
            AT_SOFTMAX(sb, bthb, mrb, lsb, ob0, ob1, lb);
            const bf16x8 pa0 = pack8(la[0], la[1], la[2], la[3], la[4], la[5], la[6], la[7]), pa1 = pack8(la[8], la[9], la[10], la[11], la[12], la[13], la[14], la[15]);
            const bf16x8 pb0 = pack8(lb[0], lb[1], lb[2], lb[3], lb[4], lb[5], lb[6], lb[7]), pb1 = pack8(lb[8], lb[9], lb[10], lb[11], lb[12], lb[13], lb[14], lb[15]);
            const LAS unsigned char* vb = lds + AT_V + (band0 + 4 * (G4 >> 1) + q4) * AT_PITCH + (16 * (G4 & 1) + 4 * p4) * 2;
#pragma unroll
            for (int s = 0; s < 2; ++s) {
                const bf16x8 va0 = cat8(tr_read(vb + (16 * s) * AT_PITCH), tr_read(vb + (16 * s + 8) * AT_PITCH));
                const bf16x8 va1 = cat8(tr_read(vb + (16 * s) * AT_PITCH + 64), tr_read(vb + (16 * s + 8) * AT_PITCH + 64));
                oa0 = MFMA32(va0, s ? pa1 : pa0, oa0); oa1 = MFMA32(va1, s ? pa1 : pa0, oa1); ob0 = MFMA32(va0, s ? pb1 : pb0, ob0); ob1 = MFMA32(va1, s ? pb1 : pb0, ob1); }
        }
#pragma unroll
        for (int x = 0; x < 2; ++x) { float ls = x ? lsb : lsa; const float mr = x ? mrb : mra, sk = x ? sinkb : sinka;
            ls += __shfl_xor(ls, 32); ls += __builtin_amdgcn_exp2f(sk - mr);
            const float inv = 1.0f / ls; const f32x16 o0 = x ? ob0 : oa0, o1 = x ? ob1 : oa1;
            bf16* op = mixcat + m * DM + (hk * 4 + hh0 + x) * 64;
#pragma unroll
            for (int rg = 0; rg < 4; ++rg) { u32x2 w0, w1;
                w0.x = cvtpk(o0[4 * rg] * inv, o0[4 * rg + 1] * inv); w0.y = cvtpk(o0[4 * rg + 2] * inv, o0[4 * rg + 3] * inv);
                w1.x = cvtpk(o1[4 * rg] * inv, o1[4 * rg + 1] * inv); w1.y = cvtpk(o1[4 * rg + 2] * inv, o1[4 * rg + 3] * inv);
                *(u32x2*)(op + 8 * rg + 4 * h) = w0; *(u32x2*)(op + 32 + 8 * rg + 4 * h) = w1; } }
        __syncthreads();
    }
}
#undef AT_SOFTMAX

struct GateVec { int ta, tb; float b0, b1, fs0, fs1, pm0, pm1, total, mx; };
struct GateRaw { float ig0, ig1, f0, f1; };
__device__ __forceinline__ GateRaw gate_loads(const float* gates, size_t m0, int head, int dir, int lane) {
    const int ta = dir == 0 ? 2 * lane : 127 - 2 * lane, tb = dir == 0 ? ta + 1 : ta - 1;
    const float* ga = gates + (m0 + ta) * 16 + dir * 8 + head; const float* gb = gates + (m0 + tb) * 16 + dir * 8 + head;
    GateRaw g; g.ig0 = ga[0]; g.ig1 = gb[0]; g.f0 = ga[4]; g.f1 = gb[4]; return g; }
__device__ __forceinline__ GateVec gate_vectors(const GateRaw& g, int dir, int lane) {
    GateVec r; r.ta = dir == 0 ? 2 * lane : 127 - 2 * lane; r.tb = dir == 0 ? r.ta + 1 : r.ta - 1;
    const float ig0 = g.ig0, ig1 = g.ig1, lf0 = logsigmoid_f(g.f0), lf1 = logsigmoid_f(g.f1);
    const float s = lf0 + lf1, incl = wave_scan_sum(s), excl = incl - s;
    r.total = __builtin_bit_cast(float, __builtin_amdgcn_readlane(__builtin_bit_cast(int, incl), 63));
    r.b0 = excl + lf0; r.b1 = r.b0 + lf1; r.fs0 = ig0 - r.b0; r.fs1 = ig1 - r.b1;
    const float pi = wave_scan_max(fmaxf(r.fs0, r.fs1)), pe = dpp_id<0x138, 0xf>(-3.0e38f, pi);
    r.pm0 = fmaxf(pe, r.fs0); r.pm1 = fmaxf(r.pm0, r.fs1);
    r.mx = __builtin_bit_cast(float, __builtin_amdgcn_readlane(__builtin_bit_cast(int, pi), 63));
    return r;
}
constexpr int MA_P = 144;
constexpr int MA_K = 0, MA_VW = 128 * MA_P, MA_WEXP = 3 * 128 * MA_P, MA_BYTES = MA_WEXP + 1024;
__device__ __forceinline__ void ph_mlstm_a(const P& p, int l, LAS unsigned char* lds, int wg, int G) {
    const int tid = opaque_tid(), lane = tid & 63, wave = __builtin_amdgcn_readfirstlane(tid >> 6), r = lane & 31, h = lane >> 5;
    const bf16* proj = (const bf16*)(p.ws + WS_PROJ); bf16* qkt = (bf16*)(p.ws + WS_QKT); const float* gates = (const float*)(p.ws + WS_GATES);
    bf16* DC = (bf16*)(p.ws + WS_DC); float* DN = (float*)(p.ws + WS_DN); float* DS = (float*)(p.ws + WS_DS);
    LAS float* wexp = (LAS float*)(lds + MA_WEXP);
    const int c8 = tid & 7, isk = (tid >> 3) & 1, tq = tid >> 4, tv = tid >> 3;
    for (int ui = 0, u; (u = unit_of(wg, G, ui, 1024)) < 1024; ++ui) {
        const int b = u >> 6, head = (u >> 4) & 3, chunk = u & 15; const size_t m0 = (size_t)b * SEQ + chunk * 128;
        const GateRaw graw = gate_loads(gates, m0, head, wave & 1, lane);
        f32x4 wv[8];
        { const float* cwp = p.conv_w + (size_t)l * 3 * 512 + isk * 256 + head * 64 + c8 * 8; const float* cbp = p.conv_b + l * 512 + isk * 256 + head * 64 + c8 * 8;
#pragma unroll
          for (int tap = 0; tap < 3; ++tap) { wv[2 * tap] = *(const f32x4*)(cwp + tap * 512); wv[2 * tap + 1] = *(const f32x4*)(cwp + tap * 512 + 4); }
          wv[6] = *(const f32x4*)cbp; wv[7] = *(const f32x4*)(cbp + 4); }
        u32x4 xl[3][4];
#pragma unroll
        for (int i = 0; i < 4; ++i) { const int t = tq + 32 * i, tpos = chunk * 128 + t; const bf16* pr = proj + (m0 + t) * PN + (isk ? C_MK : C_MQ) + head * 64 + c8 * 8;
            xl[1][i] = *(const u32x4*)pr; xl[0][i] = *(const u32x4*)(tpos > 0 ? pr - PN : pr); xl[2][i] = *(const u32x4*)(tpos < SEQ - 1 ? pr + PN : pr); }
        u32x4 vpre[2];
#pragma unroll
        for (int i = 0; i < 2; ++i) vpre[i] = *(const u32x4*)(proj + (m0 + tv + 64 * i) * PN + C_MV + head * 64 + c8 * 8);
        if (wave < 2) { const int dir = wave; const GateVec gv = gate_vectors(graw, dir, lane);
            wexp[dir * 128 + gv.ta] = __expf(gv.fs0 - gv.mx); wexp[dir * 128 + gv.tb] = __expf(gv.fs1 - gv.mx);
            if (lane == 0) { DS[(size_t)(u * 2 + dir) * 2] = gv.total; DS[(size_t)(u * 2 + dir) * 2 + 1] = gv.total + gv.mx; } }
        { const float sc = isk ? 0.125f : 1.0f;
#pragma unroll
          for (int i = 0; i < 4; ++i) { const int t = tq + 32 * i, tpos = chunk * 128 + t; const bool hp = tpos > 0, hn = tpos < SEQ - 1;
              const u32x4 z = (u32x4){0u, 0u, 0u, 0u}; const u32x4 x0 = hp ? xl[0][i] : z, x1 = xl[1][i], x2 = hn ? xl[2][i] : z;
              float y[8];
#pragma unroll
              for (int q = 0; q < 4; ++q) { const int c = 2 * q;
                  y[c] = wv[6 + (c >> 2)][c & 3] + wv[c >> 2][c & 3] * bflo(x0[q]) + wv[2 + (c >> 2)][c & 3] * bflo(x1[q]) + wv[4 + (c >> 2)][c & 3] * bflo(x2[q]);
                  y[c + 1] = wv[6 + (c >> 2)][(c & 3) + 1] + wv[c >> 2][(c & 3) + 1] * bfhi(x0[q]) + wv[2 + (c >> 2)][(c & 3) + 1] * bfhi(x1[q]) + wv[4 + (c >> 2)][(c & 3) + 1] * bfhi(x2[q]); }
#pragma unroll
              for (int k = 0; k < 8; ++k) y[k] = silu_acc(y[k]) * sc;
              u32x4 o; o.x = pk2(y[0], y[1]); o.y = pk2(y[2], y[3]); o.z = pk2(y[4], y[5]); o.w = pk2(y[6], y[7]);
              *(u32x4*)(qkt + (m0 + t) * 512 + isk * 256 + head * 64 + c8 * 8) = o;
              if (isk) *(LAS u32x4*)(lds + MA_K + t * MA_P + c8 * 16) = o; } }
        __syncthreads();
#pragma unroll
        for (int i = 0; i < 2; ++i) { const int t = tv + 64 * i; const float wf = wexp[t], wb = wexp[128 + t]; const u32x4 x = vpre[i]; u32x4 of, ob;
#pragma unroll
            for (int q = 0; q < 4; ++q) { const float lo = bflo(x[q]), hi = bfhi(x[q]); of[q] = pk2(lo * wf, hi * wf); ob[q] = pk2(lo * wb, hi * wb); }
            *(LAS u32x4*)(lds + MA_VW + t * MA_P + c8 * 16) = of; *(LAS u32x4*)(lds + MA_VW + (128 + t) * MA_P + c8 * 16) = ob; }
        __syncthreads();
        { const int dir = wave >> 2, et = (wave >> 1) & 1, dt = wave & 1;
          const int G4 = lane >> 4, i16 = lane & 15, q4 = i16 >> 2, p4 = i16 & 3;
          const LAS unsigned char* ab = lds + MA_VW + (dir * 128 + 4 * (G4 >> 1) + q4) * MA_P + (et * 32 + 16 * (G4 & 1) + 4 * p4) * 2;
          const LAS unsigned char* bb = lds + MA_K + (4 * (G4 >> 1) + q4) * MA_P + (dt * 32 + 16 * (G4 & 1) + 4 * p4) * 2;
          f32x16 acc, accn; for (int i = 0; i < 16; ++i) { acc[i] = 0.f; accn[i] = 0.f; }
#pragma unroll
          for (int ks = 0; ks < 8; ++ks) { const bf16x8 af = cat8(tr_read(ab + (16 * ks) * MA_P), tr_read(ab + (16 * ks + 8) * MA_P)), kf = cat8(tr_read(bb + (16 * ks) * MA_P), tr_read(bb + (16 * ks + 8) * MA_P));
              acc = MFMA32(af, kf, acc);
              if (et == 0) { const f32x4 w0 = *(const LAS f32x4*)(wexp + dir * 128 + 16 * ks + 4 * h), w1 = *(const LAS f32x4*)(wexp + dir * 128 + 16 * ks + 8 + 4 * h);
                  const bool r0 = r == 0; const bf16x8 wa = pack8(r0 ? w0[0] : 0.f, r0 ? w0[1] : 0.f, r0 ? w0[2] : 0.f, r0 ? w0[3] : 0.f, r0 ? w1[0] : 0.f, r0 ? w1[1] : 0.f, r0 ? w1[2] : 0.f, r0 ? w1[3] : 0.f);
                  accn = MFMA32(wa, kf, accn); } }
          bf16* dc = DC + (size_t)(u * 2 + dir) * 4096;
#pragma unroll
          for (int reg = 0; reg < 16; ++reg) dc[(et * 32 + crow(reg, h)) * 64 + dt * 32 + r] = (bf16)f2bf(acc[reg]);
          if (et == 0 && h == 0) DN[(size_t)(u * 2 + dir) * 64 + dt * 32 + r] = accn[0]; }
        __syncthreads();
    }
}
constexpr int MC_PITCH = 144;
constexpr int MC_Q = 0, MC_K = 128 * MC_PITCH, MC_V = 2 * 128 * MC_PITCH, MC_C = 3 * 128 * MC_PITCH;
constexpr int MC_X = 131072 + 1024;
constexpr int MC_VEC = MC_X, MC_COEF = MC_VEC + 3072, MC_MS = MC_COEF + 512, MC_N = MC_MS + 64;
constexpr int MC_HP = 66;
__device__ __forceinline__ void ph_mlstm_c(const P& p, int l, LAS unsigned char* lds, int wg, int G) {
    const int tid = opaque_tid(), lane = tid & 63, wave = __builtin_amdgcn_readfirstlane(tid >> 6), r = lane & 31, h = lane >> 5;
    const bf16* proj = (const bf16*)(p.ws + WS_PROJ); const bf16* qkt = (const bf16*)(p.ws + WS_QKT); const float* gates = (const float*)(p.ws + WS_GATES); bf16* mixcat = (bf16*)(p.ws + WS_MIXCAT);
    const bf16* DC = (const bf16*)(p.ws + WS_DC); const float* DN = (const float*)(p.ws + WS_DN); const float* DS = (const float*)(p.ws + WS_DS);
    LAS float* nvecS = (LAS float*)(lds + MC_N); LAS float* vfs = (LAS float*)(lds + MC_VEC); LAS float* vM = vfs + 256; LAS float* vb = vfs + 512;
    LAS float* coefS = (LAS float*)(lds + MC_COEF); LAS float* mS = (LAS float*)(lds + MC_MS);
    LAS unsigned short* hbuf = (LAS unsigned short*)lds;
    for (int ui = 0, u4; (u4 = unit_of(wg, G, ui, 256)) < 256; ++ui) {
        const int b = u4 >> 4, head = (u4 >> 2) & 3, c0 = (u4 & 3) * 4, ubase = (b * 4 + head) * 16;
        u32x4 dcr[18]; float dnr[18];
        { const f32x2c dsv = *(const f32x2c*)(DS + (size_t)((ubase + (lane & 15)) * 2 + (wave & 1)) * 2);
#pragma unroll
          for (int i = 0; i < 18; ++i) { const int dj = i >= c0 + 3 ? 1 : 0, j = dj ? i - 2 : i;
              dcr[i] = *(const u32x4*)(DC + (size_t)((ubase + j) * 2 + dj) * 4096 + tid * 8);
              dnr[i] = DN[(size_t)((ubase + j) * 2 + dj) * 64 + lane]; }
          const int dir = wave & 1, chunk = c0 + (wave >> 1), n = dir == 0 ? chunk : 15 - chunk;
          const bool in16 = lane < 16, valid = in16 && (dir == 0 ? lane < chunk : lane > chunk);
          const float bLv = in16 ? dsv[0] : 0.f, mlv = dsv[1];
          const float Pf = wave_scan_sum(bLv);
          const float Pc1 = __shfl(Pf, chunk > 0 ? chunk - 1 : 0), Pc = __shfl(Pf, chunk), P15 = __shfl(Pf, 15);
          const float Si = dir == 0 ? Pc1 - Pf : (Pf - bLv) - Pc, Sall = dir == 0 ? Pc1 : P15 - Pc;
          const float cand = valid ? mlv + Si : -3.0e38f;
          const float m = n > 0 ? fmaxf(Sall, wave_max(cand)) : 0.f;
          if (in16) coefS[wave * 16 + lane] = valid ? __expf(cand - m) : 0.f;
          if (lane == 0) mS[wave] = m; }
        __syncthreads();
        { float acc[4][8], accn[4];
#pragma unroll
          for (int k = 0; k < 4; ++k) { accn[k] = 0.f;
#pragma unroll
              for (int e = 0; e < 8; ++e) acc[k][e] = 0.f; }
#pragma unroll
          for (int i = 0; i < 18; ++i) { const int dj = i >= c0 + 3 ? 1 : 0, j = dj ? i - 2 : i;
              float x[8];
#pragma unroll
              for (int q = 0; q < 4; ++q) { x[2 * q] = bflo(dcr[i][q]); x[2 * q + 1] = bfhi(dcr[i][q]); }
#pragma unroll
              for (int k = 0; k < 4; ++k) { const float cf = coefS[(k * 2 + dj) * 16 + j]; accn[k] += cf * dnr[i];
#pragma unroll
                  for (int e = 0; e < 8; ++e) acc[k][e] += cf * x[e]; }
              if (i == 17 || ((i == 2 || i == 6 || i == 10 || i == 14) && i == c0 + 2)) { const int dd = i == 17 ? 1 : 0;
#pragma unroll
                  for (int k = 0; k < 4; ++k) { u32x4 o;
#pragma unroll
                      for (int q = 0; q < 4; ++q) o[q] = pk2(acc[k][2 * q], acc[k][2 * q + 1]);
                      *(LAS u32x4*)(lds + MC_C + ((k * 2 + dd) * 64 + (tid >> 3)) * MC_PITCH + (tid & 7) * 16) = o;
                      if (tid < 64) nvecS[(k * 2 + dd) * 64 + tid] = accn[k];
                      accn[k] = 0.f;
#pragma unroll
                      for (int e = 0; e < 8; ++e) acc[k][e] = 0.f; } } } }
#pragma unroll 1
        for (int kc = 0; kc < 4; ++kc) { const int chunk = c0 + kc; const size_t m0 = (size_t)b * SEQ + chunk * 128;
        const GateRaw graw = gate_loads(gates, m0, head, wave & 1, lane);
        u32x4 stg[6];
#pragma unroll
        for (int i = 0; i < 6; ++i) { const int id = i * 512 + tid, arr = id >> 10, rem = id & 1023, row = rem >> 3, chn = rem & 7;
            const bf16* src = arr == 2 ? proj + (m0 + row) * PN + C_MV + head * 64 + chn * 8 : qkt + (m0 + row) * 512 + arr * 256 + head * 64 + chn * 8;
            stg[i] = *(const u32x4*)src; }
        u32x4 mopre[2];
#pragma unroll
        for (int i = 0; i < 2; ++i) { const int id = i * 512 + tid; mopre[i] = *(const u32x4*)(proj + (m0 + (id >> 3)) * PN + C_MO + head * 64 + (id & 7) * 8); }
        if (wave < 2) { const int dir = wave; const GateVec gv = gate_vectors(graw, dir, lane);
            vfs[dir * 128 + gv.ta] = gv.fs0; vfs[dir * 128 + gv.tb] = gv.fs1;
            vM[dir * 128 + gv.ta] = gv.pm0; vM[dir * 128 + gv.tb] = gv.pm1;
            vb[dir * 128 + gv.ta] = gv.b0; vb[dir * 128 + gv.tb] = gv.b1; }
#pragma unroll
        for (int i = 0; i < 6; ++i) { const int id = i * 512 + tid, arr = id >> 10, rem = id & 1023, row = rem >> 3, chn = rem & 7;
            *(LAS u32x4*)(lds + arr * 128 * MC_PITCH + row * MC_PITCH + chn * 16) = stg[i]; }
        __syncthreads();
        const int dir = wave >> 2, tt = wave & 3, t = tt * 32 + r;
        const LAS unsigned char* Cs = lds + MC_C + (kc * 2 + dir) * 64 * MC_PITCH; const LAS float* nvec = nvecS + (kc * 2 + dir) * 64; const float mC = mS[kc * 2 + dir];
        f32x16 nS0, nS1, nI0, nI1; for (int i = 0; i < 16; ++i) { nS0[i] = 0.f; nS1[i] = 0.f; nI0[i] = 0.f; nI1[i] = 0.f; }
        float dinv, iw;
        {
            bf16x8 qf[4];
#pragma unroll
            for (int s = 0; s < 4; ++s) qf[s] = *(const LAS bf16x8*)(lds + MC_Q + t * MC_PITCH + (s * 16 + 8 * h) * 2);
            const float Mt = fmaxf(mC, vM[dir * 128 + t]); float rowsum = 0.f;
#pragma unroll 1
            for (int st = 0; st < 4; ++st) { if (dir == 0 ? st > tt : st < tt) continue;
                f32x16 sT; for (int i = 0; i < 16; ++i) sT[i] = 0.f;
#pragma unroll
                for (int s = 0; s < 4; ++s) { const bf16x8 kf = *(const LAS bf16x8*)(lds + MC_K + (st * 32 + r) * MC_PITCH + (s * 16 + 8 * h) * 2); sT = MFMA32(kf, qf[s], sT); }
                float pv[16];
#pragma unroll
                for (int rg = 0; rg < 4; ++rg) { const f32x4 f4 = *(const LAS f32x4*)(vfs + dir * 128 + st * 32 + 8 * rg + 4 * h);
#pragma unroll
                    for (int k = 0; k < 4; ++k) { const int si = st * 32 + 8 * rg + 4 * h + k; const bool ok = dir == 0 ? si <= t : si >= t;
                        const float dv = ok ? __expf(f4[k] - Mt) : 0.f; pv[4 * rg + k] = sT[4 * rg + k] * dv; rowsum += pv[4 * rg + k]; } }
                const bf16x8 pf0 = pack8(pv[0], pv[1], pv[2], pv[3], pv[4], pv[5], pv[6], pv[7]), pf1 = pack8(pv[8], pv[9], pv[10], pv[11], pv[12], pv[13], pv[14], pv[15]);
                const int G4 = lane >> 4, i16 = lane & 15, q4 = i16 >> 2, p4 = i16 & 3;
                const LAS unsigned char* vbp = lds + MC_V + (st * 32 + 4 * (G4 >> 1) + q4) * MC_PITCH + (16 * (G4 & 1) + 4 * p4) * 2;
#pragma unroll
                for (int s = 0; s < 2; ++s) { const bf16x8 pf = s ? pf1 : pf0;
                    const bf16x8 va0 = cat8(tr_read(vbp + (16 * s) * MC_PITCH), tr_read(vbp + (16 * s + 8) * MC_PITCH));
                    const bf16x8 va1 = cat8(tr_read(vbp + (16 * s) * MC_PITCH + 64), tr_read(vbp + (16 * s + 8) * MC_PITCH + 64));
                    nS0 = MFMA32(va0, pf, nS0); nS1 = MFMA32(va1, pf, nS1); }
            }
            float nq = 0.f;
#pragma unroll
            for (int s = 0; s < 4; ++s) { const bf16x8 cc0 = *(const LAS bf16x8*)(Cs + r * MC_PITCH + (s * 16 + 8 * h) * 2), cc1 = *(const LAS bf16x8*)(Cs + (32 + r) * MC_PITCH + (s * 16 + 8 * h) * 2);
                nI0 = MFMA32(cc0, qf[s], nI0); nI1 = MFMA32(cc1, qf[s], nI1);
#pragma unroll
                for (int j = 0; j < 8; ++j) nq += nvec[s * 16 + 8 * h + j] * bf2f((unsigned short)qf[s][j]); }
            nq += __shfl_xor(nq, 32); rowsum += __shfl_xor(rowsum, 32);
            iw = __expf(mC - Mt);
            const float den = rowsum + iw * nq, lower = __expf(-(vb[dir * 128 + t] + Mt));
            dinv = 1.0f / fmaxf(fabsf(den), lower);
        }
        __syncthreads();
#pragma unroll
        for (int reg = 0; reg < 16; ++reg) { const int e = crow(reg, h);
            hbuf[(dir * 128 + t) * MC_HP + e] = f2bf((nS0[reg] + iw * nI0[reg]) * dinv); hbuf[(dir * 128 + t) * MC_HP + 32 + e] = f2bf((nS1[reg] + iw * nI1[reg]) * dinv); }
        __syncthreads();
#pragma unroll
        for (int i = 0; i < 2; ++i) { const int id = i * 512 + tid, tq = id >> 3, e0 = (id & 7) * 8; float o[8];
#pragma unroll
            for (int k = 0; k < 4; ++k) { const unsigned wf = *(const LAS unsigned*)(hbuf + tq * MC_HP + e0 + 2 * k), wb = *(const LAS unsigned*)(hbuf + (128 + tq) * MC_HP + e0 + 2 * k);
                o[2 * k] = sigmoid_f(bflo(mopre[i][k])) * (bflo(wf) + bflo(wb)); o[2 * k + 1] = sigmoid_f(bfhi(mopre[i][k])) * (bfhi(wf) + bfhi(wb)); }
            u32x4 w; w.x = pk2(o[0], o[1]); w.y = pk2(o[2], o[3]); w.z = pk2(o[4], o[5]); w.w = pk2(o[6], o[7]);
            *(u32x4*)(mixcat + (m0 + tq) * DM + 512 + head * 64 + e0) = w; }
        __syncthreads();
        }
    }
}

typedef GAS unsigned gu32;
#define RLX_AGENT __ATOMIC_RELAXED, __HIP_MEMORY_SCOPE_AGENT
#define XB_TMO      128
#define XB_XCNT(j)  (256  + 64 * (j))
#define XB_XSUB(j)  (1280 + 64 * (j))
#define XB_XGEN(j)  (2304 + 64 * (j))
#define XB_TOP      3328
#define XB_TOPGEN   3392
#define XCD_BAR_WORDS 3456
#define XB_SPIN_CAP (1u << 18)

__device__ __forceinline__ unsigned xb_ld(unsigned* p)              { return __hip_atomic_load(p, __ATOMIC_RELAXED, __HIP_MEMORY_SCOPE_AGENT); }
__device__ __forceinline__ unsigned xb_add(unsigned* p, unsigned v) { return __hip_atomic_fetch_add(p, v, __ATOMIC_RELAXED, __HIP_MEMORY_SCOPE_AGENT); }
__device__ __forceinline__ unsigned xb_xcc_id() { return (unsigned)__builtin_amdgcn_s_getreg((3 << 11) | 20) & 0xFu; }
#define XB_SPIN(cond, bar) do { unsigned _sp = 0; while (cond) { __builtin_amdgcn_s_sleep(1); \
    if ((++_sp & 255u) == 0u) { if (xb_ld(&(bar)[XB_TMO])) break; if (_sp > XB_SPIN_CAP) { atomicAdd(&(bar)[XB_TMO], 1u); break; } } } } while (0)

struct XcdBarrier {
    unsigned* bar; unsigned x;
    volatile LAS unsigned* st;
};

__device__ __forceinline__ XcdBarrier xcd_barrier_post(unsigned* bar, volatile LAS unsigned* st) {
    XcdBarrier b; b.bar = bar; b.x = xb_xcc_id(); b.st = st;
    if (threadIdx.x == 0) (void)xb_add(&bar[XB_XCNT(b.x)], 1u);
    return b;
}
__device__ __forceinline__ void xcd_barrier_complete(unsigned* bar, unsigned x, unsigned& nloc, unsigned& nx) {
    const unsigned G = gridDim.x * gridDim.y * gridDim.z;
    unsigned sum, cnt, mine, sp = 0u;
    for (;;) {
        sum = 0u; cnt = 0u; mine = 0u;
#pragma unroll
        for (unsigned j = 0; j < 16; ++j) { const unsigned c = xb_ld(&bar[XB_XCNT(j)]); sum += c; cnt += (c > 0u) ? 1u : 0u; mine = (j == x) ? c : mine; }
        if (sum == G) break;
        __builtin_amdgcn_s_sleep(1);
        if ((++sp & 255u) == 0u) { if (xb_ld(&bar[XB_TMO])) break; if (sp > XB_SPIN_CAP) { atomicAdd(&bar[XB_TMO], 1u); break; } }
    }
    nloc = mine > 0u ? mine : 1u; nx = cnt > 0u ? cnt : 1u;
}

__device__ __forceinline__ void xcd_barrier(const XcdBarrier& b) {
    asm volatile("s_waitcnt vmcnt(0)" ::: "memory");
    __syncthreads();
    if (threadIdx.x == 0) {
        unsigned* bar = b.bar;
        __builtin_amdgcn_s_waitcnt(0);
        unsigned nloc = b.st[0], nx = b.st[1];
        if (nloc == 0u) { xcd_barrier_complete(bar, b.x, nloc, nx); b.st[0] = nloc; b.st[1] = nx; }
        const unsigned old = xb_add(&bar[XB_XSUB(b.x)], 1u);
        const unsigned gen = old / nloc;
        if (old + 1u == (gen + 1u) * nloc) {
            __builtin_amdgcn_fence(__ATOMIC_RELEASE, "agent");
            asm volatile("s_waitcnt vmcnt(0)" ::: "memory");
            const unsigned og = xb_add(&bar[XB_TOP], 1u);
            const unsigned tg = og / nx;
            if (og + 1u == (tg + 1u) * nx) xb_add(&bar[XB_TOPGEN], 1u);
            else XB_SPIN(xb_ld(&bar[XB_TOPGEN]) == tg, bar);
            __builtin_amdgcn_fence(__ATOMIC_ACQUIRE, "agent");
            xb_add(&bar[XB_XGEN(b.x)], 1u);
            asm volatile("s_waitcnt vmcnt(0)" ::: "memory");
        } else {
            XB_SPIN(xb_ld(&bar[XB_XGEN(b.x)]) == gen, bar);
            __builtin_amdgcn_fence(__ATOMIC_ACQUIRE, "agent");
            asm volatile("s_waitcnt vmcnt(0)" ::: "memory");
        }
    }
    __syncthreads();
}


constexpr int CW_Q = 8192;
__device__ __forceinline__ bool conv_batch(const P& p, int ql, volatile LAS unsigned* wl, LAS unsigned char* L) {
    const int tid = opaque_tid(), lane = tid & 63, wave = __builtin_amdgcn_readfirstlane(tid >> 6);
    if (tid == 0) wl[3] = __hip_atomic_fetch_add((unsigned*)(p.ws + WS_CTL) + CW_Q + 64 * ql, 8u, __ATOMIC_RELAXED, __HIP_MEMORY_SCOPE_AGENT);
    __syncthreads();
    const unsigned base = wl[3];
    if (base + wave < (unsigned)ITM) convert_item(p, ql, ITS + (int)base + wave, (LAS float*)L + wave * (64 * 33), lane);
    __syncthreads();
    return base + 8u < (unsigned)ITM;
}
__device__ __forceinline__ void conv_drain(const P& p, int& qa, int upto, volatile LAS unsigned* wl, LAS unsigned char* L) { while (qa <= upto) { if (!conv_batch(p, qa, wl, L)) ++qa; } }
__device__ __forceinline__ void xcd_barrier_work(const XcdBarrier& b, const P& p, int& qa, volatile LAS unsigned* wl, LAS unsigned char* L) {
    asm volatile("s_waitcnt vmcnt(0)" ::: "memory");
    __syncthreads();
    if (threadIdx.x == 0) {
        unsigned* bar = b.bar;
        __builtin_amdgcn_s_waitcnt(0);
        unsigned nloc = b.st[0], nx = b.st[1];
        if (nloc == 0u) { xcd_barrier_complete(bar, b.x, nloc, nx); b.st[0] = nloc; b.st[1] = nx; }
        const unsigned old = xb_add(&bar[XB_XSUB(b.x)], 1u);
        const unsigned gen = old / nloc;
        if (old + 1u == (gen + 1u) * nloc) {
            __builtin_amdgcn_fence(__ATOMIC_RELEASE, "agent");
            asm volatile("s_waitcnt vmcnt(0)" ::: "memory");
            const unsigned og = xb_add(&bar[XB_TOP], 1u);
            const unsigned tg = og / nx;
            if (og + 1u == (tg + 1u) * nx) { xb_add(&bar[XB_TOPGEN], 1u); wl[0] = 2u; }
            else { wl[0] = 1u; wl[1] = tg; }
        } else { wl[0] = 0u; wl[1] = gen; }
    }
    unsigned polls = 0u;
    for (;;) {
        if (threadIdx.x == 0) { unsigned* bar = b.bar; const unsigned role = wl[0], want = wl[1];
            bool done = role == 2u || (role == 1u ? xb_ld(&bar[XB_TOPGEN]) != want : xb_ld(&bar[XB_XGEN(b.x)]) != want);
            if (!done && (++polls & 255u) == 0u) { if (xb_ld(&bar[XB_TMO])) done = true; else if (polls > XB_SPIN_CAP) { atomicAdd(&bar[XB_TMO], 1u); done = true; } }
            wl[2] = done ? 1u : 0u; }
        __syncthreads();
        const bool done = wl[2] != 0u;
        __syncthreads();
        if (done) break;
        if (qa < DEPTH) { if (!conv_batch(p, qa, wl, L)) ++qa; } else __builtin_amdgcn_s_sleep(2);
    }
    if (threadIdx.x == 0) { unsigned* bar = b.bar;
        if (wl[0] != 0u) { __builtin_amdgcn_fence(__ATOMIC_ACQUIRE, "agent"); xb_add(&bar[XB_XGEN(b.x)], 1u); asm volatile("s_waitcnt vmcnt(0)" ::: "memory"); }
        else { __builtin_amdgcn_fence(__ATOMIC_ACQUIRE, "agent"); asm volatile("s_waitcnt vmcnt(0)" ::: "memory"); }
    }
    __syncthreads();
}

__device__ __forceinline__ void ph_mod(const P& p, LAS unsigned char* lds, int wg, int G) {
    const int tid = opaque_tid(), lane = tid & 63, wave = __builtin_amdgcn_readfirstlane(tid >> 6);
    LAS float* sc = (LAS float*)lds;
    LAS float* red = (LAS float*)(lds + 65536);
    if (wg >= 384) return;
    for (int i = tid; i < 16 * DM; i += 512) { const int b = i >> 10, k = i & 1023; sc[k * 16 + b] = silu_acc(p.c[i]); }
    __syncthreads();
    float* mod = (float*)(p.ws + WS_MOD);
    for (int u = wg; u < 384; u += G) { const int l = u / 96, n0 = (u % 96) * 64;
        const float* w = p.w_ada + (size_t)l * DM * 6144 + (size_t)(wave * 128) * 6144 + n0 + lane;
        float acc[16];
#pragma unroll
        for (int b = 0; b < 16; ++b) acc[b] = 0.f;
#pragma unroll 4
        for (int k = 0; k < 128; ++k) { const float wv = w[(size_t)k * 6144]; const LAS f32x4* s4 = (const LAS f32x4*)(sc + (wave * 128 + k) * 16);
#pragma unroll
            for (int q = 0; q < 4; ++q) { const f32x4 s = s4[q]; acc[4 * q] += s[0] * wv; acc[4 * q + 1] += s[1] * wv; acc[4 * q + 2] += s[2] * wv; acc[4 * q + 3] += s[3] * wv; } }
#pragma unroll
        for (int b = 0; b < 16; ++b) red[(wave * 16 + b) * 64 + lane] = acc[b];
        __syncthreads();
        for (int i = tid; i < 1024; i += 512) { const int b = i >> 6, c = i & 63; float s = p.b_ada[l * 6144 + n0 + c];
#pragma unroll
            for (int wv = 0; wv < 8; ++wv) s += red[(wv * 16 + b) * 64 + c];
            mod[((size_t)l * 16 + b) * 6144 + n0 + c] = s; }
        __syncthreads();
    }
}

constexpr int LDS_MAIN = 131072, LDS_TOTAL = 147456, MISC_OFF = LDS_MAIN + 320;
constexpr int CW_BAR = 4096;
constexpr size_t CTL_ZERO = 65536;
constexpr int NSEQ = 2 + 9 * DEPTH;
struct Args { P p; int lo, hi; };
typedef const __attribute__((address_space(4))) Args* kargs_t;
__global__ void __launch_bounds__(512, 2) mk_fwd(Args a) {
    extern __shared__ __attribute__((aligned(16))) unsigned char lds_raw[];
    LAS unsigned char* L = (LAS unsigned char*)lds_raw;
    kargs_t ap0 = (kargs_t)__builtin_amdgcn_kernarg_segment_ptr();
#define LOADP() kargs_t ap_ = ap0; asm volatile("" : "+s"(ap_)); const P p = {ap_->p.x, ap_->p.c, ap_->p.w_ada, ap_->p.b_ada, ap_->p.w_in, ap_->p.conv_w, ap_->p.conv_b, ap_->p.gate_b, ap_->p.sink, ap_->p.rel_bias, ap_->p.w_s, ap_->p.b_s, ap_->p.w_out, ap_->p.w_router, ap_->p.w_gate, ap_->p.w_up, ap_->p.w_down, ap_->p.ln_g, ap_->p.ln_b, ap_->p.out, ap_->p.ws}; unsigned char* ws = p.ws
    const int wg = blockIdx.x, G = gridDim.x;
    { const int tid = opaque_tid(); for (int i = tid; i < (LDS_TOTAL - LDS_MAIN) / 4; i += 512) ((LAS unsigned*)(L + LDS_MAIN))[i] = 0u; }
    __syncthreads();
    XcdBarrier bar;
    { LOADP(); bar = xcd_barrier_post((unsigned*)(ws + WS_CTL) + CW_BAR, (volatile LAS unsigned*)(L + MISC_OFF) + 8); }
    int seq = 0; int qa = 0;
#ifndef DUPM
#define DUPM 0
#endif
#define DUP(i) for (int rep_ = 0; rep_ < ((DUPM >> (i)) & 1); ++rep_)
#ifndef PHM
#define PHM 0xfffff
#endif
#define RUN() (seq >= a.lo && seq < a.hi)
#define SEAM() do { if (seq + 1 < a.hi) xcd_barrier_work(bar, p, qa, (volatile LAS unsigned*)(L + MISC_OFF) + 16, L); } while (0)
    if (((PHM >> 0) & 1) && RUN()) {
        LOADP(); ph_mod(p, L, wg, G);
        const int tid = opaque_tid(), lane = tid & 63, wave = __builtin_amdgcn_readfirstlane(tid >> 6), gw = wg * 8 + wave, ngw = G * 8;
        { LAS float* scr = (LAS float*)L + wave * (64 * 33); for (int it = gw; it < DEPTH * ITS; it += ngw) convert_item(p, it / ITS, it % ITS, scr, lane); }
        { bf16* wsb = (bf16*)(ws + WS_WS); for (int i = wg * 512 + tid; i < DEPTH * 4 * 128 * 128; i += G * 512) wsb[i] = (bf16)f2bf(p.w_s[i]); }
        SEAM(); }
    ++seq;
    if (((PHM >> 1) & 1) && RUN()) { LOADP(); rows_entry_simple(p, wg, G); SEAM(); }
    ++seq;
#pragma unroll 1
    for (int l = 0; l < DEPTH; ++l) {
        if (((PHM >> 2) & 1) && RUN()) { LOADP();
            pg8::Gemm g{(const bf16*)(ws + WS_H), (const bf16*)(ws + WS_WIN) + (size_t)l * PNW * DM, NTOK, PNW, DM}; pg8::EpiProj E{(bf16*)(ws + WS_PROJ), (float*)(ws + WS_GATES), p.gate_b + l * 16};
            pg8::StaticOrder S; S.init(NTOK, PNW, G, wg);
            pg8::gemm_phase<pg8::EpiProj, pg8::StaticOrder, true, true>(L, g, S, E); SEAM(); }
        ++seq;
        if (((PHM >> 3) & 1) && RUN()) { LOADP(); DUP(2) ph_attn(p, l, L, wg, G); ph_attn(p, l, L, wg, G); DUP(3) ph_gmlp(p, l, L, wg, G); ph_gmlp(p, l, L, wg, G); DUP(4) ph_mlstm_a(p, l, L, wg, G); ph_mlstm_a(p, l, L, wg, G); SEAM(); }
        ++seq;
        if (((PHM >> 4) & 1) && RUN()) { LOADP(); DUP(5) ph_mlstm_c(p, l, L, wg, G); ph_mlstm_c(p, l, L, wg, G); SEAM(); }
        ++seq;
        if (((PHM >> 5) & 1) && RUN()) { LOADP();
            pg8::Gemm g{(const bf16*)(ws + WS_MIXCAT), (const bf16*)(ws + WS_WOUT) + (size_t)l * DM * DM, NTOK, DM, DM}; pg8::EpiBf16 E{(bf16*)(ws + WS_MIX), DM};
            pg8::StaticOrder S; S.init(NTOK, DM, G, wg);
            pg8::gemm_phase<pg8::EpiBf16, pg8::StaticOrder, true, true>(L, g, S, E); SEAM(); }
        ++seq;
        if (((PHM >> 6) & 1) && RUN()) { LOADP(); DUP(9) rows_phase<1>(p, l, l == 0 ? p.x : (const float*)(ws + WS_XA), L, wg, G, true); rows_phase<1>(p, l, l == 0 ? p.x : (const float*)(ws + WS_XA), L, wg, G); SEAM(); }
        ++seq;
        if (((PHM >> 7) & 1) && RUN()) { LOADP(); ph_topk(p, L, wg, G); conv_drain(p, qa, l, (volatile LAS unsigned*)(L + MISC_OFF) + 16, L); SEAM(); }
        ++seq;
        if (((PHM >> 8) & 1) && RUN()) { LOADP();
            pg8::Gemm g{(const bf16*)(ws + WS_H8), (const bf16*)(ws + WS_WGU + (size_t)l * NE * 4096 * DM), NGRP * 256, 4096, DM, SC_A1, SC_B1}; pg8::EpiSwiGLU8 E{ws + WS_HID};
            pg8::MoeOrder1 S; S.G = G; S.c = wg; S.idx = (const unsigned short*)(ws + WS_IDX);
            pg8::gemm_phase<pg8::EpiSwiGLU8, pg8::MoeOrder1, true, true, true, true>(L, g, S, E); SEAM(); }
        ++seq;
        if (((PHM >> 9) & 1) && RUN()) { LOADP();
            pg8::Gemm g{(const bf16*)(ws + WS_HID), (const bf16*)(ws + WS_WD + (size_t)l * NE * DM * DE), NGRP * 256, DM, DE, SC_A2, SC_B2}; pg8::EpiScaleFp8 E{ws + WS_YE, (const float*)(ws + WS_GATEV)};
            pg8::MoeOrder2 S; S.G = G; S.c = wg;
            pg8::gemm_phase<pg8::EpiScaleFp8, pg8::MoeOrder2, true, true, true>(L, g, S, E); SEAM(); }
        ++seq;
        if (((PHM >> 10) & 1) && RUN()) { LOADP(); DUP(10) rows_phase<2>(p, l, (const float*)(ws + WS_XA), L, wg, G, true); rows_phase<2>(p, l, (const float*)(ws + WS_XA), L, wg, G); SEAM(); }
        ++seq;
    }
#undef RUN
#undef SEAM
#undef LOADP
}

#ifndef MK_PER_PHASE
#define MK_PER_PHASE 0
#endif
extern "C" void kernel_launch(void* const* d_in, const int* in_sizes, int n_in, void* d_out, int out_size, void* d_ws, size_t ws_size, hipStream_t stream) {
    static int grid = 0;
    if (grid == 0) {
        if (n_in != 19 || in_sizes[0] != NTOK * DM || out_size != NTOK * DM || ws_size < WS_END) {
            fprintf(stderr, "kernel_launch: unexpected shapes: n_in %d in0 %d out %d ws %zu (need %zu)\n", n_in, n_in > 0 ? in_sizes[0] : -1, out_size, ws_size, (size_t)WS_END); grid = -1; return; }
        int dev = 0, cus = 0, per_cu = 0;
        if (hipGetDevice(&dev) != hipSuccess || hipDeviceGetAttribute(&cus, hipDeviceAttributeMultiprocessorCount, dev) != hipSuccess) { fprintf(stderr, "kernel_launch: device query failed\n"); grid = -1; return; }
        if (hipFuncSetAttribute((const void*)mk_fwd, hipFuncAttributeMaxDynamicSharedMemorySize, LDS_TOTAL) != hipSuccess) { fprintf(stderr, "kernel_launch: hipFuncSetAttribute failed\n"); grid = -1; return; }
        if (hipOccupancyMaxActiveBlocksPerMultiprocessor(&per_cu, (const void*)mk_fwd, 512, LDS_TOTAL) != hipSuccess || per_cu < 1) { fprintf(stderr, "kernel_launch: occupancy query reports %d blocks per CU\n", per_cu); }
        (void)hipGetLastError();
        grid = cus;
    }
    if (grid < 0) return;
    if (hipMemsetAsync((char*)d_ws + WS_CTL, 0, CTL_ZERO, stream) != hipSuccess) { fprintf(stderr, "kernel_launch: memset failed\n"); return; }
    Args a{};
    const float** pf = (const float**)&a.p;
    for (int i = 0; i < 19; ++i) pf[i] = (const float*)d_in[i];
    a.p.out = (float*)d_out; a.p.ws = (unsigned char*)d_ws;
#if MK_PER_PHASE
    for (int s = 0; s < NSEQ; ++s) { a.lo = s; a.hi = s + 1; hipLaunchKernelGGL(mk_fwd, dim3(grid), dim3(512), LDS_TOTAL, stream, a); }
#else
    a.lo = 0; a.hi = NSEQ;
    hipLaunchKernelGGL(mk_fwd, dim3(grid), dim3(512), LDS_TOTAL, stream, a);
#endif
    const hipError_t le = hipPeekAtLastError();
    if (le != hipSuccess) fprintf(stderr, "kernel_launch: launch failed: %s\n", hipGetErrorName(le));
}
```

```cpp
#include <hip/hip_runtime.h>
#include <cstdio>
#include <cstdint>
__device__ __forceinline__ int opaque_tid() { int t = threadIdx.x; asm volatile("" : "+v"(t)); return t; }
namespace pg8 {
#define PG8_LAS __attribute__((address_space(3)))
typedef unsigned short bf16_t;
typedef short bf16x8 __attribute__((ext_vector_type(8)));
typedef float f32x4 __attribute__((ext_vector_type(4)));
typedef unsigned u32x4 __attribute__((ext_vector_type(4)));
constexpr int BM = 256, BK = 64, HALF = 128, HTB = HALF * BK * 2  , STAGE_BYTES = 8 * HTB, NXCD = 8, WGM = 8;

__host__ __device__ __forceinline__ int lds_byte(int r, int c) { const int st = (r >> 4) * 2 + (c >> 5), rr = r & 15, cc = c & 31, ob = rr * 64 + cc * 2; return st * 1024 + (ob ^ (((ob >> 9) & 1) << 5)); }
__host__ __device__ __forceinline__ void stage_rc(int b, int& R, int& C) { const int st = b / 1024, sb = b % 1024, swz = sb ^ (((sb >> 9) & 1) << 5); R = (st >> 1) * 16 + swz / 64; C = (st & 1) * 32 + (swz % 64) / 2; }
__host__ __device__ __forceinline__ int perm32(int rho) { const int n = rho >> 4, i = rho & 15; return 8 * (i >> 2) + 4 * n + (i & 3); }

struct Unit { int pm, pn; };
struct Gemm { const bf16_t* A; const bf16_t* Bt; int M, N, K; int sa, sb; };
typedef int v4i_t __attribute__((ext_vector_type(4)));
typedef int v8i_t __attribute__((ext_vector_type(8)));
__device__ __forceinline__ v8i_t cat32(bf16x8 lo, bf16x8 hi) { const v4i_t a = __builtin_bit_cast(v4i_t, lo), b = __builtin_bit_cast(v4i_t, hi); return __builtin_shufflevector(a, b, 0, 1, 2, 3, 4, 5, 6, 7); }

struct StaticOrder {
    int nM, nN, nwg, G, c;
    __host__ __device__ void init(int M, int N, int G_, int c_) { nM = M / BM; nN = N / BM; nwg = nM * nN; G = G_; c = c_; }
    __host__ __device__ bool next(int i, Unit& u) const {
        const long L = (long)i * G + c; if (L >= nwg) return false;
        int wgid = (int)L; { const int q = nwg / NXCD, r = nwg % NXCD, xcd = wgid % NXCD, off = wgid / NXCD; wgid = (xcd < r ? xcd * (q + 1) : r * (q + 1) + (xcd - r) * q) + off; }
        const int nig = WGM * nN, gid = wgid / nig, fm = gid * WGM, gsz = (nM - fm) < WGM ? (nM - fm) : WGM;
        u.pm = fm + ((wgid % nig) % gsz); u.pn = (wgid % nig) / gsz; return true;
    }
    __device__ __forceinline__ void a_ready(const Unit&) const {}
    __device__ __forceinline__ void done(const Unit&) const {}
    __device__ __forceinline__ unsigned a_rowoff_unused() const { return 0u; }
};

typedef float f32x2p __attribute__((ext_vector_type(2))); typedef __bf16 bf16x2p __attribute__((ext_vector_type(2)));
__device__ __forceinline__ unsigned cvt_pk_bf16(float lo, float hi) { const f32x2p v = {lo, hi}; return __builtin_bit_cast(unsigned, __builtin_convertvector(v, bf16x2p)); }
__device__ __forceinline__ float silu_f(float x) { return x * __builtin_amdgcn_rcpf(1.0f + __builtin_amdgcn_exp2f(x * -1.4426950408889634f)); }

struct EpiBf16 {
    static constexpr bool PERM = true, AFTER_DRAIN = false;
    bf16_t* O; int ldc;
    __device__ __forceinline__ void operator()(const f32x4 (&acc)[2][2][4][2], const Unit& u, int wr, int wc, int fr, int fq) const {
        const int row0 = u.pm * BM + wr * 64 + fr, col0 = u.pn * BM + wc * 32 + 8 * fq;
#pragma unroll
        for (int ai = 0; ai < 2; ++ai)
#pragma unroll
            for (int m = 0; m < 4; ++m) { bf16_t* rowp = O + (size_t)(row0 + ai * HALF + m * 16) * ldc + col0;
#pragma unroll
                for (int bj = 0; bj < 2; ++bj) { const f32x4 v0 = acc[ai][bj][m][0], v1 = acc[ai][bj][m][1];
                    u32x4 w; w.x = cvt_pk_bf16(v0[0], v0[1]); w.y = cvt_pk_bf16(v0[2], v0[3]); w.z = cvt_pk_bf16(v1[0], v1[1]); w.w = cvt_pk_bf16(v1[2], v1[3]);
                    *(u32x4*)(rowp + bj * HALF) = w; } }
    }
};
struct EpiProj {
    static constexpr bool PERM = true, AFTER_DRAIN = false;
    bf16_t* O; float* gates; const float* gate_b;
    __device__ __forceinline__ void operator()(const f32x4 (&acc)[2][2][4][2], const Unit& u, int wr, int wc, int fr, int fq) const {
        const int row0 = u.pm * BM + wr * 64 + fr;
        if (u.pn < 9) { const int col0 = u.pn * BM + wc * 32 + 8 * fq;
#pragma unroll
            for (int ai = 0; ai < 2; ++ai)
#pragma unroll
                for (int m = 0; m < 4; ++m) { bf16_t* rowp = O + (size_t)(row0 + ai * HALF + m * 16) * 2304 + col0;
#pragma unroll
                    for (int bj = 0; bj < 2; ++bj) { const f32x4 v0 = acc[ai][bj][m][0], v1 = acc[ai][bj][m][1];
                        u32x4 w; w.x = cvt_pk_bf16(v0[0], v0[1]); w.y = cvt_pk_bf16(v0[2], v0[3]); w.z = cvt_pk_bf16(v1[0], v1[1]); w.w = cvt_pk_bf16(v1[2], v1[3]);
                        *(u32x4*)(rowp + bj * HALF) = w; } }
        } else if (wc == 0 && fq < 2) { const f32x4 g0 = *(const f32x4*)(gate_b + 8 * fq), g1 = *(const f32x4*)(gate_b + 8 * fq + 4);
#pragma unroll
            for (int ai = 0; ai < 2; ++ai)
#pragma unroll
                for (int m = 0; m < 4; ++m) { float* gp = gates + (size_t)(row0 + ai * HALF + m * 16) * 16 + 8 * fq;
                    *(f32x4*)gp = acc[ai][0][m][0] + g0; *(f32x4*)(gp + 4) = acc[ai][0][m][1] + g1; } }
    }
};
struct EpiSwiGLU {
    static constexpr bool PERM = true, AFTER_DRAIN = false;
    bf16_t* H;
    __device__ __forceinline__ void operator()(const f32x4 (&acc)[2][2][4][2], const Unit& u, int wr, int wc, int fr, int fq) const {
        const int row0 = u.pm * BM + wr * 64 + fr, col0 = (u.pn & 15) * 128 + wc * 32 + 8 * fq;
#pragma unroll
        for (int ai = 0; ai < 2; ++ai)
#pragma unroll
            for (int m = 0; m < 4; ++m) { bf16_t* rowp = H + (size_t)(row0 + ai * HALF + m * 16) * 2048 + col0;
                const f32x4 g0 = acc[ai][0][m][0], g1 = acc[ai][0][m][1], u0 = acc[ai][1][m][0], u1 = acc[ai][1][m][1];
                u32x4 w; w.x = cvt_pk_bf16(silu_f(g0[0]) * u0[0], silu_f(g0[1]) * u0[1]); w.y = cvt_pk_bf16(silu_f(g0[2]) * u0[2], silu_f(g0[3]) * u0[3]);
                w.z = cvt_pk_bf16(silu_f(g1[0]) * u1[0], silu_f(g1[1]) * u1[1]); w.w = cvt_pk_bf16(silu_f(g1[2]) * u1[2], silu_f(g1[3]) * u1[3]);
                *(u32x4*)rowp = w; }
    }
};
__device__ __forceinline__ unsigned pk4_fp8(float a, float b, float c, float d) {
    a = __builtin_amdgcn_fmed3f(a, -448.f, 448.f); b = __builtin_amdgcn_fmed3f(b, -448.f, 448.f); c = __builtin_amdgcn_fmed3f(c, -448.f, 448.f); d = __builtin_amdgcn_fmed3f(d, -448.f, 448.f);
    int w = 0; w = __builtin_amdgcn_cvt_pk_fp8_f32(a, b, w, false); w = __builtin_amdgcn_cvt_pk_fp8_f32(c, d, w, true); return (unsigned)w; }
constexpr float HID_SCALE = 4.0f;
typedef unsigned u32x2e __attribute__((ext_vector_type(2)));
struct EpiSwiGLU8 {
    static constexpr bool PERM = true, AFTER_DRAIN = false;
    unsigned char* H;
    __device__ __forceinline__ void operator()(const f32x4 (&acc)[2][2][4][2], const Unit& u, int wr, int wc, int fr, int fq) const {
        const int row0 = u.pm * BM + wr * 64 + fr, col0 = (u.pn & 15) * 128 + wc * 32 + 8 * fq;
#pragma unroll
        for (int ai = 0; ai < 2; ++ai)
#pragma unroll
            for (int m = 0; m < 4; ++m) { unsigned char* rowp = H + (size_t)(row0 + ai * HALF + m * 16) * 2048 + col0;
                const f32x4 g0 = acc[ai][0][m][0], g1 = acc[ai][0][m][1], u0 = acc[ai][1][m][0], u1 = acc[ai][1][m][1];
                u32x2e w; w.x = pk4_fp8(silu_f(g0[0]) * u0[0] * HID_SCALE, silu_f(g0[1]) * u0[1] * HID_SCALE, silu_f(g0[2]) * u0[2] * HID_SCALE, silu_f(g0[3]) * u0[3] * HID_SCALE);
                w.y = pk4_fp8(silu_f(g1[0]) * u1[0] * HID_SCALE, silu_f(g1[1]) * u1[1] * HID_SCALE, silu_f(g1[2]) * u1[2] * HID_SCALE, silu_f(g1[3]) * u1[3] * HID_SCALE);
                *(u32x2e*)rowp = w; }
    }
};
struct EpiScaleBf16 {
    static constexpr bool PERM = true, AFTER_DRAIN = false;
    bf16_t* Y; const float* gate;
    __device__ __forceinline__ void operator()(const f32x4 (&acc)[2][2][4][2], const Unit& u, int wr, int wc, int fr, int fq) const {
        const int row0 = u.pm * BM + wr * 64 + fr, col0 = (u.pn & 3) * BM + wc * 32 + 8 * fq;
#pragma unroll
        for (int ai = 0; ai < 2; ++ai)
#pragma unroll
            for (int m = 0; m < 4; ++m) { const int r = row0 + ai * HALF + m * 16; const float gv = gate[r]; bf16_t* rowp = Y + (size_t)r * 1024 + col0;
#pragma unroll
                for (int bj = 0; bj < 2; ++bj) { const f32x4 v0 = acc[ai][bj][m][0] * gv, v1 = acc[ai][bj][m][1] * gv;
                    u32x4 w; w.x = cvt_pk_bf16(v0[0], v0[1]); w.y = cvt_pk_bf16(v0[2], v0[3]); w.z = cvt_pk_bf16(v1[0], v1[1]); w.w = cvt_pk_bf16(v1[2], v1[3]);
                    *(u32x4*)(rowp + bj * HALF) = w; } }
    }
};
constexpr float YE_SCALE = 256.0f;
struct EpiScaleFp8 {
    static constexpr bool PERM = true, AFTER_DRAIN = false;
    unsigned char* Y; const float* gate;
    __device__ __forceinline__ void operator()(const f32x4 (&acc)[2][2][4][2], const Unit& u, int wr, int wc, int fr, int fq) const {
        const int row0 = u.pm * BM + wr * 64 + fr, pcol = (u.pn & 3) * BM + 16 * (wc * 4 + fq);
#pragma unroll
        for (int ai = 0; ai < 2; ++ai)
#pragma unroll
            for (int m = 0; m < 4; ++m) { const int r = row0 + ai * HALF + m * 16; const float gv = gate[r] * YE_SCALE; u32x4 w;
#pragma unroll
                for (int bj = 0; bj < 2; ++bj) { const f32x4 v0 = acc[ai][bj][m][0] * gv, v1 = acc[ai][bj][m][1] * gv;
                    w[2 * bj] = pk4_fp8(v0[0], v0[1], v0[2], v0[3]); w[2 * bj + 1] = pk4_fp8(v1[0], v1[1], v1[2], v1[3]); }
                *(u32x4*)(Y + (size_t)r * 1024 + pcol) = w; }
    }
};
struct MoeOrder1 {
    int G, c; const unsigned short* idx;
    __device__ __forceinline__ int a_rowtok(const Unit& u, int r) const { return idx[((u.pm * 2 + (r >> 7)) * 64 + (r & 63)) * 2 + ((r >> 6) & 1)]; }
    __device__ __forceinline__ unsigned a_rowoff(const Unit& u, int r) const { return (unsigned)(((u.pm & 15) * 2048 + a_rowtok(u, r)) * 1024); }
    __device__ __forceinline__ unsigned a_rowpair(const Unit& u, int hh, int r0) const { return *(const unsigned*)(idx + ((u.pm * 2 + hh) * 64 + r0) * 2); }
    __device__ __forceinline__ unsigned a_rowoff_tok(const Unit& u, int tok) const { return (unsigned)(((u.pm & 15) * 2048 + tok) * 1024); }
    __device__ __forceinline__ bool next(int i, Unit& u) const {
        const long L = (long)i * G + c; if (L >= 4096) return false;
        const int e = (int)(L >> 8), rem = (int)(L & 255), x = rem & 7, v = rem >> 3;
        const int b = 4 * (x >> 1) + (v >> 3), j = 8 * (x & 1) + (v & 7);
        u.pm = e * 16 + b; u.pn = e * 16 + j; return true;
    }
    __device__ __forceinline__ void a_ready(const Unit&) const {}
    __device__ __forceinline__ void done(const Unit&) const {}
    __device__ __forceinline__ unsigned a_rowoff_unused() const { return 0u; }
};
struct MoeOrder2 {
    int G, c;
    __device__ __forceinline__ bool next(int i, Unit& u) const {
        const long L = (long)i * G + c; if (L >= 1024) return false;
        const int rnd = (int)(L >> 8), rem = (int)(L & 255), x = rem & 7, v = rem >> 3;
        const int e = rnd * 4 + (x >> 1), b = 8 * (x & 1) + (v >> 2), j = v & 3;
        u.pm = e * 16 + b; u.pn = e * 4 + j; return true;
    }
    __device__ __forceinline__ void a_ready(const Unit&) const {}
    __device__ __forceinline__ void done(const Unit&) const {}
    __device__ __forceinline__ unsigned a_rowoff_unused() const { return 0u; }
};

template <class Epi, class Sched, bool ALIGN_EPI = false, bool SP2 = false, bool F8 = false, bool GATH = false>
__device__ __forceinline__ void gemm_phase(PG8_LAS unsigned char* lds, const Gemm g, const Sched& S, const Epi& E) {
    const int tid = opaque_tid(), wid = __builtin_amdgcn_readfirstlane(tid >> 6), lane = tid & 63, wr = wid >> 2, wc = wid & 3, fr = lane & 15, fq = lane >> 4;
    const int K = g.K, RB = F8 ? K : 2 * K, nt = RB / 128;
    unsigned voffA[2], voffB[2];
#pragma unroll
    for (int i = 0; i < 2; ++i) { int R, C; stage_rc(tid * 16 + i * 8192, R, C); const int Rb = Epi::PERM ? ((R & ~31) + perm32(R & 31)) : R;
        voffA[i] = (unsigned)(R * RB + C * 2); voffB[i] = (unsigned)(Rb * RB + C * 2); }
    const __amdgpu_buffer_rsrc_t rsA = __builtin_amdgcn_make_buffer_rsrc((void*)g.A, 0, 0x7fffffff, 0x00020000), rsB = __builtin_amdgcn_make_buffer_rsrc((void*)g.Bt, 0, 0x7fffffff, 0x00020000);
    const size_t kstep = (size_t)(BK * 2);
    const size_t hstep = (size_t)HALF * RB;
    const size_t tstep = 2 * hstep;
    const unsigned ldsw = (unsigned)wid * 1024u;
    const int aoff = lds_byte(wr * 64 + fr, fq * 8), boff = lds_byte(wc * 32 + fr, fq * 8);
#define PG8_SA(b, h) (((b) * 2 + (h)) * HTB)
#define PG8_SB(b, h) ((4 + (b) * 2 + (h)) * HTB)
#define PG8_STAGE(bufoff, gbase, voff, rs, base) do { if constexpr (F8) { const int so_ = __builtin_amdgcn_readfirstlane((int)((const char*)(gbase) - (const char*)(base))); _Pragma("unroll") for (int _i = 0; _i < 2; ++_i) \
        __builtin_amdgcn_raw_ptr_buffer_load_lds(rs, (PG8_LAS void*)(lds + (bufoff) + ldsw + _i * 8192), 16, (int)(voff)[_i], so_, 0, 0); } \
        else { _Pragma("unroll") for (int _i = 0; _i < 2; ++_i) \
        __builtin_amdgcn_global_load_lds((const unsigned*)((const char*)(gbase) + (voff)[_i]), (PG8_LAS unsigned*)(lds + (bufoff) + ldsw + _i * 8192), 16, 0, 0); } } while (0)
#define PG8_STAGEA(bufoff, gptr, half, usenext) do { if constexpr (GATH) { const int so_ = __builtin_amdgcn_readfirstlane((int)((const char*)(gptr) - (const char*)g.A)); _Pragma("unroll") for (int _i = 0; _i < 2; ++_i) \
        __builtin_amdgcn_raw_ptr_buffer_load_lds(rsA, (PG8_LAS void*)(lds + (bufoff) + ldsw + _i * 8192), 16, (int)vAc[half][_i], so_, 0, 0); } \
        else { PG8_STAGE(bufoff, (gptr) + (half) * hstep, voffA, rsA, g.A); } } while (0)
#define PG8_GSWITCH do { if constexpr (GATH) { if (un) {   \
        asm volatile("" : "+v"(tpk[0]), "+v"(tpk[1]));     \
        _Pragma("unroll") for (int hh = 0; hh < 2; ++hh) _Pragma("unroll") for (int i = 0; i < 2; ++i) { int R, C; stage_rc(opaque_tid() * 16 + i * 8192, R, C); vAc[hh][i] = S.a_rowoff_tok(nxt, (int)((tpk[hh] >> (16 * i)) & 0xffffu)) + (unsigned)(C * 2); } } } } while (0)
#define PG8_LDA(dst, b, h) do { if constexpr (F8) { _Pragma("unroll") for (int m = 0; m < 4; ++m) dst##8[m] = cat32(*(const PG8_LAS bf16x8*)(lds + PG8_SA(b, h) + aoff + m * 2048), *(const PG8_LAS bf16x8*)(lds + PG8_SA(b, h) + aoff + m * 2048 + 1024)); } \
        else { _Pragma("unroll") for (int m = 0; m < 4; ++m) _Pragma("unroll") for (int k = 0; k < 2; ++k) dst[m][k] = *(const PG8_LAS bf16x8*)(lds + PG8_SA(b, h) + aoff + m * 2048 + k * 1024); } } while (0)
#define PG8_LDB(dst, b, h) do { if constexpr (F8) { _Pragma("unroll") for (int n = 0; n < 2; ++n) dst##8[n] = cat32(*(const PG8_LAS bf16x8*)(lds + PG8_SB(b, h) + boff + n * 2048), *(const PG8_LAS bf16x8*)(lds + PG8_SB(b, h) + boff + n * 2048 + 1024)); } \
        else { _Pragma("unroll") for (int n = 0; n < 2; ++n) _Pragma("unroll") for (int k = 0; k < 2; ++k) dst[n][k] = *(const PG8_LAS bf16x8*)(lds + PG8_SB(b, h) + boff + n * 2048 + k * 1024); } } while (0)
#define PG8_MMA(ai, bj, At, Bt) do { __builtin_amdgcn_s_setprio(1); _Pragma("unroll") for (int m = 0; m < 4; ++m) _Pragma("unroll") for (int n = 0; n < 2; ++n) { \
        if constexpr (F8) { acc[ai][bj][m][n] = __builtin_amdgcn_mfma_scale_f32_16x16x128_f8f6f4(Bt##8[n], At##8[m], acc[ai][bj][m][n], 0, 0, 0, g.sb, 0, g.sa); } \
        else { _Pragma("unroll") for (int k = 0; k < 2; ++k) acc[ai][bj][m][n] = __builtin_amdgcn_mfma_f32_16x16x32_bf16(Bt[n][k], At[m][k], acc[ai][bj][m][n], 0, 0, 0); } } __builtin_amdgcn_s_setprio(0); } while (0)
#define PG8_WAIT_V(n) asm volatile("s_waitcnt vmcnt(" #n ")" ::: "memory")
#define PG8_WAIT_L(n) asm volatile("s_waitcnt lgkmcnt(" #n ")" ::: "memory")
#define PG8_BAR __builtin_amdgcn_s_barrier()
#define PG8_SCHED __builtin_amdgcn_sched_barrier(0)
    Unit cur, nxt; int ui = 0;
    if (!S.next(0, cur)) return;
    f32x4 acc[2][2][4][2];
#pragma unroll
    for (int a = 0; a < 2; ++a)
#pragma unroll
        for (int b = 0; b < 2; ++b)
#pragma unroll
            for (int m = 0; m < 4; ++m)
#pragma unroll
                for (int n = 0; n < 2; ++n) acc[a][b][m][n] = (f32x4){0.f, 0.f, 0.f, 0.f};
    bf16x8 At[4][2], B0[2][2], B1[2][2];
    v8i_t At8[4], B08[2], B18[2];
    const char* cA = (const char*)g.A + (GATH ? (size_t)0 : (size_t)cur.pm * tstep); const char* cB = (const char*)g.Bt + (size_t)cur.pn * tstep;
    unsigned vAc[2][2];
    if constexpr (GATH) {
#pragma unroll
        for (int hh = 0; hh < 2; ++hh)
#pragma unroll
            for (int i = 0; i < 2; ++i) { int R, C; stage_rc(tid * 16 + i * 8192, R, C); vAc[hh][i] = S.a_rowoff(cur, hh * HALF + R) + (unsigned)(C * 2); } }
    S.a_ready(cur);
    if constexpr (SP2) {
        PG8_STAGE(PG8_SB(0, 0), cB, voffB, rsB, g.Bt); PG8_STAGE(PG8_SB(0, 1), cB + hstep, voffB, rsB, g.Bt); PG8_STAGEA(PG8_SA(0, 0), cA, 0, false); PG8_STAGEA(PG8_SA(0, 1), cA, 1, false);
        if (wr == 1) PG8_BAR;
        PG8_WAIT_V(2); PG8_BAR;
        PG8_STAGE(PG8_SB(1, 0), cB + kstep, voffB, rsB, g.Bt); PG8_STAGEA(PG8_SA(1, 0), cA + kstep, 0, false); PG8_STAGE(PG8_SB(1, 1), cB + hstep + kstep, voffB, rsB, g.Bt);
        PG8_WAIT_V(6); PG8_BAR;
    } else {
        PG8_STAGE(PG8_SB(0, 0), cB, voffB, rsB, g.Bt); PG8_STAGEA(PG8_SA(0, 0), cA, 0, false); PG8_STAGE(PG8_SB(0, 1), cB + hstep, voffB, rsB, g.Bt); PG8_STAGEA(PG8_SA(0, 1), cA, 1, false);
        if (wr == 1) PG8_BAR;
        PG8_WAIT_V(4); PG8_BAR;
        PG8_STAGE(PG8_SB(1, 0), cB + kstep, voffB, rsB, g.Bt); PG8_STAGEA(PG8_SA(1, 0), cA + kstep, 0, false); PG8_STAGE(PG8_SB(1, 1), cB + hstep + kstep, voffB, rsB, g.Bt);
        PG8_WAIT_V(6); PG8_BAR;
    }
    unsigned tpk[2] = {0u, 0u};
    if constexpr (GATH) { Unit n1; if (S.next(1, n1)) {
#pragma unroll
        for (int hh = 0; hh < 2; ++hh) { int R0, C0; stage_rc(opaque_tid() * 16, R0, C0); tpk[hh] = S.a_rowpair(n1, hh, R0); } } }
    for (;;) {
        const bool has_next = S.next(ui + 1, nxt);
        const char* nA = (has_next && !GATH) ? (const char*)g.A + (size_t)nxt.pm * tstep : cA; const char* nB = has_next ? (const char*)g.Bt + (size_t)nxt.pn * tstep : cB;

#pragma unroll 1
        for (int t = 0; t < nt; t += 2) {
            const bool last = (t == nt - 2); const bool un = last && has_next;

            const char* a1 = cA + (size_t)(t + 1) * kstep;
            const char* a2 = last ? nA : cA + (size_t)(t + 2) * kstep; const char* b2 = last ? nB : cB + (size_t)(t + 2) * kstep;
            const char* a3 = a2 + kstep; const char* b3 = b2 + kstep;
            if (last && has_next) S.a_ready(nxt);
            if constexpr (SP2) {
            PG8_LDB(B0, 0, 0); PG8_LDB(B1, 0, 1); PG8_SCHED; PG8_LDA(At, 0, 0); PG8_STAGEA(PG8_SA(1, 1), a1, 1, false); PG8_GSWITCH;
            PG8_WAIT_V(8); PG8_WAIT_L(0); PG8_BAR; PG8_MMA(0, 0, At, B0); PG8_MMA(0, 1, At, B1); PG8_BAR; PG8_SCHED;
            PG8_LDA(At, 0, 1); PG8_STAGE(PG8_SB(0, 0), b2, voffB, rsB, g.Bt); PG8_STAGE(PG8_SB(0, 1), b2 + hstep, voffB, rsB, g.Bt); PG8_STAGEA(PG8_SA(0, 0), a2, 0, un);
            PG8_WAIT_V(8); PG8_WAIT_L(0); PG8_BAR; PG8_MMA(1, 0, At, B0); PG8_MMA(1, 1, At, B1); PG8_BAR; PG8_SCHED;
            PG8_LDB(B0, 1, 0); PG8_LDB(B1, 1, 1); PG8_SCHED; PG8_LDA(At, 1, 0); PG8_STAGEA(PG8_SA(0, 1), a2, 1, un);
            PG8_WAIT_V(8); PG8_WAIT_L(0); PG8_BAR; PG8_MMA(0, 0, At, B0); PG8_MMA(0, 1, At, B1); PG8_BAR; PG8_SCHED;
            PG8_LDA(At, 1, 1); PG8_STAGE(PG8_SB(1, 0), b3, voffB, rsB, g.Bt); PG8_STAGE(PG8_SB(1, 1), b3 + hstep, voffB, rsB, g.Bt); PG8_STAGEA(PG8_SA(1, 0), a3, 0, un);
            PG8_WAIT_V(8); PG8_WAIT_L(0); PG8_BAR; PG8_MMA(1, 0, At, B0); PG8_MMA(1, 1, At, B1); PG8_BAR; PG8_SCHED;
            } else {
            PG8_LDB(B0, 0, 0); PG8_SCHED; PG8_LDA(At, 0, 0); PG8_STAGEA(PG8_SA(1, 1), a1, 1, false); PG8_GSWITCH;
            PG8_WAIT_L(8); PG8_BAR; PG8_WAIT_L(0); PG8_MMA(0, 0, At, B0); PG8_BAR; PG8_SCHED;
            PG8_LDB(B1, 0, 1); PG8_STAGE(PG8_SB(0, 0), b2, voffB, rsB, g.Bt);
            PG8_BAR; PG8_WAIT_L(0); PG8_MMA(0, 1, At, B1); PG8_BAR;
            PG8_LDA(At, 0, 1); PG8_STAGEA(PG8_SA(0, 0), a2, 0, un);
            PG8_BAR; PG8_WAIT_L(0); PG8_MMA(1, 0, At, B0); PG8_BAR; PG8_SCHED;
            PG8_STAGE(PG8_SB(0, 1), b2 + hstep, voffB, rsB, g.Bt);
            PG8_WAIT_V(6); PG8_BAR; PG8_MMA(1, 1, At, B1); PG8_BAR;
            PG8_LDB(B0, 1, 0); PG8_SCHED; PG8_LDA(At, 1, 0); PG8_STAGEA(PG8_SA(0, 1), a2, 1, un);
            PG8_WAIT_L(8); PG8_BAR; PG8_WAIT_L(0); PG8_MMA(0, 0, At, B0); PG8_BAR; PG8_SCHED;
            PG8_LDB(B1, 1, 1); PG8_STAGE(PG8_SB(1, 0), b3, voffB, rsB, g.Bt);
            PG8_BAR; PG8_WAIT_L(0); PG8_MMA(0, 1, At, B1); PG8_BAR;
            PG8_LDA(At, 1, 1); PG8_STAGEA(PG8_SA(1, 0), a3, 0, un);
            PG8_BAR; PG8_WAIT_L(0); PG8_MMA(1, 0, At, B0); PG8_BAR; PG8_SCHED;
            PG8_STAGE(PG8_SB(1, 1), b3 + hstep, voffB, rsB, g.Bt);
            PG8_WAIT_V(6); PG8_BAR; PG8_MMA(1, 1, At, B1); PG8_BAR;
            }
        }
        if constexpr (ALIGN_EPI) { if (wr == 0) PG8_BAR; }
        unsigned tpk2[2] = {0u, 0u};
        if constexpr (GATH) { Unit n2; if (S.next(ui + 2, n2)) {
#pragma unroll
            for (int hh = 0; hh < 2; ++hh) { int R0, C0; stage_rc(opaque_tid() * 16, R0, C0); tpk2[hh] = S.a_rowpair(n2, hh, R0); } } }
        if constexpr (!Epi::AFTER_DRAIN) { const int t2 = opaque_tid(), w2 = __builtin_amdgcn_readfirstlane(t2 >> 6), l2 = t2 & 63; E(acc, cur, w2 >> 2, w2 & 3, l2 & 15, l2 >> 4); S.done(cur); }
        if (!has_next) break;
#pragma unroll
        for (int a = 0; a < 2; ++a)
#pragma unroll
            for (int b = 0; b < 2; ++b)
#pragma unroll
                for (int m = 0; m < 4; ++m)
#pragma unroll
                    for (int n = 0; n < 2; ++n) acc[a][b][m][n] = (f32x4){0.f, 0.f, 0.f, 0.f};
        cur = nxt; cA = nA; cB = nB; ++ui;
        if constexpr (GATH) { asm volatile("" : "+v"(tpk2[0]), "+v"(tpk2[1]));
            tpk[0] = tpk2[0]; tpk[1] = tpk2[1]; }

        if constexpr (ALIGN_EPI) { if (wr == 1) PG8_BAR; }
    }
    PG8_WAIT_V(0);
    if constexpr (!ALIGN_EPI) { if (wr == 0) PG8_BAR; }
    PG8_BAR;
    if constexpr (Epi::AFTER_DRAIN) { E.fused(acc, cur, wr, wc, fr, fq, lds, wid, lane); S.done(cur); }
#undef PG8_SA
#undef PG8_SB
#undef PG8_STAGE
#undef PG8_LDA
#undef PG8_LDB
#undef PG8_MMA
#undef PG8_WAIT_V
#undef PG8_WAIT_L
#undef PG8_BAR
#undef PG8_SCHED
}
}

#define GAS __attribute__((address_space(1)))
#define LAS __attribute__((address_space(3)))
typedef unsigned short bf16;
typedef float f32x4 __attribute__((ext_vector_type(4)));
typedef unsigned u32x4 __attribute__((ext_vector_type(4)));
typedef unsigned u32x2 __attribute__((ext_vector_type(2)));
typedef short bf16x8 __attribute__((ext_vector_type(8)));

constexpr int DM = 1024, BATCH = 16, SEQ = 2048, DEPTH = 4, NTOK = BATCH * SEQ;
constexpr int PW_IN = 2320, PN = 2304, PNW = 2560;
constexpr int C_AQ = 0, C_AK = 512, C_AV = 640, C_MQ = 768, C_MK = 1024, C_MV = 1280, C_MO = 1536, C_GU = 1792, C_GV = 2048;
constexpr int NE = 16, CAP = 256, DE = 2048, NGRP = 256;
constexpr float DN_ALPHA = 1.6817928305074290f;
constexpr float LN_EPS = 1e-5f;

constexpr size_t MiB = 1u << 20;
constexpr size_t WS_CTL = 0, CTL_BYTES = 1 * MiB;
constexpr size_t WS_MOD = 1 * MiB;
constexpr size_t WS_WIN = 1520 * MiB;
constexpr size_t WS_WOUT = 22 * MiB;
constexpr size_t WS_WS = 30 * MiB;
constexpr size_t WS_GATES = 32 * MiB;
constexpr size_t WS_AFF = 34 * MiB;
constexpr size_t WS_SLOT = 36 * MiB;
constexpr size_t WS_IDX = 37 * MiB;
constexpr size_t WS_GATEV = 38 * MiB;
constexpr size_t WS_DC = 40 * MiB;
constexpr size_t WS_DN = 72 * MiB;
constexpr size_t WS_DS = 73 * MiB;
constexpr size_t WS_QKT = 80 * MiB;
constexpr size_t WS_H = 128 * MiB;
constexpr size_t WS_XA = 192 * MiB;
constexpr size_t WS_PROJ = 320 * MiB;
constexpr size_t WS_MIXCAT = 464 * MiB;
constexpr size_t WS_MIX = 528 * MiB;
constexpr size_t WS_XG = 592 * MiB;
constexpr size_t WS_HID = 720 * MiB;
constexpr size_t WS_YE = 976 * MiB;
constexpr size_t WS_WGU = 1104 * MiB;
constexpr size_t WS_WD = 1360 * MiB;
constexpr size_t WS_H8 = 1488 * MiB;
constexpr size_t WS_END = 1540 * MiB;
constexpr float W1_SCALE = 128.f, W2_SCALE = 512.f, ACT_SCALE = 8.f;
constexpr int SC_A1 = 0x7C7C7C7C, SC_B1 = 0x78787878, SC_A2 = 0x7D7D7D7D, SC_B2 = 0x76767676;
constexpr size_t WS_HFB = WS_HID;
constexpr size_t WS_VN = WS_HID + 64 * MiB;

struct P {
    const float *x, *c, *w_ada, *b_ada, *w_in, *conv_w, *conv_b, *gate_b, *sink, *rel_bias, *w_s, *b_s, *w_out, *w_router, *w_gate, *w_up, *w_down, *ln_g, *ln_b;
    float* out; unsigned char* ws;
};

typedef float f32x2c __attribute__((ext_vector_type(2))); typedef __bf16 bf16x2c __attribute__((ext_vector_type(2)));
__device__ __forceinline__ unsigned pk2(float lo, float hi) { const f32x2c v = {lo, hi}; return __builtin_bit_cast(unsigned, __builtin_convertvector(v, bf16x2c)); }
__device__ __forceinline__ unsigned f2bf(float f) { return pk2(f, 0.f) & 0xffffu; }
__device__ __forceinline__ float bf2f(unsigned short b) { return __builtin_bit_cast(float, (unsigned)b << 16); }
__device__ __forceinline__ float bflo(unsigned w) { return __builtin_bit_cast(float, w << 16); }
__device__ __forceinline__ float bfhi(unsigned w) { return __builtin_bit_cast(float, w & 0xffff0000u); }
__device__ __forceinline__ float sigmoid_f(float x) { return __builtin_amdgcn_rcpf(1.0f + __builtin_amdgcn_exp2f(x * -1.4426950408889634f)); }
__device__ __forceinline__ float silu_acc(float x) { return x * __builtin_amdgcn_rcpf(1.0f + __builtin_amdgcn_exp2f(x * -1.4426950408889634f)); }
__device__ __forceinline__ float gelu_erf(float x) { return 0.5f * x * (1.0f + erff(x * 0.70710678118654752f)); }
__device__ __forceinline__ float logsigmoid_f(float x) { return fminf(x, 0.f) - __logf(1.0f + __expf(-fabsf(x))); }
__device__ __forceinline__ int t5_bucket(int rel) {
    const int n = rel < 0 ? -rel : rel;
    int bk = n < 8 ? n : n < 12 ? 8 : n < 16 ? 9 : n < 23 ? 10 : n < 32 ? 11 : n < 46 ? 12 : n < 64 ? 13 : n < 91 ? 14 : 15;
    return bk + (rel > 0 ? 16 : 0);
}

__device__ __forceinline__ int unit_of(int wg, int G, int i, int N) {
    if (G == 256) { const int per = N >> 8; if (i >= per) return N; return ((((wg & 7) << 5) | (wg >> 3)) * per) + i; }
    const int u = wg + i * G; return u < N ? u : N;
}
template <int CTRL> __device__ __forceinline__ float dpp_f(float v) { return __builtin_bit_cast(float, __builtin_amdgcn_update_dpp(0, __builtin_bit_cast(int, v), CTRL, 0xf, 0xf, true)); }
#define DPP_X1 0xB1
#define DPP_X2 0x4E
#define DPP_HM 0x141
#define DPP_RM 0x140
__device__ __forceinline__ float r16_sum(float v) { v += dpp_f<DPP_X1>(v); v += dpp_f<DPP_X2>(v); v += dpp_f<DPP_HM>(v); v += dpp_f<DPP_RM>(v); return v; }
__device__ __forceinline__ float r16_max(float v) { v = fmaxf(v, dpp_f<DPP_X1>(v)); v = fmaxf(v, dpp_f<DPP_X2>(v)); v = fmaxf(v, dpp_f<DPP_HM>(v)); v = fmaxf(v, dpp_f<DPP_RM>(v)); return v; }
__device__ __forceinline__ float wave_sum(float v) {
#pragma unroll
    for (int o = 1; o < 64; o <<= 1) v += __shfl_xor(v, o);
    return v;
}
constexpr int RB_PITCH = 2080;
constexpr int RB_W = 0, RB_ST = 16 * RB_PITCH, RW_VEC = 100352;
__device__ __forceinline__ void r16_ln(f32x4 (&v)[16]) {
    float s = 0.f;
#pragma unroll
    for (int k = 0; k < 16; ++k) s += (v[k][0] + v[k][1]) + (v[k][2] + v[k][3]);
    const float mean = r16_sum(s) * (1.f / DM); float q = 0.f;
#pragma unroll
    for (int k = 0; k < 16; ++k) { v[k] = v[k] - mean; q += (v[k][0] * v[k][0] + v[k][1] * v[k][1]) + (v[k][2] * v[k][2] + v[k][3] * v[k][3]); }
    const float rstd = 1.0f / sqrtf(r16_sum(q) * (1.f / DM) + LN_EPS);
#pragma unroll
    for (int k = 0; k < 16; ++k) v[k] = v[k] * rstd;
}
__device__ __forceinline__ float r16_fold(const float (&acc)[16], int c) {
    float a8[8], a4[4], a2[2];
    { const bool hi = c >= 8;
#pragma unroll
      for (int e = 0; e < 8; ++e) { const float send = hi ? acc[e] : acc[e + 8], keep = hi ? acc[e + 8] : acc[e]; a8[e] = keep + dpp_f<DPP_RM>(send); } }
    { const bool hi = (c & 7) >= 4;
#pragma unroll
      for (int e = 0; e < 4; ++e) { const float send = hi ? a8[e] : a8[e + 4], keep = hi ? a8[e + 4] : a8[e]; a4[e] = keep + dpp_f<DPP_HM>(send); } }
    { const bool hi = (c & 2) != 0;
#pragma unroll
      for (int e = 0; e < 2; ++e) { const float send = hi ? a4[e] : a4[e + 2], keep = hi ? a4[e + 2] : a4[e]; a2[e] = keep + dpp_f<DPP_X2>(send); } }
    const bool hi = (c & 1) != 0; const float send = hi ? a2[0] : a2[1], keep = hi ? a2[1] : a2[0];
    return keep + dpp_f<DPP_X1>(send);
}
__device__ __forceinline__ void r16_matvec2(const f32x4 (&v0)[16], const f32x4 (&v1)[16], const LAS float* wT, int c, float& r0, float& r1) {
    float a0[16], a1[16];
    asm volatile("" ::: "memory");
#pragma unroll
    for (int e = 0; e < 16; ++e) { float s0 = 0.f, s1 = 0.f;
#pragma unroll
        for (int k = 0; k < 16; ++k) { const f32x4 w = *(const LAS f32x4*)(wT + e * DM + 64 * k + 4 * c);
            s0 += (v0[k][0] * w[0] + v0[k][1] * w[1]) + (v0[k][2] * w[2] + v0[k][3] * w[3]); s1 += (v1[k][0] * w[0] + v1[k][1] * w[1]) + (v1[k][2] * w[2] + v1[k][3] * w[3]); }
        a0[e] = s0; a1[e] = s1; }
    r0 = r16_fold(a0, c); r1 = r16_fold(a1, c);
}
#define RC(k) (128 * ((k) >> 1) + 8 * c + 4 * ((k) & 1))
__device__ __forceinline__ int rpos(int col) { return (col & ~127) | (((col >> 2) & 1) << 6) | (((col & 127) >> 3) << 2) | (col & 3); }
__device__ __forceinline__ f32x4 bf4lo(u32x4 w) { return (f32x4){bflo(w.x), bfhi(w.x), bflo(w.y), bfhi(w.y)}; }
__device__ __forceinline__ f32x4 bf4hi(u32x4 w) { return (f32x4){bflo(w.z), bfhi(w.z), bflo(w.w), bfhi(w.w)}; }
typedef float f32x2q __attribute__((ext_vector_type(2)));
__device__ __forceinline__ f32x4 fp8x4(unsigned w) { const f32x2q lo = __builtin_amdgcn_cvt_pk_f32_fp8((int)w, false), hi = __builtin_amdgcn_cvt_pk_f32_fp8((int)w, true); return (f32x4){lo[0], lo[1], hi[0], hi[1]}; }
__device__ __forceinline__ void r16_store_bf16(bf16* rowp, int c, const f32x4 (&v)[16]) {
#pragma unroll
    for (int kk = 0; kk < 8; ++kk) { u32x4 w; w.x = pk2(v[2 * kk][0], v[2 * kk][1]); w.y = pk2(v[2 * kk][2], v[2 * kk][3]); w.z = pk2(v[2 * kk + 1][0], v[2 * kk + 1][1]); w.w = pk2(v[2 * kk + 1][2], v[2 * kk + 1][3]);
        *(u32x4*)(rowp + 128 * kk + 8 * c) = w; }
}
__device__ __forceinline__ void fill_wrouter(LAS unsigned char* wb, const float* src, int tid) {
#pragma unroll
    for (int j = 0; j < 2; ++j) { const int d = tid + 512 * j; const float* sp = src + (size_t)d * 16;
        const f32x4 a0 = *(const f32x4*)sp, a1 = *(const f32x4*)(sp + 4), a2 = *(const f32x4*)(sp + 8), a3 = *(const f32x4*)(sp + 12);
#pragma unroll
        for (int k = 0; k < 4; ++k) { *(LAS bf16*)(wb + k * RB_PITCH + 2 * d) = (bf16)f2bf(a0[k]); *(LAS bf16*)(wb + (4 + k) * RB_PITCH + 2 * d) = (bf16)f2bf(a1[k]);
            *(LAS bf16*)(wb + (8 + k) * RB_PITCH + 2 * d) = (bf16)f2bf(a2[k]); *(LAS bf16*)(wb + (12 + k) * RB_PITCH + 2 * d) = (bf16)f2bf(a3[k]); } }
}
__device__ __forceinline__ void fill_vec(LAS float* dst, const float* src, int tid) {
    *(LAS f32x4*)(dst + rpos(4 * (tid & 255))) = *(const f32x4*)(src + 4 * (tid & 255));
}
__device__ __forceinline__ void rows_entry_simple(const P& p, int wg, int G) {
    const int tid = opaque_tid(), lane = tid & 63, gw = wg * 8 + (tid >> 6), ngw = G * 8;
    const float* mod = (const float*)(p.ws + WS_MOD); bf16* H = (bf16*)(p.ws + WS_H);
    for (int m = gw; m < NTOK; m += ngw) { const int b = m / SEQ; const float* mb = mod + (size_t)b * 6 * DM; const float* xr = p.x + (size_t)m * DM;
        f32x4 v[4]; float s = 0.f;
#pragma unroll
        for (int j = 0; j < 4; ++j) { v[j] = *(const f32x4*)(xr + 256 * j + 4 * lane); s += (v[j][0] + v[j][1]) + (v[j][2] + v[j][3]); }
        const float mean = wave_sum(s) * (1.f / DM); float q = 0.f;
#pragma unroll
        for (int j = 0; j < 4; ++j) { v[j] = v[j] - mean; q += (v[j][0] * v[j][0] + v[j][1] * v[j][1]) + (v[j][2] * v[j][2] + v[j][3] * v[j][3]); }
        const float rstd = 1.0f / sqrtf(wave_sum(q) * (1.f / DM) + LN_EPS);
#pragma unroll
        for (int j = 0; j < 4; ++j) { const f32x4 sc = *(const f32x4*)(mb + DM + 256 * j + 4 * lane), sh = *(const f32x4*)(mb + 256 * j + 4 * lane); const f32x4 o = v[j] * rstd * (sc + 1.0f) + sh;
            u32x2 w; w.x = pk2(o[0], o[1]); w.y = pk2(o[2], o[3]); *(u32x2*)(H + (size_t)m * DM + 256 * j + 4 * lane) = w; }
    }
}
template <int WHICH>
__device__ __forceinline__ void rows_phase(const P& p, int l, const float* xin, LAS unsigned char* L, int wg, int G, bool dummy = false) {
    const int tid = opaque_tid(), lane = tid & 63, wave = __builtin_amdgcn_readfirstlane(tid >> 6), q = lane >> 4, c = lane & 15;
    LAS float* vec = (LAS float*)(L + RW_VEC);
    const float* modl = (const float*)(p.ws + WS_MOD) + (size_t)l * BATCH * 6 * DM;
    bf16* H = (bf16*)(p.ws + (dummy ? WS_HID : WS_H)); bf16* xa = (bf16*)(p.ws + (dummy ? WS_XG : WS_XA));
    const bool xbf = (WHICH == 2) || (l != 0);
    float* affo = (float*)(p.ws + (dummy ? WS_HID + 128 * MiB : WS_AFF)); float* gato = (float*)(p.ws + (dummy ? WS_HID + 130 * MiB : WS_GATES));
    const bool last = (WHICH == 2) && (l == DEPTH - 1);
    if (WHICH == 1) fill_wrouter(L + RB_W, p.w_router + (size_t)l * DM * 16, tid);
    for (int bi = 0, blk; (blk = unit_of(wg, G, bi, NTOK / 128)) < NTOK / 128; ++bi) {
        const int b = (blk * 128) / SEQ; const float* mb = modl + (size_t)b * 6 * DM;
        __syncthreads();
        { const int half = tid >> 8;
          if (WHICH == 0) { fill_vec(vec + half * DM, mb + (half ? 0 : 1) * DM, tid); }
          if (WHICH == 1) { fill_vec(vec + half * DM, half ? p.ln_g + (size_t)(l * 2) * DM : mb + 2 * DM, tid); fill_vec(vec + (2 + half) * DM, half ? mb + 4 * DM : p.ln_b + (size_t)(l * 2) * DM, tid); if (half == 0) fill_vec(vec + 4 * DM, mb + 3 * DM, tid); }
          if (WHICH == 2) { fill_vec(vec + half * DM, half ? p.ln_g + (size_t)(l * 2 + 1) * DM : mb + 5 * DM, tid); if (half == 0) fill_vec(vec + 2 * DM, p.ln_b + (size_t)(l * 2 + 1) * DM, tid);
              if (!last) { const float* mbn = mb + (size_t)BATCH * 6 * DM; fill_vec(vec + (3 + half) * DM, mbn + (half ? 0 : 1) * DM, tid); } } }
        __syncthreads();
#pragma unroll 1
        for (int it = 0; it < 4; ++it) {
            asm volatile("" ::: "memory");
            const int m = blk * 128 + wave * 16 + it * 4 + q;
            f32x4 v[16];
            if (!xbf) {
#pragma unroll
                for (int k = 0; k < 16; ++k) v[k] = *(const f32x4*)(xin + (size_t)m * DM + RC(k)); }
            else { const bf16* xb = (const bf16*)xin + (size_t)m * DM;
#pragma unroll
                for (int kk = 0; kk < 8; ++kk) { const u32x4 w = *(const u32x4*)(xb + 128 * kk + 8 * c); v[2 * kk] = bf4lo(w); v[2 * kk + 1] = bf4hi(w); } }
            if (WHICH == 1) {
                const bf16* mix = (const bf16*)(p.ws + WS_MIX) + (size_t)m * DM;
                u32x4 mw[8];
#pragma unroll
                for (int kk = 0; kk < 8; ++kk) mw[kk] = *(const u32x4*)(mix + 128 * kk + 8 * c);
#pragma unroll
                for (int k = 0; k < 16; ++k) { const f32x4 g1 = *(const LAS f32x4*)(vec + 64 * k + 4 * c); const f32x4 mx = (k & 1) ? bf4hi(mw[k >> 1]) : bf4lo(mw[k >> 1]);
                    v[k] = v[k] * DN_ALPHA + (g1 + 1.0f) * mx; }
            }
            if (WHICH == 2) {
                const unsigned char* ye = p.ws + WS_YE; const short* slot = (const short*)(p.ws + WS_SLOT);
                const int t = m % SEQ; const int sl = slot[((size_t)b * 16 + c) * SEQ + t];
                const unsigned long long bal = __ballot(sl >= 0);
                unsigned rem = (unsigned)(bal >> (16 * q)) & 0xffffu;
                const int c0 = __popcll(bal & 0xffffull), c1 = __popcll(bal & 0xffff0000ull), c2 = __popcll(bal & 0xffff00000000ull), c3 = __popcll(bal & 0xffff000000000000ull);
                const int m01 = c0 > c1 ? c0 : c1, m23 = c2 > c3 ? c2 : c3, maxc = m01 > m23 ? m01 : m23;
                f32x4 y[16];
#pragma unroll
                for (int k = 0; k < 16; ++k) y[k] = (f32x4){0.f, 0.f, 0.f, 0.f};
                for (int kk = 0; kk < maxc; kk += 2) {
                    const bool va = rem != 0u; const int ea = va ? __builtin_ctz(rem) : 0; rem &= rem - 1u;
                    const bool vb = rem != 0u; const int eb = vb ? __builtin_ctz(rem) : 0; rem &= rem - 1u;
                    const int sa = __shfl(sl, (lane & 48) | ea), sb = __shfl(sl, (lane & 48) | eb);
                    const unsigned char* ra = ye + ((size_t)(ea * 16 + b) * CAP + (va ? sa : 0)) * DM; const unsigned char* rb = ye + ((size_t)(eb * 16 + b) * CAP + (vb ? sb : 0)) * DM;
                    u32x4 wa[4], wb[4];
#pragma unroll
                    for (int j2 = 0; j2 < 4; ++j2) { wa[j2] = *(const u32x4*)(ra + 256 * j2 + 16 * c); wb[j2] = *(const u32x4*)(rb + 256 * j2 + 16 * c); }
                    const float fa = va ? 1.f / pg8::YE_SCALE : 0.f, fb = vb ? 1.f / pg8::YE_SCALE : 0.f;
#pragma unroll
                    for (int k = 0; k < 16; ++k) { y[k] = y[k] + fp8x4(wa[k >> 2][k & 3]) * fa + fp8x4(wb[k >> 2][k & 3]) * fb; }
                }
#pragma unroll
                for (int k = 0; k < 16; ++k) { const f32x4 g2 = *(const LAS f32x4*)(vec + 64 * k + 4 * c); v[k] = v[k] * DN_ALPHA + (g2 + 1.0f) * y[k]; }
            }
            if (WHICH != 0) {
                r16_ln(v);
                const bool of32 = last && !dummy;
#pragma unroll
                for (int k = 0; k < 16; ++k) { const f32x4 gg = *(const LAS f32x4*)(vec + DM + 64 * k + 4 * c), bb = *(const LAS f32x4*)(vec + 2 * DM + 64 * k + 4 * c); v[k] = v[k] * gg + bb; }
                if (of32) {
#pragma unroll
                    for (int k = 0; k < 16; ++k) *(f32x4*)(p.out + (size_t)m * DM + RC(k)) = v[k]; }
                else r16_store_bf16(xa + (size_t)m * DM, c, v);
            }
            if (!last) {
                r16_ln(v);
                const int o_sc = WHICH == 0 ? 0 : 3, o_sh = WHICH == 0 ? 1 : 4;
#pragma unroll
                for (int k = 0; k < 16; ++k) { const f32x4 sc = *(const LAS f32x4*)(vec + o_sc * DM + 64 * k + 4 * c), sh = *(const LAS f32x4*)(vec + o_sh * DM + 64 * k + 4 * c); v[k] = v[k] * (sc + 1.0f) + sh; }
                if (WHICH == 1) { unsigned char* h8 = p.ws + (dummy ? WS_HID : WS_H8) + (size_t)m * DM;
#pragma unroll
                    for (int kk = 0; kk < 8; ++kk) { u32x2 w; w.x = pg8::pk4_fp8(v[2 * kk][0] * ACT_SCALE, v[2 * kk][1] * ACT_SCALE, v[2 * kk][2] * ACT_SCALE, v[2 * kk][3] * ACT_SCALE); w.y = pg8::pk4_fp8(v[2 * kk + 1][0] * ACT_SCALE, v[2 * kk + 1][1] * ACT_SCALE, v[2 * kk + 1][2] * ACT_SCALE, v[2 * kk + 1][3] * ACT_SCALE);
                        *(u32x2*)(h8 + 128 * kk + 8 * c) = w; } }
                else r16_store_bf16(H + (size_t)m * DM, c, v);
                if (WHICH == 1) {
                    LAS unsigned char* st = L + RB_ST + wave * (4 * RB_PITCH);
#pragma unroll
                    for (int kk = 0; kk < 8; ++kk) { u32x4 w; w.x = pk2(v[2 * kk][0], v[2 * kk][1]); w.y = pk2(v[2 * kk][2], v[2 * kk][3]); w.z = pk2(v[2 * kk + 1][0], v[2 * kk + 1][1]); w.w = pk2(v[2 * kk + 1][2], v[2 * kk + 1][3]);
                        *(LAS u32x4*)(st + q * RB_PITCH + (128 * kk + 8 * c) * 2) = w; }
                    f32x4 lg = (f32x4){0.f, 0.f, 0.f, 0.f};
                    const LAS unsigned char* ap = st + (lane & 3) * RB_PITCH + (lane >> 4) * 16; const LAS unsigned char* bp = L + RB_W + (lane & 15) * RB_PITCH + (lane >> 4) * 16;
#pragma unroll 8
                    for (int ks = 0; ks < 32; ++ks) lg = __builtin_amdgcn_mfma_f32_16x16x32_bf16(*(const LAS bf16x8*)(ap + ks * 64), *(const LAS bf16x8*)(bp + ks * 64), lg, 0, 0, 0);
                    float pr[4];
#pragma unroll
                    for (int rr = 0; rr < 4; ++rr) { const float mx = r16_max(lg[rr]), ex = __expf(lg[rr] - mx), sm = r16_sum(ex); pr[rr] = ex / sm; }
                    const float mine = q == 0 ? pr[0] : q == 1 ? pr[1] : q == 2 ? pr[2] : pr[3];
                    affo[(size_t)m * 16 + c] = mine; }
            }
        }
    }
    __syncthreads();
}

__device__ __forceinline__ void transpose_item(const float* src, size_t ld_src, bf16* dst, size_t ld_dst, LAS float* scr, int lane, int nvalid = 32) {
    if (nvalid > 0) { const int kr = lane >> 3, nc = 4 * (lane & 7);
        f32x4 t[8];
#pragma unroll
        for (int i = 0; i < 8; ++i) t[i] = *(const f32x4*)(src + (size_t)(8 * i + kr) * ld_src + nc);
#pragma unroll
        for (int i = 0; i < 8; ++i) { LAS float* d = scr + (8 * i + kr) * 33 + nc; d[0] = t[i][0]; d[1] = t[i][1]; d[2] = t[i][2]; d[3] = t[i][3]; }
    }
    asm volatile("s_waitcnt lgkmcnt(0)" ::: "memory");
    const int c = lane & 7;
#pragma unroll
    for (int j = 0; j < 4; ++j) { const int n = (lane >> 3) + 8 * j; const LAS float* s = scr + (8 * c) * 33 + n;
        u32x4 o; o.x = pk2(s[0 * 33], s[1 * 33]); o.y = pk2(s[2 * 33], s[3 * 33]); o.z = pk2(s[4 * 33], s[5 * 33]); o.w = pk2(s[6 * 33], s[7 * 33]);
        if (n >= nvalid) o = (u32x4){0u, 0u, 0u, 0u};
        *(u32x4*)(dst + (size_t)n * ld_dst + 8 * c) = o; }
    asm volatile("s_waitcnt lgkmcnt(0)" ::: "memory");
}
__device__ __forceinline__ void transpose_item8(const float* src, size_t ld_src, unsigned char* dst, size_t ld_dst, float scale, LAS float* scr, int lane) {
    { const int kr = lane >> 3, nc = 4 * (lane & 7);
        f32x4 t[8];
#pragma unroll
        for (int i = 0; i < 8; ++i) t[i] = *(const f32x4*)(src + (size_t)(8 * i + kr) * ld_src + nc);
#pragma unroll
        for (int i = 0; i < 8; ++i) { LAS float* d = scr + (8 * i + kr) * 33 + nc; d[0] = t[i][0]; d[1] = t[i][1]; d[2] = t[i][2]; d[3] = t[i][3]; } }
    asm volatile("s_waitcnt lgkmcnt(0)" ::: "memory");
    const int c = lane & 3;
#pragma unroll
    for (int j = 0; j < 2; ++j) { const int n = (lane >> 2) + 16 * j; const LAS float* s = scr + (16 * c) * 33 + n;
        u32x4 o;
#pragma unroll
        for (int q = 0; q < 4; ++q) o[q] = pg8::pk4_fp8(s[(4 * q) * 33] * scale, s[(4 * q + 1) * 33] * scale, s[(4 * q + 2) * 33] * scale, s[(4 * q + 3) * 33] * scale);
        *(u32x4*)(dst + (size_t)n * ld_dst + 16 * c) = o; }
    asm volatile("s_waitcnt lgkmcnt(0)" ::: "memory");
}
constexpr int ITL_WIN = 16 * 80, ITL_WOUT = 16 * 32, ITL_WGU = NE * 16 * 128, ITL_WD = NE * 32 * 32, ITL = ITL_WIN + ITL_WOUT + ITL_WGU + ITL_WD;
constexpr int ITS = ITL_WIN + ITL_WOUT, ITM = ITL_WGU + ITL_WD;
__device__ __forceinline__ void convert_item(const P& p, int l, int it, LAS float* scr, int lane) {
    if (it < ITL_WIN) { const int kb = it / 80, nb = it % 80, n0 = 32 * nb;
        const int sc = n0 < 1792 ? n0 : n0 < 2304 ? n0 + 16 : 1792, nvalid = n0 < 2304 ? 32 : n0 == 2304 ? 16 : 0;
        transpose_item(p.w_in + (size_t)l * DM * PW_IN + (size_t)(64 * kb) * PW_IN + sc, PW_IN, (bf16*)(p.ws + WS_WIN) + (size_t)l * PNW * DM + (size_t)n0 * DM + 64 * kb, DM, scr, lane, nvalid); return; }
    it -= ITL_WIN;
    if (it < ITL_WOUT) { const int kb = it / 32, nb = it % 32;
        transpose_item(p.w_out + (size_t)l * DM * DM + (size_t)(64 * kb) * DM + 32 * nb, DM, (bf16*)(p.ws + WS_WOUT) + (size_t)l * DM * DM + (size_t)(32 * nb) * DM + 64 * kb, DM, scr, lane); return; }
    it -= ITL_WOUT;
    if (it < ITL_WGU) { const int le = l * NE + it / (16 * 128), r = it % (16 * 128), kb = r / 128, nb = r % 128, n0 = 32 * nb, pn = n0 >> 8, w = n0 & 255;
        const float* src = (w < 128 ? p.w_gate : p.w_up) + (size_t)le * DM * DE + (size_t)(64 * kb) * DE + pn * 128 + (w & 127);
        transpose_item8(src, DE, p.ws + WS_WGU + (size_t)le * 4096 * DM + (size_t)n0 * DM + 64 * kb, DM, W1_SCALE, scr, lane); return; }
    it -= ITL_WGU;
    { const int le = l * NE + it / (32 * 32), r = it % (32 * 32), kb = r / 32, nb = r % 32;
        transpose_item8(p.w_down + (size_t)le * DE * DM + (size_t)(64 * kb) * DM + 32 * nb, DM, p.ws + WS_WD + (size_t)le * DM * DE + (size_t)(32 * nb) * DE + 64 * kb, DE, W2_SCALE, scr, lane); }
}

typedef short s16x4 __attribute__((ext_vector_type(4)));
typedef float f32x16 __attribute__((ext_vector_type(16)));
#define MFMA32(a, b, c) __builtin_amdgcn_mfma_f32_32x32x16_bf16((a), (b), (c), 0, 0, 0)
__device__ __forceinline__ int crow(int reg, int h) { return (reg & 3) + 8 * (reg >> 2) + 4 * h; }
__device__ __forceinline__ unsigned cvtpk(float lo, float hi) { return pk2(lo, hi); }
__device__ __forceinline__ bf16x8 pack8(float a0, float a1, float a2, float a3, float a4, float a5, float a6, float a7) {
    u32x4 w; w.x = cvtpk(a0, a1); w.y = cvtpk(a2, a3); w.z = cvtpk(a4, a5); w.w = cvtpk(a6, a7); return __builtin_bit_cast(bf16x8, w); }
__device__ __forceinline__ s16x4 tr_read(const LAS unsigned char* p) { typedef short v4i16_t __attribute__((ext_vector_type(4))); return __builtin_bit_cast(s16x4, __builtin_amdgcn_ds_read_tr16_b64_v4i16((LAS v4i16_t*)p)); }
__device__ __forceinline__ bf16x8 cat8(s16x4 lo, s16x4 hi) { return (bf16x8){lo[0], lo[1], lo[2], lo[3], hi[0], hi[1], hi[2], hi[3]}; }
__device__ __forceinline__ int wave_sum_i(int v) {
#pragma unroll
    for (int o = 1; o < 64; o <<= 1) v += __shfl_xor(v, o);
    return v;
}
__device__ __forceinline__ float wave_max(float v) {
#pragma unroll
    for (int o = 1; o < 64; o <<= 1) v = fmaxf(v, __shfl_xor(v, o));
    return v;
}

template <int CTRL, int RMASK> __device__ __forceinline__ float dpp_id(float ident, float v) { return __builtin_bit_cast(float, __builtin_amdgcn_update_dpp(__builtin_bit_cast(int, ident), __builtin_bit_cast(int, v), CTRL, RMASK, 0xf, false)); }
__device__ __forceinline__ float wave_scan_sum(float v) {
    v += dpp_id<0x111, 0xf>(0.f, v); v += dpp_id<0x112, 0xf>(0.f, v); v += dpp_id<0x114, 0xf>(0.f, v); v += dpp_id<0x118, 0xf>(0.f, v);
    v += dpp_id<0x142, 0xa>(0.f, v); v += dpp_id<0x143, 0xc>(0.f, v); return v; }
__device__ __forceinline__ float wave_scan_max(float v) { const float NI = -3.0e38f;
    v = fmaxf(v, dpp_id<0x111, 0xf>(NI, v)); v = fmaxf(v, dpp_id<0x112, 0xf>(NI, v)); v = fmaxf(v, dpp_id<0x114, 0xf>(NI, v)); v = fmaxf(v, dpp_id<0x118, 0xf>(NI, v));
    v = fmaxf(v, dpp_id<0x142, 0xa>(NI, v)); v = fmaxf(v, dpp_id<0x143, 0xc>(NI, v)); return v; }
__device__ __forceinline__ void ph_topk(const P& p, LAS unsigned char* lds, int wg, int G) {
    const int tid = opaque_tid(), lane = tid & 63, wave = __builtin_amdgcn_readfirstlane(tid >> 6);
    LAS unsigned* hist = (LAS unsigned*)lds;
    LAS unsigned* cnt = hist + 1024;
    const float* affp = (const float*)(p.ws + WS_AFF);
    for (int ui = 0, u; (u = unit_of(wg, G, ui, 256)) < 256; ++ui) {
        const int b = u >> 4, e = u & 15, g = e * 16 + b;
        unsigned key[4];
#pragma unroll
        for (int i = 0; i < 4; ++i) key[i] = __builtin_bit_cast(unsigned, affp[((size_t)b * SEQ + i * 512 + tid) * 16 + e]);
        hist[tid] = 0u; hist[512 + tid] = 0u;
        __syncthreads();
        unsigned thr = 0u; int need = CAP;
#pragma unroll
        for (int ps = 0; ps < 4; ++ps) { const int sh = 24 - 8 * ps;
#pragma unroll
            for (int i = 0; i < 4; ++i) { const bool in = ps == 0 || (key[i] >> (sh + 8)) == (thr >> (sh + 8));
                if (in) __hip_atomic_fetch_add(hist + ps * 256 + ((key[i] >> sh) & 255u), 1u, __ATOMIC_RELAXED, __HIP_MEMORY_SCOPE_WORKGROUP); }
            __syncthreads();
            const int lp = 63 - lane; const u32x4 h4 = *(const LAS u32x4*)(hist + ps * 256 + 4 * lp);
            const int s4 = (int)(h4.x + h4.y + h4.z + h4.w), incl = (int)wave_scan_sum((float)s4), excl = incl - s4;
            const int Ls = __builtin_ctzll(__ballot(incl >= need));
            const int c3 = excl + (int)h4.w, c2 = c3 + (int)h4.z, c1 = c2 + (int)h4.y;
            const int Bl = 4 * lp + (c3 >= need ? 3 : c2 >= need ? 2 : c1 >= need ? 1 : 0), ab = c3 >= need ? excl : c2 >= need ? c3 : c1 >= need ? c2 : c1;
            thr |= (unsigned)__builtin_amdgcn_readlane(Bl, Ls) << sh; need -= __builtin_amdgcn_readlane(ab, Ls); }
        const unsigned long long lt = (1ull << lane) - 1ull;
        unsigned long long beq[4], bsel[4];
#pragma unroll
        for (int i = 0; i < 4; ++i) { beq[i] = __ballot(key[i] == thr); if (lane == 0) cnt[i * 8 + wave] = (unsigned)__popcll(beq[i]); }
        __syncthreads();
        { const float c = lane < 32 ? (float)cnt[lane & 31] : 0.f; const float ex = wave_scan_sum(c) - c;
#pragma unroll
          for (int i = 0; i < 4; ++i) { const int eqrank = (int)__builtin_bit_cast(float, __builtin_amdgcn_readlane(__builtin_bit_cast(int, ex), i * 8 + wave)) + __popcll(beq[i] & lt);
              const bool sel = key[i] > thr || (key[i] == thr && eqrank < need);
              bsel[i] = __ballot(sel); if (lane == 0) cnt[32 + i * 8 + wave] = (unsigned)__popcll(bsel[i]); } }
        __syncthreads();
        { const float c = lane < 32 ? (float)cnt[32 + (lane & 31)] : 0.f; const float ex = wave_scan_sum(c) - c;
          unsigned short* idx = (unsigned short*)(p.ws + WS_IDX) + g * CAP; float* gv = (float*)(p.ws + WS_GATEV) + g * CAP; short* slot = (short*)(p.ws + WS_SLOT) + ((size_t)b * 16 + e) * SEQ;
#pragma unroll
          for (int i = 0; i < 4; ++i) { const int sl = (int)__builtin_bit_cast(float, __builtin_amdgcn_readlane(__builtin_bit_cast(int, ex), i * 8 + wave)) + __popcll(bsel[i] & lt); const int tok = i * 512 + tid;
              const bool sel = (bsel[i] >> lane) & 1ull;
              if (sel) { idx[(((sl >> 7) * 64 + (sl & 63)) << 1) + ((sl >> 6) & 1)] = (unsigned short)tok; gv[sl] = __builtin_bit_cast(float, key[i]); }
              slot[tok] = sel ? (short)sl : (short)-1; } }
        __syncthreads();
    }
}

__device__ __forceinline__ float gelu_as(float v) {
    const float t = __builtin_amdgcn_rcpf(fabsf(v) * 0.2316418882f + 1.0f);
    float q = t * 0.5307027145f + (-0.7265760135f); q = q * t + 0.7107068705f; q = q * t + (-0.142248368f); q = q * t + 0.127414796f; q = q * t;
    const float m = v * (q * __builtin_amdgcn_exp2f(v * v * (-0.72134752044f)));
    return v < 0.f ? m : v - m;
}
constexpr int GM_PITCH = 264;
__device__ __forceinline__ void ph_gmlp(const P& p, int l, LAS unsigned char* lds, int wg, int G) {
    const int tid = opaque_tid(), lane = tid & 63, wave = __builtin_amdgcn_readfirstlane(tid >> 6), r = lane & 31, h = lane >> 5, q = lane >> 4, c = lane & 15;
    const bf16* proj = (const bf16*)(p.ws + WS_PROJ); bf16* mixcat = (bf16*)(p.ws + WS_MIXCAT);
    const bf16* wsb = (const bf16*)(p.ws + WS_WS) + (size_t)l * 4 * 128 * 128;
    for (int ui = 0, u; (u = unit_of(wg, G, ui, 256)) < 256; ++ui) {
        const size_t m0 = (size_t)u * 128;
#pragma unroll
        for (int it = 0; it < 4; ++it) { const int t = wave * 16 + it * 4 + q;
            const bf16* src = proj + (m0 + t) * PN + C_GV + 8 * c; const u32x4 x0 = *(const u32x4*)src, x1 = *(const u32x4*)(src + 128);
            float v[16];
#pragma unroll
            for (int i = 0; i < 4; ++i) { v[2 * i] = gelu_as(bflo(x0[i])); v[2 * i + 1] = gelu_as(bfhi(x0[i])); v[8 + 2 * i] = gelu_as(bflo(x1[i])); v[8 + 2 * i + 1] = gelu_as(bfhi(x1[i])); }
            float s = 0.f;
#pragma unroll
            for (int i = 0; i < 16; ++i) s += v[i];
            const float mean = r16_sum(s) * (1.f / 256.f); float qq = 0.f;
#pragma unroll
            for (int i = 0; i < 16; ++i) { v[i] -= mean; qq += v[i] * v[i]; }
            const float rstd = 1.0f / sqrtf(r16_sum(qq) * (1.f / 256.f) + LN_EPS);
            u32x4 o0, o1;
#pragma unroll
            for (int i = 0; i < 4; ++i) { o0[i] = pk2(v[2 * i] * rstd, v[2 * i + 1] * rstd); o1[i] = pk2(v[8 + 2 * i] * rstd, v[8 + 2 * i + 1] * rstd); }
            *(LAS u32x4*)(lds + (t * GM_PITCH + 8 * c) * 2) = o0; *(LAS u32x4*)(lds + (t * GM_PITCH + 128 + 8 * c) * 2) = o1; }
        __syncthreads();
        const int tt = wave & 3, ch = wave >> 2, t = tt * 32 + r;
        u32x2 uu[4][4];
#pragma unroll
        for (int ti = 0; ti < 4; ++ti)
#pragma unroll
            for (int rg = 0; rg < 4; ++rg) uu[ti][rg] = *(const u32x2*)(proj + (m0 + t) * PN + C_GU + ch * 128 + ti * 32 + 8 * rg + 4 * h);
        const int G4 = lane >> 4, q4 = c >> 2, p4 = c & 3;
#pragma unroll
        for (int gi = 0; gi < 2; ++gi) { const int g = ch * 2 + gi;
            bf16x8 wf[8];
#pragma unroll
            for (int ks = 0; ks < 8; ++ks) wf[ks] = *(const bf16x8*)(wsb + ((size_t)g * 128 + t) * 128 + ks * 16 + 8 * h);
            const float bias = p.b_s[(l * 4 + g) * 128 + t];
#pragma unroll
            for (int ci = 0; ci < 2; ++ci) { const int c0 = g * 64 + ci * 32, ti = gi * 2 + ci;
                f32x16 acc; for (int i = 0; i < 16; ++i) acc[i] = 0.f;
                const LAS unsigned char* vb = lds + ((8 * (G4 >> 1) + q4) * GM_PITCH + c0 + 16 * (G4 & 1) + 4 * p4) * 2;
#pragma unroll
                for (int ks = 0; ks < 8; ++ks) { const bf16x8 af = cat8(tr_read(vb + (ks * 16) * GM_PITCH * 2), tr_read(vb + (ks * 16 + 4) * GM_PITCH * 2)); acc = MFMA32(af, wf[ks], acc); }
                bf16* op = mixcat + (m0 + t) * DM + 768 + c0;
#pragma unroll
                for (int rg = 0; rg < 4; ++rg) { const u32x2 w = uu[ti][rg]; u32x2 o;
                    o.x = pk2(gelu_as(bflo(w.x)) * (acc[4 * rg] + bias), gelu_as(bfhi(w.x)) * (acc[4 * rg + 1] + bias));
                    o.y = pk2(gelu_as(bflo(w.y)) * (acc[4 * rg + 2] + bias), gelu_as(bfhi(w.y)) * (acc[4 * rg + 3] + bias));
                    *(u32x2*)(op + 8 * rg + 4 * h) = o; } } }
        __syncthreads();
    }
}

constexpr int AT_PITCH = 144;
constexpr int AT_K = 0, AT_V = 384 * AT_PITCH, AT_BIAS = 2 * 384 * AT_PITCH, AT_BT = 321, AT_BYTES = AT_BIAS + 8 * AT_BT * 4;
#define AT_SOFTMAX(st, bth_, mrun_, lsum_, oa_, ob_, l2_) do { float mt_ = -3.0e38f; \
        _Pragma("unroll") for (int reg = 0; reg < 16; ++reg) { l2_[reg] = st[reg] * (0.125f * L2E) + (bth_)[band0 + crow(reg, h)]; mt_ = fmaxf(mt_, l2_[reg]); }   \
        { const auto rr_ = __builtin_amdgcn_permlane32_swap(__float_as_uint(mt_), __float_as_uint(mt_), false, false); mt_ = fmaxf(__uint_as_float(rr_[0]), __uint_as_float(rr_[1])); } \
        const float mnew_ = fmaxf(mrun_, mt_); \
        if (__any(mnew_ > mrun_)) { const float f_ = __builtin_amdgcn_exp2f(mrun_ - mnew_); lsum_ *= f_; _Pragma("unroll") for (int i = 0; i < 16; ++i) { oa_[i] *= f_; ob_[i] *= f_; } mrun_ = mnew_; } \
        float ps_ = 0.f; _Pragma("unroll") for (int reg = 0; reg < 16; ++reg) { l2_[reg] = __builtin_amdgcn_exp2f(l2_[reg] - mrun_); ps_ += l2_[reg]; } \
        lsum_ += ps_; } while (0)
__device__ __forceinline__ void ph_attn(const P& p, int l, LAS unsigned char* lds, int wg, int G) {
    const int tid = opaque_tid(), lane = tid & 63, wave = __builtin_amdgcn_readfirstlane(tid >> 6), r = lane & 31, h = lane >> 5;
    const bf16* proj = (const bf16*)(p.ws + WS_PROJ); bf16* mixcat = (bf16*)(p.ws + WS_MIXCAT);
    LAS float* bt = (LAS float*)(lds + AT_BIAS);
    const float L2E = 1.4426950408889634f;
    for (int i = tid; i < 8 * AT_BT; i += 512) { const int hd = i / AT_BT, rr = i - hd * AT_BT - 32; const int rc = rr < 0 ? 0 : (rr > 256 ? 256 : rr); const float bv = p.rel_bias[t5_bucket(rc - 128) * 8 + hd] * L2E; bt[i] = (rr < 0 || rr > 256) ? -3.0e38f : bv; }
    for (int ui = 0, u; (u = unit_of(wg, G, ui, 512)) < 512; ++ui) {
        const int b = u >> 5, n = (u >> 1) & 15, hk = u & 1;
        { u32x4 kv[6], vv[6];
#pragma unroll
          for (int i = 0; i < 6; ++i) { const int id = i * 512 + tid, row = id >> 3, chn = id & 7; int pos = (n - 1) * 128 + row; pos = pos < 0 ? 0 : (pos > SEQ - 1 ? SEQ - 1 : pos);
              const bf16* src = proj + ((size_t)b * SEQ + pos) * PN + hk * 64 + chn * 8; kv[i] = *(const u32x4*)(src + C_AK); vv[i] = *(const u32x4*)(src + C_AV); }
#pragma unroll
          for (int i = 0; i < 6; ++i) { const int id = i * 512 + tid, row = id >> 3, chn = id & 7;
              *(LAS u32x4*)(lds + AT_K + row * AT_PITCH + chn * 16) = kv[i]; *(LAS u32x4*)(lds + AT_V + row * AT_PITCH + chn * 16) = vv[i]; } }
        const int tq = wave & 3, hh0 = (wave >> 2) * 2, qloc = tq * 32 + r; const size_t m = (size_t)b * SEQ + n * 128 + qloc;
        bf16x8 qa[4], qb[4];
#pragma unroll
        for (int s = 0; s < 4; ++s) { qa[s] = *(const bf16x8*)(proj + m * PN + C_AQ + (hk * 4 + hh0) * 64 + s * 16 + 8 * h); qb[s] = *(const bf16x8*)(proj + m * PN + C_AQ + (hk * 4 + hh0 + 1) * 64 + s * 16 + 8 * h); }
        const float sinka = p.sink[l * 8 + hk * 4 + hh0] * L2E, sinkb = p.sink[l * 8 + hk * 4 + hh0 + 1] * L2E;
        __syncthreads();
        const int G4 = lane >> 4, i16 = lane & 15, q4 = i16 >> 2, p4 = i16 & 3;
        const int kt_lo = n == 0 ? 4 : tq, kt_hi = n == 15 ? 7 : 8 + tq;
#pragma unroll
        for (int x = 0; x < 2; ++x) {
            float mr = x ? sinkb : sinka, ls = 0.f; f32x16 o0, o1; for (int i = 0; i < 16; ++i) { o0[i] = 0.f; o1[i] = 0.f; }
            const LAS float* bth = bt + (hk * 4 + hh0 + x) * AT_BT + 32 - qloc;
            f32x16 sc; for (int i = 0; i < 16; ++i) sc[i] = 0.f;
            { const int band0 = (kt_lo >> 2) * 128 + (kt_lo & 3) * 32;
#pragma unroll
              for (int s = 0; s < 4; ++s) { const bf16x8 kf = *(const LAS bf16x8*)(lds + AT_K + (band0 + r) * AT_PITCH + (s * 16 + 8 * h) * 2); sc = MFMA32(kf, x ? qb[s] : qa[s], sc); } }
#pragma unroll 1
            for (int kt = kt_lo; kt <= kt_hi; ++kt) { const int kb = kt >> 2, tk = kt & 3;
                const int band0 = kb * 128 + tk * 32;
                const int ktn = kt < kt_hi ? kt + 1 : kt_hi, band0n = (ktn >> 2) * 128 + (ktn & 3) * 32;
                f32x16 sn; for (int i = 0; i < 16; ++i) sn[i] = 0.f;
#pragma unroll
                for (int s = 0; s < 4; ++s) { const bf16x8 kf = *(const LAS bf16x8*)(lds + AT_K + (band0n + r) * AT_PITCH + (s * 16 + 8 * h) * 2); sn = MFMA32(kf, x ? qb[s] : qa[s], sn); }
                float lp[16];
                AT_SOFTMAX(sc, bth, mr, ls, o0, o1, lp);
                const bf16x8 p0 = pack8(lp[0], lp[1], lp[2], lp[3], lp[4], lp[5], lp[6], lp[7]), p1 = pack8(lp[8], lp[9], lp[10], lp[11], lp[12], lp[13], lp[14], lp[15]);
                const LAS unsigned char* vb = lds + AT_V + (band0 + 4 * (G4 >> 1) + q4) * AT_PITCH + (16 * (G4 & 1) + 4 * p4) * 2;
#pragma unroll
                for (int s = 0; s < 2; ++s) {
                    const bf16x8 va0 = cat8(tr_read(vb + (16 * s) * AT_PITCH), tr_read(vb + (16 * s + 8) * AT_PITCH));
                    const bf16x8 va1 = cat8(tr_read(vb + (16 * s) * AT_PITCH + 64), tr_read(vb + (16 * s + 8) * AT_PITCH + 64));
                    o0 = MFMA32(va0, s ? p1 : p0, o0); o1 = MFMA32(va1, s ? p1 : p0, o1); }
                sc = sn;
            }
            { const float sk = x ? sinkb : sinka;
              ls += __shfl_xor(ls, 32); ls += __builtin_amdgcn_exp2f(sk - mr);
              const float inv = 1.0f / ls;
              bf16* op = mixcat + m * DM + (hk * 4 + hh0 + x) * 64;
#pragma unroll
              for (int rg = 0; rg < 4; ++rg) { u32x2 w0, w1;
                  w0.x = cvtpk(o0[4 * rg] * inv, o0[4 * rg + 1] * inv); w0.y = cvtpk(o0[4 * rg + 2] * inv, o0[4 * rg + 3] * inv);
                  w1.x = cvtpk(o1[4 * rg] * inv, o1[4 * rg + 1] * inv); w1.y = cvtpk(o1[4 * rg + 2] * inv, o1[4 * rg + 3] * inv);
                  *(u32x2*)(op + 8 * rg + 4 * h) = w0; *(u32x2*)(op + 32 + 8 * rg + 4 * h) = w1; } }
        }
        __syncthreads();
    }
}
#undef AT_SOFTMAX

struct GateVec { int ta, tb; float b0, b1, fs0, fs1, pm0, pm1, total, mx; };
struct GateRaw { float ig0, ig1, f0, f1; };
__device__ __forceinline__ GateRaw gate_loads(const float* gates, size_t m0, int head, int dir, int lane) {
    const int ta = dir == 0 ? 2 * lane : 127 - 2 * lane, tb = dir == 0 ? ta + 1 : ta - 1;
    const float* ga = gates + (m0 + ta) * 16 + dir * 8 + head; const float* gb = gates + (m0 + tb) * 16 + dir * 8 + head;
    GateRaw g; g.ig0 = ga[0]; g.ig1 = gb[0]; g.f0 = ga[4]; g.f1 = gb[4]; return g; }
__device__ __forceinline__ GateVec gate_vectors(const GateRaw& g, int dir, int lane) {
    GateVec r; r.ta = dir == 0 ? 2 * lane : 127 - 2 * lane; r.tb = dir == 0 ? r.ta + 1 : r.ta - 1;
    const float ig0 = g.ig0, ig1 = g.ig1, lf0 = logsigmoid_f(g.f0), lf1 = logsigmoid_f(g.f1);
    const float s = lf0 + lf1, incl = wave_scan_sum(s), excl = incl - s;
    r.total = __builtin_bit_cast(float, __builtin_amdgcn_readlane(__builtin_bit_cast(int, incl), 63));
    r.b0 = excl + lf0; r.b1 = r.b0 + lf1; r.fs0 = ig0 - r.b0; r.fs1 = ig1 - r.b1;
    const float pi = wave_scan_max(fmaxf(r.fs0, r.fs1)), pe = dpp_id<0x138, 0xf>(-3.0e38f, pi);
    r.pm0 = fmaxf(pe, r.fs0); r.pm1 = fmaxf(r.pm0, r.fs1);
    r.mx = __builtin_bit_cast(float, __builtin_amdgcn_readlane(__builtin_bit_cast(int, pi), 63));
    return r;
}
constexpr int MA_P = 144;
constexpr int MA_K = 0, MA_VW = 128 * MA_P, MA_WEXP = 3 * 128 * MA_P, MA_BYTES = MA_WEXP + 1024;
__device__ __forceinline__ void ph_mlstm_a(const P& p, int l, LAS unsigned char* lds, int wg, int G) {
    const int tid = opaque_tid(), lane = tid & 63, wave = __builtin_amdgcn_readfirstlane(tid >> 6), r = lane & 31, h = lane >> 5;
    const bf16* proj = (const bf16*)(p.ws + WS_PROJ); bf16* qkt = (bf16*)(p.ws + WS_QKT); const float* gates = (const float*)(p.ws + WS_GATES);
    bf16* DC = (bf16*)(p.ws + WS_DC); float* DN = (float*)(p.ws + WS_DN); float* DS = (float*)(p.ws + WS_DS);
    LAS float* wexp = (LAS float*)(lds + MA_WEXP);
    const int c8 = tid & 7, isk = (tid >> 3) & 1, tq = tid >> 4, tv = tid >> 3;
    for (int ui = 0, u; (u = unit_of(wg, G, ui, 1024)) < 1024; ++ui) {
        const int b = u >> 6, head = (u >> 4) & 3, chunk = u & 15; const size_t m0 = (size_t)b * SEQ + chunk * 128;
        const GateRaw graw = gate_loads(gates, m0, head, wave & 1, lane);
        f32x4 wv[8];
        { const float* cwp = p.conv_w + (size_t)l * 3 * 512 + isk * 256 + head * 64 + c8 * 8; const float* cbp = p.conv_b + l * 512 + isk * 256 + head * 64 + c8 * 8;
#pragma unroll
          for (int tap = 0; tap < 3; ++tap) { wv[2 * tap] = *(const f32x4*)(cwp + tap * 512); wv[2 * tap + 1] = *(const f32x4*)(cwp + tap * 512 + 4); }
          wv[6] = *(const f32x4*)cbp; wv[7] = *(const f32x4*)(cbp + 4); }
        u32x4 xl[3][4];
#pragma unroll
        for (int i = 0; i < 4; ++i) { const int t = tq + 32 * i, tpos = chunk * 128 + t; const bf16* pr = proj + (m0 + t) * PN + (isk ? C_MK : C_MQ) + head * 64 + c8 * 8;
            xl[1][i] = *(const u32x4*)pr; xl[0][i] = *(const u32x4*)(tpos > 0 ? pr - PN : pr); xl[2][i] = *(const u32x4*)(tpos < SEQ - 1 ? pr + PN : pr); }
        u32x4 vpre[2];
#pragma unroll
        for (int i = 0; i < 2; ++i) vpre[i] = *(const u32x4*)(proj + (m0 + tv + 64 * i) * PN + C_MV + head * 64 + c8 * 8);
        if (wave < 2) { const int dir = wave; const GateVec gv = gate_vectors(graw, dir, lane);
            wexp[dir * 128 + gv.ta] = __expf(gv.fs0 - gv.mx); wexp[dir * 128 + gv.tb] = __expf(gv.fs1 - gv.mx);
            if (lane == 0) { DS[(size_t)(u * 2 + dir) * 2] = gv.total; DS[(size_t)(u * 2 + dir) * 2 + 1] = gv.total + gv.mx; } }
        { const float sc = isk ? 0.125f : 1.0f;
#pragma unroll
          for (int i = 0; i < 4; ++i) { const int t = tq + 32 * i, tpos = chunk * 128 + t; const bool hp = tpos > 0, hn = tpos < SEQ - 1;
              const u32x4 z = (u32x4){0u, 0u, 0u, 0u}; const u32x4 x0 = hp ? xl[0][i] : z, x1 = xl[1][i], x2 = hn ? xl[2][i] : z;
              float y[8];
#pragma unroll
              for (int q = 0; q < 4; ++q) { const int c = 2 * q;
                  y[c] = wv[6 + (c >> 2)][c & 3] + wv[c >> 2][c & 3] * bflo(x0[q]) + wv[2 + (c >> 2)][c & 3] * bflo(x1[q]) + wv[4 + (c >> 2)][c & 3] * bflo(x2[q]);
                  y[c + 1] = wv[6 + (c >> 2)][(c & 3) + 1] + wv[c >> 2][(c & 3) + 1] * bfhi(x0[q]) + wv[2 + (c >> 2)][(c & 3) + 1] * bfhi(x1[q]) + wv[4 + (c >> 2)][(c & 3) + 1] * bfhi(x2[q]); }
#pragma unroll
              for (int k = 0; k < 8; ++k) y[k] = silu_acc(y[k]) * sc;
              u32x4 o; o.x = pk2(y[0], y[1]); o.y = pk2(y[2], y[3]); o.z = pk2(y[4], y[5]); o.w = pk2(y[6], y[7]);
              *(u32x4*)(qkt + (m0 + t) * 512 + isk * 256 + head * 64 + c8 * 8) = o;
              if (isk) *(LAS u32x4*)(lds + MA_K + t * MA_P + c8 * 16) = o; } }
        __syncthreads();
#pragma unroll
        for (int i = 0; i < 2; ++i) { const int t = tv + 64 * i; const float wf = wexp[t], wb = wexp[128 + t]; const u32x4 x = vpre[i]; u32x4 of, ob;
#pragma unroll
            for (int q = 0; q < 4; ++q) { const float lo = bflo(x[q]), hi = bfhi(x[q]); of[q] = pk2(lo * wf, hi * wf); ob[q] = pk2(lo * wb, hi * wb); }
            *(LAS u32x4*)(lds + MA_VW + t * MA_P + c8 * 16) = of; *(LAS u32x4*)(lds + MA_VW + (128 + t) * MA_P + c8 * 16) = ob; }
        __syncthreads();
        { const int dir = wave >> 2, et = (wave >> 1) & 1, dt = wave & 1;
          const int G4 = lane >> 4, i16 = lane & 15, q4 = i16 >> 2, p4 = i16 & 3;
          const LAS unsigned char* ab = lds + MA_VW + (dir * 128 + 4 * (G4 >> 1) + q4) * MA_P + (et * 32 + 16 * (G4 & 1) + 4 * p4) * 2;
          const LAS unsigned char* bb = lds + MA_K + (4 * (G4 >> 1) + q4) * MA_P + (dt * 32 + 16 * (G4 & 1) + 4 * p4) * 2;
          f32x16 acc, accn; for (int i = 0; i < 16; ++i) { acc[i] = 0.f; accn[i] = 0.f; }
#pragma unroll
          for (int ks = 0; ks < 8; ++ks) { const bf16x8 af = cat8(tr_read(ab + (16 * ks) * MA_P), tr_read(ab + (16 * ks + 8) * MA_P)), kf = cat8(tr_read(bb + (16 * ks) * MA_P), tr_read(bb + (16 * ks + 8) * MA_P));
              acc = MFMA32(af, kf, acc);
              if (et == 0) { const f32x4 w0 = *(const LAS f32x4*)(wexp + dir * 128 + 16 * ks + 4 * h), w1 = *(const LAS f32x4*)(wexp + dir * 128 + 16 * ks + 8 + 4 * h);
                  const bool r0 = r == 0; const bf16x8 wa = pack8(r0 ? w0[0] : 0.f, r0 ? w0[1] : 0.f, r0 ? w0[2] : 0.f, r0 ? w0[3] : 0.f, r0 ? w1[0] : 0.f, r0 ? w1[1] : 0.f, r0 ? w1[2] : 0.f, r0 ? w1[3] : 0.f);
                  accn = MFMA32(wa, kf, accn); } }
          bf16* dc = DC + (size_t)(u * 2 + dir) * 4096;
#pragma unroll
          for (int reg = 0; reg < 16; ++reg) dc[(et * 32 + crow(reg, h)) * 64 + dt * 32 + r] = (bf16)f2bf(acc[reg]);
          if (et == 0 && h == 0) DN[(size_t)(u * 2 + dir) * 64 + dt * 32 + r] = accn[0]; }
        __syncthreads();
    }
}
constexpr int MC_PITCH = 144;
constexpr int MC_Q = 0, MC_K = 128 * MC_PITCH, MC_V = 2 * 128 * MC_PITCH, MC_C = 3 * 128 * MC_PITCH;
constexpr int MC_X = 131072 + 1024;
constexpr int MC_VEC = MC_X, MC_COEF = MC_VEC + 3072, MC_MS = MC_COEF + 512, MC_N = MC_MS + 64;
constexpr int MC_HP = 66;
__device__ __forceinline__ void ph_mlstm_c(const P& p, int l, LAS unsigned char* lds, int wg, int G) {
    const int tid = opaque_tid(), lane = tid & 63, wave = __builtin_amdgcn_readfirstlane(tid >> 6), r = lane & 31, h = lane >> 5;
    const bf16* proj = (const bf16*)(p.ws + WS_PROJ); const bf16* qkt = (const bf16*)(p.ws + WS_QKT); const float* gates = (const float*)(p.ws + WS_GATES); bf16* mixcat = (bf16*)(p.ws + WS_MIXCAT);
    const bf16* DC = (const bf16*)(p.ws + WS_DC); const float* DN = (const float*)(p.ws + WS_DN); const float* DS = (const float*)(p.ws + WS_DS);
    LAS float* nvecS = (LAS float*)(lds + MC_N); LAS float* vfs = (LAS float*)(lds + MC_VEC); LAS float* vM = vfs + 256; LAS float* vb = vfs + 512;
    LAS float* coefS = (LAS float*)(lds + MC_COEF); LAS float* mS = (LAS float*)(lds + MC_MS);
    LAS unsigned short* hbuf = (LAS unsigned short*)lds;
    for (int ui = 0, u4; (u4 = unit_of(wg, G, ui, 256)) < 256; ++ui) {
        const int b = u4 >> 4, head = (u4 >> 2) & 3, c0 = (u4 & 3) * 4, ubase = (b * 4 + head) * 16;
        u32x4 dcr[18]; float dnr[18];
        { const f32x2c dsv = *(const f32x2c*)(DS + (size_t)((ubase + (lane & 15)) * 2 + (wave & 1)) * 2);
#pragma unroll
          for (int i = 0; i < 18; ++i) { const int dj = i >= c0 + 3 ? 1 : 0, j = dj ? i - 2 : i;
              dcr[i] = *(const u32x4*)(DC + (size_t)((ubase + j) * 2 + dj) * 4096 + tid * 8);
              dnr[i] = DN[(size_t)((ubase + j) * 2 + dj) * 64 + lane]; }
          const int dir = wave & 1, chunk = c0 + (wave >> 1), n = dir == 0 ? chunk : 15 - chunk;
          const bool in16 = lane < 16, valid = in16 && (dir == 0 ? lane < chunk : lane > chunk);
          const float bLv = in16 ? dsv[0] : 0.f, mlv = dsv[1];
          const float Pf = wave_scan_sum(bLv);
          const float Pc1 = __shfl(Pf, chunk > 0 ? chunk - 1 : 0), Pc = __shfl(Pf, chunk), P15 = __shfl(Pf, 15);
          const float Si = dir == 0 ? Pc1 - Pf : (Pf - bLv) - Pc, Sall = dir == 0 ? Pc1 : P15 - Pc;
          const float cand = valid ? mlv + Si : -3.0e38f;
          const float m = n > 0 ? fmaxf(Sall, wave_max(cand)) : 0.f;
          if (in16) coefS[wave * 16 + lane] = valid ? __expf(cand - m) : 0.f;
          if (lane == 0) mS[wave] = m; }
        __syncthreads();
        { float acc[4][8], accn[4];
#pragma unroll
          for (int k = 0; k < 4; ++k) { accn[k] = 0.f;
#pragma unroll
              for (int e = 0; e < 8; ++e) acc[k][e] = 0.f; }
#pragma unroll
          for (int i = 0; i < 18; ++i) { const int dj = i >= c0 + 3 ? 1 : 0, j = dj ? i - 2 : i;
              float x[8];
#pragma unroll
              for (int q = 0; q < 4; ++q) { x[2 * q] = bflo(dcr[i][q]); x[2 * q + 1] = bfhi(dcr[i][q]); }
#pragma unroll
              for (int k = 0; k < 4; ++k) { const float cf = coefS[(k * 2 + dj) * 16 + j]; accn[k] += cf * dnr[i];
#pragma unroll
                  for (int e = 0; e < 8; ++e) acc[k][e] += cf * x[e]; }
              if (i == 17 || ((i == 2 || i == 6 || i == 10 || i == 14) && i == c0 + 2)) { const int dd = i == 17 ? 1 : 0;
#pragma unroll
                  for (int k = 0; k < 4; ++k) { u32x4 o;
#pragma unroll
                      for (int q = 0; q < 4; ++q) o[q] = pk2(acc[k][2 * q], acc[k][2 * q + 1]);
                      *(LAS u32x4*)(lds + MC_C + ((k * 2 + dd) * 64 + (tid >> 3)) * MC_PITCH + (tid & 7) * 16) = o;
                      if (tid < 64) nvecS[(k * 2 + dd) * 64 + tid] = accn[k];
                      accn[k] = 0.f;
#pragma unroll
                      for (int e = 0; e < 8; ++e) acc[k][e] = 0.f; } } } }
#pragma unroll 1
        for (int kc = 0; kc < 4; ++kc) { const int chunk = c0 + kc; const size_t m0 = (size_t)b * SEQ + chunk * 128;
        const GateRaw graw = gate_loads(gates, m0, head, wave & 1, lane);
        u32x4 stg[6];
#pragma unroll
        for (int i = 0; i < 6; ++i) { const int id = i * 512 + tid, arr = id >> 10, rem = id & 1023, row = rem >> 3, chn = rem & 7;
            const bf16* src = arr == 2 ? proj + (m0 + row) * PN + C_MV + head * 64 + chn * 8 : qkt + (m0 + row) * 512 + arr * 256 + head * 64 + chn * 8;
            stg[i] = *(const u32x4*)src; }
        u32x4 mopre[2];
#pragma unroll
        for (int i = 0; i < 2; ++i) { const int id = i * 512 + tid; mopre[i] = *(const u32x4*)(proj + (m0 + (id >> 3)) * PN + C_MO + head * 64 + (id & 7) * 8); }
        if (wave < 2) { const int dir = wave; const GateVec gv = gate_vectors(graw, dir, lane);
            vfs[dir * 128 + gv.ta] = gv.fs0; vfs[dir * 128 + gv.tb] = gv.fs1;
            vM[dir * 128 + gv.ta] = gv.pm0; vM[dir * 128 + gv.tb] = gv.pm1;
            vb[dir * 128 + gv.ta] = gv.b0; vb[dir * 128 + gv.tb] = gv.b1; }
#pragma unroll
        for (int i = 0; i < 6; ++i) { const int id = i * 512 + tid, arr = id >> 10, rem = id & 1023, row = rem >> 3, chn = rem & 7;
            *(LAS u32x4*)(lds + arr * 128 * MC_PITCH + row * MC_PITCH + chn * 16) = stg[i]; }
        __syncthreads();
        const int dir = wave >> 2, tt = wave & 3, t = tt * 32 + r;
        const LAS unsigned char* Cs = lds + MC_C + (kc * 2 + dir) * 64 * MC_PITCH; const LAS float* nvec = nvecS + (kc * 2 + dir) * 64; const float mC = mS[kc * 2 + dir];
        f32x16 nS0, nS1, nI0, nI1; for (int i = 0; i < 16; ++i) { nS0[i] = 0.f; nS1[i] = 0.f; nI0[i] = 0.f; nI1[i] = 0.f; }
        float dinv, iw;
        {
            bf16x8 qf[4];
#pragma unroll
            for (int s = 0; s < 4; ++s) qf[s] = *(const LAS bf16x8*)(lds + MC_Q + t * MC_PITCH + (s * 16 + 8 * h) * 2);
            const float Mt = fmaxf(mC, vM[dir * 128 + t]); float rowsum = 0.f;
#pragma unroll 1
            for (int st = 0; st < 4; ++st) { if (dir == 0 ? st > tt : st < tt) continue;
                f32x16 sT; for (int i = 0; i < 16; ++i) sT[i] = 0.f;
#pragma unroll
                for (int s = 0; s < 4; ++s) { const bf16x8 kf = *(const LAS bf16x8*)(lds + MC_K + (st * 32 + r) * MC_PITCH + (s * 16 + 8 * h) * 2); sT = MFMA32(kf, qf[s], sT); }
                float pv[16];
#pragma unroll
                for (int rg = 0; rg < 4; ++rg) { const f32x4 f4 = *(const LAS f32x4*)(vfs + dir * 128 + st * 32 + 8 * rg + 4 * h);
#pragma unroll
                    for (int k = 0; k < 4; ++k) { const int si = st * 32 + 8 * rg + 4 * h + k; const bool ok = dir == 0 ? si <= t : si >= t;
                        const float dv = ok ? __expf(f4[k] - Mt) : 0.f; pv[4 * rg + k] = sT[4 * rg + k] * dv; rowsum += pv[4 * rg + k]; } }
                const bf16x8 pf0 = pack8(pv[0], pv[1], pv[2], pv[3], pv[4], pv[5], pv[6], pv[7]), pf1 = pack8(pv[8], pv[9], pv[10], pv[11], pv[12], pv[13], pv[14], pv[15]);
                const int G4 = lane >> 4, i16 = lane & 15, q4 = i16 >> 2, p4 = i16 & 3;
                const LAS unsigned char* vbp = lds + MC_V + (st * 32 + 4 * (G4 >> 1) + q4) * MC_PITCH + (16 * (G4 & 1) + 4 * p4) * 2;
#pragma unroll
                for (int s = 0; s < 2; ++s) { const bf16x8 pf = s ? pf1 : pf0;
                    const bf16x8 va0 = cat8(tr_read(vbp + (16 * s) * MC_PITCH), tr_read(vbp + (16 * s + 8) * MC_PITCH));
                    const bf16x8 va1 = cat8(tr_read(vbp + (16 * s) * MC_PITCH + 64), tr_read(vbp + (16 * s + 8) * MC_PITCH + 64));
                    nS0 = MFMA32(va0, pf, nS0); nS1 = MFMA32(va1, pf, nS1); }
            }
            float nq = 0.f;
#pragma unroll
            for (int s = 0; s < 4; ++s) { const bf16x8 cc0 = *(const LAS bf16x8*)(Cs + r * MC_PITCH + (s * 16 + 8 * h) * 2), cc1 = *(const LAS bf16x8*)(Cs + (32 + r) * MC_PITCH + (s * 16 + 8 * h) * 2);
                nI0 = MFMA32(cc0, qf[s], nI0); nI1 = MFMA32(cc1, qf[s], nI1);
#pragma unroll
                for (int j = 0; j < 8; ++j) nq += nvec[s * 16 + 8 * h + j] * bf2f((unsigned short)qf[s][j]); }
            nq += __shfl_xor(nq, 32); rowsum += __shfl_xor(rowsum, 32);
            iw = __expf(mC - Mt);
            const float den = rowsum + iw * nq, lower = __expf(-(vb[dir * 128 + t] + Mt));
            dinv = 1.0f / fmaxf(fabsf(den), lower);
        }
        __syncthreads();
#pragma unroll
        for (int reg = 0; reg < 16; ++reg) { const int e = crow(reg, h);
            hbuf[(dir * 128 + t) * MC_HP + e] = f2bf((nS0[reg] + iw * nI0[reg]) * dinv); hbuf[(dir * 128 + t) * MC_HP + 32 + e] = f2bf((nS1[reg] + iw * nI1[reg]) * dinv); }
        __syncthreads();
#pragma unroll
        for (int i = 0; i < 2; ++i) { const int id = i * 512 + tid, tq = id >> 3, e0 = (id & 7) * 8; float o[8];
#pragma unroll
            for (int k = 0; k < 4; ++k) { const unsigned wf = *(const LAS unsigned*)(hbuf + tq * MC_HP + e0 + 2 * k), wb = *(const LAS unsigned*)(hbuf + (128 + tq) * MC_HP + e0 + 2 * k);
                o[2 * k] = sigmoid_f(bflo(mopre[i][k])) * (bflo(wf) + bflo(wb)); o[2 * k + 1] = sigmoid_f(bfhi(mopre[i][k])) * (bfhi(wf) + bfhi(wb)); }
            u32x4 w; w.x = pk2(o[0], o[1]); w.y = pk2(o[2], o[3]); w.z = pk2(o[4], o[5]); w.w = pk2(o[6], o[7]);
            *(u32x4*)(mixcat + (m0 + tq) * DM + 512 + head * 64 + e0) = w; }
        __syncthreads();
        }
    }
}

typedef GAS unsigned gu32;
#define RLX_AGENT __ATOMIC_RELAXED, __HIP_MEMORY_SCOPE_AGENT
#define XB_TMO      128
#define XB_XCNT(j)  (256  + 64 * (j))
#define XB_XSUB(j)  (1280 + 64 * (j))
#define XB_XGEN(j)  (2304 + 64 * (j))
#define XB_TOP      3328
#define XB_TOPGEN   3392
#define XCD_BAR_WORDS 3456
#define XB_SPIN_CAP (1u << 18)

__device__ __forceinline__ unsigned xb_ld(unsigned* p)              { return __hip_atomic_load(p, __ATOMIC_RELAXED, __HIP_MEMORY_SCOPE_AGENT); }
__device__ __forceinline__ unsigned xb_add(unsigned* p, unsigned v) { return __hip_atomic_fetch_add(p, v, __ATOMIC_RELAXED, __HIP_MEMORY_SCOPE_AGENT); }
__device__ __forceinline__ unsigned xb_xcc_id() { return (unsigned)__builtin_amdgcn_s_getreg((3 << 11) | 20) & 0xFu; }
#define XB_SPIN(cond, bar) do { unsigned _sp = 0; while (cond) { __builtin_amdgcn_s_sleep(1); \
    if ((++_sp & 255u) == 0u) { if (xb_ld(&(bar)[XB_TMO])) break; if (_sp > XB_SPIN_CAP) { atomicAdd(&(bar)[XB_TMO], 1u); break; } } } } while (0)

struct XcdBarrier {
    unsigned* bar; unsigned x;
    volatile LAS unsigned* st;
};

__device__ __forceinline__ XcdBarrier xcd_barrier_post(unsigned* bar, volatile LAS unsigned* st) {
    XcdBarrier b; b.bar = bar; b.x = xb_xcc_id(); b.st = st;
    if (threadIdx.x == 0) (void)xb_add(&bar[XB_XCNT(b.x)], 1u);
    return b;
}
__device__ __forceinline__ void xcd_barrier_complete(unsigned* bar, unsigned x, unsigned& nloc, unsigned& nx) {
    const unsigned G = gridDim.x * gridDim.y * gridDim.z;
    unsigned sum, cnt, mine, sp = 0u;
    for (;;) {
        sum = 0u; cnt = 0u; mine = 0u;
#pragma unroll
        for (unsigned j = 0; j < 16; ++j) { const unsigned c = xb_ld(&bar[XB_XCNT(j)]); sum += c; cnt += (c > 0u) ? 1u : 0u; mine = (j == x) ? c : mine; }
        if (sum == G) break;
        __builtin_amdgcn_s_sleep(1);
        if ((++sp & 255u) == 0u) { if (xb_ld(&bar[XB_TMO])) break; if (sp > XB_SPIN_CAP) { atomicAdd(&bar[XB_TMO], 1u); break; } }
    }
    nloc = mine > 0u ? mine : 1u; nx = cnt > 0u ? cnt : 1u;
}

__device__ __forceinline__ void xcd_barrier(const XcdBarrier& b) {
    asm volatile("s_waitcnt vmcnt(0)" ::: "memory");
    __syncthreads();
    if (threadIdx.x == 0) {
        unsigned* bar = b.bar;
        __builtin_amdgcn_s_waitcnt(0);
        unsigned nloc = b.st[0], nx = b.st[1];
        if (nloc == 0u) { xcd_barrier_complete(bar, b.x, nloc, nx); b.st[0] = nloc; b.st[1] = nx; }
        const unsigned old = xb_add(&bar[XB_XSUB(b.x)], 1u);
        const unsigned gen = old / nloc;
        if (old + 1u == (gen + 1u) * nloc) {
            __builtin_amdgcn_fence(__ATOMIC_RELEASE, "agent");
            asm volatile("s_waitcnt vmcnt(0)" ::: "memory");
            const unsigned og = xb_add(&bar[XB_TOP], 1u);
            const unsigned tg = og / nx;
            if (og + 1u == (tg + 1u) * nx) xb_add(&bar[XB_TOPGEN], 1u);
            else XB_SPIN(xb_ld(&bar[XB_TOPGEN]) == tg, bar);
            __builtin_amdgcn_fence(__ATOMIC_ACQUIRE, "agent");
            xb_add(&bar[XB_XGEN(b.x)], 1u);
            asm volatile("s_waitcnt vmcnt(0)" ::: "memory");
        } else {
            XB_SPIN(xb_ld(&bar[XB_XGEN(b.x)]) == gen, bar);
            __builtin_amdgcn_fence(__ATOMIC_ACQUIRE, "agent");
            asm volatile("s_waitcnt vmcnt(0)" ::: "memory");
        }
    }
    __syncthreads();
}


constexpr int CW_Q = 8192;
__device__ __forceinline__ bool conv_batch(const P& p, int ql, volatile LAS unsigned* wl, LAS unsigned char* L) {
    const int tid = opaque_tid(), lane = tid & 63, wave = __builtin_amdgcn_readfirstlane(tid >> 6);
    if (tid == 0) wl[3] = __hip_atomic_fetch_add((unsigned*)(p.ws + WS_CTL) + CW_Q + 64 * ql, 8u, __ATOMIC_RELAXED, __HIP_MEMORY_SCOPE_AGENT);
    __syncthreads();
    const unsigned base = wl[3];
    if (base + wave < (unsigned)ITM) convert_item(p, ql, ITS + (int)base + wave, (LAS float*)L + wave * (64 * 33), lane);
    __syncthreads();
    return base + 8u < (unsigned)ITM;
}
__device__ __forceinline__ void conv_drain(const P& p, int& qa, int upto, volatile LAS unsigned* wl, LAS unsigned char* L) { while (qa <= upto) { if (!conv_batch(p, qa, wl, L)) ++qa; } }
__device__ __forceinline__ void xcd_barrier_work(const XcdBarrier& b, const P& p, int& qa, volatile LAS unsigned* wl, LAS unsigned char* L) {
    asm volatile("s_waitcnt vmcnt(0)" ::: "memory");
    __syncthreads();
    if (threadIdx.x == 0) {
        unsigned* bar = b.bar;
        __builtin_amdgcn_s_waitcnt(0);
        unsigned nloc = b.st[0], nx = b.st[1];
        if (nloc == 0u) { xcd_barrier_complete(bar, b.x, nloc, nx); b.st[0] = nloc; b.st[1] = nx; }
        const unsigned old = xb_add(&bar[XB_XSUB(b.x)], 1u);
        const unsigned gen = old / nloc;
        if (old + 1u == (gen + 1u) * nloc) {
            __builtin_amdgcn_fence(__ATOMIC_RELEASE, "agent");
            asm volatile("s_waitcnt vmcnt(0)" ::: "memory");
            const unsigned og = xb_add(&bar[XB_TOP], 1u);
            const unsigned tg = og / nx;
            if (og + 1u == (tg + 1u) * nx) { xb_add(&bar[XB_TOPGEN], 1u); wl[0] = 2u; }
            else { wl[0] = 1u; wl[1] = tg; }
        } else { wl[0] = 0u; wl[1] = gen; }
    }
    unsigned polls = 0u;
    for (;;) {
        if (threadIdx.x == 0) { unsigned* bar = b.bar; const unsigned role = wl[0], want = wl[1];
            bool done = role == 2u || (role == 1u ? xb_ld(&bar[XB_TOPGEN]) != want : xb_ld(&bar[XB_XGEN(b.x)]) != want);
            if (!done && (++polls & 255u) == 0u) { if (xb_ld(&bar[XB_TMO])) done = true; else if (polls > XB_SPIN_CAP) { atomicAdd(&bar[XB_TMO], 1u); done = true; } }
            wl[2] = done ? 1u : 0u; }
        __syncthreads();
        const bool done = wl[2] != 0u;
        __syncthreads();
        if (done) break;
        if (qa < DEPTH) { if (!conv_batch(p, qa, wl, L)) ++qa; } else __builtin_amdgcn_s_sleep(2);
    }
    if (threadIdx.x == 0) { unsigned* bar = b.bar;
        if (wl[0] != 0u) { __builtin_amdgcn_fence(__ATOMIC_ACQUIRE, "agent"); xb_add(&bar[XB_XGEN(b.x)], 1u); asm volatile("s_waitcnt vmcnt(0)" ::: "memory"); }
        else { __builtin_amdgcn_fence(__ATOMIC_ACQUIRE, "agent"); asm volatile("s_waitcnt vmcnt(0)" ::: "memory"); }
    }
    __syncthreads();
}

__device__ __forceinline__ void ph_mod(const P& p, LAS unsigned char* lds, int wg, int G) {
    const int tid = opaque_tid(), lane = tid & 63, wave = __builtin_amdgcn_readfirstlane(tid >> 6);
    LAS float* sc = (LAS float*)lds;
    LAS float* red = (LAS float*)(lds + 65536);
    if (wg >= 384) return;
    for (int i = tid; i < 16 * DM; i += 512) { const int b = i >> 10, k = i & 1023; sc[k * 16 + b] = silu_acc(p.c[i]); }
    __syncthreads();
    float* mod = (float*)(p.ws + WS_MOD);
    for (int u = wg; u < 384; u += G) { const int l = u / 96, n0 = (u % 96) * 64;
        const float* w = p.w_ada + (size_t)l * DM * 6144 + (size_t)(wave * 128) * 6144 + n0 + lane;
        float acc[16];
#pragma unroll
        for (int b = 0; b < 16; ++b) acc[b] = 0.f;
#pragma unroll 4
        for (int k = 0; k < 128; ++k) { const float wv = w[(size_t)k * 6144]; const LAS f32x4* s4 = (const LAS f32x4*)(sc + (wave * 128 + k) * 16);
#pragma unroll
            for (int q = 0; q < 4; ++q) { const f32x4 s = s4[q]; acc[4 * q] += s[0] * wv; acc[4 * q + 1] += s[1] * wv; acc[4 * q + 2] += s[2] * wv; acc[4 * q + 3] += s[3] * wv; } }
#pragma unroll
        for (int b = 0; b < 16; ++b) red[(wave * 16 + b) * 64 + lane] = acc[b];
        __syncthreads();
        for (int i = tid; i < 1024; i += 512) { const int b = i >> 6, c = i & 63; float s = p.b_ada[l * 6144 + n0 + c];
#pragma unroll
            for (int wv = 0; wv < 8; ++wv) s += red[(wv * 16 + b) * 64 + c];
            mod[((size_t)l * 16 + b) * 6144 + n0 + c] = s; }
        __syncthreads();
    }
}

constexpr int LDS_MAIN = 131072, LDS_TOTAL = 147456, MISC_OFF = LDS_MAIN + 320;
constexpr int CW_BAR = 4096;
constexpr size_t CTL_ZERO = 65536;
constexpr int NSEQ = 2 + 9 * DEPTH;
struct Args { P p; int lo, hi; };
typedef const __attribute__((address_space(4))) Args* kargs_t;
__global__ void __launch_bounds__(512, 2) mk_fwd(Args a) {
    extern __shared__ __attribute__((aligned(16))) unsigned char lds_raw[];
    LAS unsigned char* L = (LAS unsigned char*)lds_raw;
    kargs_t ap0 = (kargs_t)__builtin_amdgcn_kernarg_segment_ptr();
#define LOADP() kargs_t ap_ = ap0; asm volatile("" : "+s"(ap_)); const P p = {ap_->p.x, ap_->p.c, ap_->p.w_ada, ap_->p.b_ada, ap_->p.w_in, ap_->p.conv_w, ap_->p.conv_b, ap_->p.gate_b, ap_->p.sink, ap_->p.rel_bias, ap_->p.w_s, ap_->p.b_s, ap_->p.w_out, ap_->p.w_router, ap_->p.w_gate, ap_->p.w_up, ap_->p.w_down, ap_->p.ln_g, ap_->p.ln_b, ap_->p.out, ap_->p.ws}; unsigned char* ws = p.ws
    const int wg = blockIdx.x, G = gridDim.x;
    { const int tid = opaque_tid(); for (int i = tid; i < (LDS_TOTAL - LDS_MAIN) / 4; i += 512) ((LAS unsigned*)(L + LDS_MAIN))[i] = 0u; }
    __syncthreads();
    XcdBarrier bar;
    { LOADP(); bar = xcd_barrier_post((unsigned*)(ws + WS_CTL) + CW_BAR, (volatile LAS unsigned*)(L + MISC_OFF) + 8); }
    int seq = 0; int qa = 0;
#ifndef DUPM
#define DUPM 0
#endif
#define DUP(i) for (int rep_ = 0; rep_ < ((DUPM >> (i)) & 1); ++rep_)
#ifndef PHM
#define PHM 0xfffff
#endif
#define RUN() (seq >= a.lo && seq < a.hi)
#define SEAM() do { if (seq + 1 < a.hi) xcd_barrier_work(bar, p, qa, (volatile LAS unsigned*)(L + MISC_OFF) + 16, L); } while (0)
    if (((PHM >> 0) & 1) && RUN()) {
        LOADP(); ph_mod(p, L, wg, G);
        const int tid = opaque_tid(), lane = tid & 63, wave = __builtin_amdgcn_readfirstlane(tid >> 6), gw = wg * 8 + wave, ngw = G * 8;
        { LAS float* scr = (LAS float*)L + wave * (64 * 33); for (int it = gw; it < DEPTH * ITS; it += ngw) convert_item(p, it / ITS, it % ITS, scr, lane); }
        { bf16* wsb = (bf16*)(ws + WS_WS); for (int i = wg * 512 + tid; i < DEPTH * 4 * 128 * 128; i += G * 512) wsb[i] = (bf16)f2bf(p.w_s[i]); }
        SEAM(); }
    ++seq;
    if (((PHM >> 1) & 1) && RUN()) { LOADP(); rows_entry_simple(p, wg, G); SEAM(); }
    ++seq;
#pragma unroll 1
    for (int l = 0; l < DEPTH; ++l) {
        if (((PHM >> 2) & 1) && RUN()) { LOADP();
            pg8::Gemm g{(const bf16*)(ws + WS_H), (const bf16*)(ws + WS_WIN) + (size_t)l * PNW * DM, NTOK, PNW, DM}; pg8::EpiProj E{(bf16*)(ws + WS_PROJ), (float*)(ws + WS_GATES), p.gate_b + l * 16};
            pg8::StaticOrder S; S.init(NTOK, PNW, G, wg);
            pg8::gemm_phase<pg8::EpiProj, pg8::StaticOrder, true, true>(L, g, S, E); SEAM(); }
        ++seq;
        if (((PHM >> 3) & 1) && RUN()) { LOADP(); DUP(2) ph_attn(p, l, L, wg, G); ph_attn(p, l, L, wg, G); DUP(3) ph_gmlp(p, l, L, wg, G); ph_gmlp(p, l, L, wg, G); DUP(4) ph_mlstm_a(p, l, L, wg, G); ph_mlstm_a(p, l, L, wg, G); SEAM(); }
        ++seq;
        if (((PHM >> 4) & 1) && RUN()) { LOADP(); DUP(5) ph_mlstm_c(p, l, L, wg, G); ph_mlstm_c(p, l, L, wg, G); SEAM(); }
        ++seq;
        if (((PHM >> 5) & 1) && RUN()) { LOADP();
            pg8::Gemm g{(const bf16*)(ws + WS_MIXCAT), (const bf16*)(ws + WS_WOUT) + (size_t)l * DM * DM, NTOK, DM, DM}; pg8::EpiBf16 E{(bf16*)(ws + WS_MIX), DM};
            pg8::StaticOrder S; S.init(NTOK, DM, G, wg);
            pg8::gemm_phase<pg8::EpiBf16, pg8::StaticOrder, true, true>(L, g, S, E); SEAM(); }
        ++seq;
        if (((PHM >> 6) & 1) && RUN()) { LOADP(); DUP(9) rows_phase<1>(p, l, l == 0 ? p.x : (const float*)(ws + WS_XA), L, wg, G, true); rows_phase<1>(p, l, l == 0 ? p.x : (const float*)(ws + WS_XA), L, wg, G); SEAM(); }
        ++seq;
        if (((PHM >> 7) & 1) && RUN()) { LOADP(); ph_topk(p, L, wg, G); conv_drain(p, qa, l, (volatile LAS unsigned*)(L + MISC_OFF) + 16, L); SEAM(); }
        ++seq;
        if (((PHM >> 8) & 1) && RUN()) { LOADP();
            pg8::Gemm g{(const bf16*)(ws + WS_H8), (const bf16*)(ws + WS_WGU + (size_t)l * NE * 4096 * DM), NGRP * 256, 4096, DM, SC_A1, SC_B1}; pg8::EpiSwiGLU8 E{ws + WS_HID};
            pg8::MoeOrder1 S; S.G = G; S.c = wg; S.idx = (const unsigned short*)(ws + WS_IDX);
            pg8::gemm_phase<pg8::EpiSwiGLU8, pg8::MoeOrder1, true, true, true, true>(L, g, S, E); SEAM(); }
        ++seq;
        if (((PHM >> 9) & 1) && RUN()) { LOADP();
            pg8::Gemm g{(const bf16*)(ws + WS_HID), (const bf16*)(ws + WS_WD + (size_t)l * NE * DM * DE), NGRP * 256, DM, DE, SC_A2, SC_B2}; pg8::EpiScaleFp8 E{ws + WS_YE, (const float*)(ws + WS_GATEV)};
            pg8::MoeOrder2 S; S.G = G; S.c = wg;
            pg8::gemm_phase<pg8::EpiScaleFp8, pg8::MoeOrder2, true, true, true>(L, g, S, E); SEAM(); }
        ++seq;
        if (((PHM >> 10) & 1) && RUN()) { LOADP(); DUP(10) rows_phase<2>(p, l, (const float*)(ws + WS_XA), L, wg, G, true); rows_phase<2>(p, l, (const float*)(ws + WS_XA), L, wg, G); SEAM(); }
        ++seq;
    }
#undef RUN
#undef SEAM
#undef LOADP
}

#ifndef MK_PER_PHASE
#define MK_PER_PHASE 0
#endif
extern "C" void kernel_launch(void* const* d_in, const int* in_sizes, int n_in, void* d_out, int out_size, void* d_ws, size_t ws_size, hipStream_t stream) {
    static int grid = 0;
    if (grid == 0) {
        if (n_in != 19 || in_sizes[0] != NTOK * DM || out_size != NTOK * DM || ws_size < WS_END) {
            fprintf(stderr, "kernel_launch: unexpected shapes: n_in %d in0 %d out %d ws %zu (need %zu)\n", n_in, n_in > 0 ? in_sizes[0] : -1, out_size, ws_size, (size_t)WS_END); grid = -1; return; }
        int dev = 0, cus = 0, per_cu = 0;
        if (hipGetDevice(&dev) != hipSuccess || hipDeviceGetAttribute(&cus, hipDeviceAttributeMultiprocessorCount, dev) != hipSuccess) { fprintf(stderr, "kernel_launch: device query failed\n"); grid = -1; return; }
        if (hipFuncSetAttribute((const void*)mk_fwd, hipFuncAttributeMaxDynamicSharedMemorySize, LDS_TOTAL) != hipSuccess) { fprintf(stderr, "kernel_launch: hipFuncSetAttribute failed\n"); grid = -1; return; }
        if (hipOccupancyMaxActiveBlocksPerMultiprocessor(&per_cu, (const void*)mk_fwd, 512, LDS_TOTAL) != hipSuccess || per_cu < 1) { fprintf(stderr, "kernel_launch: occupancy query reports %d blocks per CU\n", per_cu); }
        (void)hipGetLastError();
        grid = cus;
    }
    if (grid < 0) return;
    if (hipMemsetAsync((char*)d_ws + WS_CTL, 0, CTL_ZERO, stream) != hipSuccess) { fprintf(stderr, "kernel_launch: memset failed\n"); return; }
    Args a{};
    const float** pf = (const float**)&a.p;
    for (int i = 0; i < 19; ++i) pf[i] = (const float*)d_in[i];
    a.p.out = (float*)d_out; a.p.ws = (unsigned char*)d_ws;
#if MK_PER_PHASE
    for (int s = 0; s < NSEQ; ++s) { a.lo = s; a.hi = s + 1; hipLaunchKernelGGL(mk_fwd, dim3(grid), dim3(512), LDS_TOTAL, stream, a); }
#else
    a.lo = 0; a.hi = NSEQ;
    hipLaunchKernelGGL(mk_fwd, dim3(grid), dim3(512), LDS_TOTAL, stream, a);
#endif
    const hipError_t le = hipPeekAtLastError();
    if (le != hipSuccess) fprintf(stderr, "kernel_launch: launch failed: %s\n", hipGetErrorName(le));
}
```

```cpp
#include <hip/hip_runtime.h>
#include <cstdio>
#include <cstdint>
__device__ __forceinline__ int opaque_tid() { int t = threadIdx.x; asm volatile("" : "+v"(t)); return t; }
namespace pg8 {
#define PG8_LAS __attribute__((address_space(3)))
typedef unsigned short bf16_t;
typedef short bf16x8 __attribute__((ext_vector_type(8)));
typedef float f32x4 __attribute__((ext_vector_type(4)));
typedef unsigned u32x4 __attribute__((ext_vector_type(4)));
constexpr int BM = 256, BK = 64, HALF = 128, HTB = HALF * BK * 2  , STAGE_BYTES = 8 * HTB, NXCD = 8, WGM = 8;

__host__ __device__ __forceinline__ int lds_byte(int r, int c) { const int st = (r >> 4) * 2 + (c >> 5), rr = r & 15, cc = c & 31, ob = rr * 64 + cc * 2; return st * 1024 + (ob ^ (((ob >> 9) & 1) << 5)); }
__host__ __device__ __forceinline__ void stage_rc(int b, int& R, int& C) { const int st = b / 1024, sb = b % 1024, swz = sb ^ (((sb >> 9) & 1) << 5); R = (st >> 1) * 16 + swz / 64; C = (st & 1) * 32 + (swz % 64) / 2; }
__host__ __device__ __forceinline__ int perm32(int rho) { const int n = rho >> 4, i = rho & 15; return 8 * (i >> 2) + 4 * n + (i & 3); }

struct Unit { int pm, pn; };
struct Gemm { const bf16_t* A; const bf16_t* Bt; int M, N, K; int sa, sb, sb1; };
typedef int v4i_t __attribute__((ext_vector_type(4)));
typedef int v8i_t __attribute__((ext_vector_type(8)));
__device__ __forceinline__ v8i_t cat32(bf16x8 lo, bf16x8 hi) { const v4i_t a = __builtin_bit_cast(v4i_t, lo), b = __builtin_bit_cast(v4i_t, hi); return __builtin_shufflevector(a, b, 0, 1, 2, 3, 4, 5, 6, 7); }

struct StaticOrder {
    int nM, nN, nwg, G, c;
    __host__ __device__ void init(int M, int N, int G_, int c_) { nM = M / BM; nN = N / BM; nwg = nM * nN; G = G_; c = c_; }
    __host__ __device__ bool next(int i, Unit& u) const {
        const long L = (long)i * G + c; if (L >= nwg) return false;
        int wgid = (int)L; { const int q = nwg / NXCD, r = nwg % NXCD, xcd = wgid % NXCD, off = wgid / NXCD; wgid = (xcd < r ? xcd * (q + 1) : r * (q + 1) + (xcd - r) * q) + off; }
        const int nig = WGM * nN, gid = wgid / nig, fm = gid * WGM, gsz = (nM - fm) < WGM ? (nM - fm) : WGM;
        u.pm = fm + ((wgid % nig) % gsz); u.pn = (wgid % nig) / gsz; return true;
    }
    __device__ __forceinline__ void a_ready(const Unit&) const {}
    __device__ __forceinline__ void done(const Unit&) const {}
    __device__ __forceinline__ unsigned a_rowoff_unused() const { return 0u; }
};

typedef float f32x2p __attribute__((ext_vector_type(2))); typedef __bf16 bf16x2p __attribute__((ext_vector_type(2)));
__device__ __forceinline__ unsigned cvt_pk_bf16(float lo, float hi) { const f32x2p v = {lo, hi}; return __builtin_bit_cast(unsigned, __builtin_convertvector(v, bf16x2p)); }
__device__ __forceinline__ float silu_f(float x) { return x * __builtin_amdgcn_rcpf(1.0f + __builtin_amdgcn_exp2f(x * -1.4426950408889634f)); }
__device__ __forceinline__ float silu2_f(float y) { return y * __builtin_amdgcn_rcpf(1.0f + __builtin_amdgcn_exp2f(-y)); }

struct EpiBf16 {
    static constexpr bool PERM = true, AFTER_DRAIN = false;
    bf16_t* O; int ldc;
    __device__ __forceinline__ void operator()(const f32x4 (&acc)[2][2][4][2], const Unit& u, int wr, int wc, int fr, int fq) const {
        const int row0 = u.pm * BM + wr * 64 + fr, col0 = u.pn * BM + wc * 32 + 8 * fq;
#pragma unroll
        for (int ai = 0; ai < 2; ++ai)
#pragma unroll
            for (int m = 0; m < 4; ++m) { bf16_t* rowp = O + (size_t)(row0 + ai * HALF + m * 16) * ldc + col0;
#pragma unroll
                for (int bj = 0; bj < 2; ++bj) { const f32x4 v0 = acc[ai][bj][m][0], v1 = acc[ai][bj][m][1];
                    u32x4 w; w.x = cvt_pk_bf16(v0[0], v0[1]); w.y = cvt_pk_bf16(v0[2], v0[3]); w.z = cvt_pk_bf16(v1[0], v1[1]); w.w = cvt_pk_bf16(v1[2], v1[3]);
                    *(u32x4*)(rowp + bj * HALF) = w; } }
    }
};
struct EpiProj {
    static constexpr bool PERM = true, AFTER_DRAIN = false;
    bf16_t* O; float* gates; const float* gate_b;
    __device__ __forceinline__ void operator()(const f32x4 (&acc)[2][2][4][2], const Unit& u, int wr, int wc, int fr, int fq) const {
        const int row0 = u.pm * BM + wr * 64 + fr;
        if (u.pn < 9) { const int col0 = u.pn * BM + wc * 32 + 8 * fq;
#pragma unroll
            for (int ai = 0; ai < 2; ++ai)
#pragma unroll
                for (int m = 0; m < 4; ++m) { bf16_t* rowp = O + (size_t)(row0 + ai * HALF + m * 16) * 2304 + col0;
#pragma unroll
                    for (int bj = 0; bj < 2; ++bj) { const f32x4 v0 = acc[ai][bj][m][0], v1 = acc[ai][bj][m][1];
                        u32x4 w; w.x = cvt_pk_bf16(v0[0], v0[1]); w.y = cvt_pk_bf16(v0[2], v0[3]); w.z = cvt_pk_bf16(v1[0], v1[1]); w.w = cvt_pk_bf16(v1[2], v1[3]);
                        *(u32x4*)(rowp + bj * HALF) = w; } }
        } else if (wc == 0 && fq < 2) { const f32x4 g0 = *(const f32x4*)(gate_b + 8 * fq), g1 = *(const f32x4*)(gate_b + 8 * fq + 4);
#pragma unroll
            for (int ai = 0; ai < 2; ++ai)
#pragma unroll
                for (int m = 0; m < 4; ++m) { float* gp = gates + (size_t)(row0 + ai * HALF + m * 16) * 16 + 8 * fq;
                    *(f32x4*)gp = acc[ai][0][m][0] + g0; *(f32x4*)(gp + 4) = acc[ai][0][m][1] + g1; } }
    }
};
struct EpiSwiGLU {
    static constexpr bool PERM = true, AFTER_DRAIN = false;
    bf16_t* H;
    __device__ __forceinline__ void operator()(const f32x4 (&acc)[2][2][4][2], const Unit& u, int wr, int wc, int fr, int fq) const {
        const int row0 = u.pm * BM + wr * 64 + fr, col0 = (u.pn & 15) * 128 + wc * 32 + 8 * fq;
#pragma unroll
        for (int ai = 0; ai < 2; ++ai)
#pragma unroll
            for (int m = 0; m < 4; ++m) { bf16_t* rowp = H + (size_t)(row0 + ai * HALF + m * 16) * 2048 + col0;
                const f32x4 g0 = acc[ai][0][m][0], g1 = acc[ai][0][m][1], u0 = acc[ai][1][m][0], u1 = acc[ai][1][m][1];
                u32x4 w; w.x = cvt_pk_bf16(silu_f(g0[0]) * u0[0], silu_f(g0[1]) * u0[1]); w.y = cvt_pk_bf16(silu_f(g0[2]) * u0[2], silu_f(g0[3]) * u0[3]);
                w.z = cvt_pk_bf16(silu_f(g1[0]) * u1[0], silu_f(g1[1]) * u1[1]); w.w = cvt_pk_bf16(silu_f(g1[2]) * u1[2], silu_f(g1[3]) * u1[3]);
                *(u32x4*)rowp = w; }
    }
};
__device__ __forceinline__ unsigned pk4_fp8(float a, float b, float c, float d) {
    int w = 0; w = __builtin_amdgcn_cvt_pk_fp8_f32(a, b, w, false); w = __builtin_amdgcn_cvt_pk_fp8_f32(c, d, w, true); return (unsigned)w; }
constexpr float HID_SCALE = 4.0f;
typedef unsigned u32x2e __attribute__((ext_vector_type(2)));
__device__ __forceinline__ f32x2p swiglu2(f32x2p y, f32x2p u) {
    const f32x2p e = {__builtin_amdgcn_exp2f(-y[0]), __builtin_amdgcn_exp2f(-y[1])}; const f32x2p d = e + 1.0f;
    const f32x2p r = {__builtin_amdgcn_rcpf(d[0]), __builtin_amdgcn_rcpf(d[1])}; return (y * r) * u; }
struct EpiSwiGLU8 {
    static constexpr bool PERM = true, AFTER_DRAIN = false;
    unsigned char* H;
    __device__ __forceinline__ void operator()(const f32x4 (&acc)[2][2][4][2], const Unit& u, int wr, int wc, int fr, int fq) const {
        const int row0 = u.pm * BM + wr * 64 + fr, col0 = (u.pn & 15) * 128 + wc * 32 + 8 * fq;
#pragma unroll
        for (int ai = 0; ai < 2; ++ai)
#pragma unroll
            for (int m = 0; m < 4; ++m) { unsigned char* rowp = H + (size_t)(row0 + ai * HALF + m * 16) * 2048 + col0;
                const f32x4 g0 = acc[ai][0][m][0], g1 = acc[ai][0][m][1], u0 = acc[ai][1][m][0], u1 = acc[ai][1][m][1];
                const f32x2p a0 = swiglu2((f32x2p){g0[0], g0[1]}, (f32x2p){u0[0], u0[1]}), a1 = swiglu2((f32x2p){g0[2], g0[3]}, (f32x2p){u0[2], u0[3]});
                const f32x2p b0 = swiglu2((f32x2p){g1[0], g1[1]}, (f32x2p){u1[0], u1[1]}), b1 = swiglu2((f32x2p){g1[2], g1[3]}, (f32x2p){u1[2], u1[3]});
                u32x2e w; w.x = pk4_fp8(a0[0], a0[1], a1[0], a1[1]); w.y = pk4_fp8(b0[0], b0[1], b1[0], b1[1]);
                *(u32x2e*)rowp = w; }
    }
};
struct EpiScaleBf16 {
    static constexpr bool PERM = true, AFTER_DRAIN = false;
    bf16_t* Y; const float* gate;
    __device__ __forceinline__ void operator()(const f32x4 (&acc)[2][2][4][2], const Unit& u, int wr, int wc, int fr, int fq) const {
        const int row0 = u.pm * BM + wr * 64 + fr, col0 = (u.pn & 3) * BM + wc * 32 + 8 * fq;
#pragma unroll
        for (int ai = 0; ai < 2; ++ai)
#pragma unroll
            for (int m = 0; m < 4; ++m) { const int r = row0 + ai * HALF + m * 16; const float gv = gate[r]; bf16_t* rowp = Y + (size_t)r * 1024 + col0;
#pragma unroll
                for (int bj = 0; bj < 2; ++bj) { const f32x4 v0 = acc[ai][bj][m][0] * gv, v1 = acc[ai][bj][m][1] * gv;
                    u32x4 w; w.x = cvt_pk_bf16(v0[0], v0[1]); w.y = cvt_pk_bf16(v0[2], v0[3]); w.z = cvt_pk_bf16(v1[0], v1[1]); w.w = cvt_pk_bf16(v1[2], v1[3]);
                    *(u32x4*)(rowp + bj * HALF) = w; } }
    }
};
constexpr float YE_SCALE = 256.0f;
struct EpiScaleFp8 {
    static constexpr bool PERM = true, AFTER_DRAIN = false;
    unsigned char* Y; const float* gate;
    __device__ __forceinline__ void operator()(const f32x4 (&acc)[2][2][4][2], const Unit& u, int wr, int wc, int fr, int fq) const {
        const int row0 = u.pm * BM + wr * 64 + fr, pcol = (u.pn & 3) * BM + 16 * (wc * 4 + fq);
#pragma unroll
        for (int ai = 0; ai < 2; ++ai)
#pragma unroll
            for (int m = 0; m < 4; ++m) { const int r = row0 + ai * HALF + m * 16; const float gv = gate[r] * YE_SCALE; u32x4 w;
#pragma unroll
                for (int bj = 0; bj < 2; ++bj) { const f32x4 v0 = acc[ai][bj][m][0] * gv, v1 = acc[ai][bj][m][1] * gv;
                    w[2 * bj] = pk4_fp8(v0[0], v0[1], v0[2], v0[3]); w[2 * bj + 1] = pk4_fp8(v1[0], v1[1], v1[2], v1[3]); }
                *(u32x4*)(Y + (size_t)r * 1024 + pcol) = w; }
    }
};
struct MoeOrder1 {
    int G, c; const unsigned short* idx;
    __device__ __forceinline__ int a_rowtok(const Unit& u, int r) const { return idx[((u.pm * 2 + (r >> 7)) * 64 + (r & 63)) * 2 + ((r >> 6) & 1)]; }
    __device__ __forceinline__ unsigned a_rowoff(const Unit& u, int r) const { return (unsigned)(((u.pm & 15) * 2048 + a_rowtok(u, r)) * 1024); }
    __device__ __forceinline__ unsigned a_rowpair(const Unit& u, int hh, int r0) const { return *(const unsigned*)(idx + ((u.pm * 2 + hh) * 64 + r0) * 2); }
    __device__ __forceinline__ unsigned a_rowoff_tok(const Unit& u, int tok) const { return (unsigned)(((u.pm & 15) * 2048 + tok) * 1024); }
    __device__ __forceinline__ bool next(int i, Unit& u) const {
        const long L = (long)i * G + c; if (L >= 4096) return false;
        const int e = (int)(L >> 8), rem = (int)(L & 255), x = rem & 7, v = rem >> 3;
        const int b = 4 * (x >> 1) + (v >> 3), j = 8 * (x & 1) + (v & 7);
        u.pm = e * 16 + b; u.pn = e * 16 + j; return true;
    }
    __device__ __forceinline__ void a_ready(const Unit&) const {}
    __device__ __forceinline__ void done(const Unit&) const {}
    __device__ __forceinline__ unsigned a_rowoff_unused() const { return 0u; }
};
struct MoeOrder2 {
    int G, c;
    __device__ __forceinline__ bool next(int i, Unit& u) const {
        const long L = (long)i * G + c; if (L >= 1024) return false;
        const int rnd = (int)(L >> 8), rem = (int)(L & 255), x = rem & 7, v = rem >> 3;
        const int e = rnd * 4 + (x >> 1), b = 8 * (x & 1) + (v >> 2), j = v & 3;
        u.pm = e * 16 + b; u.pn = e * 4 + j; return true;
    }
    __device__ __forceinline__ void a_ready(const Unit&) const {}
    __device__ __forceinline__ void done(const Unit&) const {}
    __device__ __forceinline__ unsigned a_rowoff_unused() const { return 0u; }
};

template <class Epi, class Sched, bool ALIGN_EPI = false, bool SP2 = false, bool F8 = false, bool GATH = false>
__device__ __forceinline__ void gemm_phase(PG8_LAS unsigned char* lds, const Gemm g, const Sched& S, const Epi& E) {
    const int tid = opaque_tid(), wid = __builtin_amdgcn_readfirstlane(tid >> 6), lane = tid & 63, wr = wid >> 2, wc = wid & 3, fr = lane & 15, fq = lane >> 4;
    const int K = g.K, RB = F8 ? K : 2 * K, nt = RB / 128;
    unsigned voffA[2], voffB[2];
#pragma unroll
    for (int i = 0; i < 2; ++i) { int R, C; stage_rc(tid * 16 + i * 8192, R, C); const int Rb = Epi::PERM ? ((R & ~31) + perm32(R & 31)) : R;
        voffA[i] = (unsigned)(R * RB + C * 2); voffB[i] = (unsigned)(Rb * RB + C * 2); }
    const __amdgpu_buffer_rsrc_t rsA = __builtin_amdgcn_make_buffer_rsrc((void*)g.A, 0, 0x7fffffff, 0x00020000), rsB = __builtin_amdgcn_make_buffer_rsrc((void*)g.Bt, 0, 0x7fffffff, 0x00020000);
    const size_t kstep = (size_t)(BK * 2);
    const size_t hstep = (size_t)HALF * RB;
    const size_t tstep = 2 * hstep;
    const unsigned ldsw = (unsigned)wid * 1024u;
    const int aoff = lds_byte(wr * 64 + fr, fq * 8), boff = lds_byte(wc * 32 + fr, fq * 8);
#define PG8_SA(b, h) (((b) * 2 + (h)) * HTB)
#define PG8_SB(b, h) ((4 + (b) * 2 + (h)) * HTB)
#define PG8_STAGE(bufoff, gbase, voff, rs, base) do { if constexpr (F8) { const int so_ = __builtin_amdgcn_readfirstlane((int)((const char*)(gbase) - (const char*)(base))); _Pragma("unroll") for (int _i = 0; _i < 2; ++_i) \
        __builtin_amdgcn_raw_ptr_buffer_load_lds(rs, (PG8_LAS void*)(lds + (bufoff) + ldsw + _i * 8192), 16, (int)(voff)[_i], so_, 0, 0); } \
        else { _Pragma("unroll") for (int _i = 0; _i < 2; ++_i) \
        __builtin_amdgcn_global_load_lds((const unsigned*)((const char*)(gbase) + (voff)[_i]), (PG8_LAS unsigned*)(lds + (bufoff) + ldsw + _i * 8192), 16, 0, 0); } } while (0)
#define PG8_STAGEA(bufoff, gptr, half, usenext) do { if constexpr (GATH) { const int so_ = __builtin_amdgcn_readfirstlane((int)((const char*)(gptr) - (const char*)g.A)); _Pragma("unroll") for (int _i = 0; _i < 2; ++_i) \
        __builtin_amdgcn_raw_ptr_buffer_load_lds(rsA, (PG8_LAS void*)(lds + (bufoff) + ldsw + _i * 8192), 16, (int)vAc[half][_i], so_, 0, 0); } \
        else { PG8_STAGE(bufoff, (gptr) + (half) * hstep, voffA, rsA, g.A); } } while (0)
#define PG8_GSWITCH do { if constexpr (GATH) { if (un) {   \
        asm volatile("" : "+v"(tpk[0]), "+v"(tpk[1]));     \
        _Pragma("unroll") for (int hh = 0; hh < 2; ++hh) _Pragma("unroll") for (int i = 0; i < 2; ++i) { int R, C; stage_rc(opaque_tid() * 16 + i * 8192, R, C); vAc[hh][i] = S.a_rowoff_tok(nxt, (int)((tpk[hh] >> (16 * i)) & 0xffffu)) + (unsigned)(C * 2); } } } } while (0)
#define PG8_LDA(dst, b, h) do { if constexpr (F8) { _Pragma("unroll") for (int m = 0; m < 4; ++m) dst##8[m] = cat32(*(const PG8_LAS bf16x8*)(lds + PG8_SA(b, h) + aoff + m * 2048), *(const PG8_LAS bf16x8*)(lds + PG8_SA(b, h) + aoff + m * 2048 + 1024)); } \
        else { _Pragma("unroll") for (int m = 0; m < 4; ++m) _Pragma("unroll") for (int k = 0; k < 2; ++k) dst[m][k] = *(const PG8_LAS bf16x8*)(lds + PG8_SA(b, h) + aoff + m * 2048 + k * 1024); } } while (0)
#define PG8_LDB(dst, b, h) do { if constexpr (F8) { _Pragma("unroll") for (int n = 0; n < 2; ++n) dst##8[n] = cat32(*(const PG8_LAS bf16x8*)(lds + PG8_SB(b, h) + boff + n * 2048), *(const PG8_LAS bf16x8*)(lds + PG8_SB(b, h) + boff + n * 2048 + 1024)); } \
        else { _Pragma("unroll") for (int n = 0; n < 2; ++n) _Pragma("unroll") for (int k = 0; k < 2; ++k) dst[n][k] = *(const PG8_LAS bf16x8*)(lds + PG8_SB(b, h) + boff + n * 2048 + k * 1024); } } while (0)
#define PG8_MMA(ai, bj, At, Bt) do { __builtin_amdgcn_s_setprio(1); _Pragma("unroll") for (int m = 0; m < 4; ++m) _Pragma("unroll") for (int n = 0; n < 2; ++n) { \
        if constexpr (F8) { acc[ai][bj][m][n] = __builtin_amdgcn_mfma_scale_f32_16x16x128_f8f6f4(Bt##8[n], At##8[m], acc[ai][bj][m][n], 0, 0, 0, (bj) ? g.sb1 : g.sb, 0, g.sa); } \
        else { _Pragma("unroll") for (int k = 0; k < 2; ++k) acc[ai][bj][m][n] = __builtin_amdgcn_mfma_f32_16x16x32_bf16(Bt[n][k], At[m][k], acc[ai][bj][m][n], 0, 0, 0); } } __builtin_amdgcn_s_setprio(0); } while (0)
#define PG8_WAIT_V(n) asm volatile("s_waitcnt vmcnt(" #n ")" ::: "memory")
#define PG8_WAIT_L(n) asm volatile("s_waitcnt lgkmcnt(" #n ")" ::: "memory")
#define PG8_BAR __builtin_amdgcn_s_barrier()
#define PG8_SCHED __builtin_amdgcn_sched_barrier(0)
    Unit cur, nxt; int ui = 0;
    if (!S.next(0, cur)) return;
    f32x4 acc[2][2][4][2];
#pragma unroll
    for (int a = 0; a < 2; ++a)
#pragma unroll
        for (int b = 0; b < 2; ++b)
#pragma unroll
            for (int m = 0; m < 4; ++m)
#pragma unroll
                for (int n = 0; n < 2; ++n) acc[a][b][m][n] = (f32x4){0.f, 0.f, 0.f, 0.f};
    bf16x8 At[4][2], B0[2][2], B1[2][2];
    v8i_t At8[4], B08[2], B18[2];
    const char* cA = (const char*)g.A + (GATH ? (size_t)0 : (size_t)cur.pm * tstep); const char* cB = (const char*)g.Bt + (size_t)cur.pn * tstep;
    unsigned vAc[2][2];
    if constexpr (GATH) {
#pragma unroll
        for (int hh = 0; hh < 2; ++hh)
#pragma unroll
            for (int i = 0; i < 2; ++i) { int R, C; stage_rc(tid * 16 + i * 8192, R, C); vAc[hh][i] = S.a_rowoff(cur, hh * HALF + R) + (unsigned)(C * 2); } }
    S.a_ready(cur);
    if constexpr (SP2) {
        PG8_STAGE(PG8_SB(0, 0), cB, voffB, rsB, g.Bt); PG8_STAGE(PG8_SB(0, 1), cB + hstep, voffB, rsB, g.Bt); PG8_STAGEA(PG8_SA(0, 0), cA, 0, false); PG8_STAGEA(PG8_SA(0, 1), cA, 1, false);
        if (wr == 1) PG8_BAR;
        PG8_WAIT_V(2); PG8_BAR;
        PG8_STAGE(PG8_SB(1, 0), cB + kstep, voffB, rsB, g.Bt); PG8_STAGEA(PG8_SA(1, 0), cA + kstep, 0, false); PG8_STAGE(PG8_SB(1, 1), cB + hstep + kstep, voffB, rsB, g.Bt);
        PG8_WAIT_V(6); PG8_BAR;
    } else {
        PG8_STAGE(PG8_SB(0, 0), cB, voffB, rsB, g.Bt); PG8_STAGEA(PG8_SA(0, 0), cA, 0, false); PG8_STAGE(PG8_SB(0, 1), cB + hstep, voffB, rsB, g.Bt); PG8_STAGEA(PG8_SA(0, 1), cA, 1, false);
        if (wr == 1) PG8_BAR;
        PG8_WAIT_V(4); PG8_BAR;
        PG8_STAGE(PG8_SB(1, 0), cB + kstep, voffB, rsB, g.Bt); PG8_STAGEA(PG8_SA(1, 0), cA + kstep, 0, false); PG8_STAGE(PG8_SB(1, 1), cB + hstep + kstep, voffB, rsB, g.Bt);
        PG8_WAIT_V(6); PG8_BAR;
    }
    unsigned tpk[2] = {0u, 0u};
    if constexpr (GATH) { Unit n1; if (S.next(1, n1)) {
#pragma unroll
        for (int hh = 0; hh < 2; ++hh) { int R0, C0; stage_rc(opaque_tid() * 16, R0, C0); tpk[hh] = S.a_rowpair(n1, hh, R0); } } }
    for (;;) {
        const bool has_next = S.next(ui + 1, nxt);
        const char* nA = (has_next && !GATH) ? (const char*)g.A + (size_t)nxt.pm * tstep : cA; const char* nB = has_next ? (const char*)g.Bt + (size_t)nxt.pn * tstep : cB;

#pragma unroll 1
        for (int t = 0; t < nt; t += 2) {
            const bool last = (t == nt - 2); const bool un = last && has_next;

            const char* a1 = cA + (size_t)(t + 1) * kstep;
            const char* a2 = last ? nA : cA + (size_t)(t + 2) * kstep; const char* b2 = last ? nB : cB + (size_t)(t + 2) * kstep;
            const char* a3 = a2 + kstep; const char* b3 = b2 + kstep;
            if (last && has_next) S.a_ready(nxt);
            if constexpr (SP2) {
            PG8_LDB(B0, 0, 0); PG8_LDB(B1, 0, 1); PG8_SCHED; PG8_LDA(At, 0, 0); PG8_STAGEA(PG8_SA(1, 1), a1, 1, false); PG8_GSWITCH;
            PG8_WAIT_V(8); PG8_WAIT_L(0); PG8_BAR; PG8_MMA(0, 0, At, B0); PG8_MMA(0, 1, At, B1); PG8_BAR; PG8_SCHED;
            PG8_LDA(At, 0, 1); PG8_STAGE(PG8_SB(0, 0), b2, voffB, rsB, g.Bt); PG8_STAGE(PG8_SB(0, 1), b2 + hstep, voffB, rsB, g.Bt); PG8_STAGEA(PG8_SA(0, 0), a2, 0, un);
            PG8_WAIT_V(8); PG8_WAIT_L(0); PG8_BAR; PG8_MMA(1, 0, At, B0); PG8_MMA(1, 1, At, B1); PG8_BAR; PG8_SCHED;
            PG8_LDB(B0, 1, 0); PG8_LDB(B1, 1, 1); PG8_SCHED; PG8_LDA(At, 1, 0); PG8_STAGEA(PG8_SA(0, 1), a2, 1, un);
            PG8_WAIT_V(8); PG8_WAIT_L(0); PG8_BAR; PG8_MMA(0, 0, At, B0); PG8_MMA(0, 1, At, B1); PG8_BAR; PG8_SCHED;
            PG8_LDA(At, 1, 1); PG8_STAGE(PG8_SB(1, 0), b3, voffB, rsB, g.Bt); PG8_STAGE(PG8_SB(1, 1), b3 + hstep, voffB, rsB, g.Bt); PG8_STAGEA(PG8_SA(1, 0), a3, 0, un);
            PG8_WAIT_V(8); PG8_WAIT_L(0); PG8_BAR; PG8_MMA(1, 0, At, B0); PG8_MMA(1, 1, At, B1); PG8_BAR; PG8_SCHED;
            } else {
            PG8_LDB(B0, 0, 0); PG8_SCHED; PG8_LDA(At, 0, 0); PG8_STAGEA(PG8_SA(1, 1), a1, 1, false); PG8_GSWITCH;
            PG8_WAIT_L(8); PG8_BAR; PG8_WAIT_L(0); PG8_MMA(0, 0, At, B0); PG8_BAR; PG8_SCHED;
            PG8_LDB(B1, 0, 1); PG8_STAGE(PG8_SB(0, 0), b2, voffB, rsB, g.Bt);
            PG8_BAR; PG8_WAIT_L(0); PG8_MMA(0, 1, At, B1); PG8_BAR;
            PG8_LDA(At, 0, 1); PG8_STAGEA(PG8_SA(0, 0), a2, 0, un);
            PG8_BAR; PG8_WAIT_L(0); PG8_MMA(1, 0, At, B0); PG8_BAR; PG8_SCHED;
            PG8_STAGE(PG8_SB(0, 1), b2 + hstep, voffB, rsB, g.Bt);
            PG8_WAIT_V(6); PG8_BAR; PG8_MMA(1, 1, At, B1); PG8_BAR;
            PG8_LDB(B0, 1, 0); PG8_SCHED; PG8_LDA(At, 1, 0); PG8_STAGEA(PG8_SA(0, 1), a2, 1, un);
            PG8_WAIT_L(8); PG8_BAR; PG8_WAIT_L(0); PG8_MMA(0, 0, At, B0); PG8_BAR; PG8_SCHED;
            PG8_LDB(B1, 1, 1); PG8_STAGE(PG8_SB(1, 0), b3, voffB, rsB, g.Bt);
            PG8_BAR; PG8_WAIT_L(0); PG8_MMA(0, 1, At, B1); PG8_BAR;
            PG8_LDA(At, 1, 1); PG8_STAGEA(PG8_SA(1, 0), a3, 0, un);
            PG8_BAR; PG8_WAIT_L(0); PG8_MMA(1, 0, At, B0); PG8_BAR; PG8_SCHED;
            PG8_STAGE(PG8_SB(1, 1), b3 + hstep, voffB, rsB, g.Bt);
            PG8_WAIT_V(6); PG8_BAR; PG8_MMA(1, 1, At, B1); PG8_BAR;
            }
        }
        if constexpr (ALIGN_EPI) { if (wr == 0) PG8_BAR; }
        unsigned tpk2[2] = {0u, 0u};
        if constexpr (GATH) { Unit n2; if (S.next(ui + 2, n2)) {
#pragma unroll
            for (int hh = 0; hh < 2; ++hh) { int R0, C0; stage_rc(opaque_tid() * 16, R0, C0); tpk2[hh] = S.a_rowpair(n2, hh, R0); } } }
        if constexpr (!Epi::AFTER_DRAIN) { const int t2 = opaque_tid(), w2 = __builtin_amdgcn_readfirstlane(t2 >> 6), l2 = t2 & 63; E(acc, cur, w2 >> 2, w2 & 3, l2 & 15, l2 >> 4); S.done(cur); }
        if (!has_next) break;
#pragma unroll
        for (int a = 0; a < 2; ++a)
#pragma unroll
            for (int b = 0; b < 2; ++b)
#pragma unroll
                for (int m = 0; m < 4; ++m)
#pragma unroll
                    for (int n = 0; n < 2; ++n) acc[a][b][m][n] = (f32x4){0.f, 0.f, 0.f, 0.f};
        cur = nxt; cA = nA; cB = nB; ++ui;
        if constexpr (GATH) { asm volatile("" : "+v"(tpk2[0]), "+v"(tpk2[1]));
            tpk[0] = tpk2[0]; tpk[1] = tpk2[1]; }

        if constexpr (ALIGN_EPI) { if (wr == 1) PG8_BAR; }
    }
    PG8_WAIT_V(0);
    if constexpr (!ALIGN_EPI) { if (wr == 0) PG8_BAR; }
    PG8_BAR;
    if constexpr (Epi::AFTER_DRAIN) { E.fused(acc, cur, wr, wc, fr, fq, lds, wid, lane); S.done(cur); }
#undef PG8_SA
#undef PG8_SB
#undef PG8_STAGE
#undef PG8_LDA
#undef PG8_LDB
#undef PG8_MMA
#undef PG8_WAIT_V
#undef PG8_WAIT_L
#undef PG8_BAR
#undef PG8_SCHED
}
}

#define GAS __attribute__((address_space(1)))
#define LAS __attribute__((address_space(3)))
typedef unsigned short bf16;
typedef float f32x4 __attribute__((ext_vector_type(4)));
typedef unsigned u32x4 __attribute__((ext_vector_type(4)));
typedef unsigned u32x2 __attribute__((ext_vector_type(2)));
typedef short bf16x8 __attribute__((ext_vector_type(8)));

constexpr int DM = 1024, BATCH = 16, SEQ = 2048, DEPTH = 4, NTOK = BATCH * SEQ;
constexpr int PW_IN = 2320, PN = 2304, PNW = 2560;
constexpr int C_AQ = 0, C_AK = 512, C_AV = 640, C_MQ = 768, C_MK = 1024, C_MV = 1280, C_MO = 1536, C_GU = 1792, C_GV = 2048;
constexpr int NE = 16, CAP = 256, DE = 2048, NGRP = 256;
constexpr float DN_ALPHA = 1.6817928305074290f;
constexpr float LN_EPS = 1e-5f;

constexpr size_t MiB = 1u << 20;
constexpr size_t WS_CTL = 0, CTL_BYTES = 1 * MiB;
constexpr size_t WS_MOD = 1 * MiB;
constexpr size_t WS_WIN = 1520 * MiB;
constexpr size_t WS_WOUT = 22 * MiB;
constexpr size_t WS_WS = 30 * MiB;
constexpr size_t WS_GATES = 32 * MiB;
constexpr size_t WS_AFF = 34 * MiB;
constexpr size_t WS_SLOT = 36 * MiB;
constexpr size_t WS_IDX = 37 * MiB;
constexpr size_t WS_GATEV = 38 * MiB;
constexpr size_t WS_DC = 40 * MiB;
constexpr size_t WS_DN = 72 * MiB;
constexpr size_t WS_DS = 73 * MiB;
constexpr size_t WS_QKT = 80 * MiB;
constexpr size_t WS_H = 128 * MiB;
constexpr size_t WS_XA = 192 * MiB;
constexpr size_t WS_PROJ = 320 * MiB;
constexpr size_t WS_MIXCAT = 464 * MiB;
constexpr size_t WS_MIX = 528 * MiB;
constexpr size_t WS_XG = 592 * MiB;
constexpr size_t WS_HID = 720 * MiB;
constexpr size_t WS_YE = 976 * MiB;
constexpr size_t WS_WGU = 1104 * MiB;
constexpr size_t WS_WD = 1360 * MiB;
constexpr size_t WS_H8 = 1488 * MiB;
constexpr size_t WS_END = 1540 * MiB;
constexpr float W1_SCALE = 128.f, W2_SCALE = 512.f, ACT_SCALE = 8.f;
constexpr int SC_A1 = 0x7C7C7C7C, SC_B1 = 0x78787878, SC_A2 = 0x7D7D7D7D, SC_B2 = 0x76767676;
constexpr size_t WS_HFB = WS_HID;
constexpr size_t WS_VN = WS_HID + 64 * MiB;

struct P {
    const float *x, *c, *w_ada, *b_ada, *w_in, *conv_w, *conv_b, *gate_b, *sink, *rel_bias, *w_s, *b_s, *w_out, *w_router, *w_gate, *w_up, *w_down, *ln_g, *ln_b;
    float* out; unsigned char* ws;
};

typedef float f32x2c __attribute__((ext_vector_type(2))); typedef __bf16 bf16x2c __attribute__((ext_vector_type(2)));
__device__ __forceinline__ unsigned pk2(float lo, float hi) { const f32x2c v = {lo, hi}; return __builtin_bit_cast(unsigned, __builtin_convertvector(v, bf16x2c)); }
__device__ __forceinline__ unsigned f2bf(float f) { return pk2(f, 0.f) & 0xffffu; }
__device__ __forceinline__ float bf2f(unsigned short b) { return __builtin_bit_cast(float, (unsigned)b << 16); }
__device__ __forceinline__ float bflo(unsigned w) { return __builtin_bit_cast(float, w << 16); }
__device__ __forceinline__ float bfhi(unsigned w) { return __builtin_bit_cast(float, w & 0xffff0000u); }
__device__ __forceinline__ float sigmoid_f(float x) { return __builtin_amdgcn_rcpf(1.0f + __builtin_amdgcn_exp2f(x * -1.4426950408889634f)); }
__device__ __forceinline__ float silu_acc(float x) { return x * __builtin_amdgcn_rcpf(1.0f + __builtin_amdgcn_exp2f(x * -1.4426950408889634f)); }
__device__ __forceinline__ float gelu_erf(float x) { return 0.5f * x * (1.0f + erff(x * 0.70710678118654752f)); }
__device__ __forceinline__ float logsigmoid_f(float x) { return fminf(x, 0.f) - __logf(1.0f + __expf(-fabsf(x))); }
__device__ __forceinline__ int t5_bucket(int rel) {
    const int n = rel < 0 ? -rel : rel;
    int bk = n < 8 ? n : n < 12 ? 8 : n < 16 ? 9 : n < 23 ? 10 : n < 32 ? 11 : n < 46 ? 12 : n < 64 ? 13 : n < 91 ? 14 : 15;
    return bk + (rel > 0 ? 16 : 0);
}

__device__ __forceinline__ int unit_of(int wg, int G, int i, int N) {
    if (G == 256) { const int per = N >> 8; if (i >= per) return N; return ((((wg & 7) << 5) | (wg >> 3)) * per) + i; }
    const int u = wg + i * G; return u < N ? u : N;
}
template <int CTRL> __device__ __forceinline__ float dpp_f(float v) { return __builtin_bit_cast(float, __builtin_amdgcn_update_dpp(0, __builtin_bit_cast(int, v), CTRL, 0xf, 0xf, true)); }
#define DPP_X1 0xB1
#define DPP_X2 0x4E
#define DPP_HM 0x141
#define DPP_RM 0x140
__device__ __forceinline__ float r16_sum(float v) { v += dpp_f<DPP_X1>(v); v += dpp_f<DPP_X2>(v); v += dpp_f<DPP_HM>(v); v += dpp_f<DPP_RM>(v); return v; }
__device__ __forceinline__ float r16_max(float v) { v = fmaxf(v, dpp_f<DPP_X1>(v)); v = fmaxf(v, dpp_f<DPP_X2>(v)); v = fmaxf(v, dpp_f<DPP_HM>(v)); v = fmaxf(v, dpp_f<DPP_RM>(v)); return v; }
__device__ __forceinline__ float wave_sum(float v) {
#pragma unroll
    for (int o = 1; o < 64; o <<= 1) v += __shfl_xor(v, o);
    return v;
}
constexpr int RB_PITCH = 2080;
constexpr int RB_W = 0, RB_ST = 16 * RB_PITCH, RW_VEC = 100352;
__device__ __forceinline__ void r16_ln(f32x4 (&v)[16]) {
    float s = 0.f;
#pragma unroll
    for (int k = 0; k < 16; ++k) s += (v[k][0] + v[k][1]) + (v[k][2] + v[k][3]);
    const float mean = r16_sum(s) * (1.f / DM); float q = 0.f;
#pragma unroll
    for (int k = 0; k < 16; ++k) { v[k] = v[k] - mean; q += (v[k][0] * v[k][0] + v[k][1] * v[k][1]) + (v[k][2] * v[k][2] + v[k][3] * v[k][3]); }
    const float rstd = 1.0f / sqrtf(r16_sum(q) * (1.f / DM) + LN_EPS);
#pragma unroll
    for (int k = 0; k < 16; ++k) v[k] = v[k] * rstd;
}
__device__ __forceinline__ float r16_fold(const float (&acc)[16], int c) {
    float a8[8], a4[4], a2[2];
    { const bool hi = c >= 8;
#pragma unroll
      for (int e = 0; e < 8; ++e) { const float send = hi ? acc[e] : acc[e + 8], keep = hi ? acc[e + 8] : acc[e]; a8[e] = keep + dpp_f<DPP_RM>(send); } }
    { const bool hi = (c & 7) >= 4;
#pragma unroll
      for (int e = 0; e < 4; ++e) { const float send = hi ? a8[e] : a8[e + 4], keep = hi ? a8[e + 4] : a8[e]; a4[e] = keep + dpp_f<DPP_HM>(send); } }
    { const bool hi = (c & 2) != 0;
#pragma unroll
      for (int e = 0; e < 2; ++e) { const float send = hi ? a4[e] : a4[e + 2], keep = hi ? a4[e + 2] : a4[e]; a2[e] = keep + dpp_f<DPP_X2>(send); } }
    const bool hi = (c & 1) != 0; const float send = hi ? a2[0] : a2[1], keep = hi ? a2[1] : a2[0];
    return keep + dpp_f<DPP_X1>(send);
}
__device__ __forceinline__ void r16_matvec2(const f32x4 (&v0)[16], const f32x4 (&v1)[16], const LAS float* wT, int c, float& r0, float& r1) {
    float a0[16], a1[16];
    asm volatile("" ::: "memory");
#pragma unroll
    for (int e = 0; e < 16; ++e) { float s0 = 0.f, s1 = 0.f;
#pragma unroll
        for (int k = 0; k < 16; ++k) { const f32x4 w = *(const LAS f32x4*)(wT + e * DM + 64 * k + 4 * c);
            s0 += (v0[k][0] * w[0] + v0[k][1] * w[1]) + (v0[k][2] * w[2] + v0[k][3] * w[3]); s1 += (v1[k][0] * w[0] + v1[k][1] * w[1]) + (v1[k][2] * w[2] + v1[k][3] * w[3]); }
        a0[e] = s0; a1[e] = s1; }
    r0 = r16_fold(a0, c); r1 = r16_fold(a1, c);
}
#define RC(k) (128 * ((k) >> 1) + 8 * c + 4 * ((k) & 1))
__device__ __forceinline__ int rpos(int col) { return (col & ~127) | (((col >> 2) & 1) << 6) | (((col & 127) >> 3) << 2) | (col & 3); }
__device__ __forceinline__ f32x4 bf4lo(u32x4 w) { return (f32x4){bflo(w.x), bfhi(w.x), bflo(w.y), bfhi(w.y)}; }
__device__ __forceinline__ f32x4 bf4hi(u32x4 w) { return (f32x4){bflo(w.z), bfhi(w.z), bflo(w.w), bfhi(w.w)}; }
typedef float f32x2q __attribute__((ext_vector_type(2)));
__device__ __forceinline__ f32x4 fp8x4(unsigned w) { const f32x2q lo = __builtin_amdgcn_cvt_pk_f32_fp8((int)w, false), hi = __builtin_amdgcn_cvt_pk_f32_fp8((int)w, true); return (f32x4){lo[0], lo[1], hi[0], hi[1]}; }
__device__ __forceinline__ void r16_store_bf16(bf16* rowp, int c, const f32x4 (&v)[16]) {
#pragma unroll
    for (int kk = 0; kk < 8; ++kk) { u32x4 w; w.x = pk2(v[2 * kk][0], v[2 * kk][1]); w.y = pk2(v[2 * kk][2], v[2 * kk][3]); w.z = pk2(v[2 * kk + 1][0], v[2 * kk + 1][1]); w.w = pk2(v[2 * kk + 1][2], v[2 * kk + 1][3]);
        *(u32x4*)(rowp + 128 * kk + 8 * c) = w; }
}
__device__ __forceinline__ void fill_wrouter(LAS unsigned char* wb, const float* src, int tid) {
#pragma unroll
    for (int j = 0; j < 2; ++j) { const int d = tid + 512 * j; const float* sp = src + (size_t)d * 16;
        const f32x4 a0 = *(const f32x4*)sp, a1 = *(const f32x4*)(sp + 4), a2 = *(const f32x4*)(sp + 8), a3 = *(const f32x4*)(sp + 12);
#pragma unroll
        for (int k = 0; k < 4; ++k) { *(LAS bf16*)(wb + k * RB_PITCH + 2 * d) = (bf16)f2bf(a0[k]); *(LAS bf16*)(wb + (4 + k) * RB_PITCH + 2 * d) = (bf16)f2bf(a1[k]);
            *(LAS bf16*)(wb + (8 + k) * RB_PITCH + 2 * d) = (bf16)f2bf(a2[k]); *(LAS bf16*)(wb + (12 + k) * RB_PITCH + 2 * d) = (bf16)f2bf(a3[k]); } }
}
__device__ __forceinline__ void fill_vec(LAS float* dst, const float* src, int tid) {
    *(LAS f32x4*)(dst + rpos(4 * (tid & 255))) = *(const f32x4*)(src + 4 * (tid & 255));
}
__device__ __forceinline__ void rows_entry_simple(const P& p, int wg, int G) {
    const int tid = opaque_tid(), lane = tid & 63, gw = wg * 8 + (tid >> 6), ngw = G * 8;
    const float* mod = (const float*)(p.ws + WS_MOD); bf16* H = (bf16*)(p.ws + WS_H);
    for (int m = gw; m < NTOK; m += ngw) { const int b = m / SEQ; const float* mb = mod + (size_t)b * 6 * DM; const float* xr = p.x + (size_t)m * DM;
        f32x4 v[4]; float s = 0.f;
#pragma unroll
        for (int j = 0; j < 4; ++j) { v[j] = *(const f32x4*)(xr + 256 * j + 4 * lane); s += (v[j][0] + v[j][1]) + (v[j][2] + v[j][3]); }
        const float mean = wave_sum(s) * (1.f / DM); float q = 0.f;
#pragma unroll
        for (int j = 0; j < 4; ++j) { v[j] = v[j] - mean; q += (v[j][0] * v[j][0] + v[j][1] * v[j][1]) + (v[j][2] * v[j][2] + v[j][3] * v[j][3]); }
        const float rstd = 1.0f / sqrtf(wave_sum(q) * (1.f / DM) + LN_EPS);
#pragma unroll
        for (int j = 0; j < 4; ++j) { const f32x4 sc = *(const f32x4*)(mb + DM + 256 * j + 4 * lane), sh = *(const f32x4*)(mb + 256 * j + 4 * lane); const f32x4 o = v[j] * rstd * (sc + 1.0f) + sh;
            u32x2 w; w.x = pk2(o[0], o[1]); w.y = pk2(o[2], o[3]); *(u32x2*)(H + (size_t)m * DM + 256 * j + 4 * lane) = w; }
    }
}
template <int WHICH>
__device__ __forceinline__ void rows_phase(const P& p, int l, const float* xin, LAS unsigned char* L, int wg, int G, bool dummy = false) {
    const int tid = opaque_tid(), lane = tid & 63, wave = __builtin_amdgcn_readfirstlane(tid >> 6), q = lane >> 4, c = lane & 15;
    LAS float* vec = (LAS float*)(L + RW_VEC);
    const float* modl = (const float*)(p.ws + WS_MOD) + (size_t)l * BATCH * 6 * DM;
    bf16* H = (bf16*)(p.ws + (dummy ? WS_HID : WS_H)); bf16* xa = (bf16*)(p.ws + (dummy ? WS_XG : WS_XA));
    const bool xbf = (WHICH == 2) || (l != 0);
    float* affo = (float*)(p.ws + (dummy ? WS_HID + 128 * MiB : WS_AFF)); float* gato = (float*)(p.ws + (dummy ? WS_HID + 130 * MiB : WS_GATES));
    const bool last = (WHICH == 2) && (l == DEPTH - 1);
    if (WHICH == 1) fill_wrouter(L + RB_W, p.w_router + (size_t)l * DM * 16, tid);
    for (int bi = 0, blk; (blk = unit_of(wg, G, bi, NTOK / 128)) < NTOK / 128; ++bi) {
        const int b = (blk * 128) / SEQ; const float* mb = modl + (size_t)b * 6 * DM;
        __syncthreads();
        { const int half = tid >> 8;
          if (WHICH == 0) { fill_vec(vec + half * DM, mb + (half ? 0 : 1) * DM, tid); }
          if (WHICH == 1) { fill_vec(vec + half * DM, half ? p.ln_g + (size_t)(l * 2) * DM : mb + 2 * DM, tid); fill_vec(vec + (2 + half) * DM, half ? mb + 4 * DM : p.ln_b + (size_t)(l * 2) * DM, tid); if (half == 0) fill_vec(vec + 4 * DM, mb + 3 * DM, tid); }
          if (WHICH == 2) { fill_vec(vec + half * DM, half ? p.ln_g + (size_t)(l * 2 + 1) * DM : mb + 5 * DM, tid); if (half == 0) fill_vec(vec + 2 * DM, p.ln_b + (size_t)(l * 2 + 1) * DM, tid);
              if (!last) { const float* mbn = mb + (size_t)BATCH * 6 * DM; fill_vec(vec + (3 + half) * DM, mbn + (half ? 0 : 1) * DM, tid); } } }
        __syncthreads();
#pragma unroll 1
        for (int it = 0; it < 4; ++it) {
            asm volatile("" ::: "memory");
            const int m = blk * 128 + wave * 16 + it * 4 + q;
            f32x4 v[16];
            if (!xbf) {
#pragma unroll
                for (int k = 0; k < 16; ++k) v[k] = *(const f32x4*)(xin + (size_t)m * DM + RC(k)); }
            else { const bf16* xb = (const bf16*)xin + (size_t)m * DM;
#pragma unroll
                for (int kk = 0; kk < 8; ++kk) { const u32x4 w = *(const u32x4*)(xb + 128 * kk + 8 * c); v[2 * kk] = bf4lo(w); v[2 * kk + 1] = bf4hi(w); } }
            if (WHICH == 1) {
                const bf16* mix = (const bf16*)(p.ws + WS_MIX) + (size_t)m * DM;
                u32x4 mw[8];
#pragma unroll
                for (int kk = 0; kk < 8; ++kk) mw[kk] = *(const u32x4*)(mix + 128 * kk + 8 * c);
#pragma unroll
                for (int k = 0; k < 16; ++k) { const f32x4 g1 = *(const LAS f32x4*)(vec + 64 * k + 4 * c); const f32x4 mx = (k & 1) ? bf4hi(mw[k >> 1]) : bf4lo(mw[k >> 1]);
                    v[k] = v[k] * DN_ALPHA + (g1 + 1.0f) * mx; }
            }
            if (WHICH == 2) {
                const unsigned char* ye = p.ws + WS_YE; const short* slot = (const short*)(p.ws + WS_SLOT);
                const int t = m % SEQ; const int sl = slot[((size_t)b * 16 + c) * SEQ + t];
                const unsigned long long bal = __ballot(sl >= 0);
                unsigned rem = (unsigned)(bal >> (16 * q)) & 0xffffu;
                const int c0 = __popcll(bal & 0xffffull), c1 = __popcll(bal & 0xffff0000ull), c2 = __popcll(bal & 0xffff00000000ull), c3 = __popcll(bal & 0xffff000000000000ull);
                const int m01 = c0 > c1 ? c0 : c1, m23 = c2 > c3 ? c2 : c3, maxc = m01 > m23 ? m01 : m23;
                f32x4 y[16];
#pragma unroll
                for (int k = 0; k < 16; ++k) y[k] = (f32x4){0.f, 0.f, 0.f, 0.f};
                for (int kk = 0; kk < maxc; kk += 2) {
                    const bool va = rem != 0u; const int ea = va ? __builtin_ctz(rem) : 0; rem &= rem - 1u;
                    const bool vb = rem != 0u; const int eb = vb ? __builtin_ctz(rem) : 0; rem &= rem - 1u;
                    const int sa = __shfl(sl, (lane & 48) | ea), sb = __shfl(sl, (lane & 48) | eb);
                    const unsigned char* ra = ye + ((size_t)(ea * 16 + b) * CAP + (va ? sa : 0)) * DM; const unsigned char* rb = ye + ((size_t)(eb * 16 + b) * CAP + (vb ? sb : 0)) * DM;
                    u32x4 wa[4], wb[4];
#pragma unroll
                    for (int j2 = 0; j2 < 4; ++j2) { wa[j2] = *(const u32x4*)(ra + 256 * j2 + 16 * c); wb[j2] = *(const u32x4*)(rb + 256 * j2 + 16 * c); }
                    const float fa = va ? 1.f / pg8::YE_SCALE : 0.f, fb = vb ? 1.f / pg8::YE_SCALE : 0.f;
#pragma unroll
                    for (int k = 0; k < 16; ++k) { y[k] = y[k] + fp8x4(wa[k >> 2][k & 3]) * fa + fp8x4(wb[k >> 2][k & 3]) * fb; }
                }
#pragma unroll
                for (int k = 0; k < 16; ++k) { const f32x4 g2 = *(const LAS f32x4*)(vec + 64 * k + 4 * c); v[k] = v[k] * DN_ALPHA + (g2 + 1.0f) * y[k]; }
            }
            if (WHICH != 0) {
                r16_ln(v);
                const bool of32 = last && !dummy;
#pragma unroll
                for (int k = 0; k < 16; ++k) { const f32x4 gg = *(const LAS f32x4*)(vec + DM + 64 * k + 4 * c), bb = *(const LAS f32x4*)(vec + 2 * DM + 64 * k + 4 * c); v[k] = v[k] * gg + bb; }
                if (of32) {
#pragma unroll
                    for (int k = 0; k < 16; ++k) *(f32x4*)(p.out + (size_t)m * DM + RC(k)) = v[k]; }
                else r16_store_bf16(xa + (size_t)m * DM, c, v);
            }
            if (!last) {
                r16_ln(v);
                const int o_sc = WHICH == 0 ? 0 : 3, o_sh = WHICH == 0 ? 1 : 4;
#pragma unroll
                for (int k = 0; k < 16; ++k) { const f32x4 sc = *(const LAS f32x4*)(vec + o_sc * DM + 64 * k + 4 * c), sh = *(const LAS f32x4*)(vec + o_sh * DM + 64 * k + 4 * c); v[k] = v[k] * (sc + 1.0f) + sh; }
                if (WHICH == 1) { unsigned char* h8 = p.ws + (dummy ? WS_HID : WS_H8) + (size_t)m * DM;
#pragma unroll
                    for (int kk = 0; kk < 8; ++kk) { u32x2 w; w.x = pg8::pk4_fp8(v[2 * kk][0] * ACT_SCALE, v[2 * kk][1] * ACT_SCALE, v[2 * kk][2] * ACT_SCALE, v[2 * kk][3] * ACT_SCALE); w.y = pg8::pk4_fp8(v[2 * kk + 1][0] * ACT_SCALE, v[2 * kk + 1][1] * ACT_SCALE, v[2 * kk + 1][2] * ACT_SCALE, v[2 * kk + 1][3] * ACT_SCALE);
                        *(u32x2*)(h8 + 128 * kk + 8 * c) = w; } }
                else r16_store_bf16(H + (size_t)m * DM, c, v);
                if (WHICH == 1) {
                    LAS unsigned char* st = L + RB_ST + wave * (4 * RB_PITCH);
#pragma unroll
                    for (int kk = 0; kk < 8; ++kk) { u32x4 w; w.x = pk2(v[2 * kk][0], v[2 * kk][1]); w.y = pk2(v[2 * kk][2], v[2 * kk][3]); w.z = pk2(v[2 * kk + 1][0], v[2 * kk + 1][1]); w.w = pk2(v[2 * kk + 1][2], v[2 * kk + 1][3]);
                        *(LAS u32x4*)(st + q * RB_PITCH + (128 * kk + 8 * c) * 2) = w; }
                    const LAS unsigned char* ap = st + (lane & 3) * RB_PITCH + (lane >> 4) * 16; const LAS unsigned char* bp = L + RB_W + (lane & 15) * RB_PITCH + (lane >> 4) * 16;
                    f32x4 lgp[4];
#pragma unroll
                    for (int j = 0; j < 4; ++j) lgp[j] = (f32x4){0.f, 0.f, 0.f, 0.f};
#pragma unroll
                    for (int kg = 0; kg < 8; ++kg) { bf16x8 af[4], bfr[4];
#pragma unroll
                        for (int j = 0; j < 4; ++j) { af[j] = *(const LAS bf16x8*)(ap + (kg * 4 + j) * 64); bfr[j] = *(const LAS bf16x8*)(bp + (kg * 4 + j) * 64); }
#pragma unroll
                        for (int j = 0; j < 4; ++j) lgp[j] = __builtin_amdgcn_mfma_f32_16x16x32_bf16(af[j], bfr[j], lgp[j], 0, 0, 0); }
                    const f32x4 lg = (lgp[0] + lgp[1]) + (lgp[2] + lgp[3]);
                    float pr[4];
#pragma unroll
                    for (int rr = 0; rr < 4; ++rr) { const float mx = r16_max(lg[rr]), ex = __expf(lg[rr] - mx), sm = r16_sum(ex); pr[rr] = ex / sm; }
                    const float mine = q == 0 ? pr[0] : q == 1 ? pr[1] : q == 2 ? pr[2] : pr[3];
                    affo[(size_t)m * 16 + c] = mine; }
            }
        }
    }
    __syncthreads();
}

__device__ __forceinline__ void transpose_item(const float* src, size_t ld_src, bf16* dst, size_t ld_dst, LAS float* scr, int lane, int nvalid = 32) {
    if (nvalid > 0) { const int kr = lane >> 3, nc = 4 * (lane & 7);
        f32x4 t[8];
#pragma unroll
        for (int i = 0; i < 8; ++i) t[i] = *(const f32x4*)(src + (size_t)(8 * i + kr) * ld_src + nc);
#pragma unroll
        for (int i = 0; i < 8; ++i) { LAS float* d = scr + (8 * i + kr) * 33 + nc; d[0] = t[i][0]; d[1] = t[i][1]; d[2] = t[i][2]; d[3] = t[i][3]; }
    }
    asm volatile("s_waitcnt lgkmcnt(0)" ::: "memory");
    const int c = lane & 7;
#pragma unroll
    for (int j = 0; j < 4; ++j) { const int n = (lane >> 3) + 8 * j; const LAS float* s = scr + (8 * c) * 33 + n;
        u32x4 o; o.x = pk2(s[0 * 33], s[1 * 33]); o.y = pk2(s[2 * 33], s[3 * 33]); o.z = pk2(s[4 * 33], s[5 * 33]); o.w = pk2(s[6 * 33], s[7 * 33]);
        if (n >= nvalid) o = (u32x4){0u, 0u, 0u, 0u};
        *(u32x4*)(dst + (size_t)n * ld_dst + 8 * c) = o; }
    asm volatile("s_waitcnt lgkmcnt(0)" ::: "memory");
}
__device__ __forceinline__ void transpose_item8(const float* src, size_t ld_src, unsigned char* dst, size_t ld_dst, float scale, LAS float* scr, int lane) {
    { const int kr = lane >> 3, nc = 4 * (lane & 7);
        f32x4 t[8];
#pragma unroll
        for (int i = 0; i < 8; ++i) t[i] = *(const f32x4*)(src + (size_t)(8 * i + kr) * ld_src + nc);
#pragma unroll
        for (int i = 0; i < 8; ++i) { LAS float* d = scr + (8 * i + kr) * 33 + nc; d[0] = t[i][0]; d[1] = t[i][1]; d[2] = t[i][2]; d[3] = t[i][3]; } }
    asm volatile("s_waitcnt lgkmcnt(0)" ::: "memory");
    const int c = lane & 3;
#pragma unroll
    for (int j = 0; j < 2; ++j) { const int n = (lane >> 2) + 16 * j; const LAS float* s = scr + (16 * c) * 33 + n;
        u32x4 o;
#pragma unroll
        for (int q = 0; q < 4; ++q) o[q] = pg8::pk4_fp8(s[(4 * q) * 33] * scale, s[(4 * q + 1) * 33] * scale, s[(4 * q + 2) * 33] * scale, s[(4 * q + 3) * 33] * scale);
        *(u32x4*)(dst + (size_t)n * ld_dst + 16 * c) = o; }
    asm volatile("s_waitcnt lgkmcnt(0)" ::: "memory");
}
constexpr int ITL_WIN = 16 * 80, ITL_WOUT = 16 * 32, ITL_WGU = NE * 16 * 128, ITL_WD = NE * 32 * 32, ITL = ITL_WIN + ITL_WOUT + ITL_WGU + ITL_WD;
constexpr int ITS = ITL_WIN + ITL_WOUT, ITM = ITL_WGU + ITL_WD;
__device__ __forceinline__ void convert_item(const P& p, int l, int it, LAS float* scr, int lane) {
    if (it < ITL_WIN) { const int kb = it / 80, nb = it % 80, n0 = 32 * nb;
        const int sc = n0 < 1792 ? n0 : n0 < 2304 ? n0 + 16 : 1792, nvalid = n0 < 2304 ? 32 : n0 == 2304 ? 16 : 0;
        transpose_item(p.w_in + (size_t)l * DM * PW_IN + (size_t)(64 * kb) * PW_IN + sc, PW_IN, (bf16*)(p.ws + WS_WIN) + (size_t)l * PNW * DM + (size_t)n0 * DM + 64 * kb, DM, scr, lane, nvalid); return; }
    it -= ITL_WIN;
    if (it < ITL_WOUT) { const int kb = it / 32, nb = it % 32;
        transpose_item(p.w_out + (size_t)l * DM * DM + (size_t)(64 * kb) * DM + 32 * nb, DM, (bf16*)(p.ws + WS_WOUT) + (size_t)l * DM * DM + (size_t)(32 * nb) * DM + 64 * kb, DM, scr, lane); return; }
    it -= ITL_WOUT;
    if (it < ITL_WGU) { const int le = l * NE + it / (16 * 128), r = it % (16 * 128), kb = r / 128, nb = r % 128, n0 = 32 * nb, pn = n0 >> 8, w = n0 & 255;
        const float* src = (w < 128 ? p.w_gate : p.w_up) + (size_t)le * DM * DE + (size_t)(64 * kb) * DE + pn * 128 + (w & 127);
        transpose_item8(src, DE, p.ws + WS_WGU + (size_t)le * 4096 * DM + (size_t)n0 * DM + 64 * kb, DM, w < 128 ? W1_SCALE * 1.4426950408889634f : W1_SCALE * 0.6931471805599453f, scr, lane); return; }
    it -= ITL_WGU;
    { const int le = l * NE + it / (32 * 32), r = it % (32 * 32), kb = r / 32, nb = r % 32;
        transpose_item8(p.w_down + (size_t)le * DE * DM + (size_t)(64 * kb) * DM + 32 * nb, DM, p.ws + WS_WD + (size_t)le * DM * DE + (size_t)(32 * nb) * DE + 64 * kb, DE, W2_SCALE, scr, lane); }
}

typedef short s16x4 __attribute__((ext_vector_type(4)));
typedef float f32x16 __attribute__((ext_vector_type(16)));
#define MFMA32(a, b, c) __builtin_amdgcn_mfma_f32_32x32x16_bf16((a), (b), (c), 0, 0, 0)
__device__ __forceinline__ int crow(int reg, int h) { return (reg & 3) + 8 * (reg >> 2) + 4 * h; }
__device__ __forceinline__ unsigned cvtpk(float lo, float hi) { return pk2(lo, hi); }
__device__ __forceinline__ bf16x8 pack8(float a0, float a1, float a2, float a3, float a4, float a5, float a6, float a7) {
    u32x4 w; w.x = cvtpk(a0, a1); w.y = cvtpk(a2, a3); w.z = cvtpk(a4, a5); w.w = cvtpk(a6, a7); return __builtin_bit_cast(bf16x8, w); }
__device__ __forceinline__ s16x4 tr_read(const LAS unsigned char* p) { typedef short v4i16_t __attribute__((ext_vector_type(4))); return __builtin_bit_cast(s16x4, __builtin_amdgcn_ds_read_tr16_b64_v4i16((LAS v4i16_t*)p)); }
__device__ __forceinline__ bf16x8 cat8(s16x4 lo, s16x4 hi) { return (bf16x8){lo[0], lo[1], lo[2], lo[3], hi[0], hi[1], hi[2], hi[3]}; }
__device__ __forceinline__ int wave_sum_i(int v) {
#pragma unroll
    for (int o = 1; o < 64; o <<= 1) v += __shfl_xor(v, o);
    return v;
}
__device__ __forceinline__ float wave_max(float v) {
#pragma unroll
    for (int o = 1; o < 64; o <<= 1) v = fmaxf(v, __shfl_xor(v, o));
    return v;
}

template <int CTRL, int RMASK> __device__ __forceinline__ float dpp_id(float ident, float v) { return __builtin_bit_cast(float, __builtin_amdgcn_update_dpp(__builtin_bit_cast(int, ident), __builtin_bit_cast(int, v), CTRL, RMASK, 0xf, false)); }
__device__ __forceinline__ float wave_scan_sum(float v) {
    v += dpp_id<0x111, 0xf>(0.f, v); v += dpp_id<0x112, 0xf>(0.f, v); v += dpp_id<0x114, 0xf>(0.f, v); v += dpp_id<0x118, 0xf>(0.f, v);
    v += dpp_id<0x142, 0xa>(0.f, v); v += dpp_id<0x143, 0xc>(0.f, v); return v; }
__device__ __forceinline__ float wave_scan_max(float v) { const float NI = -3.0e38f;
    v = fmaxf(v, dpp_id<0x111, 0xf>(NI, v)); v = fmaxf(v, dpp_id<0x112, 0xf>(NI, v)); v = fmaxf(v, dpp_id<0x114, 0xf>(NI, v)); v = fmaxf(v, dpp_id<0x118, 0xf>(NI, v));
    v = fmaxf(v, dpp_id<0x142, 0xa>(NI, v)); v = fmaxf(v, dpp_id<0x143, 0xc>(NI, v)); return v; }
__device__ __forceinline__ void ph_topk(const P& p, LAS unsigned char* lds, int wg, int G) {
    const int tid = opaque_tid(), lane = tid & 63, wave = __builtin_amdgcn_readfirstlane(tid >> 6);
    LAS unsigned* hist = (LAS unsigned*)lds;
    LAS unsigned* cnt = hist + 1024;
    const float* affp = (const float*)(p.ws + WS_AFF);
    for (int ui = 0, u; (u = unit_of(wg, G, ui, 256)) < 256; ++ui) {
        const int b = u >> 4, e = u & 15, g = e * 16 + b;
        unsigned key[4];
#pragma unroll
        for (int i = 0; i < 4; ++i) key[i] = __builtin_bit_cast(unsigned, affp[((size_t)b * SEQ + i * 512 + tid) * 16 + e]);
        hist[tid] = 0u; hist[512 + tid] = 0u;
        __syncthreads();
        unsigned thr = 0u; int need = CAP;
#pragma unroll
        for (int ps = 0; ps < 4; ++ps) { const int sh = 24 - 8 * ps;
#pragma unroll
            for (int i = 0; i < 4; ++i) { const bool in = ps == 0 || (key[i] >> (sh + 8)) == (thr >> (sh + 8));
                if (in) __hip_atomic_fetch_add(hist + ps * 256 + ((key[i] >> sh) & 255u), 1u, __ATOMIC_RELAXED, __HIP_MEMORY_SCOPE_WORKGROUP); }
            __syncthreads();
            const int lp = 63 - lane; const u32x4 h4 = *(const LAS u32x4*)(hist + ps * 256 + 4 * lp);
            const int s4 = (int)(h4.x + h4.y + h4.z + h4.w), incl = (int)wave_scan_sum((float)s4), excl = incl - s4;
            const int Ls = __builtin_ctzll(__ballot(incl >= need));
            const int c3 = excl + (int)h4.w, c2 = c3 + (int)h4.z, c1 = c2 + (int)h4.y;
            const int Bl = 4 * lp + (c3 >= need ? 3 : c2 >= need ? 2 : c1 >= need ? 1 : 0), ab = c3 >= need ? excl : c2 >= need ? c3 : c1 >= need ? c2 : c1;
            thr |= (unsigned)__builtin_amdgcn_readlane(Bl, Ls) << sh; need -= __builtin_amdgcn_readlane(ab, Ls); }
        const unsigned long long lt = (1ull << lane) - 1ull;
        unsigned long long beq[4], bsel[4];
#pragma unroll
        for (int i = 0; i < 4; ++i) { beq[i] = __ballot(key[i] == thr); if (lane == 0) cnt[i * 8 + wave] = (unsigned)__popcll(beq[i]); }
        __syncthreads();
        { const float c = lane < 32 ? (float)cnt[lane & 31] : 0.f; const float ex = wave_scan_sum(c) - c;
#pragma unroll
          for (int i = 0; i < 4; ++i) { const int eqrank = (int)__builtin_bit_cast(float, __builtin_amdgcn_readlane(__builtin_bit_cast(int, ex), i * 8 + wave)) + __popcll(beq[i] & lt);
              const bool sel = key[i] > thr || (key[i] == thr && eqrank < need);
              bsel[i] = __ballot(sel); if (lane == 0) cnt[32 + i * 8 + wave] = (unsigned)__popcll(bsel[i]); } }
        __syncthreads();
        { const float c = lane < 32 ? (float)cnt[32 + (lane & 31)] : 0.f; const float ex = wave_scan_sum(c) - c;
          unsigned short* idx = (unsigned short*)(p.ws + WS_IDX) + g * CAP; float* gv = (float*)(p.ws + WS_GATEV) + g * CAP; short* slot = (short*)(p.ws + WS_SLOT) + ((size_t)b * 16 + e) * SEQ;
#pragma unroll
          for (int i = 0; i < 4; ++i) { const int sl = (int)__builtin_bit_cast(float, __builtin_amdgcn_readlane(__builtin_bit_cast(int, ex), i * 8 + wave)) + __popcll(bsel[i] & lt); const int tok = i * 512 + tid;
              const bool sel = (bsel[i] >> lane) & 1ull;
              if (sel) { idx[(((sl >> 7) * 64 + (sl & 63)) << 1) + ((sl >> 6) & 1)] = (unsigned short)tok; gv[sl] = __builtin_bit_cast(float, key[i]); }
              slot[tok] = sel ? (short)sl : (short)-1; } }
        __syncthreads();
    }
}

__device__ __forceinline__ u32x4 swap_pair16(u32x2 wa, u32x2 wb) {
    const auto s0 = __builtin_amdgcn_permlane32_swap(wa.x, wb.x, false, false); const auto s1 = __builtin_amdgcn_permlane32_swap(wa.y, wb.y, false, false);
    return (u32x4){(unsigned)s0[0], (unsigned)s1[0], (unsigned)s0[1], (unsigned)s1[1]}; }
__device__ __forceinline__ float gelu_as(float v) {
    const float t = __builtin_amdgcn_rcpf(fabsf(v) * 0.2316418882f + 1.0f);
    float q = t * 0.5307027145f + (-0.7265760135f); q = q * t + 0.7107068705f; q = q * t + (-0.142248368f); q = q * t + 0.127414796f; q = q * t;
    const float m = v * (q * __builtin_amdgcn_exp2f(v * v * (-0.72134752044f)));
    return v < 0.f ? m : v - m;
}
constexpr int GM_PITCH = 264;
__device__ __forceinline__ void ph_gmlp(const P& p, int l, LAS unsigned char* lds, int wg, int G) {
    const int tid = opaque_tid(), lane = tid & 63, wave = __builtin_amdgcn_readfirstlane(tid >> 6), r = lane & 31, h = lane >> 5, q = lane >> 4, c = lane & 15;
    const bf16* proj = (const bf16*)(p.ws + WS_PROJ); bf16* mixcat = (bf16*)(p.ws + WS_MIXCAT);
    const bf16* wsb = (const bf16*)(p.ws + WS_WS) + (size_t)l * 4 * 128 * 128;
    for (int ui = 0, u; (u = unit_of(wg, G, ui, 256)) < 256; ++ui) {
        const size_t m0 = (size_t)u * 128;
        u32x4 xs[4][2];
#pragma unroll
        for (int it = 0; it < 4; ++it) { const bf16* src = proj + (m0 + wave * 16 + it * 4 + q) * PN + C_GV + 8 * c; xs[it][0] = *(const u32x4*)src; xs[it][1] = *(const u32x4*)(src + 128); }
        const int tt = wave & 3, ch = wave >> 2, t = tt * 32 + r;
        u32x2 uu[4][4]; bf16x8 wf2[2][8]; float bias2[2];
#pragma unroll
        for (int ti = 0; ti < 4; ++ti)
#pragma unroll
            for (int rg = 0; rg < 4; ++rg) uu[ti][rg] = *(const u32x2*)(proj + (m0 + t) * PN + C_GU + ch * 128 + ti * 32 + 8 * rg + 4 * h);
#pragma unroll
        for (int gi = 0; gi < 2; ++gi) { const int g = ch * 2 + gi;
#pragma unroll
            for (int ks = 0; ks < 8; ++ks) wf2[gi][ks] = *(const bf16x8*)(wsb + ((size_t)g * 128 + t) * 128 + ks * 16 + 8 * h);
            bias2[gi] = p.b_s[(l * 4 + g) * 128 + t]; }
#pragma unroll
        for (int it = 0; it < 4; ++it) { const int t1 = wave * 16 + it * 4 + q;
            const u32x4 x0 = xs[it][0], x1 = xs[it][1];
            float v[16];
#pragma unroll
            for (int i = 0; i < 4; ++i) { v[2 * i] = gelu_as(bflo(x0[i])); v[2 * i + 1] = gelu_as(bfhi(x0[i])); v[8 + 2 * i] = gelu_as(bflo(x1[i])); v[8 + 2 * i + 1] = gelu_as(bfhi(x1[i])); }
            float s = 0.f;
#pragma unroll
            for (int i = 0; i < 16; ++i) s += v[i];
            const float mean = r16_sum(s) * (1.f / 256.f); float qq = 0.f;
#pragma unroll
            for (int i = 0; i < 16; ++i) { v[i] -= mean; qq += v[i] * v[i]; }
            const float rstd = 1.0f / sqrtf(r16_sum(qq) * (1.f / 256.f) + LN_EPS);
            u32x4 o0, o1;
#pragma unroll
            for (int i = 0; i < 4; ++i) { o0[i] = pk2(v[2 * i] * rstd, v[2 * i + 1] * rstd); o1[i] = pk2(v[8 + 2 * i] * rstd, v[8 + 2 * i + 1] * rstd); }
            *(LAS u32x4*)(lds + (t1 * GM_PITCH + 8 * c) * 2) = o0; *(LAS u32x4*)(lds + (t1 * GM_PITCH + 128 + 8 * c) * 2) = o1; }
        __syncthreads();
        const int G4 = lane >> 4, q4 = c >> 2, p4 = c & 3;
#pragma unroll
        for (int gi = 0; gi < 2; ++gi) { const int g = ch * 2 + gi;
            const bf16x8 (&wf)[8] = wf2[gi]; const float bias = bias2[gi];
#pragma unroll
            for (int ci = 0; ci < 2; ++ci) { const int c0 = g * 64 + ci * 32, ti = gi * 2 + ci;
                f32x16 acc; for (int i = 0; i < 16; ++i) acc[i] = 0.f;
                const LAS unsigned char* vb = lds + ((8 * (G4 >> 1) + q4) * GM_PITCH + c0 + 16 * (G4 & 1) + 4 * p4) * 2;
#pragma unroll
                for (int ks = 0; ks < 8; ++ks) { const bf16x8 af = cat8(tr_read(vb + (ks * 16) * GM_PITCH * 2), tr_read(vb + (ks * 16 + 4) * GM_PITCH * 2)); acc = MFMA32(af, wf[ks], acc); }
                bf16* op = mixcat + (m0 + t) * DM + 768 + c0;
#pragma unroll
                for (int rp = 0; rp < 4; rp += 2) { u32x2 o[2];
#pragma unroll
                    for (int j = 0; j < 2; ++j) { const int rg = rp + j; const u32x2 w = uu[ti][rg];
                        o[j].x = pk2(gelu_as(bflo(w.x)) * (acc[4 * rg] + bias), gelu_as(bfhi(w.x)) * (acc[4 * rg + 1] + bias));
                        o[j].y = pk2(gelu_as(bflo(w.y)) * (acc[4 * rg + 2] + bias), gelu_as(bfhi(w.y)) * (acc[4 * rg + 3] + bias)); }
                    *(u32x4*)(op + 8 * (rp + h)) = swap_pair16(o[0], o[1]); } } }
        __syncthreads();
    }
}

constexpr int AT_PITCH = 144;
constexpr int AT_K = 0, AT_V = 384 * AT_PITCH, AT_BIAS = 2 * 384 * AT_PITCH, AT_BT = 321, AT_BYTES = AT_BIAS + 8 * AT_BT * 4;
#define AT_SOFTMAX(st, bth_, mrun_, lsum_, oa_, ob_, l2_) do { float mt_ = -3.0e38f; \
        _Pragma("unroll") for (int reg = 0; reg < 16; ++reg) { l2_[reg] = st[reg] * (0.125f * L2E) + (bth_)[band0 + crow(reg, h)]; mt_ = fmaxf(mt_, l2_[reg]); }   \
        { const auto rr_ = __builtin_amdgcn_permlane32_swap(__float_as_uint(mt_), __float_as_uint(mt_), false, false); mt_ = fmaxf(__uint_as_float(rr_[0]), __uint_as_float(rr_[1])); } \
        const float mnew_ = fmaxf(mrun_, mt_); \
        if (__any(mt_ > mrun_ + 8.0f)) {   const float f_ = __builtin_amdgcn_exp2f(mrun_ - mnew_); lsum_ *= f_; _Pragma("unroll") for (int i = 0; i < 16; ++i) { oa_[i] *= f_; ob_[i] *= f_; } mrun_ = mnew_; } \
        f32x2c ps2_ = {0.f, 0.f}; const f32x2c mm_ = {mrun_, mrun_};   \
        _Pragma("unroll") for (int i2 = 0; i2 < 8; ++i2) { const f32x2c t_ = (f32x2c){l2_[2 * i2], l2_[2 * i2 + 1]} - mm_; const f32x2c e_ = {__builtin_amdgcn_exp2f(t_[0]), __builtin_amdgcn_exp2f(t_[1])}; l2_[2 * i2] = e_[0]; l2_[2 * i2 + 1] = e_[1]; ps2_ += e_; } \
        lsum_ += ps2_[0] + ps2_[1]; } while (0)
__device__ __forceinline__ void ph_attn(const P& p, int l, LAS unsigned char* lds, int wg, int G) {
    const int tid = opaque_tid(), lane = tid & 63, wave = __builtin_amdgcn_readfirstlane(tid >> 6), r = lane & 31, h = lane >> 5;
    const bf16* proj = (const bf16*)(p.ws + WS_PROJ); bf16* mixcat = (bf16*)(p.ws + WS_MIXCAT);
    LAS float* bt = (LAS float*)(lds + AT_BIAS);
    const float L2E = 1.4426950408889634f;
    for (int i = tid; i < 8 * AT_BT; i += 512) { const int hd = i / AT_BT, rr = i - hd * AT_BT - 32; const int rc = rr < 0 ? 0 : (rr > 256 ? 256 : rr); const float bv = p.rel_bias[t5_bucket(rc - 128) * 8 + hd] * L2E; bt[i] = (rr < 0 || rr > 256) ? -3.0e38f : bv; }
    for (int ui = 0, u; (u = unit_of(wg, G, ui, 512)) < 512; ++ui) {
        const int b = u >> 5, n = (u >> 1) & 15, hk = u & 1;
        { u32x4 kv[6], vv[6];
#pragma unroll
          for (int i = 0; i < 6; ++i) { const int id = i * 512 + tid, row = id >> 3, chn = id & 7; int pos = (n - 1) * 128 + row; pos = pos < 0 ? 0 : (pos > SEQ - 1 ? SEQ - 1 : pos);
              const bf16* src = proj + ((size_t)b * SEQ + pos) * PN + hk * 64 + chn * 8; kv[i] = *(const u32x4*)(src + C_AK); vv[i] = *(const u32x4*)(src + C_AV); }
#pragma unroll
          for (int i = 0; i < 6; ++i) { const int id = i * 512 + tid, row = id >> 3, chn = id & 7;
              *(LAS u32x4*)(lds + AT_K + row * AT_PITCH + chn * 16) = kv[i]; *(LAS u32x4*)(lds + AT_V + row * AT_PITCH + chn * 16) = vv[i]; } }
        const int tq = wave & 3, hh0 = (wave >> 2) * 2, qloc = tq * 32 + r; const size_t m = (size_t)b * SEQ + n * 128 + qloc;
        bf16x8 qa[4], qb[4];
#pragma unroll
        for (int s = 0; s < 4; ++s) { qa[s] = *(const bf16x8*)(proj + m * PN + C_AQ + (hk * 4 + hh0) * 64 + s * 16 + 8 * h); qb[s] = *(const bf16x8*)(proj + m * PN + C_AQ + (hk * 4 + hh0 + 1) * 64 + s * 16 + 8 * h); }
        const float sinka = p.sink[l * 8 + hk * 4 + hh0] * L2E, sinkb = p.sink[l * 8 + hk * 4 + hh0 + 1] * L2E;
        __syncthreads();
        const int G4 = lane >> 4, i16 = lane & 15, q4 = i16 >> 2, p4 = i16 & 3;
        const int kt_lo = n == 0 ? 4 : tq, kt_hi = n == 15 ? 7 : 8 + tq;
#pragma unroll
        for (int x = 0; x < 2; ++x) {
            float mr = x ? sinkb : sinka, ls = 0.f; f32x16 o0, o1; for (int i = 0; i < 16; ++i) { o0[i] = 0.f; o1[i] = 0.f; }
            const LAS float* bth = bt + (hk * 4 + hh0 + x) * AT_BT + 32 - qloc;
            f32x16 sc; for (int i = 0; i < 16; ++i) sc[i] = 0.f;
            { const int band0 = (kt_lo >> 2) * 128 + (kt_lo & 3) * 32;
#pragma unroll
              for (int s = 0; s < 4; ++s) { const bf16x8 kf = *(const LAS bf16x8*)(lds + AT_K + (band0 + r) * AT_PITCH + (s * 16 + 8 * h) * 2); sc = MFMA32(kf, x ? qb[s] : qa[s], sc); } }
#pragma unroll 1
            for (int kt = kt_lo; kt <= kt_hi; ++kt) { const int kb = kt >> 2, tk = kt & 3;
                const int band0 = kb * 128 + tk * 32;
                const int ktn = kt < kt_hi ? kt + 1 : kt_hi, band0n = (ktn >> 2) * 128 + (ktn & 3) * 32;
                f32x16 sn; for (int i = 0; i < 16; ++i) sn[i] = 0.f;
#pragma unroll
                for (int s = 0; s < 4; ++s) { const bf16x8 kf = *(const LAS bf16x8*)(lds + AT_K + (band0n + r) * AT_PITCH + (s * 16 + 8 * h) * 2); sn = MFMA32(kf, x ? qb[s] : qa[s], sn); }
                float lp[16];
                AT_SOFTMAX(sc, bth, mr, ls, o0, o1, lp);
                const bf16x8 p0 = pack8(lp[0], lp[1], lp[2], lp[3], lp[4], lp[5], lp[6], lp[7]), p1 = pack8(lp[8], lp[9], lp[10], lp[11], lp[12], lp[13], lp[14], lp[15]);
                const LAS unsigned char* vb = lds + AT_V + (band0 + 4 * (G4 >> 1) + q4) * AT_PITCH + (16 * (G4 & 1) + 4 * p4) * 2;
#pragma unroll
                for (int s = 0; s < 2; ++s) {
                    const bf16x8 va0 = cat8(tr_read(vb + (16 * s) * AT_PITCH), tr_read(vb + (16 * s + 8) * AT_PITCH));
                    const bf16x8 va1 = cat8(tr_read(vb + (16 * s) * AT_PITCH + 64), tr_read(vb + (16 * s + 8) * AT_PITCH + 64));
                    o0 = MFMA32(va0, s ? p1 : p0, o0); o1 = MFMA32(va1, s ? p1 : p0, o1); }
                sc = sn;
            }
            { const float sk = x ? sinkb : sinka;
              ls += __shfl_xor(ls, 32); ls += __builtin_amdgcn_exp2f(sk - mr);
              const float inv = 1.0f / ls;
              bf16* op = mixcat + m * DM + (hk * 4 + hh0 + x) * 64;
#pragma unroll
              for (int rp = 0; rp < 4; rp += 2) { u32x2 w0[2], w1[2];
#pragma unroll
                  for (int j = 0; j < 2; ++j) { const int rg = rp + j;
                      w0[j].x = cvtpk(o0[4 * rg] * inv, o0[4 * rg + 1] * inv); w0[j].y = cvtpk(o0[4 * rg + 2] * inv, o0[4 * rg + 3] * inv);
                      w1[j].x = cvtpk(o1[4 * rg] * inv, o1[4 * rg + 1] * inv); w1[j].y = cvtpk(o1[4 * rg + 2] * inv, o1[4 * rg + 3] * inv); }
                  *(u32x4*)(op + 8 * (rp + h)) = swap_pair16(w0[0], w0[1]); *(u32x4*)(op + 32 + 8 * (rp + h)) = swap_pair16(w1[0], w1[1]); } }
        }
        __syncthreads();
    }
}
#undef AT_SOFTMAX

struct GateVec { int ta, tb; float b0, b1, fs0, fs1, pm0, pm1, total, mx; };
struct GateRaw { float ig0, ig1, f0, f1; };
__device__ __forceinline__ GateRaw gate_loads(const float* gates, size_t m0, int head, int dir, int lane) {
    const int ta = dir == 0 ? 2 * lane : 127 - 2 * lane, tb = dir == 0 ? ta + 1 : ta - 1;
    const float* ga = gates + (m0 + ta) * 16 + dir * 8 + head; const float* gb = gates + (m0 + tb) * 16 + dir * 8 + head;
    GateRaw g; g.ig0 = ga[0]; g.ig1 = gb[0]; g.f0 = ga[4]; g.f1 = gb[4]; return g; }
__device__ __forceinline__ GateVec gate_vectors(const GateRaw& g, int dir, int lane) {
    GateVec r; r.ta = dir == 0 ? 2 * lane : 127 - 2 * lane; r.tb = dir == 0 ? r.ta + 1 : r.ta - 1;
    const float ig0 = g.ig0, ig1 = g.ig1, lf0 = logsigmoid_f(g.f0), lf1 = logsigmoid_f(g.f1);
    const float s = lf0 + lf1, incl = wave_scan_sum(s), excl = incl - s;
    r.total = __builtin_bit_cast(float, __builtin_amdgcn_readlane(__builtin_bit_cast(int, incl), 63));
    r.b0 = excl + lf0; r.b1 = r.b0 + lf1; r.fs0 = ig0 - r.b0; r.fs1 = ig1 - r.b1;
    const float pi = wave_scan_max(fmaxf(r.fs0, r.fs1)), pe = dpp_id<0x138, 0xf>(-3.0e38f, pi);
    r.pm0 = fmaxf(pe, r.fs0); r.pm1 = fmaxf(r.pm0, r.fs1);
    r.mx = __builtin_bit_cast(float, __builtin_amdgcn_readlane(__builtin_bit_cast(int, pi), 63));
    return r;
}
constexpr int MA_P = 144;
constexpr int MA_K = 0, MA_VW = 128 * MA_P, MA_WEXP = 3 * 128 * MA_P, MA_BYTES = MA_WEXP + 1024;
__device__ __forceinline__ void ph_mlstm_a(const P& p, int l, LAS unsigned char* lds, int wg, int G) {
    const int tid = opaque_tid(), lane = tid & 63, wave = __builtin_amdgcn_readfirstlane(tid >> 6), r = lane & 31, h = lane >> 5;
    const bf16* proj = (const bf16*)(p.ws + WS_PROJ); bf16* qkt = (bf16*)(p.ws + WS_QKT); const float* gates = (const float*)(p.ws + WS_GATES);
    bf16* DC = (bf16*)(p.ws + WS_DC); float* DN = (float*)(p.ws + WS_DN); float* DS = (float*)(p.ws + WS_DS);
    LAS float* wexp = (LAS float*)(lds + MA_WEXP);
    const int c8 = tid & 7, isk = (tid >> 3) & 1, tq = tid >> 4, tv = tid >> 3;
    for (int ui = 0, u; (u = unit_of(wg, G, ui, 1024)) < 1024; ++ui) {
        const int b = u >> 6, head = (u >> 4) & 3, chunk = u & 15; const size_t m0 = (size_t)b * SEQ + chunk * 128;
        const GateRaw graw = gate_loads(gates, m0, head, wave & 1, lane);
        f32x4 wv[8];
        { const float* cwp = p.conv_w + (size_t)l * 3 * 512 + isk * 256 + head * 64 + c8 * 8; const float* cbp = p.conv_b + l * 512 + isk * 256 + head * 64 + c8 * 8;
#pragma unroll
          for (int tap = 0; tap < 3; ++tap) { wv[2 * tap] = *(const f32x4*)(cwp + tap * 512); wv[2 * tap + 1] = *(const f32x4*)(cwp + tap * 512 + 4); }
          wv[6] = *(const f32x4*)cbp; wv[7] = *(const f32x4*)(cbp + 4); }
        u32x4 xl[3][4];
#pragma unroll
        for (int i = 0; i < 4; ++i) { const int t = tq + 32 * i, tpos = chunk * 128 + t; const bf16* pr = proj + (m0 + t) * PN + (isk ? C_MK : C_MQ) + head * 64 + c8 * 8;
            xl[1][i] = *(const u32x4*)pr; xl[0][i] = *(const u32x4*)(tpos > 0 ? pr - PN : pr); xl[2][i] = *(const u32x4*)(tpos < SEQ - 1 ? pr + PN : pr); }
        u32x4 vpre[2];
#pragma unroll
        for (int i = 0; i < 2; ++i) vpre[i] = *(const u32x4*)(proj + (m0 + tv + 64 * i) * PN + C_MV + head * 64 + c8 * 8);
        if (wave < 2) { const int dir = wave; const GateVec gv = gate_vectors(graw, dir, lane);
            wexp[dir * 128 + gv.ta] = __expf(gv.fs0 - gv.mx); wexp[dir * 128 + gv.tb] = __expf(gv.fs1 - gv.mx);
            if (lane == 0) { DS[(size_t)(u * 2 + dir) * 2] = gv.total; DS[(size_t)(u * 2 + dir) * 2 + 1] = gv.total + gv.mx; } }
        { const float sc = isk ? 0.125f : 1.0f;
#pragma unroll
          for (int i = 0; i < 4; ++i) { const int t = tq + 32 * i, tpos = chunk * 128 + t; const bool hp = tpos > 0, hn = tpos < SEQ - 1;
              const u32x4 z = (u32x4){0u, 0u, 0u, 0u}; const u32x4 x0 = hp ? xl[0][i] : z, x1 = xl[1][i], x2 = hn ? xl[2][i] : z;
              float y[8];
#pragma unroll
              for (int q = 0; q < 4; ++q) { const int c = 2 * q;
                  y[c] = wv[6 + (c >> 2)][c & 3] + wv[c >> 2][c & 3] * bflo(x0[q]) + wv[2 + (c >> 2)][c & 3] * bflo(x1[q]) + wv[4 + (c >> 2)][c & 3] * bflo(x2[q]);
                  y[c + 1] = wv[6 + (c >> 2)][(c & 3) + 1] + wv[c >> 2][(c & 3) + 1] * bfhi(x0[q]) + wv[2 + (c >> 2)][(c & 3) + 1] * bfhi(x1[q]) + wv[4 + (c >> 2)][(c & 3) + 1] * bfhi(x2[q]); }
#pragma unroll
              for (int k = 0; k < 8; ++k) y[k] = silu_acc(y[k]) * sc;
              u32x4 o; o.x = pk2(y[0], y[1]); o.y = pk2(y[2], y[3]); o.z = pk2(y[4], y[5]); o.w = pk2(y[6], y[7]);
              *(u32x4*)(qkt + (m0 + t) * 512 + isk * 256 + head * 64 + c8 * 8) = o;
              if (isk) *(LAS u32x4*)(lds + MA_K + t * MA_P + c8 * 16) = o; } }
        __syncthreads();
#pragma unroll
        for (int i = 0; i < 2; ++i) { const int t = tv + 64 * i; const float wf = wexp[t], wb = wexp[128 + t]; const u32x4 x = vpre[i]; u32x4 of, ob;
#pragma unroll
            for (int q = 0; q < 4; ++q) { const float lo = bflo(x[q]), hi = bfhi(x[q]); of[q] = pk2(lo * wf, hi * wf); ob[q] = pk2(lo * wb, hi * wb); }
            *(LAS u32x4*)(lds + MA_VW + t * MA_P + c8 * 16) = of; *(LAS u32x4*)(lds + MA_VW + (128 + t) * MA_P + c8 * 16) = ob; }
        __syncthreads();
        { const int dir = wave >> 2, et = (wave >> 1) & 1, dt = wave & 1;
          const int G4 = lane >> 4, i16 = lane & 15, q4 = i16 >> 2, p4 = i16 & 3;
          const LAS unsigned char* ab = lds + MA_VW + (dir * 128 + 4 * (G4 >> 1) + q4) * MA_P + (et * 32 + 16 * (G4 & 1) + 4 * p4) * 2;
          const LAS unsigned char* bb = lds + MA_K + (4 * (G4 >> 1) + q4) * MA_P + (dt * 32 + 16 * (G4 & 1) + 4 * p4) * 2;
          f32x16 acc, accn; for (int i = 0; i < 16; ++i) { acc[i] = 0.f; accn[i] = 0.f; }
#pragma unroll
          for (int ks = 0; ks < 8; ++ks) { const bf16x8 af = cat8(tr_read(ab + (16 * ks) * MA_P), tr_read(ab + (16 * ks + 8) * MA_P)), kf = cat8(tr_read(bb + (16 * ks) * MA_P), tr_read(bb + (16 * ks + 8) * MA_P));
              acc = MFMA32(af, kf, acc);
              if (et == 0) { const f32x4 w0 = *(const LAS f32x4*)(wexp + dir * 128 + 16 * ks + 4 * h), w1 = *(const LAS f32x4*)(wexp + dir * 128 + 16 * ks + 8 + 4 * h);
                  const bool r0 = r == 0; const bf16x8 wa = pack8(r0 ? w0[0] : 0.f, r0 ? w0[1] : 0.f, r0 ? w0[2] : 0.f, r0 ? w0[3] : 0.f, r0 ? w1[0] : 0.f, r0 ? w1[1] : 0.f, r0 ? w1[2] : 0.f, r0 ? w1[3] : 0.f);
                  accn = MFMA32(wa, kf, accn); } }
          bf16* dcT = DC + (size_t)(u * 2 + dir) * 4096 + (dt * 32 + r) * 64 + et * 32;
#pragma unroll
          for (int rp = 0; rp < 4; rp += 2) { u32x2 w[2];
#pragma unroll
              for (int j = 0; j < 2; ++j) { const int rg = rp + j; w[j].x = pk2(acc[4 * rg], acc[4 * rg + 1]); w[j].y = pk2(acc[4 * rg + 2], acc[4 * rg + 3]); }
              *(u32x4*)(dcT + 8 * (rp + h)) = swap_pair16(w[0], w[1]); }
          if (et == 0 && h == 0) DN[(size_t)(u * 2 + dir) * 64 + dt * 32 + r] = accn[0]; }
        __syncthreads();
    }
}
constexpr int MC_PITCH = 144;
constexpr int MC_Q = 0, MC_K = 128 * MC_PITCH, MC_V = 2 * 128 * MC_PITCH, MC_C = 3 * 128 * MC_PITCH;
constexpr int MC_X = 131072 + 1024;
constexpr int MC_VEC = MC_X, MC_COEF = MC_VEC + 3072, MC_MS = MC_COEF + 512, MC_N = MC_MS + 64;
constexpr float L2E_ = 1.4426950408889634f;
constexpr int MC_HP = 66;
__device__ __forceinline__ void ph_mlstm_c(const P& p, int l, LAS unsigned char* lds, int wg, int G) {
    const int tid = opaque_tid(), lane = tid & 63, wave = __builtin_amdgcn_readfirstlane(tid >> 6), r = lane & 31, h = lane >> 5;
    const bf16* proj = (const bf16*)(p.ws + WS_PROJ); const bf16* qkt = (const bf16*)(p.ws + WS_QKT); const float* gates = (const float*)(p.ws + WS_GATES); bf16* mixcat = (bf16*)(p.ws + WS_MIXCAT);
    const bf16* DC = (const bf16*)(p.ws + WS_DC); const float* DN = (const float*)(p.ws + WS_DN); const float* DS = (const float*)(p.ws + WS_DS);
    LAS float* nvecS = (LAS float*)(lds + MC_N); LAS float* vfs = (LAS float*)(lds + MC_VEC); LAS float* vM = vfs + 256; LAS float* vb = vfs + 512;
    LAS float* coefS = (LAS float*)(lds + MC_COEF); LAS float* mS = (LAS float*)(lds + MC_MS);
    LAS unsigned short* hbuf = (LAS unsigned short*)lds;
    for (int ui = 0, u4; (u4 = unit_of(wg, G, ui, 256)) < 256; ++ui) {
        const int b = u4 >> 4, head = (u4 >> 2) & 3, c0 = (u4 & 3) * 4, ubase = (b * 4 + head) * 16;
        u32x4 dcr[18]; float dnr[18];
        { const f32x2c dsv = *(const f32x2c*)(DS + (size_t)((ubase + (lane & 15)) * 2 + (wave & 1)) * 2);
#pragma unroll
          for (int i = 0; i < 18; ++i) { const int dj = i >= c0 + 3 ? 1 : 0, j = dj ? i - 2 : i;
              dcr[i] = *(const u32x4*)(DC + (size_t)((ubase + j) * 2 + dj) * 4096 + tid * 8);
              dnr[i] = DN[(size_t)((ubase + j) * 2 + dj) * 64 + lane]; }
          const int dir = wave & 1, chunk = c0 + (wave >> 1), n = dir == 0 ? chunk : 15 - chunk;
          const bool in16 = lane < 16, valid = in16 && (dir == 0 ? lane < chunk : lane > chunk);
          const float bLv = in16 ? dsv[0] : 0.f, mlv = dsv[1];
          const float Pf = wave_scan_sum(bLv);
          const float Pc1 = __shfl(Pf, chunk > 0 ? chunk - 1 : 0), Pc = __shfl(Pf, chunk), P15 = __shfl(Pf, 15);
          const float Si = dir == 0 ? Pc1 - Pf : (Pf - bLv) - Pc, Sall = dir == 0 ? Pc1 : P15 - Pc;
          const float cand = valid ? mlv + Si : -3.0e38f;
          const float m = n > 0 ? fmaxf(Sall, wave_max(cand)) : 0.f;
          if (in16) coefS[wave * 16 + lane] = valid ? __expf(cand - m) : 0.f;
          if (lane == 0) mS[wave] = m * L2E_; }
        __syncthreads();
        { float acc[4][8], accn[4];
#pragma unroll
          for (int k = 0; k < 4; ++k) { accn[k] = 0.f;
#pragma unroll
              for (int e = 0; e < 8; ++e) acc[k][e] = 0.f; }
#pragma unroll
          for (int i = 0; i < 18; ++i) { const int dj = i >= c0 + 3 ? 1 : 0, j = dj ? i - 2 : i;
              float x[8];
#pragma unroll
              for (int q = 0; q < 4; ++q) { x[2 * q] = bflo(dcr[i][q]); x[2 * q + 1] = bfhi(dcr[i][q]); }
#pragma unroll
              for (int k = 0; k < 4; ++k) { const float cf = coefS[(k * 2 + dj) * 16 + j]; accn[k] += cf * dnr[i];
#pragma unroll
                  for (int e = 0; e < 8; ++e) acc[k][e] += cf * x[e]; }
              if (i == 17 || ((i == 2 || i == 6 || i == 10 || i == 14) && i == c0 + 2)) { const int dd = i == 17 ? 1 : 0;
#pragma unroll
                  for (int k = 0; k < 4; ++k) { u32x4 o;
#pragma unroll
                      for (int q = 0; q < 4; ++q) o[q] = pk2(acc[k][2 * q], acc[k][2 * q + 1]);
                      *(LAS u32x4*)(lds + MC_C + ((k * 2 + dd) * 64 + (tid >> 3)) * MC_PITCH + (tid & 7) * 16) = o;
                      if (tid < 64) nvecS[(k * 2 + dd) * 64 + tid] = accn[k];
                      accn[k] = 0.f;
#pragma unroll
                      for (int e = 0; e < 8; ++e) acc[k][e] = 0.f; } } } }
#define MC_CHUNK_LOADS(GR, ST, MO, mm) do { GR = gate_loads(gates, (mm), head, wave & 1, lane); \
        _Pragma("unroll") for (int i = 0; i < 6; ++i) { const int id = i * 512 + tid, arr = id >> 10, rem = id & 1023, row = rem >> 3, chn = rem & 7; \
            const bf16* src = arr == 2 ? proj + ((mm) + row) * PN + C_MV + head * 64 + chn * 8 : qkt + ((mm) + row) * 512 + arr * 256 + head * 64 + chn * 8; ST[i] = *(const u32x4*)src; } \
        _Pragma("unroll") for (int i = 0; i < 2; ++i) { const int id = i * 512 + tid; MO[i] = *(const u32x4*)(proj + ((mm) + (id >> 3)) * PN + C_MO + head * 64 + (id & 7) * 8); } } while (0)
        GateRaw grawA[2]; u32x4 stgA[2][6], mopreA[2][2];
        MC_CHUNK_LOADS(grawA[0], stgA[0], mopreA[0], (size_t)b * SEQ + c0 * 128);
#pragma unroll
        for (int kc = 0; kc < 4; ++kc) { const int chunk = c0 + kc; const size_t m0 = (size_t)b * SEQ + chunk * 128;
        const GateRaw& graw = grawA[kc & 1]; const u32x4 (&stg)[6] = stgA[kc & 1]; const u32x4 (&mopre)[2] = mopreA[kc & 1];
        if (wave < 2) { const int dir = wave; const GateVec gv = gate_vectors(graw, dir, lane);
            vfs[dir * 128 + gv.ta] = gv.fs0 * L2E_; vfs[dir * 128 + gv.tb] = gv.fs1 * L2E_;
            vM[dir * 128 + gv.ta] = gv.pm0 * L2E_; vM[dir * 128 + gv.tb] = gv.pm1 * L2E_;
            vb[dir * 128 + gv.ta] = gv.b0 * L2E_; vb[dir * 128 + gv.tb] = gv.b1 * L2E_; }
#pragma unroll
        for (int i = 0; i < 6; ++i) { const int id = i * 512 + tid, arr = id >> 10, rem = id & 1023, row = rem >> 3, chn = rem & 7;
            *(LAS u32x4*)(lds + arr * 128 * MC_PITCH + row * MC_PITCH + chn * 16) = stg[i]; }
        __syncthreads();
        if (kc < 3) MC_CHUNK_LOADS(grawA[(kc + 1) & 1], stgA[(kc + 1) & 1], mopreA[(kc + 1) & 1], (size_t)b * SEQ + (chunk + 1) * 128);
        const int dir = wave >> 2, tt = wave & 3, t = tt * 32 + r;
        const LAS unsigned char* Cs = lds + MC_C + (kc * 2 + dir) * 64 * MC_PITCH; const LAS float* nvec = nvecS + (kc * 2 + dir) * 64; const float mC = mS[kc * 2 + dir];
        f32x16 nS0, nS1, nI0, nI1; for (int i = 0; i < 16; ++i) { nS0[i] = 0.f; nS1[i] = 0.f; nI0[i] = 0.f; nI1[i] = 0.f; }
        float dinv, iw;
        {
            bf16x8 qf[4];
#pragma unroll
            for (int s = 0; s < 4; ++s) qf[s] = *(const LAS bf16x8*)(lds + MC_Q + t * MC_PITCH + (s * 16 + 8 * h) * 2);
            const float Mt = fmaxf(mC, vM[dir * 128 + t]); float rowsum = 0.f;
#pragma unroll 1
            for (int st = 0; st < 4; ++st) { if (dir == 0 ? st > tt : st < tt) continue;
                f32x16 sT; for (int i = 0; i < 16; ++i) sT[i] = 0.f;
#pragma unroll
                for (int s = 0; s < 4; ++s) { const bf16x8 kf = *(const LAS bf16x8*)(lds + MC_K + (st * 32 + r) * MC_PITCH + (s * 16 + 8 * h) * 2); sT = MFMA32(kf, qf[s], sT); }
                float pv[16];
                if (st == tt) {
#pragma unroll
                    for (int rg = 0; rg < 4; ++rg) { const f32x4 f4 = *(const LAS f32x4*)(vfs + dir * 128 + st * 32 + 8 * rg + 4 * h);
#pragma unroll
                        for (int k = 0; k < 4; ++k) { const int dl = (8 * rg + 4 * h + k) - r; const bool ok = dir == 0 ? dl <= 0 : dl >= 0;
                            const float dv = ok ? __builtin_amdgcn_exp2f(f4[k] - Mt) : 0.f; pv[4 * rg + k] = sT[4 * rg + k] * dv; rowsum += pv[4 * rg + k]; } } }
                else {
#pragma unroll
                    for (int rg = 0; rg < 4; ++rg) { const f32x4 f4 = *(const LAS f32x4*)(vfs + dir * 128 + st * 32 + 8 * rg + 4 * h);
#pragma unroll
                        for (int k = 0; k < 4; ++k) { const float dv = __builtin_amdgcn_exp2f(f4[k] - Mt); pv[4 * rg + k] = sT[4 * rg + k] * dv; rowsum += pv[4 * rg + k]; } } }
                const bf16x8 pf0 = pack8(pv[0], pv[1], pv[2], pv[3], pv[4], pv[5], pv[6], pv[7]), pf1 = pack8(pv[8], pv[9], pv[10], pv[11], pv[12], pv[13], pv[14], pv[15]);
                const int G4 = lane >> 4, i16 = lane & 15, q4 = i16 >> 2, p4 = i16 & 3;
                const LAS unsigned char* vbp = lds + MC_V + (st * 32 + 4 * (G4 >> 1) + q4) * MC_PITCH + (16 * (G4 & 1) + 4 * p4) * 2;
#pragma unroll
                for (int s = 0; s < 2; ++s) { const bf16x8 pf = s ? pf1 : pf0;
                    const bf16x8 va0 = cat8(tr_read(vbp + (16 * s) * MC_PITCH), tr_read(vbp + (16 * s + 8) * MC_PITCH));
                    const bf16x8 va1 = cat8(tr_read(vbp + (16 * s) * MC_PITCH + 64), tr_read(vbp + (16 * s + 8) * MC_PITCH + 64));
                    nS0 = MFMA32(va0, pf, nS0); nS1 = MFMA32(va1, pf, nS1); }
            }
            float nq = 0.f;
            {
              const int G4c = lane >> 4, i16c = lane & 15, q4c = i16c >> 2, p4c = i16c & 3;
              const LAS unsigned char* cbp = Cs + (4 * (G4c >> 1) + q4c) * MC_PITCH + (16 * (G4c & 1) + 4 * p4c) * 2;
              const LAS unsigned char* qbp = lds + MC_Q + t * MC_PITCH + (4 * h) * 2;
#pragma unroll
              for (int s = 0; s < 4; ++s) {
                  const bf16x8 cc0 = cat8(tr_read(cbp + (16 * s) * MC_PITCH), tr_read(cbp + (16 * s + 8) * MC_PITCH)), cc1 = cat8(tr_read(cbp + (16 * s) * MC_PITCH + 64), tr_read(cbp + (16 * s + 8) * MC_PITCH + 64));
                  const bf16x8 q2 = cat8(*(const LAS s16x4*)(qbp + (16 * s) * 2), *(const LAS s16x4*)(qbp + (16 * s + 8) * 2));
                  nI0 = MFMA32(cc0, q2, nI0); nI1 = MFMA32(cc1, q2, nI1);
#pragma unroll
                  for (int j = 0; j < 8; ++j) nq += nvec[s * 16 + 8 * h + j] * bf2f((unsigned short)qf[s][j]); } }
            nq += __shfl_xor(nq, 32); rowsum += __shfl_xor(rowsum, 32);
            iw = __builtin_amdgcn_exp2f(mC - Mt);
            const float den = rowsum + iw * nq, lower = __builtin_amdgcn_exp2f(-(vb[dir * 128 + t] + Mt));
            dinv = 1.0f / fmaxf(fabsf(den), lower);
        }
        __syncthreads();
#pragma unroll
        for (int reg = 0; reg < 16; ++reg) { const int e = crow(reg, h);
            hbuf[(dir * 128 + t) * MC_HP + e] = f2bf((nS0[reg] + iw * nI0[reg]) * dinv); hbuf[(dir * 128 + t) * MC_HP + 32 + e] = f2bf((nS1[reg] + iw * nI1[reg]) * dinv); }
        __syncthreads();
#pragma unroll
        for (int i = 0; i < 2; ++i) { const int id = i * 512 + tid, tq = id >> 3, e0 = (id & 7) * 8; float o[8];
#pragma unroll
            for (int k = 0; k < 4; ++k) { const unsigned wf = *(const LAS unsigned*)(hbuf + tq * MC_HP + e0 + 2 * k), wb = *(const LAS unsigned*)(hbuf + (128 + tq) * MC_HP + e0 + 2 * k);
                o[2 * k] = sigmoid_f(bflo(mopre[i][k])) * (bflo(wf) + bflo(wb)); o[2 * k + 1] = sigmoid_f(bfhi(mopre[i][k])) * (bfhi(wf) + bfhi(wb)); }
            u32x4 w; w.x = pk2(o[0], o[1]); w.y = pk2(o[2], o[3]); w.z = pk2(o[4], o[5]); w.w = pk2(o[6], o[7]);
            *(u32x4*)(mixcat + (m0 + tq) * DM + 512 + head * 64 + e0) = w; }
        __syncthreads();
        }
#undef MC_CHUNK_LOADS
    }
}

typedef GAS unsigned gu32;
#define RLX_AGENT __ATOMIC_RELAXED, __HIP_MEMORY_SCOPE_AGENT
#define XB_TMO      128
#define XB_XCNT(j)  (256  + 64 * (j))
#define XB_XSUB(j)  (1280 + 64 * (j))
#define XB_XGEN(j)  (2304 + 64 * (j))
#define XB_TOP      3328
#define XB_TOPGEN   3392
#define XCD_BAR_WORDS 3456
#define XB_SPIN_CAP (1u << 18)

__device__ __forceinline__ unsigned xb_ld(unsigned* p)              { return __hip_atomic_load(p, __ATOMIC_RELAXED, __HIP_MEMORY_SCOPE_AGENT); }
__device__ __forceinline__ unsigned xb_add(unsigned* p, unsigned v) { return __hip_atomic_fetch_add(p, v, __ATOMIC_RELAXED, __HIP_MEMORY_SCOPE_AGENT); }
__device__ __forceinline__ unsigned xb_xcc_id() { return (unsigned)__builtin_amdgcn_s_getreg((3 << 11) | 20) & 0xFu; }
#define XB_SPIN(cond, bar) do { unsigned _sp = 0; while (cond) { __builtin_amdgcn_s_sleep(1); \
    if ((++_sp & 255u) == 0u) { if (xb_ld(&(bar)[XB_TMO])) break; if (_sp > XB_SPIN_CAP) { atomicAdd(&(bar)[XB_TMO], 1u); break; } } } } while (0)

struct XcdBarrier {
    unsigned* bar; unsigned x;
    volatile LAS unsigned* st;
};

__device__ __forceinline__ XcdBarrier xcd_barrier_post(unsigned* bar, volatile LAS unsigned* st) {
    XcdBarrier b; b.bar = bar; b.x = xb_xcc_id(); b.st = st;
    if (threadIdx.x == 0) (void)xb_add(&bar[XB_XCNT(b.x)], 1u);
    return b;
}
__device__ __forceinline__ void xcd_barrier_complete(unsigned* bar, unsigned x, unsigned& nloc, unsigned& nx) {
    const unsigned G = gridDim.x * gridDim.y * gridDim.z;
    unsigned sum, cnt, mine, sp = 0u;
    for (;;) {
        sum = 0u; cnt = 0u; mine = 0u;
#pragma unroll
        for (unsigned j = 0; j < 16; ++j) { const unsigned c = xb_ld(&bar[XB_XCNT(j)]); sum += c; cnt += (c > 0u) ? 1u : 0u; mine = (j == x) ? c : mine; }
        if (sum == G) break;
        __builtin_amdgcn_s_sleep(1);
        if ((++sp & 255u) == 0u) { if (xb_ld(&bar[XB_TMO])) break; if (sp > XB_SPIN_CAP) { atomicAdd(&bar[XB_TMO], 1u); break; } }
    }
    nloc = mine > 0u ? mine : 1u; nx = cnt > 0u ? cnt : 1u;
}

__device__ __forceinline__ void xcd_barrier(const XcdBarrier& b) {
    asm volatile("s_waitcnt vmcnt(0)" ::: "memory");
    __syncthreads();
    if (threadIdx.x == 0) {
        unsigned* bar = b.bar;
        __builtin_amdgcn_s_waitcnt(0);
        unsigned nloc = b.st[0], nx = b.st[1];
        if (nloc == 0u) { xcd_barrier_complete(bar, b.x, nloc, nx); b.st[0] = nloc; b.st[1] = nx; }
        const unsigned old = xb_add(&bar[XB_XSUB(b.x)], 1u);
        const unsigned gen = old / nloc;
        if (old + 1u == (gen + 1u) * nloc) {
            __builtin_amdgcn_fence(__ATOMIC_RELEASE, "agent");
            asm volatile("s_waitcnt vmcnt(0)" ::: "memory");
            const unsigned og = xb_add(&bar[XB_TOP], 1u);
            const unsigned tg = og / nx;
            if (og + 1u == (tg + 1u) * nx) xb_add(&bar[XB_TOPGEN], 1u);
            else XB_SPIN(xb_ld(&bar[XB_TOPGEN]) == tg, bar);
            __builtin_amdgcn_fence(__ATOMIC_ACQUIRE, "agent");
            xb_add(&bar[XB_XGEN(b.x)], 1u);
            asm volatile("s_waitcnt vmcnt(0)" ::: "memory");
        } else {
            XB_SPIN(xb_ld(&bar[XB_XGEN(b.x)]) == gen, bar);
            __builtin_amdgcn_fence(__ATOMIC_ACQUIRE, "agent");
            asm volatile("s_waitcnt vmcnt(0)" ::: "memory");
        }
    }
    __syncthreads();
}


constexpr int CW_Q = 8192;
__device__ __forceinline__ bool conv_batch(const P& p, int ql, volatile LAS unsigned* wl, LAS unsigned char* L) {
    const int tid = opaque_tid(), lane = tid & 63, wave = __builtin_amdgcn_readfirstlane(tid >> 6);
    if (tid == 0) wl[3] = __hip_atomic_fetch_add((unsigned*)(p.ws + WS_CTL) + CW_Q + 64 * ql, 8u, __ATOMIC_RELAXED, __HIP_MEMORY_SCOPE_AGENT);
    __syncthreads();
    const unsigned base = wl[3];
    if (base + wave < (unsigned)ITM) convert_item(p, ql, ITS + (int)base + wave, (LAS float*)L + wave * (64 * 33), lane);
    __syncthreads();
    return base + 8u < (unsigned)ITM;
}
__device__ __forceinline__ void conv_drain(const P& p, int& qa, int upto, volatile LAS unsigned* wl, LAS unsigned char* L) { while (qa <= upto) { if (!conv_batch(p, qa, wl, L)) ++qa; } }
__device__ __forceinline__ void xcd_barrier_work(const XcdBarrier& b, const P& p, int& qa, volatile LAS unsigned* wl, LAS unsigned char* L) {
    asm volatile("s_waitcnt vmcnt(0)" ::: "memory");
    __syncthreads();
    if (threadIdx.x == 0) {
        unsigned* bar = b.bar;
        __builtin_amdgcn_s_waitcnt(0);
        unsigned nloc = b.st[0], nx = b.st[1];
        if (nloc == 0u) { xcd_barrier_complete(bar, b.x, nloc, nx); b.st[0] = nloc; b.st[1] = nx; }
        const unsigned old = xb_add(&bar[XB_XSUB(b.x)], 1u);
        const unsigned gen = old / nloc;
        if (old + 1u == (gen + 1u) * nloc) {
            __builtin_amdgcn_fence(__ATOMIC_RELEASE, "agent");
            asm volatile("s_waitcnt vmcnt(0)" ::: "memory");
            const unsigned og = xb_add(&bar[XB_TOP], 1u);
            const unsigned tg = og / nx;
            if (og + 1u == (tg + 1u) * nx) { xb_add(&bar[XB_TOPGEN], 1u); wl[0] = 2u; }
            else { wl[0] = 1u; wl[1] = tg; }
        } else { wl[0] = 0u; wl[1] = gen; }
    }
    unsigned polls = 0u;
    for (;;) {
        if (threadIdx.x == 0) { unsigned* bar = b.bar; const unsigned role = wl[0], want = wl[1];
            bool done = role == 2u || (role == 1u ? xb_ld(&bar[XB_TOPGEN]) != want : xb_ld(&bar[XB_XGEN(b.x)]) != want);
            if (!done && (++polls & 255u) == 0u) { if (xb_ld(&bar[XB_TMO])) done = true; else if (polls > XB_SPIN_CAP) { atomicAdd(&bar[XB_TMO], 1u); done = true; } }
            wl[2] = done ? 1u : 0u; }
        __syncthreads();
        const bool done = wl[2] != 0u;
        __syncthreads();
        if (done) break;
        if (qa < DEPTH) { if (!conv_batch(p, qa, wl, L)) ++qa; } else __builtin_amdgcn_s_sleep(2);
    }
    if (threadIdx.x == 0) { unsigned* bar = b.bar;
        if (wl[0] != 0u) { __builtin_amdgcn_fence(__ATOMIC_ACQUIRE, "agent"); xb_add(&bar[XB_XGEN(b.x)], 1u); asm volatile("s_waitcnt vmcnt(0)" ::: "memory"); }
        else { __builtin_amdgcn_fence(__ATOMIC_ACQUIRE, "agent"); asm volatile("s_waitcnt vmcnt(0)" ::: "memory"); }
    }
    __syncthreads();
}

__device__ __forceinline__ void ph_mod(const P& p, LAS unsigned char* lds, int wg, int G) {
    const int tid = opaque_tid(), lane = tid & 63, wave = __builtin_amdgcn_readfirstlane(tid >> 6);
    LAS float* sc = (LAS float*)lds;
    LAS float* red = (LAS float*)(lds + 65536);
    if (wg >= 384) return;
    for (int i = tid; i < 16 * DM; i += 512) { const int b = i >> 10, k = i & 1023; sc[k * 16 + b] = silu_acc(p.c[i]); }
    __syncthreads();
    float* mod = (float*)(p.ws + WS_MOD);
    for (int u = wg; u < 384; u += G) { const int l = u / 96, n0 = (u % 96) * 64;
        const float* w = p.w_ada + (size_t)l * DM * 6144 + (size_t)(wave * 128) * 6144 + n0 + lane;
        float acc[16];
#pragma unroll
        for (int b = 0; b < 16; ++b) acc[b] = 0.f;
#pragma unroll 4
        for (int k = 0; k < 128; ++k) { const float wv = w[(size_t)k * 6144]; const LAS f32x4* s4 = (const LAS f32x4*)(sc + (wave * 128 + k) * 16);
#pragma unroll
            for (int q = 0; q < 4; ++q) { const f32x4 s = s4[q]; acc[4 * q] += s[0] * wv; acc[4 * q + 1] += s[1] * wv; acc[4 * q + 2] += s[2] * wv; acc[4 * q + 3] += s[3] * wv; } }
#pragma unroll
        for (int b = 0; b < 16; ++b) red[(wave * 16 + b) * 64 + lane] = acc[b];
        __syncthreads();
        for (int i = tid; i < 1024; i += 512) { const int b = i >> 6, c = i & 63; float s = p.b_ada[l * 6144 + n0 + c];
#pragma unroll
            for (int wv = 0; wv < 8; ++wv) s += red[(wv * 16 + b) * 64 + c];
            mod[((size_t)l * 16 + b) * 6144 + n0 + c] = s; }
        __syncthreads();
    }
}

constexpr int LDS_MAIN = 131072, LDS_TOTAL = 147456, MISC_OFF = LDS_MAIN + 320;
constexpr int CW_BAR = 4096;
constexpr size_t CTL_ZERO = 65536;
constexpr int NSEQ = 2 + 9 * DEPTH;
struct Args { P p; int lo, hi; };
typedef const __attribute__((address_space(4))) Args* kargs_t;
__global__ void __launch_bounds__(512, 2) mk_fwd(Args a) {
    extern __shared__ __attribute__((aligned(16))) unsigned char lds_raw[];
    LAS unsigned char* L = (LAS unsigned char*)lds_raw;
    kargs_t ap0 = (kargs_t)__builtin_amdgcn_kernarg_segment_ptr();
#define LOADP() kargs_t ap_ = ap0; asm volatile("" : "+s"(ap_)); const P p = {ap_->p.x, ap_->p.c, ap_->p.w_ada, ap_->p.b_ada, ap_->p.w_in, ap_->p.conv_w, ap_->p.conv_b, ap_->p.gate_b, ap_->p.sink, ap_->p.rel_bias, ap_->p.w_s, ap_->p.b_s, ap_->p.w_out, ap_->p.w_router, ap_->p.w_gate, ap_->p.w_up, ap_->p.w_down, ap_->p.ln_g, ap_->p.ln_b, ap_->p.out, ap_->p.ws}; unsigned char* ws = p.ws
    const int wg = blockIdx.x, G = gridDim.x;
    { const int tid = opaque_tid(); for (int i = tid; i < (LDS_TOTAL - LDS_MAIN) / 4; i += 512) ((LAS unsigned*)(L + LDS_MAIN))[i] = 0u; }
    __syncthreads();
    __builtin_amdgcn_s_setreg(1 | (23 << 6), 1u);
    XcdBarrier bar;
    { LOADP(); bar = xcd_barrier_post((unsigned*)(ws + WS_CTL) + CW_BAR, (volatile LAS unsigned*)(L + MISC_OFF) + 8); }
    int seq = 0; int qa = 0;
#ifndef DUPM
#define DUPM 0
#endif
#define DUP(i) for (int rep_ = 0; rep_ < ((DUPM >> (i)) & 1); ++rep_)
#ifndef PHM
#define PHM 0xfffff
#endif
#define RUN() (seq >= a.lo && seq < a.hi)
#define SEAM() do { if (seq + 1 < a.hi) xcd_barrier_work(bar, p, qa, (volatile LAS unsigned*)(L + MISC_OFF) + 16, L); } while (0)
    if (((PHM >> 0) & 1) && RUN()) {
        LOADP(); ph_mod(p, L, wg, G);
        const int tid = opaque_tid(), lane = tid & 63, wave = __builtin_amdgcn_readfirstlane(tid >> 6), gw = wg * 8 + wave, ngw = G * 8;
        { LAS float* scr = (LAS float*)L + wave * (64 * 33); for (int it = gw; it < DEPTH * ITS; it += ngw) convert_item(p, it / ITS, it % ITS, scr, lane); }
        { bf16* wsb = (bf16*)(ws + WS_WS); for (int i = wg * 512 + tid; i < DEPTH * 4 * 128 * 128; i += G * 512) wsb[i] = (bf16)f2bf(p.w_s[i]); }
        SEAM(); }
    ++seq;
    if (((PHM >> 1) & 1) && RUN()) { LOADP(); rows_entry_simple(p, wg, G); SEAM(); }
    ++seq;
#pragma unroll 1
    for (int l = 0; l < DEPTH; ++l) {
        if (((PHM >> 2) & 1) && RUN()) { LOADP();
            pg8::Gemm g{(const bf16*)(ws + WS_H), (const bf16*)(ws + WS_WIN) + (size_t)l * PNW * DM, NTOK, PNW, DM}; pg8::EpiProj E{(bf16*)(ws + WS_PROJ), (float*)(ws + WS_GATES), p.gate_b + l * 16};
            pg8::StaticOrder S; S.init(NTOK, PNW, G, wg);
            pg8::gemm_phase<pg8::EpiProj, pg8::StaticOrder, true, true>(L, g, S, E); SEAM(); }
        ++seq;
        if (((PHM >> 3) & 1) && RUN()) { LOADP(); DUP(2) ph_attn(p, l, L, wg, G); ph_attn(p, l, L, wg, G); DUP(3) ph_gmlp(p, l, L, wg, G); ph_gmlp(p, l, L, wg, G); DUP(4) ph_mlstm_a(p, l, L, wg, G); ph_mlstm_a(p, l, L, wg, G); SEAM(); }
        ++seq;
        if (((PHM >> 4) & 1) && RUN()) { LOADP(); DUP(5) ph_mlstm_c(p, l, L, wg, G); ph_mlstm_c(p, l, L, wg, G); SEAM(); }
        ++seq;
        if (((PHM >> 5) & 1) && RUN()) { LOADP();
            pg8::Gemm g{(const bf16*)(ws + WS_MIXCAT), (const bf16*)(ws + WS_WOUT) + (size_t)l * DM * DM, NTOK, DM, DM}; pg8::EpiBf16 E{(bf16*)(ws + WS_MIX), DM};
            pg8::StaticOrder S; S.init(NTOK, DM, G, wg);
            pg8::gemm_phase<pg8::EpiBf16, pg8::StaticOrder, true, true>(L, g, S, E); SEAM(); }
        ++seq;
        if (((PHM >> 6) & 1) && RUN()) { LOADP(); DUP(9) rows_phase<1>(p, l, l == 0 ? p.x : (const float*)(ws + WS_XA), L, wg, G, true); rows_phase<1>(p, l, l == 0 ? p.x : (const float*)(ws + WS_XA), L, wg, G); SEAM(); }
        ++seq;
        if (((PHM >> 7) & 1) && RUN()) { LOADP(); ph_topk(p, L, wg, G); conv_drain(p, qa, l, (volatile LAS unsigned*)(L + MISC_OFF) + 16, L); SEAM(); }
        ++seq;
        if (((PHM >> 8) & 1) && RUN()) { LOADP();
            pg8::Gemm g{(const bf16*)(ws + WS_H8), (const bf16*)(ws + WS_WGU + (size_t)l * NE * 4096 * DM), NGRP * 256, 4096, DM, SC_A1, SC_B1, SC_B1 + 0x02020202};     pg8::EpiSwiGLU8 E{ws + WS_HID};
            pg8::MoeOrder1 S; S.G = G; S.c = wg; S.idx = (const unsigned short*)(ws + WS_IDX);
            pg8::gemm_phase<pg8::EpiSwiGLU8, pg8::MoeOrder1, true, true, true, true>(L, g, S, E); SEAM(); }
        ++seq;
        if (((PHM >> 9) & 1) && RUN()) { LOADP();
            pg8::Gemm g{(const bf16*)(ws + WS_HID), (const bf16*)(ws + WS_WD + (size_t)l * NE * DM * DE), NGRP * 256, DM, DE, SC_A2, SC_B2, SC_B2}; pg8::EpiScaleFp8 E{ws + WS_YE, (const float*)(ws + WS_GATEV)};
            pg8::MoeOrder2 S; S.G = G; S.c = wg;
            pg8::gemm_phase<pg8::EpiScaleFp8, pg8::MoeOrder2, true, true, true>(L, g, S, E); SEAM(); }
        ++seq;
        if (((PHM >> 10) & 1) && RUN()) { LOADP(); DUP(10) rows_phase<2>(p, l, (const float*)(ws + WS_XA), L, wg, G, true); rows_phase<2>(p, l, (const float*)(ws + WS_XA), L, wg, G); SEAM(); }
        ++seq;
    }
#undef RUN
#undef SEAM
#undef LOADP
}

#ifndef MK_PER_PHASE
#define MK_PER_PHASE 0
#endif
extern "C" void kernel_launch(void* const* d_in, const int* in_sizes, int n_in, void* d_out, int out_size, void* d_ws, size_t ws_size, hipStream_t stream) {
    static int grid = 0;
    if (grid == 0) {
        if (n_in != 19 || in_sizes[0] != NTOK * DM || out_size != NTOK * DM || ws_size < WS_END) {
            fprintf(stderr, "kernel_launch: unexpected shapes: n_in %d in0 %d out %d ws %zu (need %zu)\n", n_in, n_in > 0 ? in_sizes[0] : -1, out_size, ws_size, (size_t)WS_END); grid = -1; return; }
        int dev = 0, cus = 0, per_cu = 0;
        if (hipGetDevice(&dev) != hipSuccess || hipDeviceGetAttribute(&cus, hipDeviceAttributeMultiprocessorCount, dev) != hipSuccess) { fprintf(stderr, "kernel_launch: device query failed\n"); grid = -1; return; }
        if (hipFuncSetAttribute((const void*)mk_fwd, hipFuncAttributeMaxDynamicSharedMemorySize, LDS_TOTAL) != hipSuccess) { fprintf(stderr, "kernel_launch: hipFuncSetAttribute failed\n"); grid = -1; return; }
        if (hipOccupancyMaxActiveBlocksPerMultiprocessor(&per_cu, (const void*)mk_fwd, 512, LDS_TOTAL) != hipSuccess || per_cu < 1) { fprintf(stderr, "kernel_launch: occupancy query reports %d blocks per CU\n", per_cu); }
        (void)hipGetLastError();
        grid = cus;
    }
    if (grid < 0) return;
    if (hipMemsetAsync((char*)d_ws + WS_CTL, 0, CTL_ZERO, stream) != hipSuccess) { fprintf(stderr, "kernel_launch: memset failed\n"); return; }
    Args a{};
    const float** pf = (const float**)&a.p;
    for (int i = 0; i < 19; ++i) pf[i] = (const float*)d_in[i];
    a.p.out = (float*)d_out; a.p.ws = (unsigned char*)d_ws;
#if MK_PER_PHASE
    for (int s = 0; s < NSEQ; ++s) { a.lo = s; a.hi = s + 1; hipLaunchKernelGGL(mk_fwd, dim3(grid), dim3(512), LDS_TOTAL, stream, a); }
#else
    a.lo = 0; a.hi = NSEQ;
    hipLaunchKernelGGL(mk_fwd, dim3(grid), dim3(512), LDS_TOTAL, stream, a);
#endif
    const hipError_t le = hipPeekAtLastError();
    if (le != hipSuccess) fprintf(stderr, "kernel_launch: launch failed: %s\n", hipGetErrorName(le));
}
```
